# Optimizing an MI355X kernel written in HIP

```python
import math
import jax
import jax.numpy as jnp
from jax import lax
import numpy as np

D_MODEL = 1024
BATCH = 8
SEQ = 4096
DEPTH = 4

N_A_LAYERS = DEPTH // 2
N_B_LAYERS = DEPTH - N_A_LAYERS
RMS_EPS = 1e-5

GLA_HEADS = 4
GLA_KEY_DIM = D_MODEL // 2
GLA_VAL_DIM = D_MODEL
GLA_HK = GLA_KEY_DIM // GLA_HEADS
GLA_HV = GLA_VAL_DIM // GLA_HEADS
GLA_RANK = 16
GLA_TAU = 16.0
GLA_CHUNK = 64

NSA_HEADS = 16
NSA_GROUPS = 4
NSA_HPG = NSA_HEADS // NSA_GROUPS
NSA_HD = D_MODEL // NSA_HEADS
CMP_LEN = 32
CMP_STRIDE = 16
CMP_HIDDEN = 2 * NSA_HD
SLC_LEN = 64
SLC_TOPK = 16
WIN = 512
NSA_Q_BLOCK = 64

N_EXPERTS = 32
TOP_K = 4
EXPERT_FF = D_MODEL
SWIGLU_LIMIT = 7.0
SWIGLU_ALPHA = 1.702
MOE_BLOCK = 128

FORCE = 1e4
NEG = -1e30

kernel_name = 'yoco_gla_nsa_moe_adaln_trunk'


def rms_norm(x, g):
    xf = x.astype(jnp.float32)
    y = xf * lax.rsqrt(jnp.mean(xf * xf, axis=-1, keepdims=True) + RMS_EPS)
    return (y * g.astype(jnp.float32)).astype(x.dtype)


def modulate(h, shift, scale):
    return h * (1.0 + scale[:, None, :]) + shift[:, None, :]


def alibi_slopes(n):
    start = 2.0 ** (-8.0 / n)
    return jnp.asarray(start ** np.arange(1, n + 1), jnp.float32)


def masked_softmax(s, mask):
    s = jnp.where(mask, s, NEG)
    p = jax.nn.softmax(s, axis=-1)
    return jnp.where(mask, p, 0.0)


def gla_mixer(h, w_in, w_gate2, b_gate, norm_g, w_out):
    B, S, _ = h.shape
    nc = S // GLA_CHUNK
    proj = h @ w_in
    cuts = [GLA_KEY_DIM, 2 * GLA_KEY_DIM, 2 * GLA_KEY_DIM + GLA_VAL_DIM, 2 * GLA_KEY_DIM + 2 * GLA_VAL_DIM]
    q, k, v, r, g_lr = jnp.split(proj, cuts, axis=-1)
    log_a = jax.nn.log_sigmoid((g_lr @ w_gate2 + b_gate).astype(jnp.float32)) / GLA_TAU

    def to_chunks(t, hd):
        return t.astype(jnp.float32).reshape(B, nc, GLA_CHUNK, GLA_HEADS, hd).transpose(0, 3, 1, 2, 4)

    q = to_chunks(q, GLA_HK) * (GLA_HK ** -0.5)
    k = to_chunks(k, GLA_HK)
    v = to_chunks(v, GLA_HV)
    b = jnp.cumsum(to_chunks(log_a, GLA_HK), axis=3)
    b_last = b[:, :, :, -1:, :]
    q_dec = q * jnp.exp(b)
    k_intra = k * jnp.exp(-b)
    k_inter = k * jnp.exp(b_last - b)
    causal = jnp.tril(jnp.ones((GLA_CHUNK, GLA_CHUNK), bool))
    att = jnp.where(causal, jnp.einsum('bhncd,bhnsd->bhncs', q_dec, k_intra), 0.0)
    o_intra = jnp.einsum('bhncs,bhnse->bhnce', att, v)

    def step(state, xs):
        qd, ki, vv, dl = xs
        o = jnp.einsum('bhcd,bhde->bhce', qd, state)
        state = state * dl[..., None] + jnp.einsum('bhcd,bhce->bhde', ki, vv)
        return state, o

    decay_last = jnp.exp(b_last[:, :, :, 0, :])
    xs = (jnp.moveaxis(q_dec, 2, 0), jnp.moveaxis(k_inter, 2, 0), jnp.moveaxis(v, 2, 0), jnp.moveaxis(decay_last, 2, 0))
    state0 = jnp.zeros((B, GLA_HEADS, GLA_HK, GLA_HV), jnp.float32)
    _, o_inter = lax.scan(step, state0, xs)
    o = o_intra + jnp.moveaxis(o_inter, 0, 2)
    o = o * lax.rsqrt(jnp.mean(o * o, axis=-1, keepdims=True) + RMS_EPS)
    o = o.transpose(0, 2, 3, 1, 4).reshape(B, S, GLA_VAL_DIM) * norm_g.astype(jnp.float32)
    o = o.astype(h.dtype) * jax.nn.silu(r)
    return o @ w_out


def nsa_shared_kv(x, cs, kv_norm_g, kv_ada_w, kv_ada_b, kv_w, cmp_pos, cmp_w1, cmp_b1, cmp_w2, cmp_b2):
    B, S, _ = x.shape
    shift, scale = jnp.split(cs @ kv_ada_w + kv_ada_b, 2, axis=-1)
    h = modulate(rms_norm(x, kv_norm_g), shift, scale)
    kv = (h @ kv_w).reshape(B, S, 6, NSA_GROUPS, NSA_HD).transpose(2, 0, 3, 1, 4)
    n_cmp = (S - CMP_LEN) // CMP_STRIDE + 1
    idx = jnp.arange(n_cmp)[:, None] * CMP_STRIDE + jnp.arange(CMP_LEN)[None, :]
    blocks = kv[0:2][:, :, :, idx, :] + cmp_pos[:, None, None, None]
    flat = blocks.reshape(2, B, NSA_GROUPS, n_cmp, CMP_LEN * NSA_HD)
    hid = jax.nn.gelu(jnp.einsum('tbgnf,tfe->tbgne', flat, cmp_w1) + cmp_b1[:, None, None, None])
    comp = jnp.einsum('tbgne,ted->tbgnd', hid, cmp_w2) + cmp_b2[:, None, None, None]
    return (comp[0], comp[1], kv[2], kv[3], kv[4], kv[5])


def nsa_mixer(h, shared, w_in, b_gate, w_out):
    k_cmp, v_cmp, k_slc, v_slc, k_win, v_win = shared
    B, S, _ = h.shape
    proj = h @ w_in
    q = proj[..., :NSA_HEADS * NSA_HD].reshape(B, S, NSA_GROUPS, NSA_HPG, NSA_HD) * (NSA_HD ** -0.5)
    gates = jax.nn.sigmoid((proj[..., NSA_HEADS * NSA_HD:] + b_gate).astype(jnp.float32))
    gates = gates.reshape(B, S, 3, NSA_GROUPS, NSA_HPG)
    slopes = alibi_slopes(NSA_HEADS).reshape(NSA_GROUPS, NSA_HPG)[None, :, :, None, None]
    n_cmp = k_cmp.shape[2]
    n_slc = S // SLC_LEN
    topk = min(SLC_TOPK, n_slc)
    cmp_start = jnp.arange(n_cmp) * CMP_STRIDE
    cmp_end = cmp_start + CMP_LEN - 1
    slc_start = jnp.arange(n_slc) * SLC_LEN
    overlap = ((cmp_start[:, None] <= slc_start[None, :] + SLC_LEN - 1) & (cmp_end[:, None] >= slc_start[None, :])).astype(jnp.float32)
    kb = k_slc.reshape(B, NSA_GROUPS, n_slc, SLC_LEN, NSA_HD)
    vb = v_slc.reshape(B, NSA_GROUPS, n_slc, SLC_LEN, NSA_HD)
    pad = ((0, 0), (0, 0), (WIN, 0), (0, 0))
    k_win_p = jnp.pad(k_win, pad)
    v_win_p = jnp.pad(v_win, pad)
    b_ix = jnp.arange(B)[:, None, None, None]
    g_ix = jnp.arange(NSA_GROUPS)[None, :, None, None]
    blk_ids = jnp.arange(n_slc)

    def block(qi):
        q0 = qi * NSA_Q_BLOCK
        qb = lax.dynamic_slice_in_dim(q, q0, NSA_Q_BLOCK, axis=1)
        gb = lax.dynamic_slice_in_dim(gates, q0, NSA_Q_BLOCK, axis=1)
        t = q0 + jnp.arange(NSA_Q_BLOCK)
        dist_c = t[:, None] - cmp_end[None, :]
        s_c = jnp.einsum('bqghd,bgnd->bghqn', qb, k_cmp).astype(jnp.float32) - slopes * dist_c.astype(jnp.float32)
        p_c = masked_softmax(s_c, dist_c >= 0)
        o_c = jnp.einsum('bghqn,bgnd->bqghd', p_c, v_cmp)
        imp = jnp.einsum('bghqn,nj->bgqj', p_c, overlap)
        cur = t // SLC_LEN
        valid_b = blk_ids[None, :] <= cur[:, None]
        forced = (blk_ids[None, :] == 0) | (blk_ids[None, :] == cur[:, None]) | (blk_ids[None, :] == cur[:, None] - 1)
        score = jnp.where(valid_b, imp + jnp.where(forced, FORCE, 0.0), -FORCE)
        _, sel = lax.top_k(score, topk)
        k_sel = kb[b_ix, g_ix, sel].reshape(B, NSA_GROUPS, NSA_Q_BLOCK, topk * SLC_LEN, NSA_HD)
        v_sel = vb[b_ix, g_ix, sel].reshape(B, NSA_GROUPS, NSA_Q_BLOCK, topk * SLC_LEN, NSA_HD)
        key_pos = (sel[..., None] * SLC_LEN + jnp.arange(SLC_LEN)).reshape(B, NSA_GROUPS, NSA_Q_BLOCK, topk * SLC_LEN)
        dist_s = t[None, None, :, None] - key_pos
        s_s = jnp.einsum('bqghd,bgqkd->bghqk', qb, k_sel).astype(jnp.float32) - slopes * dist_s[:, :, None].astype(jnp.float32)
        p_s = masked_softmax(s_s, (dist_s >= 0)[:, :, None])
        o_s = jnp.einsum('bghqk,bgqkd->bqghd', p_s, v_sel)
        k_w = lax.dynamic_slice_in_dim(k_win_p, q0, NSA_Q_BLOCK + WIN, axis=2)
        v_w = lax.dynamic_slice_in_dim(v_win_p, q0, NSA_Q_BLOCK + WIN, axis=2)
        kw_pos = q0 - WIN + jnp.arange(NSA_Q_BLOCK + WIN)
        dist_w = t[:, None] - kw_pos[None, :]
        mask_w = (dist_w >= 0) & (dist_w < WIN) & (kw_pos[None, :] >= 0)
        s_w = jnp.einsum('bqghd,bgkd->bghqk', qb, k_w).astype(jnp.float32) - slopes * dist_w.astype(jnp.float32)
        p_w = masked_softmax(s_w, mask_w)
        o_w = jnp.einsum('bghqk,bgkd->bqghd', p_w, v_w)
        return gb[:, :, 0, :, :, None] * o_c + gb[:, :, 1, :, :, None] * o_s + gb[:, :, 2, :, :, None] * o_w

    outs = lax.map(block, jnp.arange(S // NSA_Q_BLOCK))
    o = jnp.moveaxis(outs, 0, 1).reshape(B, S, NSA_HEADS * NSA_HD).astype(h.dtype)
    return o @ w_out


def clamped_swiglu(gu):
    gate = jnp.minimum(gu[..., ::2], SWIGLU_LIMIT)
    up = jnp.clip(gu[..., 1::2], -SWIGLU_LIMIT, SWIGLU_LIMIT)
    return (up + 1.0) * gate * jax.nn.sigmoid(SWIGLU_ALPHA * gate)


def moe_ffn(h, router_w, router_b, w_gu, b_gu, w_down, b_down):
    B, S, D = h.shape
    n_tok = B * S
    xt = h.reshape(n_tok, D)
    logits = (xt @ router_w + router_b).astype(jnp.float32)
    top_val, top_idx = lax.top_k(logits, TOP_K)
    top_w = jax.nn.softmax(top_val, axis=-1)
    n_asg = n_tok * TOP_K
    e_flat = top_idx.reshape(n_asg)
    w_flat = top_w.reshape(n_asg)
    tok_flat = jnp.arange(n_asg, dtype=jnp.int32) // TOP_K
    order = jnp.argsort(e_flat)
    e_sorted = e_flat[order]
    counts = jnp.bincount(e_flat, length=N_EXPERTS)
    padded = (counts + MOE_BLOCK - 1) // MOE_BLOCK * MOE_BLOCK
    ends_padded = jnp.cumsum(padded)
    start_padded = ends_padded - padded
    start_sorted = jnp.cumsum(counts) - counts
    dest = start_padded[e_sorted] + jnp.arange(n_asg, dtype=jnp.int32) - start_sorted[e_sorted]
    cap = n_asg + N_EXPERTS * MOE_BLOCK
    n_blk = cap // MOE_BLOCK
    buf_tok = jnp.full((cap,), n_tok, jnp.int32).at[dest].set(tok_flat[order])
    buf_w = jnp.zeros((cap,), jnp.float32).at[dest].set(w_flat[order])
    blk_expert = jnp.minimum(jnp.searchsorted(ends_padded, jnp.arange(n_blk) * MOE_BLOCK, side='right'), N_EXPERTS - 1)
    x_pad = jnp.concatenate([xt, jnp.zeros((1, D), xt.dtype)], axis=0)

    def expert_block(args):
        tok, e = args
        gu = x_pad[tok] @ w_gu[e] + b_gu[e]
        return clamped_swiglu(gu) @ w_down[e] + b_down[e]

    ys = lax.map(expert_block, (buf_tok.reshape(n_blk, MOE_BLOCK), blk_expert))
    ys = ys.reshape(cap, D).astype(jnp.float32) * buf_w[:, None]
    out = jnp.zeros((n_tok + 1, D), jnp.float32).at[buf_tok].add(ys)[:n_tok]
    return out.reshape(B, S, D).astype(h.dtype)


def setup_inputs(seed: int = 0) -> dict:
    key = jax.random.key(seed)
    ks = list(jax.random.split(key, 32))

    def nrm(shape, scale):
        return jax.random.normal(ks.pop(), shape, jnp.float32) * scale

    D = D_MODEL
    gla_in = 2 * GLA_KEY_DIM + 2 * GLA_VAL_DIM + GLA_RANK
    kv_out = 6 * NSA_GROUPS * NSA_HD
    nsa_in = NSA_HEADS * NSA_HD + 3 * NSA_HEADS
    return {
        'x': nrm((BATCH, SEQ, D), 1.0),
        'c': nrm((BATCH, D), 1.0),
        'ada_w': nrm((DEPTH, D, 6 * D), 0.5 * D ** -0.5),
        'ada_b': nrm((DEPTH, 6 * D), 0.02),
        'norm1_g': 1.0 + nrm((DEPTH, D), 0.02),
        'norm2_g': 1.0 + nrm((DEPTH, D), 0.02),
        'gla_w_in': nrm((N_A_LAYERS, D, gla_in), D ** -0.5),
        'gla_w_gate2': nrm((N_A_LAYERS, GLA_RANK, GLA_KEY_DIM), GLA_RANK ** -0.5),
        'gla_b_gate': nrm((N_A_LAYERS, GLA_KEY_DIM), 0.1),
        'gla_norm_g': 1.0 + nrm((N_A_LAYERS, GLA_VAL_DIM), 0.02),
        'gla_w_out': nrm((N_A_LAYERS, GLA_VAL_DIM, D), GLA_VAL_DIM ** -0.5),
        'kv_norm_g': 1.0 + nrm((D,), 0.02),
        'kv_ada_w': nrm((D, 2 * D), 0.5 * D ** -0.5),
        'kv_ada_b': nrm((2 * D,), 0.02),
        'kv_w': nrm((D, kv_out), D ** -0.5),
        'cmp_pos': nrm((2, CMP_LEN, NSA_HD), 0.1),
        'cmp_w1': nrm((2, CMP_LEN * NSA_HD, CMP_HIDDEN), (CMP_LEN * NSA_HD) ** -0.5),
        'cmp_b1': nrm((2, CMP_HIDDEN), 0.02),
        'cmp_w2': nrm((2, CMP_HIDDEN, NSA_HD), CMP_HIDDEN ** -0.5),
        'cmp_b2': nrm((2, NSA_HD), 0.02),
        'nsa_w_in': nrm((N_B_LAYERS, D, nsa_in), D ** -0.5),
        'nsa_b_gate': nrm((N_B_LAYERS, 3 * NSA_HEADS), 0.1),
        'nsa_w_out': nrm((N_B_LAYERS, NSA_HEADS * NSA_HD, D), (NSA_HEADS * NSA_HD) ** -0.5),
        'router_w': nrm((DEPTH, D, N_EXPERTS), D ** -0.5),
        'router_b': nrm((DEPTH, N_EXPERTS), 0.01),
        'moe_w_gate_up': nrm((DEPTH, N_EXPERTS, D, 2 * EXPERT_FF), D ** -0.5),
        'moe_b_gate_up': nrm((DEPTH, N_EXPERTS, 2 * EXPERT_FF), 0.01),
        'moe_w_down': nrm((DEPTH, N_EXPERTS, EXPERT_FF, D), EXPERT_FF ** -0.5),
        'moe_b_down': nrm((DEPTH, N_EXPERTS, D), 0.01),
        'final_g': 1.0 + nrm((D,), 0.02),
    }


def reference(x, c, ada_w, ada_b, norm1_g, norm2_g, gla_w_in, gla_w_gate2, gla_b_gate, gla_norm_g, gla_w_out, kv_norm_g, kv_ada_w, kv_ada_b, kv_w, cmp_pos, cmp_w1, cmp_b1, cmp_w2, cmp_b2, nsa_w_in, nsa_b_gate, nsa_w_out, router_w, router_b, moe_w_gate_up, moe_b_gate_up, moe_w_down, moe_b_down, final_g):
    cs = jax.nn.silu(c)
    shared = None
    for layer in range(DEPTH):
        mod = cs @ ada_w[layer] + ada_b[layer]
        sh1, sc1, g1, sh2, sc2, g2 = jnp.split(mod, 6, axis=-1)
        h = modulate(rms_norm(x, norm1_g[layer]), sh1, sc1)
        if layer < N_A_LAYERS:
            i = layer
            y = gla_mixer(h, gla_w_in[i], gla_w_gate2[i], gla_b_gate[i], gla_norm_g[i], gla_w_out[i])
        else:
            i = layer - N_A_LAYERS
            y = nsa_mixer(h, shared, nsa_w_in[i], nsa_b_gate[i], nsa_w_out[i])
        x = x + g1[:, None, :] * y
        h = modulate(rms_norm(x, norm2_g[layer]), sh2, sc2)
        x = x + g2[:, None, :] * moe_ffn(h, router_w[layer], router_b[layer], moe_w_gate_up[layer], moe_b_gate_up[layer], moe_w_down[layer], moe_b_down[layer])
        if layer == N_A_LAYERS - 1:
            shared = nsa_shared_kv(x, cs, kv_norm_g, kv_ada_w, kv_ada_b, kv_w, cmp_pos, cmp_w1, cmp_b1, cmp_w2, cmp_b2)
    return rms_norm(x, final_g)
```

```cpp
#include <hip/hip_runtime.h>
#include <stdint.h>
#include <math.h>

namespace {
constexpr int NB = 8, SEQ = 4096, DM = 1024, NT = NB * SEQ;
constexpr int GLA_IN = 3088, NSA_IN = 1072, KV_OUT = 1536;
constexpr int NE = 32, TOPK = 4, NASG = NT * TOPK;
constexpr int MPAD = 128;
constexpr int CAP = NASG + NE * MPAD;
constexpr int NCMP = 255;

__device__ __forceinline__ float sigm(float x) { return 1.f / (1.f + expf(-x)); }
__device__ __forceinline__ float siluf(float x) { return x / (1.f + expf(-x)); }
__device__ __forceinline__ float logsigmoidf(float z) { return fminf(z, 0.f) - log1pf(expf(-fabsf(z))); }
__device__ __forceinline__ float gelu_tanh(float x) { return 0.5f * x * (1.f + tanhf(0.7978845608028654f * (x + 0.044715f * x * x * x))); }

__global__ __launch_bounds__(256) void k_mod(const float* c, const float* ada_w, const float* ada_b, const float* kv_ada_w,
                                             const float* kv_ada_b, float* mod, float* kvmod) {
    __shared__ float cs[8][1024];
    const int tid = threadIdx.x;
    for (int i = tid; i < 8192; i += 256) { float v = c[i]; cs[i >> 10][i & 1023] = siluf(v); }
    __syncthreads();
    const int col = blockIdx.x * 256 + tid;
    const float* w; int ldw; float* out; int ldo; const float* bias;
    if (col < 4 * 6144) { int L = col / 6144, j = col % 6144; w = ada_w + (size_t)L * 1024 * 6144 + j; ldw = 6144; bias = ada_b + L * 6144 + j; out = mod + (size_t)L * 8 * 6144 + j; ldo = 6144; }
    else { int j = col - 4 * 6144; w = kv_ada_w + j; ldw = 2048; bias = kv_ada_b + j; out = kvmod + j; ldo = 2048; }
    float acc[8];
#pragma unroll
    for (int b = 0; b < 8; ++b) acc[b] = 0.f;
    for (int k = 0; k < 1024; ++k) { float wv = w[(size_t)k * ldw];
#pragma unroll
        for (int b = 0; b < 8; ++b) acc[b] += cs[b][k] * wv; }
    const float bv = *bias;
#pragma unroll
    for (int b = 0; b < 8; ++b) out[b * ldo] = acc[b] + bv;
}

__global__ __launch_bounds__(256) void k_norm(const float* x, const float* g, const float* shift, const float* scale, float* out, int ldmod) {
    __shared__ float red[4];
    const int row = blockIdx.x, tid = threadIdx.x, b = row / SEQ;
    const float4 v = *(const float4*)(x + (size_t)row * DM + tid * 4);
    float ss = v.x * v.x + v.y * v.y + v.z * v.z + v.w * v.w;
    for (int o = 32; o > 0; o >>= 1) ss += __shfl_xor(ss, o);
    if ((tid & 63) == 0) red[tid >> 6] = ss;
    __syncthreads();
    ss = red[0] + red[1] + red[2] + red[3];
    const float r = rsqrtf(ss * (1.f / DM) + 1e-5f);
    float vv[4] = {v.x, v.y, v.z, v.w}, o4[4];
#pragma unroll
    for (int j = 0; j < 4; ++j) { const int col = tid * 4 + j; float y = vv[j] * r * g[col];
        if (shift) y = y * (1.f + scale[b * ldmod + col]) + shift[b * ldmod + col];
        o4[j] = y; }
    *(float4*)(out + (size_t)row * DM + tid * 4) = make_float4(o4[0], o4[1], o4[2], o4[3]);
}

template <class AF, class BF, class EF>
__global__ __launch_bounds__(256) void k_gemm(AF af, BF bf, EF ef, int M, int N, int K) {
    __shared__ float As[16][132];
    __shared__ float Bs[16][132];
    const int m0 = blockIdx.y * 128, n0 = blockIdx.x * 128, z = blockIdx.z;
    if (!af.active(z, m0)) return;
    const int tid = threadIdx.x, ty = tid >> 4, tx = tid & 15;
    float acc[8][8];
#pragma unroll
    for (int i = 0; i < 8; ++i)
#pragma unroll
        for (int j = 0; j < 8; ++j) acc[i][j] = 0.f;
    for (int k0 = 0; k0 < K; k0 += 16) {
        { const int r = tid >> 1, kk = (tid & 1) * 8, m = m0 + r;
#pragma unroll
          for (int j = 0; j < 8; ++j) As[kk + j][r] = (m < M) ? af(z, m, k0 + kk + j) : 0.f; }
        { const int kk = tid >> 4, cc = (tid & 15) * 8;
#pragma unroll
          for (int j = 0; j < 8; ++j) { const int n = n0 + cc + j; Bs[kk][cc + j] = (n < N) ? bf(z, m0, k0 + kk, n) : 0.f; } }
        __syncthreads();
#pragma unroll
        for (int kk = 0; kk < 16; ++kk) {
            float a[8], b[8];
#pragma unroll
            for (int i = 0; i < 8; ++i) a[i] = As[kk][ty * 8 + i];
#pragma unroll
            for (int j = 0; j < 8; ++j) b[j] = Bs[kk][tx * 8 + j];
#pragma unroll
            for (int i = 0; i < 8; ++i)
#pragma unroll
                for (int j = 0; j < 8; ++j) acc[i][j] += a[i] * b[j];
        }
        __syncthreads();
    }
#pragma unroll
    for (int i = 0; i < 8; ++i) { const int m = m0 + ty * 8 + i; if (m < M) ef(z, m, m0, n0 + tx * 8, acc[i], N); }
}

struct ARow { const float* A; long lda; __device__ bool active(int, int) const { return true; } __device__ float operator()(int, int m, int k) const { return A[(size_t)m * lda + k]; } };
struct AGather { const float* A; const int* tok; const int* tile_e; __device__ bool active(int, int m0) const { return tile_e[m0 / MPAD] >= 0; }
    __device__ float operator()(int, int m, int k) const { const int t = tok[m]; return t >= 0 ? A[(size_t)t * DM + k] : 0.f; } };
struct ARowsIdx { const float* A; const int* tile_e; __device__ bool active(int, int m0) const { return tile_e[m0 / MPAD] >= 0; }
    __device__ float operator()(int, int m, int k) const { return A[(size_t)m * DM + k]; } };
struct ACmp { const float* kv6; const float* pos; __device__ bool active(int, int) const { return true; }
    __device__ float operator()(int z, int m, int k) const { const int t = z >> 5, b = (z >> 2) & 7, g = z & 3, l = k >> 6, d = k & 63;
        return kv6[(size_t)(b * SEQ + 16 * m + l) * KV_OUT + t * 256 + g * 64 + d] + pos[t * 2048 + k]; } };
struct AHid { const float* hid; __device__ bool active(int, int) const { return true; } __device__ float operator()(int z, int m, int k) const { return hid[((size_t)z * NCMP + m) * 128 + k]; } };
struct BMat { const float* B; long ldb; __device__ float operator()(int, int, int k, int n) const { return B[(size_t)k * ldb + n]; } };
struct BExpert { const float* B; const int* tile_e; long ldb; size_t estride; __device__ float operator()(int, int m0, int k, int n) const { const int e = tile_e[m0 / MPAD]; return B[(size_t)e * estride + (size_t)k * ldb + n]; } };
struct BCmp { const float* B; long ldb; size_t tstride; __device__ float operator()(int z, int, int k, int n) const { return B[(size_t)(z >> 5) * tstride + (size_t)k * ldb + n]; } };
struct EStore { float* C; long ldc; __device__ void operator()(int, int m, int, int n0, const float (&v)[8], int N) const {
#pragma unroll
    for (int j = 0; j < 8; ++j) if (n0 + j < N) C[(size_t)m * ldc + n0 + j] = v[j]; } };
struct EResid { float* X; const float* gate; long ldg; __device__ void operator()(int, int m, int, int n0, const float (&v)[8], int N) const { const int b = m / SEQ;
#pragma unroll
    for (int j = 0; j < 8; ++j) { const int n = n0 + j; X[(size_t)m * DM + n] += gate[b * ldg + n] * v[j]; } } };
struct ENsaIn { float* qn; float* gates; const float* bg; __device__ void operator()(int, int m, int, int n0, const float (&v)[8], int N) const {
#pragma unroll
    for (int j = 0; j < 8; ++j) { const int n = n0 + j; if (n < 1024) qn[(size_t)m * 1024 + n] = v[j] * 0.125f; else if (n < N) gates[(size_t)m * 48 + (n - 1024)] = sigm(v[j] + bg[n - 1024]); } } };
struct ESwiglu { float* act; const float* bgu; const int* tile_e; __device__ void operator()(int, int m, int m0, int n0, const float (&v)[8], int N) const { const int e = tile_e[m0 / MPAD];
#pragma unroll
    for (int j = 0; j < 4; ++j) { const int n = n0 + 2 * j; float gt = v[2 * j] + bgu[e * 2048 + n], up = v[2 * j + 1] + bgu[e * 2048 + n + 1];
        gt = fminf(gt, 7.f); up = fminf(fmaxf(up, -7.f), 7.f); act[(size_t)m * 1024 + (n >> 1)] = (up + 1.f) * gt * sigm(1.702f * gt); } } };
struct EDown { float* y; const float* bd; const int* tile_e; __device__ void operator()(int, int m, int m0, int n0, const float (&v)[8], int N) const { const int e = tile_e[m0 / MPAD];
#pragma unroll
    for (int j = 0; j < 8; ++j) y[(size_t)m * 1024 + n0 + j] = v[j] + bd[e * 1024 + n0 + j]; } };
struct ECmp1 { float* hid; const float* b1; __device__ void operator()(int z, int m, int, int n0, const float (&v)[8], int N) const {
#pragma unroll
    for (int j = 0; j < 8; ++j) hid[((size_t)z * NCMP + m) * 128 + n0 + j] = gelu_tanh(v[j] + b1[(z >> 5) * 128 + n0 + j]); } };
struct ECmp2 { float* comp; const float* b2; __device__ void operator()(int z, int m, int, int n0, const float (&v)[8], int N) const {
#pragma unroll
    for (int j = 0; j < 8; ++j) if (n0 + j < N) comp[((size_t)z * NCMP + m) * 64 + n0 + j] = v[j] + b2[(z >> 5) * 64 + n0 + j]; } };

__global__ __launch_bounds__(256) void k_gla_gate(const float* proj, const float* w2, const float* bg, float* loga) {
    const size_t i = (size_t)blockIdx.x * 256 + threadIdx.x;
    const int t = (int)(i >> 9), j = (int)(i & 511);
    float z = bg[j];
#pragma unroll
    for (int r = 0; r < 16; ++r) z += proj[(size_t)t * GLA_IN + 3072 + r] * w2[r * 512 + j];
    loga[i] = logsigmoidf(z) * (1.f / 16.f);
}
__global__ __launch_bounds__(256) void k_gla_rec(const float* proj, const float* loga, float* oraw) {
    __shared__ float sq[128], sk[128], sa[128];
    const int b = blockIdx.x >> 2, h = blockIdx.x & 3, e = threadIdx.x;
    float st[128];
#pragma unroll
    for (int d = 0; d < 128; ++d) st[d] = 0.f;
    for (int t = 0; t < SEQ; ++t) {
        const size_t row = (size_t)(b * SEQ + t);
        if (e < 128) { sq[e] = proj[row * GLA_IN + h * 128 + e]; sa[e] = expf(loga[row * 512 + h * 128 + e]); }
        else { sk[e - 128] = proj[row * GLA_IN + 512 + h * 128 + (e - 128)]; }
        const float v = proj[row * GLA_IN + 1024 + h * 256 + e];
        __syncthreads();
        float o = 0.f;
#pragma unroll
        for (int d = 0; d < 128; ++d) { st[d] = st[d] * sa[d] + sk[d] * v; o += sq[d] * st[d]; }
        oraw[row * DM + h * 256 + e] = o * 0.08838834764831845f;
        __syncthreads();
    }
}
__global__ __launch_bounds__(256) void k_gla_post(const float* oraw, const float* proj, const float* ng, float* o) {
    const int row = blockIdx.x, h = threadIdx.x >> 6, l = threadIdx.x & 63;
    const float4 v = *(const float4*)(oraw + (size_t)row * DM + h * 256 + l * 4);
    float ss = v.x * v.x + v.y * v.y + v.z * v.z + v.w * v.w;
    for (int s = 32; s > 0; s >>= 1) ss += __shfl_xor(ss, s);
    const float r = rsqrtf(ss * (1.f / 256.f) + 1e-5f);
    float vv[4] = {v.x, v.y, v.z, v.w};
#pragma unroll
    for (int j = 0; j < 4; ++j) { const int col = h * 256 + l * 4 + j; const float rr = proj[(size_t)row * GLA_IN + 2048 + col];
        o[(size_t)row * DM + col] = vv[j] * r * ng[col] * siluf(rr); }
}

__global__ __launch_bounds__(64) void k_nsa_cmp(const float* qn, const float* comp, float* pc, float* oc) {
    const int idx = blockIdx.x * 64 + threadIdx.x;
    const int bt = idx >> 4, hd = idx & 15, b = bt / SEQ, t = bt % SEQ, g = hd >> 2;
    const float slope = exp2f(-0.5f * (hd + 1));
    float q[64];
#pragma unroll
    for (int d = 0; d < 64; ++d) q[d] = qn[(size_t)bt * 1024 + hd * 64 + d];
    const int nv = t >= 31 ? min(NCMP, (t - 31) / 16 + 1) : 0;
    const float* kc = comp + (size_t)(0 * 32 + b * 4 + g) * NCMP * 64;
    const float* vc = comp + (size_t)(1 * 32 + b * 4 + g) * NCMP * 64;
    float* pr = pc + (size_t)idx * 256;
    float mx = -1e30f;
    for (int n = 0; n < nv; ++n) { float s = 0.f;
#pragma unroll
        for (int d = 0; d < 64; ++d) s += q[d] * kc[n * 64 + d];
        s -= slope * (float)(t - (16 * n + 31)); pr[n] = s; mx = fmaxf(mx, s); }
    float l = 0.f;
    for (int n = 0; n < nv; ++n) l += expf(pr[n] - mx);
    const float inv = nv > 0 ? 1.f / l : 0.f;
    float o[64];
#pragma unroll
    for (int d = 0; d < 64; ++d) o[d] = 0.f;
    for (int n = 0; n < nv; ++n) { const float p = expf(pr[n] - mx) * inv; pr[n] = p;
#pragma unroll
        for (int d = 0; d < 64; ++d) o[d] += p * vc[n * 64 + d]; }
    for (int n = nv; n < 256; ++n) pr[n] = 0.f;
#pragma unroll
    for (int d = 0; d < 64; ++d) oc[(size_t)idx * 64 + d] = o[d];
}
__global__ __launch_bounds__(64) void k_nsa_sel(const float* pc, unsigned long long* sel) {
    __shared__ float sc[64][65];
    const int idx = blockIdx.x * 64 + threadIdx.x;
    const int bt = idx >> 2, g = idx & 3, t = bt % SEQ, cur = t >> 6, tid = threadIdx.x;
    for (int j = 0; j < 64; ++j) {
        float imp = 0.f;
        for (int hp = 0; hp < 4; ++hp) { const float* pr = pc + ((size_t)bt * 16 + g * 4 + hp) * 256;
            for (int n = max(4 * j - 1, 0); n <= min(4 * j + 3, NCMP - 1); ++n) imp += pr[n]; }
        const bool valid = j <= cur, forced = (j == 0) || (j == cur) || (j == cur - 1);
        sc[tid][j] = valid ? imp + (forced ? 1e4f : 0.f) : -1e4f;
    }
    unsigned long long m = 0ull;
    for (int r = 0; r < 16; ++r) { float best = -3e38f; int bi = 0;
        for (int j = 0; j < 64; ++j) { const float v = sc[tid][j]; if (v > best) { best = v; bi = j; } }
        m |= 1ull << bi; sc[tid][bi] = -3e38f; }
    sel[idx] = m;
}
__global__ __launch_bounds__(64) void k_nsa_attn(const float* qn, const float* gates, const float* kv6, const float* oc, const unsigned long long* sel, float* o) {
    const int idx = blockIdx.x * 64 + threadIdx.x;
    const int bt = idx >> 4, hd = idx & 15, b = bt / SEQ, t = bt % SEQ, g = hd >> 2, cur = t >> 6;
    const float slope = exp2f(-0.5f * (hd + 1));
    float q[64];
#pragma unroll
    for (int d = 0; d < 64; ++d) q[d] = qn[(size_t)bt * 1024 + hd * 64 + d];
    const float gc = gates[(size_t)bt * 48 + 0 * 16 + hd], gs = gates[(size_t)bt * 48 + 1 * 16 + hd], gw = gates[(size_t)bt * 48 + 2 * 16 + hd];
    float res[64];
#pragma unroll
    for (int d = 0; d < 64; ++d) res[d] = gc * oc[(size_t)idx * 64 + d];
    const unsigned long long msk = sel[(size_t)bt * 4 + g];
    for (int br = 0; br < 2; ++br) {
        float acc[64];
#pragma unroll
        for (int d = 0; d < 64; ++d) acc[d] = 0.f;
        float mx = -1e30f, l = 0.f;
        const int kcol = (br == 0 ? 2 : 4) * 256 + g * 64, vcol = kcol + 256;
        const int jlo = br == 0 ? 0 : max(0, t - 511), jhi = br == 0 ? cur : t;
        for (int j = jlo; j <= jhi; ++j) {
            int k0, k1;
            if (br == 0) { if (!((msk >> j) & 1ull)) continue; k0 = 64 * j; k1 = min(64 * j + 63, t); } else { k0 = j; k1 = j; }
            for (int key = k0; key <= k1; ++key) {
                const float* kr = kv6 + (size_t)(b * SEQ + key) * KV_OUT + kcol; const float* vr = kv6 + (size_t)(b * SEQ + key) * KV_OUT + vcol;
                float s = 0.f;
#pragma unroll
                for (int d = 0; d < 64; ++d) s += q[d] * kr[d];
                s -= slope * (float)(t - key);
                const float mn = fmaxf(mx, s), sc = expf(mx - mn), p = expf(s - mn);
                l = l * sc + p; mx = mn;
#pragma unroll
                for (int d = 0; d < 64; ++d) acc[d] = acc[d] * sc + p * vr[d];
            }
        }
        const float gg = (br == 0 ? gs : gw) / l;
#pragma unroll
        for (int d = 0; d < 64; ++d) res[d] += gg * acc[d];
    }
#pragma unroll
    for (int d = 0; d < 64; ++d) o[(size_t)bt * 1024 + hd * 64 + d] = res[d];
}

__global__ __launch_bounds__(256) void k_router(const float* h, const float* rw, const float* rb, float* logits) {
    const size_t i = (size_t)blockIdx.x * 256 + threadIdx.x;
    const int t = (int)(i >> 5), e = (int)(i & 31);
    float acc = 0.f;
    for (int k = 0; k < 1024; ++k) acc += h[(size_t)t * DM + k] * rw[k * 32 + e];
    logits[i] = acc + rb[e];
}
__global__ __launch_bounds__(256) void k_top4(const float* logits, int* topi, float* topw, int* cnt) {
    const int t = blockIdx.x * 256 + threadIdx.x;
    float v[32];
#pragma unroll
    for (int e = 0; e < 32; ++e) v[e] = logits[(size_t)t * 32 + e];
    float tv[4]; int ti[4];
#pragma unroll
    for (int r = 0; r < 4; ++r) { float best = -3e38f; int bi = 0;
#pragma unroll
        for (int e = 0; e < 32; ++e) if (v[e] > best) { best = v[e]; bi = e; }
        tv[r] = best; ti[r] = bi;
#pragma unroll
        for (int e = 0; e < 32; ++e) if (e == bi) v[e] = -3e38f; }
    float s = 0.f, w[4];
#pragma unroll
    for (int r = 0; r < 4; ++r) { w[r] = expf(tv[r] - tv[0]); s += w[r]; }
#pragma unroll
    for (int r = 0; r < 4; ++r) { topi[t * 4 + r] = ti[r]; topw[t * 4 + r] = w[r] / s; atomicAdd(&cnt[ti[r]], 1); }
}
__global__ void k_offsets(int* cnt, int* tile_e) {
    if (threadIdx.x == 0 && blockIdx.x == 0) { int s = 0;
        for (int e = 0; e < NE; ++e) { cnt[64 + e] = s; const int p = (cnt[e] + MPAD - 1) / MPAD * MPAD; for (int tl = s / MPAD; tl < (s + p) / MPAD; ++tl) tile_e[tl] = e; s += p; }
        cnt[64 + NE] = s; for (int tl = s / MPAD; tl < CAP / MPAD; ++tl) tile_e[tl] = -1; }
}
__global__ __launch_bounds__(256) void k_assign(const int* topi, int* cnt, int* stok, int* pos) {
    const int i = blockIdx.x * 256 + threadIdx.x;
    const int e = topi[i];
    const int p = cnt[64 + e] + atomicAdd(&cnt[32 + e], 1);
    stok[p] = i >> 2; pos[i] = p;
}
__global__ __launch_bounds__(256) void k_combine(float* x, const float* y, const int* pos, const float* topw, const float* gate, int ldg) {
    const int row = blockIdx.x, tid = threadIdx.x, b = row / SEQ;
    float acc[4] = {0.f, 0.f, 0.f, 0.f};
    for (int r = 0; r < 4; ++r) { const float w = topw[row * 4 + r]; const float4 v = *(const float4*)(y + (size_t)pos[row * 4 + r] * DM + tid * 4);
        acc[0] += w * v.x; acc[1] += w * v.y; acc[2] += w * v.z; acc[3] += w * v.w; }
    float4 xv = *(float4*)(x + (size_t)row * DM + tid * 4);
    const float* gp = gate + b * ldg + tid * 4;
    xv.x += gp[0] * acc[0]; xv.y += gp[1] * acc[1]; xv.z += gp[2] * acc[2]; xv.w += gp[3] * acc[3];
    *(float4*)(x + (size_t)row * DM + tid * 4) = xv;
}

template <class AF, class BF, class EF>
void gemm(hipStream_t s, int M, int N, int K, int Z, AF af, BF bf, EF ef) {
    dim3 grid((N + 127) / 128, (M + 127) / 128, Z);
    hipLaunchKernelGGL((k_gemm<AF, BF, EF>), grid, dim3(256), 0, s, af, bf, ef, M, N, K);
}
}

extern "C" void kernel_launch(void* const* d_in, const int* in_sizes, int n_in, void* d_out, int out_size, void* d_ws, size_t ws_size, hipStream_t stream) {
    const float* x_in = (const float*)d_in[0];      const float* c = (const float*)d_in[1];
    const float* ada_w = (const float*)d_in[2];     const float* ada_b = (const float*)d_in[3];
    const float* norm1_g = (const float*)d_in[4];   const float* norm2_g = (const float*)d_in[5];
    const float* gla_w_in = (const float*)d_in[6];  const float* gla_w_gate2 = (const float*)d_in[7];
    const float* gla_b_gate = (const float*)d_in[8]; const float* gla_norm_g = (const float*)d_in[9];
    const float* gla_w_out = (const float*)d_in[10]; const float* kv_norm_g = (const float*)d_in[11];
    const float* kv_ada_w = (const float*)d_in[12]; const float* kv_ada_b = (const float*)d_in[13];
    const float* kv_w = (const float*)d_in[14];     const float* cmp_pos = (const float*)d_in[15];
    const float* cmp_w1 = (const float*)d_in[16];   const float* cmp_b1 = (const float*)d_in[17];
    const float* cmp_w2 = (const float*)d_in[18];   const float* cmp_b2 = (const float*)d_in[19];
    const float* nsa_w_in = (const float*)d_in[20]; const float* nsa_b_gate = (const float*)d_in[21];
    const float* nsa_w_out = (const float*)d_in[22]; const float* router_w = (const float*)d_in[23];
    const float* router_b = (const float*)d_in[24]; const float* moe_w_gu = (const float*)d_in[25];
    const float* moe_b_gu = (const float*)d_in[26]; const float* moe_w_down = (const float*)d_in[27];
    const float* moe_b_down = (const float*)d_in[28]; const float* final_g = (const float*)d_in[29];
    float* out = (float*)d_out;

    char* wp = (char*)d_ws; size_t off = 0;
    auto alloc = [&](size_t bytes) { void* p = wp + off; off += (bytes + 255) & ~(size_t)255; return p; };
    float* mod = (float*)alloc((size_t)4 * 8 * 6144 * 4);
    float* kvmod = (float*)alloc((size_t)8 * 2048 * 4);
    float* x = (float*)alloc((size_t)NT * DM * 4);
    float* h = (float*)alloc((size_t)NT * DM * 4);
    float* hkv = (float*)alloc((size_t)NT * DM * 4);
    float* proj = (float*)alloc((size_t)NT * GLA_IN * 4);
    float* loga = (float*)alloc((size_t)NT * 512 * 4);
    float* oraw = (float*)alloc((size_t)NT * DM * 4);
    float* o = (float*)alloc((size_t)NT * DM * 4);
    float* kv6 = (float*)alloc((size_t)NT * KV_OUT * 4);
    float* hid = (float*)alloc((size_t)64 * NCMP * 128 * 4);
    float* comp = (float*)alloc((size_t)64 * NCMP * 64 * 4);
    float* gates = (float*)alloc((size_t)NT * 48 * 4);
    float* pc = (float*)alloc((size_t)NT * 16 * 256 * 4);
    float* oc = (float*)alloc((size_t)NT * 16 * 64 * 4);
    unsigned long long* sel = (unsigned long long*)alloc((size_t)NT * 4 * 8);
    float* logits = (float*)alloc((size_t)NT * 32 * 4);
    int* topi = (int*)alloc((size_t)NT * 4 * 4);
    float* topw = (float*)alloc((size_t)NT * 4 * 4);
    int* cnt = (int*)alloc(128 * 4);
    int* stok = (int*)alloc((size_t)CAP * 4);
    int* pos = (int*)alloc((size_t)NT * 4 * 4);
    int* tile_e = (int*)alloc((size_t)(CAP / MPAD) * 4);
    float* act = (float*)alloc((size_t)CAP * DM * 4);
    float* y = (float*)alloc((size_t)CAP * DM * 4);
    float* qn = proj;
    if (off > ws_size) return;

    (void)hipMemcpyAsync(x, x_in, (size_t)NT * DM * 4, hipMemcpyDeviceToDevice, stream);
    hipLaunchKernelGGL(k_mod, dim3(104), dim3(256), 0, stream, c, ada_w, ada_b, kv_ada_w, kv_ada_b, mod, kvmod);

    for (int L = 0; L < 4; ++L) {
        const float* md = mod + (size_t)L * 8 * 6144;
        hipLaunchKernelGGL(k_norm, dim3(NT), dim3(256), 0, stream, x, norm1_g + L * DM, md + 0, md + 1024, h, 6144);
        if (L < 2) {
            const int i = L;
            gemm(stream, NT, GLA_IN, DM, 1, ARow{h, DM}, BMat{gla_w_in + (size_t)i * DM * GLA_IN, GLA_IN}, EStore{proj, GLA_IN});
            hipLaunchKernelGGL(k_gla_gate, dim3(NT * 512 / 256), dim3(256), 0, stream, proj, gla_w_gate2 + i * 16 * 512, gla_b_gate + i * 512, loga);
            hipLaunchKernelGGL(k_gla_rec, dim3(32), dim3(256), 0, stream, proj, loga, oraw);
            hipLaunchKernelGGL(k_gla_post, dim3(NT), dim3(256), 0, stream, oraw, proj, gla_norm_g + i * DM, o);
            gemm(stream, NT, DM, DM, 1, ARow{o, DM}, BMat{gla_w_out + (size_t)i * DM * DM, DM}, EResid{x, md + 2048, 6144});
        } else {
            const int i = L - 2;
            gemm(stream, NT, NSA_IN, DM, 1, ARow{h, DM}, BMat{nsa_w_in + (size_t)i * DM * NSA_IN, NSA_IN}, ENsaIn{qn, gates, nsa_b_gate + i * 48});
            hipLaunchKernelGGL(k_nsa_cmp, dim3(NT * 16 / 64), dim3(64), 0, stream, qn, comp, pc, oc);
            hipLaunchKernelGGL(k_nsa_sel, dim3(NT * 4 / 64), dim3(64), 0, stream, pc, sel);
            hipLaunchKernelGGL(k_nsa_attn, dim3(NT * 16 / 64), dim3(64), 0, stream, qn, gates, kv6, oc, sel, o);
            gemm(stream, NT, DM, DM, 1, ARow{o, DM}, BMat{nsa_w_out + (size_t)i * DM * DM, DM}, EResid{x, md + 2048, 6144});
        }
        hipLaunchKernelGGL(k_norm, dim3(NT), dim3(256), 0, stream, x, norm2_g + L * DM, md + 3072, md + 4096, h, 6144);
        hipLaunchKernelGGL(k_router, dim3(NT * 32 / 256), dim3(256), 0, stream, h, router_w + (size_t)L * DM * 32, router_b + L * 32, logits);
        (void)hipMemsetAsync(cnt, 0, 128 * 4, stream);
        (void)hipMemsetAsync(stok, 0xFF, (size_t)CAP * 4, stream);
        hipLaunchKernelGGL(k_top4, dim3(NT / 256), dim3(256), 0, stream, logits, topi, topw, cnt);
        hipLaunchKernelGGL(k_offsets, dim3(1), dim3(64), 0, stream, cnt, tile_e);
        hipLaunchKernelGGL(k_assign, dim3(NASG / 256), dim3(256), 0, stream, topi, cnt, stok, pos);
        gemm(stream, CAP, 2048, DM, 1, AGather{h, stok, tile_e}, BExpert{moe_w_gu + (size_t)L * NE * DM * 2048, tile_e, 2048, (size_t)DM * 2048},
             ESwiglu{act, moe_b_gu + (size_t)L * NE * 2048, tile_e});
        gemm(stream, CAP, DM, DM, 1, ARowsIdx{act, tile_e}, BExpert{moe_w_down + (size_t)L * NE * DM * DM, tile_e, DM, (size_t)DM * DM},
             EDown{y, moe_b_down + (size_t)L * NE * DM, tile_e});
        hipLaunchKernelGGL(k_combine, dim3(NT), dim3(256), 0, stream, x, y, pos, topw, md + 5120, 6144);
        if (L == 1) {
            hipLaunchKernelGGL(k_norm, dim3(NT), dim3(256), 0, stream, x, kv_norm_g, kvmod + 0, kvmod + 1024, hkv, 2048);
            gemm(stream, NT, KV_OUT, DM, 1, ARow{hkv, DM}, BMat{kv_w, KV_OUT}, EStore{kv6, KV_OUT});
            gemm(stream, NCMP, 128, 2048, 64, ACmp{kv6, cmp_pos}, BCmp{cmp_w1, 128, (size_t)2048 * 128}, ECmp1{hid, cmp_b1});
            gemm(stream, NCMP, 64, 128, 64, AHid{hid}, BCmp{cmp_w2, 64, (size_t)128 * 64}, ECmp2{comp, cmp_b2});
        }
    }
    hipLaunchKernelGGL(k_norm, dim3(NT), dim3(256), 0, stream, x, final_g, (const float*)nullptr, (const float*)nullptr, out, 0);
}
```

```cpp
#include <hip/hip_runtime.h>
#include <stdint.h>
#include <math.h>

namespace {
constexpr int NB = 8, SEQ = 4096, DM = 1024, NT = NB * SEQ;
constexpr int GLA_IN = 3088, NSA_IN = 1072, KV_OUT = 1536;
constexpr int NE = 32, TOPK = 4, NASG = NT * TOPK;
constexpr int MPAD = 256;
constexpr int CAP = NASG + NE * MPAD;
constexpr int NCMP = 255;
constexpr int NTHR = 512;

__device__ __forceinline__ unsigned short f2bf(float f) { unsigned u = __float_as_uint(f); u += 0x7FFFu + ((u >> 16) & 1u); return (unsigned short)(u >> 16); }
typedef __bf16 hbf16x2_t __attribute__((ext_vector_type(2)));
typedef float hf32x2_t __attribute__((ext_vector_type(2)));
__device__ __forceinline__ unsigned pack_bf16(float lo, float hi) { const hf32x2_t v = {lo, hi}; const hbf16x2_t r = __builtin_convertvector(v, hbf16x2_t); return __builtin_bit_cast(unsigned, r); }
__device__ __forceinline__ unsigned pack_bf16_v(float lo, float hi) { return pack_bf16(lo, hi); }
__device__ __forceinline__ float fast_exp(float x) { return __builtin_amdgcn_exp2f(x * 1.4426950408889634f); }
__device__ __forceinline__ float fast_logsigmoid(float z) { return fminf(z, 0.f) - 0.6931471805599453f * __builtin_amdgcn_logf(1.f + __builtin_amdgcn_exp2f(-fabsf(z) * 1.4426950408889634f)); }
__device__ __forceinline__ float fast_silu(float x) { return x * __builtin_amdgcn_rcpf(1.f + __builtin_amdgcn_exp2f(-1.4426950408889634f * x)); }
__device__ __forceinline__ float sigm(float x) { return 1.f / (1.f + expf(-x)); }
__device__ __forceinline__ float siluf(float x) { return x / (1.f + expf(-x)); }
__device__ __forceinline__ float logsigmoidf(float z) { return fminf(z, 0.f) - log1pf(expf(-fabsf(z))); }
__device__ __forceinline__ float gelu_tanh(float x) { return 0.5f * x * (1.f + tanhf(0.7978845608028654f * (x + 0.044715f * x * x * x))); }

#define XB_TMO      128
#define XB_XCNT(j)  (256  + 64 * (j))
#define XB_XSUB(j)  (1280 + 64 * (j))
#define XB_XGEN(j)  (2304 + 64 * (j))
#define XB_TOP      3328
#define XB_TOPGEN   3392
#define XCD_BAR_WORDS 3456
#define XB_SPIN_CAP (1u << 22)
#define LAS __attribute__((address_space(3)))

__device__ __forceinline__ unsigned xb_ld(unsigned* p)              { return __hip_atomic_load(p, __ATOMIC_RELAXED, __HIP_MEMORY_SCOPE_AGENT); }
__device__ __forceinline__ unsigned xb_add(unsigned* p, unsigned v) { return __hip_atomic_fetch_add(p, v, __ATOMIC_RELAXED, __HIP_MEMORY_SCOPE_AGENT); }
__device__ __forceinline__ unsigned xb_xcc_id() { return (unsigned)__builtin_amdgcn_s_getreg((3 << 11) | 20) & 0xFu; }
#define XB_SPIN(cond, bar) do { unsigned _sp = 0; while (cond) { __builtin_amdgcn_s_sleep(1); \
    if ((++_sp & 255u) == 0u) { if (xb_ld(&(bar)[XB_TMO])) break; if (_sp > XB_SPIN_CAP) { atomicAdd(&(bar)[XB_TMO], 1u); break; } } } } while (0)

struct XcdBarrier { unsigned* bar; unsigned x; volatile LAS unsigned* st; };

__device__ __forceinline__ XcdBarrier xcd_barrier_post(unsigned* bar, volatile LAS unsigned* st) {
    XcdBarrier b; b.bar = bar; b.x = xb_xcc_id(); b.st = st;
    if (threadIdx.x == 0) (void)xb_add(&bar[XB_XCNT(b.x)], 1u);
    return b;
}
__device__ __forceinline__ void xcd_barrier_complete(unsigned* bar, unsigned x, unsigned& nloc, unsigned& nx) {
    const unsigned G = gridDim.x * gridDim.y * gridDim.z;
    unsigned sum, cnt, mine, sp = 0u;
    for (;;) {
        sum = 0u; cnt = 0u; mine = 0u;
#pragma unroll
        for (unsigned j = 0; j < 16; ++j) { const unsigned c = xb_ld(&bar[XB_XCNT(j)]); sum += c; cnt += (c > 0u) ? 1u : 0u; mine = (j == x) ? c : mine; }
        if (sum == G) break;
        __builtin_amdgcn_s_sleep(1);
        if ((++sp & 255u) == 0u) { if (xb_ld(&bar[XB_TMO])) break; if (sp > XB_SPIN_CAP) { atomicAdd(&bar[XB_TMO], 1u); break; } }
    }
    nloc = mine > 0u ? mine : 1u; nx = cnt > 0u ? cnt : 1u;
}
__device__ __forceinline__ void xcd_barrier(const XcdBarrier& b, int wv) {
    asm volatile("s_waitcnt vmcnt(0)" ::: "memory");
    __syncthreads();
    int ln_; asm volatile("v_mbcnt_lo_u32_b32 %0, -1, 0\n\tv_mbcnt_hi_u32_b32 %0, -1, %0" : "=v"(ln_));
    if (wv == 0 && ln_ == 0) {
        unsigned* bar = b.bar;
        __builtin_amdgcn_s_waitcnt(0);
        unsigned nloc = b.st[0], nx = b.st[1];
        if (nloc == 0u) { xcd_barrier_complete(bar, b.x, nloc, nx); b.st[0] = nloc; b.st[1] = nx; }
        const unsigned old = xb_add(&bar[XB_XSUB(b.x)], 1u);
        const unsigned gen = old / nloc;
        if (old + 1u == (gen + 1u) * nloc) {
            __builtin_amdgcn_fence(__ATOMIC_RELEASE, "agent");
            asm volatile("s_waitcnt vmcnt(0)" ::: "memory");
            const unsigned og = xb_add(&bar[XB_TOP], 1u);
            const unsigned tg = og / nx;
            if (og + 1u == (tg + 1u) * nx) xb_add(&bar[XB_TOPGEN], 1u);
            else XB_SPIN(xb_ld(&bar[XB_TOPGEN]) == tg, bar);
            __builtin_amdgcn_fence(__ATOMIC_ACQUIRE, "agent");
            xb_add(&bar[XB_XGEN(b.x)], 1u);
            asm volatile("s_waitcnt vmcnt(0)" ::: "memory");
        } else {
            XB_SPIN(xb_ld(&bar[XB_XGEN(b.x)]) == gen, bar);
            __builtin_amdgcn_fence(__ATOMIC_ACQUIRE, "agent");
            asm volatile("s_waitcnt vmcnt(0)" ::: "memory");
        }
    }
    __syncthreads();
}
struct ARow { const float* A; long lda; __device__ bool active(int, int) const { return true; } __device__ float operator()(int, int m, int k) const { return A[(size_t)m * lda + k]; } };
struct AGather { const float* A; const int* tok; const int* tile_e; __device__ bool active(int, int m0) const { return tile_e[m0 / MPAD] >= 0; }
    __device__ float operator()(int, int m, int k) const { const int t = tok[m]; return t >= 0 ? A[(size_t)t * DM + k] : 0.f; } };
struct ARowsIdx { const float* A; const int* tile_e; __device__ bool active(int, int m0) const { return tile_e[m0 / MPAD] >= 0; }
    __device__ float operator()(int, int m, int k) const { return A[(size_t)m * DM + k]; } };
struct ACmp { const float* kv6; const float* pos; __device__ bool active(int, int) const { return true; }
    __device__ float operator()(int z, int m, int k) const { const int t = z >> 5, b = (z >> 2) & 7, g = z & 3, l = k >> 6, d = k & 63;
        return kv6[(size_t)(b * SEQ + 16 * m + l) * KV_OUT + t * 256 + g * 64 + d] + pos[t * 2048 + k]; } };
struct AHid { const float* hid; __device__ bool active(int, int) const { return true; } __device__ float operator()(int z, int m, int k) const { return hid[((size_t)z * NCMP + m) * 128 + k]; } };
struct BMat { const float* B; long ldb; __device__ float operator()(int, int, int k, int n) const { return B[(size_t)k * ldb + n]; } };
struct BExpert { const float* B; const int* tile_e; long ldb; size_t estride; __device__ float operator()(int, int m0, int k, int n) const { const int e = tile_e[m0 / MPAD]; return B[(size_t)e * estride + (size_t)k * ldb + n]; } };
struct BCmp { const float* B; long ldb; size_t tstride; __device__ float operator()(int z, int, int k, int n) const { return B[(size_t)(z >> 5) * tstride + (size_t)k * ldb + n]; } };
struct EStore { float* C; long ldc; __device__ void operator()(int, int m, int, int n0, const float (&v)[8], int N) const {
#pragma unroll
    for (int j = 0; j < 8; ++j) if (n0 + j < N) C[(size_t)m * ldc + n0 + j] = v[j]; } };
struct EResid { float* X; const float* gate; long ldg; __device__ void operator()(int, int m, int, int n0, const float (&v)[8], int N) const { const int b = m / SEQ;
#pragma unroll
    for (int j = 0; j < 8; ++j) { const int n = n0 + j; X[(size_t)m * DM + n] += gate[b * ldg + n] * v[j]; } } };
struct ENsaIn { float* qn; float* gates; const float* bg; __device__ void operator()(int, int m, int, int n0, const float (&v)[8], int N) const {
#pragma unroll
    for (int j = 0; j < 8; ++j) { const int n = n0 + j; if (n < 1024) qn[(size_t)m * 1024 + n] = v[j] * 0.125f; else if (n < N) gates[(size_t)m * 48 + (n - 1024)] = sigm(v[j] + bg[n - 1024]); } } };
struct ESwiglu { float* act; const float* bgu; const int* tile_e; __device__ void operator()(int, int m, int m0, int n0, const float (&v)[8], int N) const { const int e = tile_e[m0 / MPAD];
#pragma unroll
    for (int j = 0; j < 4; ++j) { const int n = n0 + 2 * j; float gt = v[2 * j] + bgu[e * 2048 + n], up = v[2 * j + 1] + bgu[e * 2048 + n + 1];
        gt = fminf(gt, 7.f); up = fminf(fmaxf(up, -7.f), 7.f); act[(size_t)m * 1024 + (n >> 1)] = (up + 1.f) * gt * sigm(1.702f * gt); } } };
struct EDown { float* y; const float* bd; const int* tile_e; __device__ void operator()(int, int m, int m0, int n0, const float (&v)[8], int N) const { const int e = tile_e[m0 / MPAD];
#pragma unroll
    for (int j = 0; j < 8; ++j) y[(size_t)m * 1024 + n0 + j] = v[j] + bd[e * 1024 + n0 + j]; } };
struct ECmp1 { float* hid; const float* b1; __device__ void operator()(int z, int m, int, int n0, const float (&v)[8], int N) const {
#pragma unroll
    for (int j = 0; j < 8; ++j) if (n0 + j < N) hid[((size_t)z * NCMP + m) * 128 + n0 + j] = gelu_tanh(v[j] + b1[(z >> 5) * 128 + n0 + j]); } };
struct ECmp2 { float* comp; const float* b2; __device__ void operator()(int z, int m, int, int n0, const float (&v)[8], int N) const {
#pragma unroll
    for (int j = 0; j < 8; ++j) if (n0 + j < N) comp[((size_t)z * NCMP + m) * 64 + n0 + j] = v[j] + b2[(z >> 5) * 64 + n0 + j]; } };

struct ECmp2b { unsigned short* kcmp; unsigned short* vcmpT; const float* b2; __device__ void operator()(int z, int m, int, int n0, const float (&v)[8], int N) const { const int t = z >> 5, bg = z & 31;
#pragma unroll
    for (int j = 0; j < 8; ++j) { const int d = n0 + j; if (d < N) { const unsigned short o = f2bf(v[j] + b2[t * 64 + d]); if (t == 0) kcmp[((size_t)bg * 256 + m) * 64 + d] = o; else vcmpT[((size_t)bg * 64 + d) * 256 + ((m & ~15) | (((m >> 2) & 1) << 3) | (((m >> 3) & 1) << 2) | (m & 3))] = o; } } } };
struct AHid4 { const float* hidp; const float* c1; __device__ bool active(int, int) const { return true; } __device__ float operator()(int z, int m, int k) const {
    const size_t o = ((size_t)z * NCMP + m) * 128 + k, st = (size_t)64 * NCMP * 128;
    return gelu_tanh(hidp[o] + hidp[o + st] + hidp[o + 2 * st] + hidp[o + 3 * st] + c1[(z >> 5) * 128 + k]); } };
namespace g8 {
typedef unsigned short bf16_t;
typedef short bf16x8 __attribute__((ext_vector_type(8)));
typedef float f32x4 __attribute__((ext_vector_type(4)));
constexpr bool TAIL_HALVES = false;
constexpr int BM = 256, BK = 64, HALF = 128, HTB = HALF * BK * 2, STAGE_BYTES = 8 * HTB, NXCD = 8, WGM = 8;

__device__ __forceinline__ int lds_byte(int r, int c) { const int st = (r >> 4) * 2 + (c >> 5), rr = r & 15, cc = c & 31, ob = rr * 64 + cc * 2; return st * 1024 + (ob ^ (((ob >> 9) & 1) << 5)); }
__device__ __forceinline__ void stage_rc(int b, int& R, int& C) { const int st = b / 1024, sb = b % 1024, swz = sb ^ (((sb >> 9) & 1) << 5); R = (st >> 1) * 16 + swz / 64; C = (st & 1) * 32 + (swz % 64) / 2; }

struct Unit { int pm, pn, ord, half; };
struct Order {
    int nM, nN, nwg, G, c, wgm;
    __device__ __forceinline__ void init(int nM_, int nN_, int G_, int c_, int wgm_ = WGM) { nM = nM_; nN = nN_; nwg = nM * nN; G = G_; c = c_; wgm = wgm_; }
    __device__ __forceinline__ bool next(int i, Unit& u) const {
        long L = (long)i * G + c; u.ord = i; u.half = -1;
        const int F = nwg / G, r = nwg - F * G;
        if (TAIL_HALVES && r > 0 && 2 * r <= G && L >= (long)F * G) { const long h = L - (long)F * G; if (h >= 2 * r) return false; u.half = (int)(h & 1); L = (long)F * G + (h >> 1); }
        if (L >= nwg) return false;
        int wgid = (int)L; { const int q = nwg / NXCD, rr = nwg % NXCD, xcd = wgid % NXCD, off = wgid / NXCD; wgid = (xcd < rr ? xcd * (q + 1) : rr * (q + 1) + (xcd - rr) * q) + off; }
        const int nig = wgm * nN, gid = wgid / nig, fm = gid * wgm, gsz = (nM - fm) < wgm ? (nM - fm) : wgm;
        u.pm = fm + ((wgid % nig) % gsz); u.pn = (wgid % nig) / gsz; return true;
    }
};

template <class Prob, class Epi>
__device__ __forceinline__ void gemm_phase(LAS unsigned char* lds, const Prob& S, const Epi& E, int wv) {
    int tz; asm volatile("v_mbcnt_lo_u32_b32 %0, -1, 0\n\tv_mbcnt_hi_u32_b32 %0, -1, %0" : "=v"(tz)); tz += wv * 64;
    const int tid = tz, wid = __builtin_amdgcn_readfirstlane(tid >> 6), lane = tid & 63, wr = wid >> 2, wc = wid & 3, fr = lane & 15, fq = lane >> 4;
    constexpr int K = Prob::K, nt = K / BK;
    int Rr[2], Cc[2];
    unsigned voffB[2];
#pragma unroll
    for (int i = 0; i < 2; ++i) { stage_rc(tid * 16 + i * 8192, Rr[i], Cc[i]); voffB[i] = (unsigned)(Rr[i] * Prob::LDB + Cc[i]) * 2u; }
    const size_t kstep = (size_t)(BK * 2);
    const size_t hstepB = (size_t)HALF * Prob::LDB * 2;
    const unsigned ldsw = (unsigned)wid * 1024u;
    const int aoff = lds_byte(wr * 64 + fr, fq * 8), boff = lds_byte(wc * 32 + fr, fq * 8);
#define G8_SA(b, h) (((b) * 2 + (h)) * HTB)
#define G8_SB(b, h) ((4 + (b) * 2 + (h)) * HTB)
#define G8_STAGE(bufoff, gbase, voff) do { _Pragma("unroll") for (int _i = 0; _i < 2; ++_i) \
        __builtin_amdgcn_global_load_lds((const unsigned*)((const char*)(gbase) + (voff)[_i]), (LAS unsigned*)(lds + (bufoff) + ldsw + _i * 8192), 16, 0, 0); } while (0)
#define G8_LDA(dst, b, h) do { _Pragma("unroll") for (int m = 0; m < 4; ++m) _Pragma("unroll") for (int k = 0; k < 2; ++k) dst[m][k] = *(const LAS bf16x8*)(lds + G8_SA(b, h) + aoff + m * 2048 + k * 1024); } while (0)
#define G8_LDB(dst, b, h) do { _Pragma("unroll") for (int n = 0; n < 2; ++n) _Pragma("unroll") for (int k = 0; k < 2; ++k) dst[n][k] = *(const LAS bf16x8*)(lds + G8_SB(b, h) + boff + n * 2048 + k * 1024); } while (0)
#define G8_MMA(ai, bj, At, Bt) do { __builtin_amdgcn_s_setprio(1); _Pragma("unroll") for (int m = 0; m < 4; ++m) _Pragma("unroll") for (int n = 0; n < 2; ++n) _Pragma("unroll") for (int k = 0; k < 2; ++k) \
        acc[ai][bj][m][n] = __builtin_amdgcn_mfma_f32_16x16x32_bf16(Bt[n][k], At[m][k], acc[ai][bj][m][n], 0, 0, 0); __builtin_amdgcn_s_setprio(0); } while (0)
#define G8_WAIT_V(n) asm volatile("s_waitcnt vmcnt(" #n ")" ::: "memory")
#define G8_WAIT_L(n) asm volatile("s_waitcnt lgkmcnt(" #n ")" ::: "memory")
#define G8_BAR __builtin_amdgcn_s_barrier()
#define G8_SCHED __builtin_amdgcn_sched_barrier(0)
#define G8_AOFFS(dst, u) do { _Pragma("unroll") for (int _h = 0; _h < 2; ++_h) _Pragma("unroll") for (int _i = 0; _i < 2; ++_i) dst[_h][_i] = S.a_off(u, _h * HALF + Rr[_i]) + (unsigned)Cc[_i] * 2u; } while (0)
    S.prep(tid);
    Unit cur, nxt; int ui = 0;
    if (!S.next(0, cur)) return;
    f32x4 acc[2][2][4][2];
#pragma unroll
    for (int a = 0; a < 2; ++a)
#pragma unroll
        for (int b = 0; b < 2; ++b)
#pragma unroll
            for (int m = 0; m < 4; ++m)
#pragma unroll
                for (int n = 0; n < 2; ++n) acc[a][b][m][n] = (f32x4){0.f, 0.f, 0.f, 0.f};
    bf16x8 At[4][2], B0[2][2], B1[2][2];
    unsigned vA[2][2], nvA[2][2];
    const char* cA = S.a_base(cur); const char* cB = S.b_base(cur) + (cur.half > 0 ? hstepB : 0);
    size_t h2c = cur.half >= 0 ? 0 : hstepB;
    G8_AOFFS(vA, cur);
    S.unit_begin(cur, wid, lane);
    G8_STAGE(G8_SB(0, 0), cB, voffB); G8_STAGE(G8_SA(0, 0), cA, vA[0]); G8_STAGE(G8_SB(0, 1), cB + h2c, voffB); G8_STAGE(G8_SA(0, 1), cA, vA[1]);
    if (wr == 1) G8_BAR;
    G8_WAIT_V(4); G8_BAR;
    G8_STAGE(G8_SB(1, 0), cB + kstep, voffB); G8_STAGE(G8_SA(1, 0), cA + kstep, vA[0]); G8_STAGE(G8_SB(1, 1), cB + h2c + kstep, voffB);
    G8_WAIT_V(6); G8_BAR;
    for (;;) {
        const bool has_next = S.next(ui + 1, nxt);
        const char* nA = has_next ? S.a_base(nxt) : cA; const char* nB = has_next ? S.b_base(nxt) + (nxt.half > 0 ? hstepB : 0) : cB;
        const size_t h2n = has_next ? (nxt.half >= 0 ? 0 : hstepB) : h2c;
        const bool chalf = cur.half >= 0;
        if (has_next) { G8_AOFFS(nvA, nxt); } else {
#pragma unroll
            for (int _h = 0; _h < 2; ++_h)
#pragma unroll
                for (int _i = 0; _i < 2; ++_i) nvA[_h][_i] = vA[_h][_i]; }
#pragma unroll 1
        for (int t = 0; t < nt; t += 2) {
            const bool last = (t == nt - 2);
            const char* a1 = cA + (size_t)(t + 1) * kstep;
            const char* a2 = last ? nA : cA + (size_t)(t + 2) * kstep; const char* b2 = last ? nB : cB + (size_t)(t + 2) * kstep;
            const char* a3 = a2 + kstep; const char* b3 = b2 + kstep; const size_t hs2 = last ? h2n : h2c;
            unsigned w0[2], w1[2];
#pragma unroll
            for (int _i = 0; _i < 2; ++_i) { w0[_i] = last ? nvA[0][_i] : vA[0][_i]; w1[_i] = last ? nvA[1][_i] : vA[1][_i]; }
            G8_LDB(B0, 0, 0); G8_SCHED; G8_LDA(At, 0, 0); G8_STAGE(G8_SA(1, 1), a1, vA[1]);
            G8_WAIT_L(8); G8_BAR; G8_WAIT_L(0); G8_MMA(0, 0, At, B0); G8_BAR; G8_SCHED;
            if (!chalf) { G8_LDB(B1, 0, 1); } G8_STAGE(G8_SB(0, 0), b2, voffB);
            G8_BAR; G8_WAIT_L(0); if (!chalf) { G8_MMA(0, 1, At, B1); } G8_BAR;
            G8_LDA(At, 0, 1); G8_STAGE(G8_SA(0, 0), a2, w0);
            G8_BAR; G8_WAIT_L(0); G8_MMA(1, 0, At, B0); G8_BAR; G8_SCHED;
            G8_STAGE(G8_SB(0, 1), b2 + hs2, voffB);
            G8_WAIT_V(6); G8_BAR; if (!chalf) { G8_MMA(1, 1, At, B1); } G8_BAR;
            G8_LDB(B0, 1, 0); G8_SCHED; G8_LDA(At, 1, 0); G8_STAGE(G8_SA(0, 1), a2, w1);
            G8_WAIT_L(8); G8_BAR; G8_WAIT_L(0); G8_MMA(0, 0, At, B0); G8_BAR; G8_SCHED;
            if (!chalf) { G8_LDB(B1, 1, 1); } G8_STAGE(G8_SB(1, 0), b3, voffB);
            G8_BAR; G8_WAIT_L(0); if (!chalf) { G8_MMA(0, 1, At, B1); } G8_BAR;
            G8_LDA(At, 1, 1); G8_STAGE(G8_SA(1, 0), a3, w0);
            G8_BAR; G8_WAIT_L(0); G8_MMA(1, 0, At, B0); G8_BAR; G8_SCHED;
            G8_STAGE(G8_SB(1, 1), b3 + hs2, voffB);
            G8_WAIT_V(6); G8_BAR; if (!chalf) { G8_MMA(1, 1, At, B1); } G8_BAR;
        }
        if (wr == 0) G8_BAR;
        E(acc, cur, wr, wc, fr, fq);
        if (!has_next) break;
#pragma unroll
        for (int a = 0; a < 2; ++a)
#pragma unroll
            for (int b = 0; b < 2; ++b)
#pragma unroll
                for (int m = 0; m < 4; ++m)
#pragma unroll
                    for (int n = 0; n < 2; ++n) acc[a][b][m][n] = (f32x4){0.f, 0.f, 0.f, 0.f};
        cur = nxt; cA = nA; cB = nB; h2c = h2n; ++ui;
        S.unit_begin(cur, wid, lane);
#pragma unroll
        for (int _h = 0; _h < 2; ++_h)
#pragma unroll
            for (int _i = 0; _i < 2; ++_i) vA[_h][_i] = nvA[_h][_i];
        if (wr == 1) G8_BAR;
    }
    G8_WAIT_V(0);
    G8_BAR;
#undef G8_SA
#undef G8_SB
#undef G8_STAGE
#undef G8_LDA
#undef G8_LDB
#undef G8_MMA
#undef G8_WAIT_V
#undef G8_WAIT_L
#undef G8_BAR
#undef G8_SCHED
#undef G8_AOFFS
}

template <class F> struct EpiQuad {
    F f;
    __device__ __forceinline__ void operator()(const f32x4 (&acc)[2][2][4][2], const Unit& u, int wr, int wc, int fr, int fq) const {
#pragma unroll
        for (int ai = 0; ai < 2; ++ai)
#pragma unroll
            for (int m = 0; m < 4; ++m) { const int row = u.pm * BM + ai * HALF + wr * 64 + m * 16 + fr;
#pragma unroll
                for (int bj = 0; bj < 2; ++bj) { if (u.half >= 0 && bj == 1) continue;
#pragma unroll
                    for (int n = 0; n < 2; ++n) f(u, row, u.pn * BM + (u.half >= 0 ? u.half : bj) * HALF + wc * 32 + n * 16 + 4 * fq, acc[ai][bj][m][n]); } }
    }
};
template <class F> struct EpiPair {
    F f;
    __device__ __forceinline__ void operator()(const f32x4 (&acc)[2][2][4][2], const Unit& u, int wr, int wc, int fr, int fq) const {
#pragma unroll
        for (int ai = 0; ai < 2; ++ai)
#pragma unroll
            for (int m = 0; m < 4; ++m) { const int row = u.pm * BM + ai * HALF + wr * 64 + m * 16 + fr;
#pragma unroll
                for (int bj = 0; bj < 2; ++bj) { if (u.half >= 0 && bj == 1) continue;
                    f(u, row, u.pn * BM + (u.half >= 0 ? u.half : bj) * HALF + wc * 32, fq, wr * 4 + wc, acc[ai][bj][m][0], acc[ai][bj][m][1]); } }
    }
};
}
using g8::Unit; using g8::f32x4;
template <int K_> struct ProbPlain : g8::Order {
    static constexpr int K = K_, LDB = K_;
    const char* A; const char* Bt; long lda;
    __device__ __forceinline__ void prep(int) const {}
    __device__ __forceinline__ void unit_begin(const Unit&, int, int) const {}
    __device__ __forceinline__ const char* a_base(const Unit& u) const { return A + (size_t)u.pm * 256 * lda; }
    __device__ __forceinline__ unsigned a_off(const Unit&, int row) const { return (unsigned)(row * lda); }
    __device__ __forceinline__ const char* b_base(const Unit& u) const { return Bt + (size_t)u.pn * 256 * K * 2; }
};
constexpr int MX_TE = 0, MX_AOFF = 2240, MX_BIAS = MX_AOFF + 18 * 1024, MX_END = MX_BIAS + 2048;
template <int K_, bool GATHER> struct ProbMoe : g8::Order {
    static constexpr int K = K_, LDB = K_;
    const char* A; const char* Bt; const int* tok; const int* tile_e; const float* bias; size_t estride; int nbias; LAS unsigned char* xl;
    __device__ __forceinline__ void prep(int tid) const {
        LAS int* te = (LAS int*)(xl + MX_TE);
        for (int i = tid; i < nM; i += NTHR) te[i] = tile_e[i];
        if (GATHER) { LAS unsigned* ao = (LAS unsigned*)(xl + MX_AOFF); int tv[18];
#pragma unroll
            for (int i = 0; i < 18; ++i) { Unit u; tv[i] = -1; if (tid < 256 && next(i, u)) tv[i] = tok[u.pm * 256 + tid]; }
#pragma unroll
            for (int i = 0; i < 18; ++i) if (tid < 256) ao[i * 256 + tid] = tv[i] >= 0 ? (unsigned)tv[i] * (K * 2) : 0u; }
        __syncthreads();
    }
    __device__ __forceinline__ int expert(const Unit& u) const { return __builtin_amdgcn_readfirstlane(((LAS int*)(xl + MX_TE))[u.pm]); }
    __device__ __forceinline__ void unit_begin(const Unit& u, int wid, int lane) const {
        if (wid == 0) __builtin_amdgcn_global_load_lds((const unsigned*)(bias + (size_t)expert(u) * nbias + u.pn * 256 + lane * 4), (LAS unsigned*)(xl + MX_BIAS + (u.ord & 1) * 1024), 16, 0, 0);
    }
    __device__ __forceinline__ const char* a_base(const Unit& u) const { return GATHER ? A : A + (size_t)u.pm * 256 * K * 2; }
    __device__ __forceinline__ unsigned a_off(const Unit& u, int row) const { if (GATHER) return ((LAS unsigned*)(xl + MX_AOFF))[u.ord * 256 + row]; return (unsigned)(row * K * 2); }
    __device__ __forceinline__ const char* b_base(const Unit& u) const { return Bt + (size_t)expert(u) * estride + (size_t)u.pn * 256 * K * 2; }
};
struct ProbCmp : g8::Order {
    static constexpr int K = 512, LDB = 2048;
    const char* csrc; const char* W1t;
    __device__ __forceinline__ void prep(int) const {}
    __device__ __forceinline__ void unit_begin(const Unit&, int, int) const {}
    __device__ __forceinline__ const char* a_base(const Unit& u) const { return csrc + (size_t)(u.pm >> 2) * SEQ * 64 * 2 + (u.pm & 3) * 1024; }
    __device__ __forceinline__ unsigned a_off(const Unit&, int row) const { return (unsigned)(row * 2048); }
    __device__ __forceinline__ const char* b_base(const Unit& u) const { return W1t + (size_t)(u.pm >> 7) * 256 * 2048 * 2 + (u.pm & 3) * 1024; }
};
typedef unsigned au32x2_ __attribute__((ext_vector_type(2)));
__device__ __forceinline__ uint2 pk4(const f32x4& v) { return make_uint2(pack_bf16(v[0], v[1]), pack_bf16(v[2], v[3])); }
__device__ __forceinline__ void st_pair16(unsigned short* grp, int fq, uint2 qa, uint2 qb) {
    const auto rx = __builtin_amdgcn_permlane16_swap(qa.x, qb.x, false, false);
    const auto ry = __builtin_amdgcn_permlane16_swap(qa.y, qb.y, false, false);
    *(uint4*)(grp + ((fq & 1) ? 16 + 4 * (fq - 1) : 4 * fq)) = make_uint4(rx[0], ry[0], rx[1], ry[1]);
}
struct QStoreF32 { float* C; long ldc; int N; __device__ __forceinline__ void operator()(const Unit&, int row, int col, const f32x4& v) const { if (col < N) *(f32x4*)(C + (size_t)row * ldc + col) = v; } };
template <bool INF32> struct EpiResid {
    const void* Xin; unsigned short* Xout; const float* gate; long ldg;
    __device__ __forceinline__ void operator()(const f32x4 (&acc)[2][2][4][2], const Unit& u, int wr, int wc, int fr, int fq) const {
        const int row0 = u.pm * 256 + wr * 64 + fr, col0 = u.pn * 256 + wc * 32 + 4 * fq, b = (u.pm * 256) / SEQ;
        if (u.half >= 0) {
#pragma unroll
            for (int ai = 0; ai < 2; ++ai)
#pragma unroll
                for (int m = 0; m < 4; ++m)
#pragma unroll
                    for (int n = 0; n < 2; ++n) { const size_t o_ = (size_t)(row0 + ai * 128 + m * 16) * DM + col0 + u.half * 128 + n * 16;
                        const f32x4 g4 = *(const f32x4*)(gate + b * ldg + col0 + u.half * 128 + n * 16); f32x4 xv;
                        if (INF32) xv = *(const f32x4*)((const float*)Xin + o_);
                        else { const uint2 q = *(const uint2*)((const unsigned short*)Xin + o_); xv = (f32x4){__uint_as_float(q.x << 16), __uint_as_float(q.x & 0xffff0000u), __uint_as_float(q.y << 16), __uint_as_float(q.y & 0xffff0000u)}; }
                        const f32x4 o = xv + g4 * acc[ai][0][m][n]; *(uint2*)(Xout + o_) = make_uint2(pack_bf16(o[0], o[1]), pack_bf16(o[2], o[3])); }
            return;
        }
        f32x4 gv[2][2];
#pragma unroll
        for (int bj = 0; bj < 2; ++bj)
#pragma unroll
            for (int n = 0; n < 2; ++n) gv[bj][n] = *(const f32x4*)(gate + b * ldg + col0 + bj * 128 + n * 16);
#pragma unroll
        for (int ai = 0; ai < 2; ++ai) {
            if (INF32) {
#pragma unroll
                for (int bj = 0; bj < 2; ++bj) {
                    f32x4 xv[4][2];
#pragma unroll
                    for (int m = 0; m < 4; ++m)
#pragma unroll
                        for (int n = 0; n < 2; ++n) xv[m][n] = *(const f32x4*)((const float*)Xin + (size_t)(row0 + ai * 128 + m * 16) * DM + col0 + bj * 128 + n * 16);
                    __builtin_amdgcn_sched_barrier(0);
#pragma unroll
                    for (int m = 0; m < 4; ++m)
                        { const f32x4 o0 = xv[m][0] + gv[bj][0] * acc[ai][bj][m][0], o1 = xv[m][1] + gv[bj][1] * acc[ai][bj][m][1];
                          st_pair16(Xout + (size_t)(row0 + ai * 128 + m * 16) * DM + u.pn * 256 + wc * 32 + bj * 128, fq, pk4(o0), pk4(o1)); }
                }
            } else {
                uint2 xu[4][2][2];
#pragma unroll
                for (int m = 0; m < 4; ++m)
#pragma unroll
                    for (int bj = 0; bj < 2; ++bj)
#pragma unroll
                        for (int n = 0; n < 2; ++n) xu[m][bj][n] = *(const uint2*)((const unsigned short*)Xin + (size_t)(row0 + ai * 128 + m * 16) * DM + col0 + bj * 128 + n * 16);
                __builtin_amdgcn_sched_barrier(0);
#pragma unroll
                for (int m = 0; m < 4; ++m)
#pragma unroll
                    for (int bj = 0; bj < 2; ++bj) { f32x4 o2[2];
#pragma unroll
                        for (int n = 0; n < 2; ++n) { const uint2 q = xu[m][bj][n];
                            const f32x4 xv = (f32x4){__uint_as_float(q.x << 16), __uint_as_float(q.x & 0xffff0000u), __uint_as_float(q.y << 16), __uint_as_float(q.y & 0xffff0000u)};
                            o2[n] = xv + gv[bj][n] * acc[ai][bj][m][n]; }
                        st_pair16(Xout + (size_t)(row0 + ai * 128 + m * 16) * DM + u.pn * 256 + wc * 32 + bj * 128, fq, pk4(o2[0]), pk4(o2[1])); }
            }
        }
    }
};
struct QNsaIn { float* qn; float* gates; const float* bg; __device__ __forceinline__ void operator()(const Unit&, int row, int col, const f32x4& v) const {
    if (col < 1024) *(f32x4*)(qn + (size_t)row * 1024 + col) = v * 0.125f;
    else if (col < NSA_IN) { const int c = col - 1024; f32x4 o; for (int j = 0; j < 4; ++j) o[j] = sigm(v[j] + bg[c + j]); *(f32x4*)(gates + (size_t)row * 48 + c) = o; } } };
struct QNsaIn2 { unsigned short* qb; float* gates; const float* bg; __device__ __forceinline__ void operator()(const Unit&, int row, int col, const f32x4& v) const {
    if (col < 1024) { const float sc = 0.125f * 1.4426950408889634f; *(uint2*)(qb + (size_t)row * 1024 + col) = make_uint2(pack_bf16(v[0] * sc, v[1] * sc), pack_bf16(v[2] * sc, v[3] * sc)); }
    else if (col < NSA_IN) { const int c = col - 1024; f32x4 o; for (int j = 0; j < 4; ++j) o[j] = sigm(v[j] + bg[c + j]); *(f32x4*)(gates + (size_t)row * 48 + c) = o; } } };
struct QKv2 { unsigned short *csrc, *kslc, *vslcT, *kwin, *vwinT; __device__ __forceinline__ void operator()(const Unit&, int row, int col, const f32x4& v) const {
    const int j = col >> 8, g = (col >> 6) & 3, d = col & 63, b = row / SEQ, s = row % SEQ, bg = b * 4 + g;
    if (j < 2) *(uint2*)(csrc + ((size_t)((j * 32 + bg) * SEQ + s)) * 64 + d) = make_uint2(pack_bf16(v[0], v[1]), pack_bf16(v[2], v[3]));
    else if (j == 2 || j == 4) *(uint2*)((j == 2 ? kslc : kwin) + ((size_t)bg * SEQ + s) * 64 + d) = make_uint2(pack_bf16(v[0], v[1]), pack_bf16(v[2], v[3]));
    else { const int sp = (s & ~15) | (((s >> 2) & 1) << 3) | (((s >> 3) & 1) << 2) | (s & 3);
        unsigned short* vt = (j == 3 ? vslcT : vwinT) + ((size_t)bg * 64 + d) * SEQ + sp;
#pragma unroll
        for (int i = 0; i < 4; ++i) vt[(size_t)i * SEQ] = f2bf(v[i]); } } };
struct QGlaIn { unsigned short *qk, *vT, *rb; float* glr; __device__ __forceinline__ void operator()(const Unit&, int row, int col, const f32x4& v) const {
    if (col < 1024) *(uint2*)(qk + (size_t)row * 1024 + col) = make_uint2(pack_bf16(v[0], v[1]), pack_bf16(v[2], v[3]));
    else if (col < 2048) { const int ce = col - 1024, b = row / SEQ, s = row % SEQ; unsigned short* vt = vT + ((size_t)(b * 4 + (ce >> 8)) * 256 + (ce & 255)) * SEQ + s;
#pragma unroll
        for (int i = 0; i < 4; ++i) vt[(size_t)i * SEQ] = f2bf(v[i]); }
    else if (col < 3072) *(uint2*)(rb + (size_t)row * 1024 + (col - 2048)) = make_uint2(pack_bf16(v[0], v[1]), pack_bf16(v[2], v[3]));
    else if (col < GLA_IN) *(f32x4*)(glr + (size_t)row * 16 + (col - 3072)) = v; } };
__device__ __forceinline__ float fast_sigm(float x) { return __builtin_amdgcn_rcpf(1.f + __builtin_amdgcn_exp2f(-1.4426950408889634f * x)); }
typedef float f32x2_ __attribute__((ext_vector_type(2)));
template <bool PERMK>
__device__ __forceinline__ void st_vT_tile(LAS unsigned char* T, unsigned short* vt_col0, int row, int fq, const f32x4& v0, const f32x4& v1) {
    const int fr = row & 15, lane16 = fr, g = fq;
    *(LAS au32x2_*)(T + fr * 64 + fq * 8) = (au32x2_){pack_bf16(v0[0], v0[1]), pack_bf16(v0[2], v0[3])};
    *(LAS au32x2_*)(T + fr * 64 + 32 + fq * 8) = (au32x2_){pack_bf16(v1[0], v1[1]), pack_bf16(v1[2], v1[3])};
    const int colblk = g & 1, th = g >> 1, j = lane16 >> 2, q = lane16 & 3;
    const int t0 = PERMK ? 4 * th : 8 * th, t1 = PERMK ? 8 + 4 * th : 8 * th + 4;
    LAS unsigned char* a0 = T + (t0 + j) * 64 + colblk * 32 + q * 8;
    LAS unsigned char* a1 = T + (t1 + j) * 64 + colblk * 32 + q * 8;
    au32x2_ r0, r1;
    asm volatile("s_waitcnt lgkmcnt(0)\n\tds_read_b64_tr_b16 %0, %2\n\tds_read_b64_tr_b16 %1, %3\n\ts_waitcnt lgkmcnt(0)" : "=&v"(r0), "=&v"(r1) : "v"(a0), "v"(a1) : "memory");
    *(uint4*)(vt_col0 + (size_t)(colblk * 16 + lane16) * SEQ + 8 * th) = make_uint4(r0.x, r0.y, r1.x, r1.y);
}
struct PGlaIn { unsigned short *qk, *vT, *rb; float* glr; LAS unsigned char* tl; __device__ __forceinline__ void operator()(const Unit&, int row, int gb, int fq, int wv, const f32x4& v0, const f32x4& v1) const {
    if (gb < 1024) st_pair16(qk + (size_t)row * 1024 + gb, fq, pk4(v0), pk4(v1));
    else if (gb < 2048) { const int b = row / SEQ, s = row % SEQ;
#pragma unroll
        for (int n = 0; n < 2; ++n) { const int ce = gb - 1024 + n * 16 + 4 * fq; unsigned short* vt = vT + ((size_t)(b * 4 + (ce >> 8)) * 256 + (ce & 255)) * SEQ + s; const f32x4& v = n ? v1 : v0;
#pragma unroll
            for (int i = 0; i < 4; ++i) vt[(size_t)i * SEQ] = f2bf(v[i]); } }
    else if (gb < 3072) st_pair16(rb + (size_t)row * 1024 + (gb - 2048), fq, pk4(v0), pk4(v1));
    else if (gb == 3072) *(f32x4*)(glr + (size_t)row * 16 + 4 * fq) = v0; } };
struct PNsaIn { unsigned short* qb; float* gates; const float* bg; __device__ __forceinline__ void operator()(const Unit&, int row, int gb, int fq, int, const f32x4& v0, const f32x4& v1) const {
    if (gb < 1024) { const float sc = 0.125f * 1.4426950408889634f; st_pair16(qb + (size_t)row * 1024 + gb, fq, pk4(v0 * sc), pk4(v1 * sc)); }
    else {
#pragma unroll
        for (int n = 0; n < 2; ++n) { const int c = gb - 1024 + n * 16 + 4 * fq; if (c < 48) { const f32x4& v = n ? v1 : v0; f32x4 o; for (int j = 0; j < 4; ++j) o[j] = sigm(v[j] + bg[c + j]); *(f32x4*)(gates + (size_t)row * 48 + c) = o; } } } } };
struct PKv { unsigned short *csrc, *kslc, *vslcT, *kwin, *vwinT; LAS unsigned char* tl; __device__ __forceinline__ void operator()(const Unit&, int row, int gb, int fq, int wv, const f32x4& v0, const f32x4& v1) const {
    const int j = gb >> 8, g = (gb >> 6) & 3, d0 = gb & 63, b = row / SEQ, s = row % SEQ, bg = b * 4 + g;
    if (j < 2) st_pair16(csrc + ((size_t)((j * 32 + bg) * SEQ + s)) * 64 + d0, fq, pk4(v0), pk4(v1));
    else if (j == 2 || j == 4) st_pair16((j == 2 ? kslc : kwin) + ((size_t)bg * SEQ + s) * 64 + d0, fq, pk4(v0), pk4(v1));
    else { const int sp = (s & ~15) | (((s >> 2) & 1) << 3) | (((s >> 3) & 1) << 2) | (s & 3);
#pragma unroll
        for (int n = 0; n < 2; ++n) { unsigned short* vt = (j == 3 ? vslcT : vwinT) + ((size_t)bg * 64 + d0 + n * 16 + 4 * fq) * SEQ + sp; const f32x4& v = n ? v1 : v0;
#pragma unroll
            for (int i = 0; i < 4; ++i) vt[(size_t)i * SEQ] = f2bf(v[i]); } } } };
struct QSwiglu { unsigned short* act; LAS unsigned char* xl; __device__ __forceinline__ void operator()(const Unit& u, int row, int col, const f32x4& v) const {
    const f32x4 bv = *(const LAS f32x4*)(xl + MX_BIAS + (u.ord & 1) * 1024 + (col - u.pn * 256) * 4);
    f32x2_ G = (f32x2_){v[0], v[2]} + (f32x2_){bv[0], bv[2]}, U = (f32x2_){v[1], v[3]} + (f32x2_){bv[1], bv[3]};
    G.x = fminf(G.x, 7.f); G.y = fminf(G.y, 7.f);
    U.x = __builtin_amdgcn_fmed3f(U.x, -7.f, 7.f); U.y = __builtin_amdgcn_fmed3f(U.y, -7.f, 7.f);
    f32x2_ E = G * (-1.702f * 1.4426950408889634f); E.x = __builtin_amdgcn_exp2f(E.x); E.y = __builtin_amdgcn_exp2f(E.y);
    f32x2_ S = E + 1.0f; S.x = __builtin_amdgcn_rcpf(S.x); S.y = __builtin_amdgcn_rcpf(S.y);
    const f32x2_ R = ((U + 1.0f) * G) * S;
    *(unsigned*)(act + (size_t)row * 1024 + (col >> 1)) = pack_bf16(R.x, R.y); } };
struct QDownF { float* y; const float* bd; const int* tile_e; __device__ __forceinline__ void operator()(const Unit& u, int row, int col, const f32x4& v) const {
    const int e = tile_e[u.pm]; *(f32x4*)(y + (size_t)row * 1024 + col) = v + *(const f32x4*)(bd + e * 1024 + col); } };
struct EpiSwiglu { unsigned short* act; LAS unsigned char* xl;
    __device__ __forceinline__ void operator()(const f32x4 (&acc)[2][2][4][2], const Unit& u, int wr, int wc, int fr, int fq) const {
        const int row0 = u.pm * 256 + wr * 64 + fr, cl0 = wc * 32 + 4 * fq;
        f32x4 bv[2][2];
#pragma unroll
        for (int bj = 0; bj < 2; ++bj)
#pragma unroll
            for (int n = 0; n < 2; ++n) bv[bj][n] = *(const LAS f32x4*)(xl + MX_BIAS + (u.ord & 1) * 1024 + (cl0 + bj * 128 + n * 16) * 4);
#pragma unroll
        for (int ai = 0; ai < 2; ++ai)
#pragma unroll
            for (int mp = 0; mp < 2; ++mp) {
                f32x2_ G[8], U[8], E[8];
#pragma unroll
                for (int q = 0; q < 8; ++q) { const int m = mp * 2 + (q >> 2), bj = (q >> 1) & 1, n = q & 1; const f32x4 v = acc[ai][bj][m][n]; const f32x4 b4 = bv[bj][n];
                    G[q] = (f32x2_){v[0], v[2]} + (f32x2_){b4[0], b4[2]}; U[q] = (f32x2_){v[1], v[3]} + (f32x2_){b4[1], b4[3]}; }
#pragma unroll
                for (int q = 0; q < 8; ++q) { G[q].x = fminf(G[q].x, 7.f); G[q].y = fminf(G[q].y, 7.f); U[q].x = __builtin_amdgcn_fmed3f(U[q].x, -7.f, 7.f); U[q].y = __builtin_amdgcn_fmed3f(U[q].y, -7.f, 7.f);
                    E[q] = G[q] * (-1.702f * 1.4426950408889634f); }
#pragma unroll
                for (int q = 0; q < 8; ++q) { E[q].x = __builtin_amdgcn_exp2f(E[q].x); E[q].y = __builtin_amdgcn_exp2f(E[q].y); }
#pragma unroll
                for (int q = 0; q < 8; ++q) { E[q] = E[q] + 1.0f; U[q] = (U[q] + 1.0f) * G[q]; }
#pragma unroll
                for (int q = 0; q < 8; ++q) { E[q].x = __builtin_amdgcn_rcpf(E[q].x); E[q].y = __builtin_amdgcn_rcpf(E[q].y); }
#pragma unroll
                for (int mm = 0; mm < 2; ++mm) { const int m = mp * 2 + mm; unsigned pk[4];
#pragma unroll
                    for (int q4 = 0; q4 < 4; ++q4) { const f32x2_ R = U[mm * 4 + q4] * E[mm * 4 + q4]; pk[q4] = pack_bf16(R.x, R.y); }
                    *(uint4*)(act + (size_t)(row0 + ai * 128 + m * 16) * 1024 + u.pn * 128 + wc * 32 + fq * 8) = make_uint4(pk[0], pk[1], pk[2], pk[3]); }
            }
    }
};
struct EpiDown { unsigned short* y; LAS unsigned char* xl;
    __device__ __forceinline__ void operator()(const f32x4 (&acc)[2][2][4][2], const Unit& u, int wr, int wc, int fr, int fq) const {
        const int hb_ = u.half >= 0 ? u.half : 0; const int nbj = u.half >= 0 ? 1 : 2;
        const int row0 = u.pm * 256 + wr * 64 + fr, cl0 = wc * 32 + 4 * fq;
        f32x4 bv[2][2];
#pragma unroll
        for (int bj = 0; bj < 2; ++bj)
#pragma unroll
            for (int n = 0; n < 2; ++n) bv[bj][n] = *(const LAS f32x4*)(xl + MX_BIAS + (u.ord & 1) * 1024 + (cl0 + (bj + hb_ < 2 ? bj + hb_ : 1) * 128 + n * 16) * 4);
#pragma unroll
        for (int ai = 0; ai < 2; ++ai)
#pragma unroll
            for (int m = 0; m < 4; ++m) {
                unsigned short* rowp = y + (size_t)(row0 + ai * 128 + m * 16) * 1024 + u.pn * 256 + wc * 32;
#pragma unroll
                for (int bj = 0; bj < 2; ++bj) { if (bj >= nbj) continue;
                    const f32x4 o0 = acc[ai][bj][m][0] + bv[bj][0], o1 = acc[ai][bj][m][1] + bv[bj][1];
                    st_pair16(rowp + (bj + hb_) * 128, fq, make_uint2(pack_bf16(o0[0], o0[1]), pack_bf16(o0[2], o0[3])), make_uint2(pack_bf16(o1[0], o1[1]), pack_bf16(o1[2], o1[3]))); }
            }
    }
};
struct QKv { float* kv6; unsigned short* csrc; __device__ __forceinline__ void operator()(const Unit&, int row, int col, const f32x4& v) const {
    *(f32x4*)(kv6 + (size_t)row * KV_OUT + col) = v;
    if (col < 512) { const int t = col >> 8, g = (col >> 6) & 3, d = col & 63, b = row / SEQ, s = row % SEQ;
        *(uint2*)(csrc + ((size_t)((t * 32 + b * 4 + g) * SEQ + s)) * 64 + d) = make_uint2(pack_bf16(v[0], v[1]), pack_bf16(v[2], v[3])); } } };
struct QCmp1 { float* hidp; __device__ __forceinline__ void operator()(const Unit& u, int row, int col, const f32x4& v) const {
    const int z = u.pm >> 2, ks = u.pm & 3, n = row - u.pm * 256; if (col < 128 && n < NCMP) *(f32x4*)(hidp + (((size_t)ks * 64 + z) * NCMP + n) * 128 + col) = v; } };

struct P {
    const float *x_in, *c, *ada_w, *ada_b, *norm1_g, *norm2_g, *gla_w_in, *gla_w_gate2, *gla_b_gate, *gla_norm_g, *gla_w_out, *kv_norm_g, *kv_ada_w, *kv_ada_b,
        *kv_w, *cmp_pos, *cmp_w1, *cmp_b1, *cmp_w2, *cmp_b2, *nsa_w_in, *nsa_b_gate, *nsa_w_out, *router_w, *router_b, *moe_w_gu, *moe_b_gu, *moe_w_down, *moe_b_down, *final_g;
    float* out; unsigned* bar;
    float *mod, *kvmod, *hid, *gates, *topw, *c1, *glr, *gdl;
    unsigned short *x, *y, *hb, *ob, *act, *csrc, *qb, *kslc, *vslcT, *kwin, *vwinT, *kcmp, *vcmpT, *gqk, *gvT, *grb, *gqd, *gki, *gST, *gUT, *wt_gla_in, *wt_gla_out, *wt_kv, *wt_nsa_in, *wt_nsa_out, *wt_cmp1, *wt_gu, *wt_down;
    unsigned long long* sel; int *topi, *cnt, *cntb, *stok, *pos, *tile_e;
};
typedef const P __attribute__((address_space(4)))* KP;
constexpr int LDS_BAR_OFF = g8::STAGE_BYTES;
constexpr int LDS_X_OFF = g8::STAGE_BYTES + 64;
constexpr size_t kDynLds = LDS_X_OFF + MX_END;
__device__ __forceinline__ float* dyn_smem() { extern __shared__ __attribute__((aligned(16))) float smem_[]; return smem_; }
struct Ctx {
int nb_s;
int wv_s;
#define LAUNDER() int tid_; asm volatile("v_mbcnt_lo_u32_b32 %0, -1, 0\n\tv_mbcnt_hi_u32_b32 %0, -1, %0" : "=v"(tid_)); tid_ += wv_s * 64; const int bid_ = blockIdx.x; const int GTID = bid_ * NTHR + tid_; const int GSZ = nb_s * NTHR; (void)GTID; (void)GSZ;
#define SHX(v, o) __uint_as_float((unsigned)__builtin_amdgcn_ds_bpermute(((tid_ ^ (o)) & 63) << 2, (int)__float_as_uint(v)))

__device__ __forceinline__ void ph_mod(const float* c, const float* ada_w, const float* ada_b, const float* kv_ada_w, const float* kv_ada_b,
                                       float* mod, float* kvmod, float* smem) {
    LAUNDER();
    float (*cs)[1024] = (float (*)[1024])smem;
    float* red = smem + 8192;
    for (int i = tid_; i < 8192; i += NTHR) { float v = c[i]; cs[i >> 10][i & 1023] = siluf(v); }
    __syncthreads();
    const int ncol = 4 * 6144 + 2048, cl = tid_ & 127, kq = tid_ >> 7;
    for (int c0 = bid_ * 128; c0 < ncol; c0 += nb_s * 128) {
        const int col = c0 + cl;
        const float* w = nullptr; int ldw = 0; float* out = nullptr; int ldo = 0; const float* bias = nullptr;
        if (col < 4 * 6144) { int L = col / 6144, j = col % 6144; w = ada_w + (size_t)L * 1024 * 6144 + j; ldw = 6144; bias = ada_b + L * 6144 + j; out = mod + (size_t)L * 8 * 6144 + j; ldo = 6144; }
        else if (col < ncol) { int j = col - 4 * 6144; w = kv_ada_w + j; ldw = 2048; bias = kv_ada_b + j; out = kvmod + j; ldo = 2048; }
        float acc[8];
#pragma unroll
        for (int b = 0; b < 8; ++b) acc[b] = 0.f;
        if (w) {
#pragma unroll 4
            for (int k = kq * 256; k < kq * 256 + 256; ++k) { const float wv = w[(size_t)k * ldw];
#pragma unroll
                for (int b = 0; b < 8; ++b) acc[b] += cs[b][k] * wv; } }
#pragma unroll
        for (int b = 0; b < 8; ++b) red[(kq * 128 + cl) * 8 + b] = acc[b];
        __syncthreads();
        if (kq == 0 && w) { const float bv = *bias;
#pragma unroll
            for (int b = 0; b < 8; ++b) out[b * ldo] = red[cl * 8 + b] + red[(128 + cl) * 8 + b] + red[(256 + cl) * 8 + b] + red[(384 + cl) * 8 + b] + bv; }
        __syncthreads();
    }
}

__device__ __forceinline__ void ph_norm(const float* x, const float* g, const float* shift, const float* scale, float* out, unsigned short* outb, int ldmod) {
    LAUNDER();
    const int lane = tid_ & 63;
    float4 gg[4], vn[4];
#pragma unroll
    for (int j = 0; j < 4; ++j) { gg[j] = *(const float4*)(g + j * 256 + lane * 4); vn[j] = make_float4(0.f, 0.f, 0.f, 0.f); }
    if ((GTID >> 6) < NT) {
#pragma unroll
        for (int j = 0; j < 4; ++j) vn[j] = *(const float4*)(x + (size_t)(GTID >> 6) * DM + j * 256 + lane * 4); }
    for (int row = GTID >> 6; row < NT; row += GSZ >> 6) {
        const int b = row / SEQ;
        float4 v[4], sc[4], sh[4]; float ss = 0.f;
#pragma unroll
        for (int j = 0; j < 4; ++j) { v[j] = vn[j]; sc[j] = make_float4(0.f, 0.f, 0.f, 0.f); sh[j] = sc[j];
            if (shift) { sc[j] = *(const float4*)(scale + b * ldmod + j * 256 + lane * 4); sh[j] = *(const float4*)(shift + b * ldmod + j * 256 + lane * 4); } }
        { const int nr = row + (GSZ >> 6);
          if (nr < NT) {
#pragma unroll
              for (int j = 0; j < 4; ++j) vn[j] = *(const float4*)(x + (size_t)nr * DM + j * 256 + lane * 4); } }
#pragma unroll
        for (int j = 0; j < 4; ++j) ss += v[j].x * v[j].x + v[j].y * v[j].y + v[j].z * v[j].z + v[j].w * v[j].w;
        for (int o = 32; o > 0; o >>= 1) ss += SHX(ss, o);
        const float r = rsqrtf(ss * (1.f / DM) + 1e-5f);
#pragma unroll
        for (int j = 0; j < 4; ++j) { const int col = j * 256 + lane * 4;
            float4 y = make_float4(v[j].x * r * gg[j].x, v[j].y * r * gg[j].y, v[j].z * r * gg[j].z, v[j].w * r * gg[j].w);
            if (shift) { y.x = y.x * (1.f + sc[j].x) + sh[j].x; y.y = y.y * (1.f + sc[j].y) + sh[j].y; y.z = y.z * (1.f + sc[j].z) + sh[j].z; y.w = y.w * (1.f + sc[j].w) + sh[j].w; }
            if (out) *(float4*)(out + (size_t)row * DM + col) = y;
            if (outb) *(uint2*)(outb + (size_t)row * DM + col) = make_uint2(pack_bf16(y.x, y.y), pack_bf16(y.z, y.w)); }
    }
}

template <class AF, class BF, class EF>
__device__ __forceinline__ void ph_gemm(AF af, BF bf, EF ef, int M, int N, int K, int Z, float* smem) {
    LAUNDER();
    float (*As)[132] = (float (*)[132])smem;
    float (*Bs)[132] = (float (*)[132])(smem + 16 * 132);
    const int tm = (M + 127) / 128, tn = (N + 127) / 128, total = Z * tm * tn;
    const int tid = tid_, ty = tid >> 4, tx = tid & 15;
    for (int it = bid_; it < total; it += nb_s) {
        const int z = it / (tm * tn), rr = it % (tm * tn), m0 = (rr / tn) * 128, n0 = (rr % tn) * 128;
        if (!af.active(z, m0)) continue;
        float acc[4][8];
#pragma unroll
        for (int i = 0; i < 4; ++i)
#pragma unroll
            for (int j = 0; j < 8; ++j) acc[i][j] = 0.f;
#pragma unroll 1
        for (int k0 = 0; k0 < K; k0 += 16) {
            { const int r = tid >> 2, kk = (tid & 3) * 4, m = m0 + r;
#pragma unroll
              for (int j = 0; j < 4; ++j) As[kk + j][r] = (m < M) ? af(z, m, k0 + kk + j) : 0.f; }
            { const int kk = tid >> 5, cc = (tid & 31) * 4;
#pragma unroll
              for (int j = 0; j < 4; ++j) { const int n = n0 + cc + j; Bs[kk][cc + j] = (n < N) ? bf(z, m0, k0 + kk, n) : 0.f; } }
            __syncthreads();
#pragma unroll
            for (int kk = 0; kk < 16; ++kk) {
                float a[4], b[8];
#pragma unroll
                for (int i = 0; i < 4; ++i) a[i] = As[kk][ty * 4 + i];
#pragma unroll
                for (int j = 0; j < 8; ++j) b[j] = Bs[kk][tx * 8 + j];
#pragma unroll
                for (int i = 0; i < 4; ++i)
#pragma unroll
                    for (int j = 0; j < 8; ++j) acc[i][j] += a[i] * b[j];
            }
            __syncthreads();
        }
#pragma unroll
        for (int i = 0; i < 4; ++i) { const int m = m0 + ty * 4 + i; if (m < M) ef(z, m, m0, n0 + tx * 8, acc[i], N); }
    }
}

__device__ __forceinline__ void ph_gla_gate(const float* proj, const float* w2, const float* bg, float* loga) {
    LAUNDER();
    for (size_t i = GTID; i < (size_t)NT * 512; i += GSZ) {
        const int t = (int)(i >> 9), j = (int)(i & 511);
        float z = bg[j];
#pragma unroll
        for (int r = 0; r < 16; ++r) z += proj[(size_t)t * GLA_IN + 3072 + r] * w2[r * 512 + j];
        loga[i] = logsigmoidf(z) * (1.f / 16.f);
    }
}
__device__ __forceinline__ void ph_gla_rec(const float* proj, const float* loga, float* oraw, float* smem) {
    LAUNDER();
    if (bid_ >= 16) return;
    const int half = tid_ >> 8, e = tid_ & 255, item = bid_ * 2 + half;
    float* sq = smem + half * 384; float* sk = sq + 128; float* sa = sk + 128;
    const int b = item >> 2, h = item & 3;
    float st[128];
#pragma unroll
    for (int d = 0; d < 128; ++d) st[d] = 0.f;
    const float* pr = proj + (size_t)b * SEQ * GLA_IN + h * 128 + (e < 128 ? e : 512 + (e - 128));
    const float* pa = loga + (size_t)b * SEQ * 512 + h * 128 + (e & 127);
    const float* pv = proj + (size_t)b * SEQ * GLA_IN + 1024 + h * 256 + e;
    float* po = oraw + (size_t)b * SEQ * DM + h * 256 + e;
#pragma unroll 1
    for (int t = 0; t < SEQ; ++t) {
        if (e < 128) { sq[e] = *pr; sa[e] = expf(*pa); } else { sk[e - 128] = *pr; }
        const float v = *pv;
        __syncthreads();
        float o = 0.f;
#pragma unroll
        for (int d = 0; d < 128; ++d) { st[d] = st[d] * sa[d] + sk[d] * v; o += sq[d] * st[d]; }
        *po = o * 0.08838834764831845f;
        __syncthreads();
        pr += GLA_IN; pa += 512; pv += GLA_IN; po += DM;
    }
}
__device__ __forceinline__ void ph_gla_post(const float* oraw, const float* proj, const float* ng, unsigned short* ob) {
    LAUNDER();
    const int l = tid_ & 63;
    for (int it = GTID >> 6; it < NT * 4; it += GSZ >> 6) {
        const int row = it >> 2, h = it & 3;
        const float4 v = *(const float4*)(oraw + (size_t)row * DM + h * 256 + l * 4);
        float ss = v.x * v.x + v.y * v.y + v.z * v.z + v.w * v.w;
        for (int s = 32; s > 0; s >>= 1) ss += SHX(ss, s);
        const float r = rsqrtf(ss * (1.f / 256.f) + 1e-5f);
        float vv[4] = {v.x, v.y, v.z, v.w};
#pragma unroll
        for (int j = 0; j < 4; ++j) { const int col = h * 256 + l * 4 + j; const float rr = proj[(size_t)row * GLA_IN + 2048 + col];
            ob[(size_t)row * DM + col] = f2bf(vv[j] * r * ng[col] * siluf(rr)); }
    }
}

__device__ __forceinline__ void ph_nsa_cmp(const float* qn, const float* comp, float* pc, float* oc) {
    LAUNDER();
    for (int idx = GTID; idx < NT * 16; idx += GSZ) {
        const int bt = idx >> 4, hd = idx & 15, b = bt / SEQ, t = bt % SEQ, g = hd >> 2;
        const float slope = exp2f(-0.5f * (hd + 1));
        float q[64];
#pragma unroll
        for (int d = 0; d < 64; ++d) q[d] = qn[(size_t)bt * 1024 + hd * 64 + d];
        const int nv = t >= 31 ? min(NCMP, (t - 31) / 16 + 1) : 0;
        const float* kc = comp + (size_t)(0 * 32 + b * 4 + g) * NCMP * 64;
        const float* vc = comp + (size_t)(1 * 32 + b * 4 + g) * NCMP * 64;
        float* pr = pc + (size_t)idx * 256;
        float mx = -1e30f;
        for (int n = 0; n < nv; ++n) { float s = 0.f;
#pragma unroll
            for (int d = 0; d < 64; ++d) s += q[d] * kc[n * 64 + d];
            s -= slope * (float)(t - (16 * n + 31)); pr[n] = s; mx = fmaxf(mx, s); }
        float l = 0.f;
        for (int n = 0; n < nv; ++n) l += expf(pr[n] - mx);
        const float inv = nv > 0 ? 1.f / l : 0.f;
        float o[64];
#pragma unroll
        for (int d = 0; d < 64; ++d) o[d] = 0.f;
        for (int n = 0; n < nv; ++n) { const float p = expf(pr[n] - mx) * inv; pr[n] = p;
#pragma unroll
            for (int d = 0; d < 64; ++d) o[d] += p * vc[n * 64 + d]; }
        for (int n = nv; n < 256; ++n) pr[n] = 0.f;
#pragma unroll
        for (int d = 0; d < 64; ++d) oc[(size_t)idx * 64 + d] = o[d];
    }
}
__device__ __forceinline__ void ph_nsa_sel(const float* pc, unsigned long long* sel) {
    LAUNDER();
    const int j = tid_ & 63;
    for (int idx = GTID >> 6; idx < NT * 4; idx += GSZ >> 6) {
        const int bt = idx >> 2, g = idx & 3, t = bt % SEQ, cur = t >> 6;
        float imp = 0.f;
        for (int hp = 0; hp < 4; ++hp) { const float* pr = pc + ((size_t)bt * 16 + g * 4 + hp) * 256;
            for (int n = max(4 * j - 1, 0); n <= min(4 * j + 3, NCMP - 1); ++n) imp += pr[n]; }
        const bool valid = j <= cur, forced = (j == 0) || (j == cur) || (j == cur - 1);
        const float s = valid ? imp + (forced ? 1e4f : 0.f) : -1e4f;
        int rank = 0;
        for (int jj = 0; jj < 64; ++jj) { const float sj = __uint_as_float((unsigned)__builtin_amdgcn_ds_bpermute(jj << 2, (int)__float_as_uint(s))); rank += (sj > s || (sj == s && jj < j)) ? 1 : 0; }
        const unsigned long long m = __ballot(rank < 16);
        if (j == 0) sel[idx] = m;
    }
}
__device__ __forceinline__ void ph_nsa_attn(const float* qn, const float* gates, const float* kv6, const float* oc, const unsigned long long* sel, float* o, unsigned short* ob) {
    LAUNDER();
    for (int idx = GTID; idx < NT * 16; idx += GSZ) {
        const int bt = idx >> 4, hd = idx & 15, b = bt / SEQ, t = bt % SEQ, g = hd >> 2, cur = t >> 6;
        const float slope = exp2f(-0.5f * (hd + 1));
        float q[64];
#pragma unroll
        for (int d = 0; d < 64; ++d) q[d] = qn[(size_t)bt * 1024 + hd * 64 + d];
        const float gc = gates[(size_t)bt * 48 + 0 * 16 + hd], gs = gates[(size_t)bt * 48 + 1 * 16 + hd], gw = gates[(size_t)bt * 48 + 2 * 16 + hd];
        const unsigned long long msk = sel[(size_t)bt * 4 + g];
        float* orow = o + (size_t)bt * 1024 + hd * 64;
        for (int br = 0; br < 2; ++br) {
            float acc[64];
#pragma unroll
            for (int d = 0; d < 64; ++d) acc[d] = 0.f;
            float mx = -1e30f, l = 0.f;
            const int kcol = (br == 0 ? 2 : 4) * 256 + g * 64, vcol = kcol + 256;
            const int jlo = br == 0 ? 0 : max(0, t - 511), jhi = br == 0 ? cur : t;
            for (int j = jlo; j <= jhi; ++j) {
                int k0, k1;
                if (br == 0) { if (!((msk >> j) & 1ull)) continue; k0 = 64 * j; k1 = min(64 * j + 63, t); } else { k0 = j; k1 = j; }
                for (int key = k0; key <= k1; ++key) {
                    const float* kr = kv6 + (size_t)(b * SEQ + key) * KV_OUT + kcol; const float* vr = kv6 + (size_t)(b * SEQ + key) * KV_OUT + vcol;
                    float s = 0.f;
#pragma unroll
                    for (int d = 0; d < 64; ++d) s += q[d] * kr[d];
                    s -= slope * (float)(t - key);
                    const float mn = fmaxf(mx, s), sc = expf(mx - mn), p = expf(s - mn);
                    l = l * sc + p; mx = mn;
#pragma unroll
                    for (int d = 0; d < 64; ++d) acc[d] = acc[d] * sc + p * vr[d];
                }
            }
            const float gg = (br == 0 ? gs : gw) / l;
            if (br == 0) {
#pragma unroll
                for (int d = 0; d < 64; ++d) orow[d] = gc * oc[(size_t)idx * 64 + d] + gg * acc[d];
            } else {
#pragma unroll
                for (int d = 0; d < 64; ++d) ob[(size_t)bt * 1024 + hd * 64 + d] = f2bf(orow[d] + gg * acc[d]);
            }
        }
    }
}

__device__ __forceinline__ void ph_router(const float* h, const float* rw, const float* rb, float* logits) {
    LAUNDER();
    for (size_t i = GTID; i < (size_t)NT * 32; i += GSZ) {
        const int t = (int)(i >> 5), e = (int)(i & 31);
        float acc = 0.f;
        for (int k = 0; k < 1024; ++k) acc += h[(size_t)t * DM + k] * rw[k * 32 + e];
        logits[i] = acc + rb[e];
    }
}
__device__ __forceinline__ void ph_top4(const float* logits, int* topi, float* topw, int* cnt) {
    LAUNDER();
    for (int t = GTID; t < NT; t += GSZ) {
        float v[32];
#pragma unroll
        for (int e = 0; e < 32; ++e) v[e] = logits[(size_t)t * 32 + e];
        float tv[4]; int ti[4];
#pragma unroll
        for (int r = 0; r < 4; ++r) { float best = -3e38f; int bi = 0;
#pragma unroll
            for (int e = 0; e < 32; ++e) if (v[e] > best) { best = v[e]; bi = e; }
            tv[r] = best; ti[r] = bi;
#pragma unroll
            for (int e = 0; e < 32; ++e) if (e == bi) v[e] = -3e38f; }
        float s = 0.f, w[4];
#pragma unroll
        for (int r = 0; r < 4; ++r) { w[r] = expf(tv[r] - tv[0]); s += w[r]; }
#pragma unroll
        for (int r = 0; r < 4; ++r) { topi[t * 4 + r] = ti[r]; topw[t * 4 + r] = w[r] / s; atomicAdd(&cnt[ti[r]], 1); }
    }
}
__device__ __forceinline__ void ph_offsets(int* cnt, int* tile_e) {
    LAUNDER();
    if (tid_ == 0 && bid_ == 0) { int s = 0;
        for (int e = 0; e < NE; ++e) { cnt[64 + e] = s; const int p = (cnt[e] + MPAD - 1) / MPAD * MPAD; for (int tl = s / MPAD; tl < (s + p) / MPAD; ++tl) tile_e[tl] = e; s += p; }
        cnt[64 + NE] = s; for (int tl = s / MPAD; tl < CAP / MPAD; ++tl) tile_e[tl] = -1; }
}
__device__ __forceinline__ void ph_assign(const int* topi, int* cnt, int* stok, int* pos) {
    LAUNDER();
    for (int i = GTID; i < NASG; i += GSZ) {
        const int e = topi[i];
        const int p = cnt[64 + e] + atomicAdd(&cnt[32 + e], 1);
        stok[p] = i >> 2; pos[i] = p;
    }
}
__device__ __forceinline__ void ph_combine(float* x, const float* y, const int* pos, const float* topw, const float* gate, int ldg) {
    LAUNDER();
    const int lane = tid_ & 63;
    for (int row = GTID >> 6; row < NT; row += GSZ >> 6) {
        const int b = row / SEQ;
#pragma unroll
        for (int j = 0; j < 4; ++j) { const int col = j * 256 + lane * 4;
            float4 acc = make_float4(0.f, 0.f, 0.f, 0.f);
            for (int r = 0; r < 4; ++r) { const float w = topw[row * 4 + r]; const float4 v = *(const float4*)(y + (size_t)pos[row * 4 + r] * DM + col);
                acc.x += w * v.x; acc.y += w * v.y; acc.z += w * v.z; acc.w += w * v.w; }
            float4 xv = *(float4*)(x + (size_t)row * DM + col); const float4 gp = *(const float4*)(gate + b * ldg + col);
            xv.x += gp.x * acc.x; xv.y += gp.y * acc.y; xv.z += gp.z * acc.z; xv.w += gp.w * acc.w;
            *(float4*)(x + (size_t)row * DM + col) = xv; }
    }
}
template <bool PERM128 = false>
__device__ __forceinline__ void ph_convT(const float* src, unsigned short* dst, int K, int N, int Npad, int nmat, float* smem) {
    LAUNDER();
    unsigned (*TT)[64][33] = (unsigned (*)[64][33])smem;
    const int tk = K / 64, tn = Npad / 64, per = tk * tn, total = nmat * per;
    const int kp = tid_ >> 4, ln = (tid_ & 15) * 4;
    float4 v0 = make_float4(0.f, 0.f, 0.f, 0.f), v1 = v0;
    auto fetch = [&](int it, float4& a, float4& b) {
        const int mat = it / per, r = it % per, k0 = (r / tn) * 64, n0 = (r % tn) * 64;
        const float* s = src + (size_t)mat * K * N;
        a = make_float4(0.f, 0.f, 0.f, 0.f); b = a;
        int ka = k0 + 2 * kp, kb = ka + 1;
        if (PERM128) {
            ka = (ka & ~127) | (((ka >> 2) & 1) * 64 + ((ka >> 5) & 3) * 16 + ((ka >> 1) & 1) * 8 + ((ka >> 3) & 3) * 2 + (ka & 1));
            kb = (kb & ~127) | (((kb >> 2) & 1) * 64 + ((kb >> 5) & 3) * 16 + ((kb >> 1) & 1) * 8 + ((kb >> 3) & 3) * 2 + (kb & 1)); }
        if (n0 + ln < N) { a = *(const float4*)(s + (size_t)ka * N + n0 + ln); b = *(const float4*)(s + (size_t)kb * N + n0 + ln); }
    };
    int it = bid_, par = 0;
    if (it < total) fetch(it, v0, v1);
    while (it < total) {
        TT[par][ln][kp] = pack_bf16(v0.x, v1.x); TT[par][ln + 1][kp] = pack_bf16(v0.y, v1.y); TT[par][ln + 2][kp] = pack_bf16(v0.z, v1.z); TT[par][ln + 3][kp] = pack_bf16(v0.w, v1.w);
        const int nxt = it + nb_s;
        if (nxt < total) fetch(nxt, v0, v1);
        __syncthreads();
        { const int mat = it / per, r = it % per, k0 = (r / tn) * 64, n0 = (r % tn) * 64;
          unsigned short* d = dst + (size_t)mat * Npad * K;
          const int n = tid_ >> 3, c = tid_ & 7;
          *(uint4*)(d + (size_t)(n0 + n) * K + k0 + 8 * c) = make_uint4(TT[par][n][4 * c], TT[par][n][4 * c + 1], TT[par][n][4 * c + 2], TT[par][n][4 * c + 3]); }
        it = nxt; par ^= 1;
    }
    __syncthreads();
}
__device__ __forceinline__ void ph_c1(const float* pos, const float* w1, const float* b1, float* c1, float* smem) {
    LAUNDER();
    for (int o = bid_; o < 256; o += nb_s) {
        const int t = o >> 7, e = o & 127; float acc = 0.f;
#pragma unroll
        for (int j = 0; j < 4; ++j) { const int f = tid_ + 512 * j; acc += pos[t * 2048 + f] * w1[((size_t)t * 2048 + f) * 128 + e]; }
#pragma unroll
        for (int s = 32; s > 0; s >>= 1) acc += SHX(acc, s);
        if ((tid_ & 63) == 0) smem[tid_ >> 6] = acc;
        __syncthreads();
        if (tid_ == 0) { float s = b1[t * 128 + e]; for (int w = 0; w < 8; ++w) s += smem[w]; c1[o] = s; }
        __syncthreads();
    }
}
typedef short a_bf16x8 __attribute__((ext_vector_type(8)));
typedef float a_f32x16 __attribute__((ext_vector_type(16)));
typedef unsigned au32x4 __attribute__((ext_vector_type(4)));
typedef unsigned au32x2 __attribute__((ext_vector_type(2)));
static constexpr int AT_TB = 8192;
static constexpr int AT_KC = 0, AT_VC = 4 * AT_TB, AT_KS = 8 * AT_TB, AT_VS = 12 * AT_TB, AT_IMP = g8::STAGE_BYTES + 64  , AT_SELM = AT_IMP + 16384, AT_WM = AT_SELM + 512, AT_END = AT_WM + 64, AT_ONES = AT_END + 8;
static_assert(16 * AT_TB <= g8::STAGE_BYTES && AT_END + 16 <= g8::STAGE_BYTES + 64 + MX_END, "attention LDS map must fit");

__device__ __forceinline__ float xhalf_max(float v) { auto rr = __builtin_amdgcn_permlane32_swap(__float_as_uint(v), __float_as_uint(v), false, false); return fmaxf(__uint_as_float(rr[0]), __uint_as_float(rr[1])); }
__device__ __forceinline__ float xhalf_sum(float v) { auto rr = __builtin_amdgcn_permlane32_swap(__float_as_uint(v), __float_as_uint(v), false, false); return __uint_as_float(rr[0]) + __uint_as_float(rr[1]); }

__device__ __forceinline__ void at_dma1(LAS unsigned char* buf, const char* gb, unsigned go, int wid) {
    __builtin_amdgcn_global_load_lds((const unsigned*)(gb + go), (LAS unsigned*)(buf + wid * 1024), 16, 0, 0);
}
__device__ __forceinline__ void at_glds(LAS unsigned char* buf, const char* gb, unsigned go, int wid) {
    unsigned sv; const unsigned la = (unsigned)(unsigned long long)(buf + wid * 1024);
    asm volatile("s_mov_b32 %0, m0\n\ts_mov_b32 m0, %3\n\ts_nop 0\n\tglobal_load_lds_dwordx4 %1, %2\n\ts_mov_b32 m0, %0" : "=&s"(sv) : "v"(go), "s"(gb), "s"(la) : "memory");
}
__device__ __forceinline__ void at_dma(LAS unsigned char* kbuf, LAS unsigned char* vbuf, const char* kb, const char* vb, unsigned ko, unsigned vo, int wid) {
    at_dma1(kbuf, kb, ko, wid); at_dma1(vbuf, vb, vo, wid);
}
#define AT_SWZ(row, g) ((row) * 128 + ((((g) ^ (((row) >> 1) & 7))) << 4))
#define AT_REGOFF(i) (((i) & 3) + 8 * ((i) >> 2))
__device__ __forceinline__ void at_qk(LAS unsigned char* kbuf, const a_bf16x8 (&qf)[4], a_f32x16 (&st)[2], const int (&off4)[4], float base, float slk, int hh) {
    a_bf16x8 kf[2][4];
#pragma unroll
    for (int kt = 0; kt < 2; ++kt)
#pragma unroll
        for (int s = 0; s < 4; ++s) kf[kt][s] = *(const LAS a_bf16x8*)(kbuf + 4096 * kt + off4[s]);
    a_f32x16 a0, a1;
    const float b0 = base + slk * (float)(4 * hh), b1 = base + slk * (float)(32 + 4 * hh);
#pragma unroll
    for (int i = 0; i < 16; ++i) { a0[i] = b0 + slk * (float)AT_REGOFF(i); a1[i] = b1 + slk * (float)AT_REGOFF(i); }
    __builtin_amdgcn_sched_barrier(0);
    __builtin_amdgcn_s_setprio(1);
#pragma unroll
    for (int s = 0; s < 4; ++s) {
        a0 = __builtin_amdgcn_mfma_f32_32x32x16_bf16(kf[0][s], qf[s], a0, 0, 0, 0);
        a1 = __builtin_amdgcn_mfma_f32_32x32x16_bf16(kf[1][s], qf[s], a1, 0, 0, 0);
    }
    __builtin_amdgcn_s_setprio(0);
    st[0] = a0; st[1] = a1;
}
__device__ __forceinline__ void at_vload(LAS unsigned char* vbuf, a_bf16x8 (&vf)[2][4], const int (&off4)[4]) {
#pragma unroll
    for (int dt = 0; dt < 2; ++dt)
#pragma unroll
        for (int ks = 0; ks < 4; ++ks) vf[dt][ks] = *(const LAS a_bf16x8*)(vbuf + 4096 * dt + off4[ks]);
}
__device__ __forceinline__ void at_pack(const a_f32x16 (&p)[2], a_bf16x8 (&pb)[4]) {
#pragma unroll
    for (int kt = 0; kt < 2; ++kt)
#pragma unroll
        for (int s = 0; s < 2; ++s) {
            au32x4 pw = {pack_bf16(p[kt][8 * s + 0], p[kt][8 * s + 1]), pack_bf16(p[kt][8 * s + 2], p[kt][8 * s + 3]), pack_bf16(p[kt][8 * s + 4], p[kt][8 * s + 5]), pack_bf16(p[kt][8 * s + 6], p[kt][8 * s + 7])};
            pb[kt * 2 + s] = *reinterpret_cast<a_bf16x8*>(&pw); }
}
__device__ __forceinline__ void at_pv(const a_bf16x8 (&vf)[2][4], const a_bf16x8 (&pb)[4], a_f32x16 (&O)[2]) {
    __builtin_amdgcn_s_setprio(1);
#pragma unroll
    for (int ks = 0; ks < 4; ++ks) {
        O[0] = __builtin_amdgcn_mfma_f32_32x32x16_bf16(vf[0][ks], pb[ks], O[0], 0, 0, 0);
        O[1] = __builtin_amdgcn_mfma_f32_32x32x16_bf16(vf[1][ks], pb[ks], O[1], 0, 0, 0);
    }
    __builtin_amdgcn_s_setprio(0);
}
__device__ __forceinline__ void at_mask(a_f32x16 (&st)[2], int hh, int klo, int khi) {
    int d0 = 4 * hh - klo; unsigned span = (unsigned)(khi - klo); const bool any = khi >= klo;
    asm volatile("" : "+v"(d0)); asm volatile("" : "+v"(span));
#pragma unroll
    for (int kt = 0; kt < 2; ++kt)
#pragma unroll
        for (int i = 0; i < 16; ++i) { const bool ok = any && ((unsigned)(32 * kt + AT_REGOFF(i) + d0) <= span); st[kt][i] = ok ? st[kt][i] : -INFINITY; }
}
__device__ __forceinline__ float at_rowmax(const a_f32x16 (&st)[2]) {
    float mt = st[0][0];
#pragma unroll
    for (int i = 1; i < 16; ++i) mt = fmaxf(mt, st[0][i]);
#pragma unroll
    for (int i = 0; i < 16; ++i) mt = fmaxf(mt, st[1][i]);
    return xhalf_max(mt);
}
__device__ __forceinline__ void at_softmax_rel(a_f32x16 (&st)[2], float mref, bool first, float& m, float& l, a_f32x16 (&O)[2]) {
    const float mt = at_rowmax(st);
    float ps = 0.f;
    if (first || __any(mt > 6.f)) {
        float delta = first ? mt : fmaxf(mt, 0.f); delta = (delta == -INFINITY) ? 0.f : delta;
#pragma unroll
        for (int kt = 0; kt < 2; ++kt)
#pragma unroll
            for (int i = 0; i < 16; ++i) { const float pv = __builtin_amdgcn_exp2f(st[kt][i] - delta); st[kt][i] = pv; ps += pv; }
        const float alpha = first ? 0.f : __builtin_amdgcn_exp2f(-delta);
        l = l * alpha + ps; m = mref + delta;
#pragma unroll
        for (int dt = 0; dt < 2; ++dt)
#pragma unroll
            for (int i = 0; i < 16; ++i) O[dt][i] *= alpha;
    } else {
#pragma unroll
        for (int kt = 0; kt < 2; ++kt)
#pragma unroll
            for (int i = 0; i < 16; ++i) { const float pv = __builtin_amdgcn_exp2f(st[kt][i]); st[kt][i] = pv; ps += pv; }
        l += ps;
    }
}

__device__ __forceinline__ void at_mask2(a_f32x16& s0, a_f32x16& s1, int hh, int klo, int khi) {
    const bool any = khi >= klo;
    int d0 = any ? 4 * hh - klo : 0x40000000; unsigned span = any ? (unsigned)(khi - klo) : 0u;
    asm volatile("" : "+v"(d0)); asm volatile("" : "+v"(span));
#pragma unroll
    for (int i = 0; i < 16; ++i) {
        s0[i] = ((unsigned)(AT_REGOFF(i) + d0) <= span) ? s0[i] : -INFINITY;
        s1[i] = ((unsigned)(32 + AT_REGOFF(i) + d0) <= span) ? s1[i] : -INFINITY; }
}
#define AT_MX3(a, b, c) __builtin_fmaxf(__builtin_fmaxf((a), (b)), (c))
__device__ __forceinline__ float at_rowmax2(const a_f32x16& p0, const a_f32x16& p1) {
    float a = AT_MX3(p0[0], p0[1], p1[0]), b = AT_MX3(p0[2], p0[3], p1[1]); a = AT_MX3(a, p1[2], p1[3]);
#pragma unroll
    for (int r = 4; r < 16; r += 4) { a = AT_MX3(a, p0[r], p0[r + 1]); b = AT_MX3(b, p0[r + 2], p0[r + 3]); a = AT_MX3(a, p1[r], p1[r + 1]); b = AT_MX3(b, p1[r + 2], p1[r + 3]); }
    return xhalf_max(__builtin_fmaxf(a, b));
}

__device__ __forceinline__ void ph_nsa_attn_mfma(const unsigned short* qb, const float* gates, const unsigned short* kcmp, const unsigned short* vcmpT,
                                                 const unsigned short* kslc, const unsigned short* vslcT, const unsigned short* kwin, const unsigned short* vwinT,
                                                 unsigned short* ob, int* qcnt, LAS unsigned char* lds) {
    LAUNDER();
    const int wid = wv_s;
    constexpr float LOG2E = 1.4426950408889634f;
    int lane, r, hh, hp, ql, tl = 0, tq = 0, tqh = 0; unsigned ko, voS; int off4[4]; float sl = 0.f;
#define AT_DERIVE(q0_, g_) do { asm volatile("v_mbcnt_lo_u32_b32 %0, -1, 0\n\tv_mbcnt_hi_u32_b32 %0, -1, %0" : "=v"(lane)); r = lane & 31; hh = lane >> 5; hp = r >> 3; ql = r & 7; \
        const int drow_ = 8 * wid + (lane >> 3), dgc_ = (lane & 7) ^ ((drow_ >> 1) & 7); ko = (unsigned)(drow_ * 128 + dgc_ * 16); voS = (unsigned)(drow_ * SEQ * 2 + dgc_ * 16); \
        _Pragma("unroll") for (int s_ = 0; s_ < 4; ++s_) off4[s_] = r * 128 + ((((2 * s_ + hh) ^ ((r >> 1) & 7))) << 4); \
        tl = wid * 8 + ql; tq = (q0_) + tl; tqh = tq - 4 * hh; sl = exp2f(-0.5f * (float)((g_) * 4 + hp + 1)) * LOG2E; } while (0)
    LAS int* qslot = (LAS int*)(lds + AT_END);
    const bool dyn = nb_s == 256;
    int kq = 0, I = bid_, it = 0;
    if (tid_ == 0) { qslot[2] = ~0; qslot[3] = ~0; }
    if (dyn) { if (tid_ == 0) qslot[0] = atomicAdd(qcnt + (bid_ & 7), 1); }
    __syncthreads();
    if (dyn) kq = qslot[0];
    for (;;) {
        if (dyn ? kq >= 256 : I >= 2048) break;
        int knext = 0;
        int lane0; asm volatile("v_mbcnt_lo_u32_b32 %0, -1, 0\n\tv_mbcnt_hi_u32_b32 %0, -1, %0" : "=v"(lane0));
        if (dyn && wid == 0 && lane0 == 0) knext = atomicAdd(qcnt + (bid_ & 7), 1);
        int qi = 63 - (I >> 5), bg = I & 31;
        if (dyn) { bg = (bid_ & 7) + 8 * (kq >> 6); qi = 63 - (kq & 63); }
        const int b = bg >> 2, g = bg & 3, q0 = qi * 64, cur = qi;
        AT_DERIVE(q0, g);
        const int hd = g * 4 + hp;
        const unsigned voC = (unsigned)((8 * wid + (lane >> 3)) * 512 + ((lane & 7) ^ (((8 * wid + (lane >> 3)) >> 1) & 7)) * 16);
        a_bf16x8 qf[4];
#pragma unroll
        for (int s = 0; s < 4; ++s) qf[s] = *(const a_bf16x8*)(qb + (size_t)(b * SEQ + tq) * 1024 + hd * 64 + 16 * s + 8 * hh);
        const float* gp = gates + (size_t)(b * SEQ + tq) * 48 + hd;
        const float gc = gp[0], gs = gp[16], gw = gp[32];
        a_f32x16 Ot[2];
#pragma unroll
        for (int dt = 0; dt < 2; ++dt)
#pragma unroll
            for (int i = 0; i < 16; ++i) Ot[dt][i] = 0.f;
        const int nlast_blk = (q0 + 63 >= 31) ? min(254, (q0 + 63 - 31) >> 4) : -1;
        const int ntc = nlast_blk >= 0 ? (nlast_blk >> 6) + 1 : 0;
        const int nlast = (tq >= 31) ? min(254, (tq - 31) >> 4) : -1;
        for (int T = 0; T < ntc; ++T) at_dma(lds + AT_KC + T * AT_TB, lds + AT_VC + T * AT_TB, (const char*)(kcmp + ((size_t)bg * 256 + 64 * T) * 64), (const char*)(vcmpT + (size_t)bg * 64 * 256 + 64 * T), ko, voC, wid);
        { LAS float* imp = (LAS float*)(lds + AT_IMP) + wid * 512;
#pragma unroll
          for (int i = 0; i < 8; ++i) imp[lane + 64 * i] = 0.f; }
        unsigned long long ptodo = (cur >= 8 ? (0x1FFull << (cur - 8)) : ((1ull << (cur + 1)) - 1ull));
        int pn = __builtin_popcountll(ptodo), pj0 = 0, pj1 = 0, pj2 = 0;
        {
            const char* kbw = (const char*)(kwin + (size_t)bg * SEQ * 64); const char* vbw = (const char*)(vwinT + (size_t)bg * 64 * SEQ);
            pj0 = 63 - __builtin_clzll(ptodo); ptodo &= ~(1ull << pj0);
            at_glds(lds + AT_KS, kbw + (size_t)pj0 * 8192, ko, wid); at_glds(lds + AT_VS, vbw + (size_t)pj0 * 128, voS, wid);
            if (pn > 1) { pj1 = 63 - __builtin_clzll(ptodo); ptodo &= ~(1ull << pj1); at_glds(lds + AT_KS + AT_TB, kbw + (size_t)pj1 * 8192, ko, wid); }
            if (pn > 2) { pj2 = 63 - __builtin_clzll(ptodo); ptodo &= ~(1ull << pj2); at_glds(lds + AT_KS + 2 * AT_TB, kbw + (size_t)pj2 * 8192, ko, wid); }
        }
        if (pn > 2) { asm volatile("s_waitcnt vmcnt(4)" ::: "memory"); } else if (pn > 1) { asm volatile("s_waitcnt vmcnt(3)" ::: "memory"); } else { asm volatile("s_waitcnt vmcnt(2)" ::: "memory"); }
        __syncthreads();
        {
            float m = -INFINITY, l = 0.f;
            a_f32x16 st[2], Oc[2];
#pragma unroll
            for (int dt = 0; dt < 2; ++dt)
#pragma unroll
                for (int i = 0; i < 16; ++i) Oc[dt][i] = 0.f;
            for (int T = 0; T < ntc; ++T) {
                at_qk(lds + AT_KC + T * AT_TB, qf, st, off4, sl * (float)(1024 * T + 31 - tq), sl * 16.f, hh);
                at_mask(st, hh, 0, nlast - 64 * T);
                const float mt = at_rowmax(st);
                const float mn = fmaxf(m, mt), ms = (mn == -INFINITY) ? 0.f : mn;
                float ps = 0.f;
#pragma unroll
                for (int kt = 0; kt < 2; ++kt)
#pragma unroll
                    for (int i = 0; i < 16; ++i) ps += __builtin_amdgcn_exp2f(st[kt][i] - ms);
                l = l * __builtin_amdgcn_exp2f(m - ms) + ps; m = mn;
            }
            l = xhalf_sum(l);
            const float ms = (m == -INFINITY) ? 0.f : m, inv = l > 0.f ? 1.f / l : 0.f;
            LAS float* imp = (LAS float*)(lds + AT_IMP) + wid * 512 + ql * 64;
            for (int T = 0; T < ntc; ++T) {
                at_qk(lds + AT_KC + T * AT_TB, qf, st, off4, sl * (float)(1024 * T + 31 - tq) - ms, sl * 16.f, hh);
                at_mask(st, hh, 0, nlast - 64 * T);
#pragma unroll
                for (int kt = 0; kt < 2; ++kt)
#pragma unroll
                    for (int i = 0; i < 16; ++i) st[kt][i] = __builtin_amdgcn_exp2f(st[kt][i]) * inv;
#pragma unroll
                for (int kt = 0; kt < 2; ++kt)
#pragma unroll
                    for (int c = 0; c < 4; ++c) {
                        float qs = (st[kt][4 * c] + st[kt][4 * c + 1]) + (st[kt][4 * c + 2] + st[kt][4 * c + 3]), ls = st[kt][4 * c + 3];
                        qs += SHX(qs, 8); qs += SHX(qs, 16); ls += SHX(ls, 8); ls += SHX(ls, 16);
                        const int j = 16 * T + 8 * kt + 2 * c + hh;
                        if (hp == 0) { (void)__hip_atomic_fetch_add(imp + j, qs, __ATOMIC_RELAXED, __HIP_MEMORY_SCOPE_WORKGROUP); if (j < 63) (void)__hip_atomic_fetch_add(imp + j + 1, ls, __ATOMIC_RELAXED, __HIP_MEMORY_SCOPE_WORKGROUP); }
                    }
                { a_bf16x8 vf[2][4], pb[4]; at_pack(st, pb); at_vload(lds + AT_VC + T * AT_TB, vf, off4); at_pv(vf, pb, Oc); }
            }
#pragma unroll
            for (int dt = 0; dt < 2; ++dt)
#pragma unroll
                for (int i = 0; i < 16; ++i) Ot[dt][i] = gc * Oc[dt][i];
        }
        unsigned long long wor = 0ull;
        asm volatile("s_waitcnt lgkmcnt(0)" ::: "memory"); __builtin_amdgcn_wave_barrier();
        {
            const bool valid = lane <= cur, forced = (lane == 0) || (lane == cur) || (lane == cur - 1);
            const unsigned long long vmask = __ballot(valid);
            if (cur < 16) {
                if (lane == 0) {
#pragma unroll
                    for (int q = 0; q < 8; ++q) ((LAS unsigned long long*)(lds + AT_SELM))[wid * 8 + q] = vmask; }
                wor = vmask;
            } else {
                for (int q = 0; q < 8; q += 4) {
                    unsigned key[4], T[4];
#pragma unroll
                    for (int c = 0; c < 4; ++c) {
                        const float s = ((LAS float*)(lds + AT_IMP))[wid * 512 + (q + c) * 64 + lane];
                        const float sc = valid ? (forced ? 1e30f : s) : -1e30f;
                        const unsigned ub = __float_as_uint(sc); key[c] = (ub & 0x80000000u) ? ~ub : (ub | 0x80000000u); T[c] = 0u; }
#pragma unroll 1
                    for (int bit = 31; bit >= 0; --bit) {
#pragma unroll
                        for (int c = 0; c < 4; ++c) { const unsigned cand = T[c] | (1u << bit); if (__builtin_popcountll(__ballot(key[c] >= cand)) >= 16) T[c] = cand; } }
#pragma unroll
                    for (int c = 0; c < 4; ++c) {
                        unsigned long long selm = __ballot(key[c] > T[c]), eq = __ballot(key[c] == T[c]);
                        int need = 16 - __builtin_popcountll(selm);
                        for (; need > 0; --need) { const unsigned long long low = eq & (0ull - eq); selm |= low; eq ^= low; }
                        const unsigned long long mk = selm & vmask;
                        if (lane == 0) ((LAS unsigned long long*)(lds + AT_SELM))[wid * 8 + q + c] = mk;
                        wor |= mk; }
                }
            }
            if (lane == 0) ((LAS unsigned long long*)(lds + AT_WM))[wid] = wor;
        }
        __syncthreads();
        unsigned long long U = 0ull;
#pragma unroll
        for (int w = 0; w < 8; ++w) U |= ((LAS unsigned long long*)(lds + AT_WM))[w];
        U = ((unsigned long long)__builtin_amdgcn_readfirstlane((unsigned)(U >> 32)) << 32) | (unsigned long long)__builtin_amdgcn_readfirstlane((unsigned)U);
        { LAS float* gl = (LAS float*)(lds + AT_IMP) + wid * 128 + lane; gl[0] = gs; gl[64] = gw; if (dyn && wid == 0 && lane == 0) qslot[1] = knext; }
        AT_DERIVE(q0, g);
#define AT_OTP(v_) LAS float* v_; { int lx_; asm volatile("v_mbcnt_lo_u32_b32 %0, -1, 0\n\tv_mbcnt_hi_u32_b32 %0, -1, %0" : "=v"(lx_)); v_ = (LAS float*)(lds + AT_KC) + wid * 2048 + lx_ * 4; }
        { AT_OTP(otp);
#pragma unroll
        for (int c = 0; c < 8; ++c) *(LAS g8::f32x4*)(otp + c * 256) = g8::f32x4{Ot[c >> 2][4 * (c & 3)], Ot[c >> 2][4 * (c & 3) + 1], Ot[c >> 2][4 * (c & 3) + 2], Ot[c >> 2][4 * (c & 3) + 3]}; }
#define AT_SB() __builtin_amdgcn_sched_barrier(0)
#define AT_PIN(x) asm volatile("" : "+v"(x))
#define AT_MF(a, b, c) __builtin_amdgcn_mfma_f32_32x32x16_bf16(a, b, c, 0, 0, 0)
#define AT_WAIT_BAR(N) asm volatile("s_waitcnt vmcnt(" #N ") lgkmcnt(0)\n\ts_barrier" ::: "memory")
#define AT_KF(i) ((float)AT_REGOFF(i))
#define AT_PB(w) (*reinterpret_cast<a_bf16x8*>(&(w)))
#define AT_PK(P, i) pack_bf16(P[i], P[(i) + 1])
        for (int bi = 0; bi < 2; ++bi) {
            const int br = 1 - bi;
            const char* kbase = (const char*)((br == 0 ? kslc : kwin) + (size_t)bg * SEQ * 64);
            const char* vbase = (const char*)((br == 0 ? vslcT : vwinT) + (size_t)bg * 64 * SEQ);
            unsigned long long todo = ptodo;
            const int n = pn;
            const LAS unsigned* selp = (const LAS unsigned*)(lds + (br == 0 ? AT_SELM : AT_ONES)) + (br == 0 ? (wid * 8 + ql) * 2 : 0);
            float m = 0.f, l = 0.f, f_ = 1.f; bool resc_ = false;
            a_f32x16 O0, O1, pA0, pA1, pB0, pB1;
#pragma unroll
            for (int i = 0; i < 16; ++i) { O0[i] = 0.f; O1[i] = 0.f; }
            a_bf16x8 kf[8], vf[8]; au32x4 pw0, pw1, pw2, pw3;
            int sl_prev = 0, sl_cur = 0, sl_next = AT_TB;
#define AT_ROT() do { sl_prev = sl_cur; sl_cur = sl_next; sl_next = (sl_next == 2 * AT_TB) ? 0 : sl_next + AT_TB; } while (0)
#define AT_DMAK(jj, so) at_glds(lds + AT_KS + (so), kbase + (size_t)(jj) * 8192, ko, wid)
#define AT_DMAV(jj, so) at_glds(lds + AT_VS + (so), vbase + (size_t)(jj) * 128, voS, wid)
#define AT_POP(jv) do { jv = 63 - __builtin_clzll(todo); todo &= ~(1ull << jv); } while (0)
#define AT_BIAS(jj) ((((selp[(jj) >> 5] >> ((jj) & 31)) & 1u) != 0u) ? (sl * (float)(64 * (jj) - tqh) - m) : -INFINITY)
#define AT_KRD(s) do { kf[2 * (s)] = *(const LAS a_bf16x8*)(kb_ + off4[s]); kf[2 * (s) + 1] = *(const LAS a_bf16x8*)(kb_ + 4096 + off4[s]); } while (0)
#define AT_VRD(i) do { vf[i] = *(const LAS a_bf16x8*)(vp_ + 4096 * ((i) >> 2) + off4[(i) & 3]); } while (0)
            int q1 = pj0, q2 = pj1, q3 = pj2, jnew = 0;
            if (bi == 1) { AT_DMAV(q1, 0); AT_WAIT_BAR(1); } else { AT_WAIT_BAR(0); }
            {
                LAS unsigned char* kb_ = lds + AT_KS;
#pragma unroll
                for (int s = 0; s < 4; ++s) AT_KRD(s);
                const float b = AT_BIAS(q1); float slo = sl; AT_PIN(slo);
#pragma unroll
                for (int i = 0; i < 16; ++i) { pA0[i] = __builtin_fmaf(slo, AT_KF(i), b); pA1[i] = __builtin_fmaf(slo, AT_KF(i) + 32.f, b); }
#pragma unroll
                for (int s = 0; s < 4; ++s) { pA0 = AT_MF(kf[2 * s], qf[s], pA0); pA1 = AT_MF(kf[2 * s + 1], qf[s], pA1); }
                if (q1 == cur || (br == 1 && q1 == cur - 8)) { int lx_; asm volatile("v_mbcnt_lo_u32_b32 %0, -1, 0\n\tv_mbcnt_hi_u32_b32 %0, -1, %0" : "=v"(lx_)); const int tlx_ = wid * 8 + (lx_ & 7);
                    if (q1 == cur) at_mask2(pA0, pA1, lx_ >> 5, 0, tlx_); else at_mask2(pA0, pA1, lx_ >> 5, tlx_ + 1, 63); }
                const float rm = at_rowmax2(pA0, pA1), d = (rm == -INFINITY) ? 0.f : rm; m = d;
#pragma unroll
                for (int i = 0; i < 16; ++i) { pA0[i] = __builtin_amdgcn_exp2f(pA0[i] - d); pA1[i] = __builtin_amdgcn_exp2f(pA1[i] - d); }
            }
            AT_WAIT_BAR(0);
            q1 = q2; q2 = q3; q3 = 0;
            if (n > 3) { AT_POP(q3); AT_DMAK(q3, 0); }
            if (n > 1) AT_DMAV(q1, AT_TB);
            AT_ROT();
            {
                LAS unsigned char* kb_ = lds + AT_KS + sl_cur;
#pragma unroll
                for (int s = 0; s < 4; ++s) AT_KRD(s);
                const float b = AT_BIAS(q1); float slo = sl; AT_PIN(slo);
#pragma unroll
                for (int i = 0; i < 16; ++i) { pB0[i] = __builtin_fmaf(slo, AT_KF(i), b); pB1[i] = __builtin_fmaf(slo, AT_KF(i) + 32.f, b); }
            }
            if (n > 3) { AT_WAIT_BAR(2); } else if (n > 1) { AT_WAIT_BAR(1); } else { AT_WAIT_BAR(0); }
#define AT_GAPA(MF_, a0, a1, a2, a3, W0, W1, PW) do { MF_; sacc += a0; sacc += a1; sacc += a2; sacc += a3; W0; W1; AT_PIN(PW); AT_PIN(sacc); AT_SB(); } while (0)
#define AT_GAPB(MF_, X, i, Y, KO) do { MF_; X[i] = __builtin_amdgcn_exp2f(X[i]); X[(i) + 1] = __builtin_amdgcn_exp2f(X[(i) + 1]); X[(i) + 2] = __builtin_amdgcn_exp2f(X[(i) + 2]); X[(i) + 3] = __builtin_amdgcn_exp2f(X[(i) + 3]); \
        Y[i] = __builtin_fmaf(slo, AT_KF(i) + KO, bn); Y[(i) + 1] = __builtin_fmaf(slo, AT_KF((i) + 1) + KO, bn); Y[(i) + 2] = __builtin_fmaf(slo, AT_KF((i) + 2) + KO, bn); Y[(i) + 3] = __builtin_fmaf(slo, AT_KF((i) + 3) + KO, bn); \
        AT_PIN(X); AT_PIN(Y); AT_SB(); } while (0)
#define AT_STEP(C0, C1, P0, P1, t) do { AT_SB(); \
            const unsigned selw_ = selp[q2 >> 5];                                  \
            { LAS unsigned char* vp_ = lds + AT_VS + sl_prev; \
              AT_VRD(0); AT_SB(); float sacc = P0[0] + P0[1]; \
                                  AT_GAPA(C0 = AT_MF(kf[0], qf[0], C0), P0[2], P0[3], P0[4], P0[5],     pw0[0] = AT_PK(P0, 0),  pw0[1] = AT_PK(P0, 2),  pw0); \
              AT_VRD(4); AT_SB(); AT_GAPA(C1 = AT_MF(kf[1], qf[0], C1), P0[6], P0[7], P0[8], P0[9],     pw0[2] = AT_PK(P0, 4),  pw0[3] = AT_PK(P0, 6),  pw0); \
              AT_VRD(1); AT_SB(); AT_GAPA(C0 = AT_MF(kf[2], qf[1], C0), P0[10], P0[11], P0[12], P0[13], pw1[0] = AT_PK(P0, 8),  pw1[1] = AT_PK(P0, 10), pw1); \
              AT_VRD(5); AT_SB(); AT_GAPA(C1 = AT_MF(kf[3], qf[1], C1), P0[14], P0[15], P1[0], P1[1],   pw1[2] = AT_PK(P0, 12), pw1[3] = AT_PK(P0, 14), pw1); \
              AT_VRD(2); AT_SB(); AT_GAPA(C0 = AT_MF(kf[4], qf[2], C0), P1[2], P1[3], P1[4], P1[5],     pw2[0] = AT_PK(P1, 0),  pw2[1] = AT_PK(P1, 2),  pw2); \
              AT_VRD(6); AT_SB(); AT_GAPA(C1 = AT_MF(kf[5], qf[2], C1), P1[6], P1[7], P1[8], P1[9],     pw2[2] = AT_PK(P1, 4),  pw2[3] = AT_PK(P1, 6),  pw2); \
              AT_VRD(3); AT_SB(); AT_GAPA(C0 = AT_MF(kf[6], qf[3], C0), P1[10], P1[11], P1[12], P1[13], pw3[0] = AT_PK(P1, 8),  pw3[1] = AT_PK(P1, 10), pw3); \
              AT_VRD(7); AT_SB(); AT_GAPA(C1 = AT_MF(kf[7], qf[3], C1), P1[14], P1[15], 0.f, 0.f,       pw3[2] = AT_PK(P1, 12), pw3[3] = AT_PK(P1, 14), pw3); \
              l += sacc; } \
            jnew = 0; \
            if ((t) + 3 < n) { AT_POP(jnew); AT_DMAK(jnew, sl_cur); }              \
            if ((t) + 1 < n) AT_DMAV(q2, sl_next); \
            if (q1 == cur || (br == 1 && q1 == cur - 8)) { int lx_; asm volatile("v_mbcnt_lo_u32_b32 %0, -1, 0\n\tv_mbcnt_hi_u32_b32 %0, -1, %0" : "=v"(lx_)); const int tlx_ = wid * 8 + (lx_ & 7); \
                if (q1 == cur) at_mask2(C0, C1, lx_ >> 5, 0, tlx_); else at_mask2(C0, C1, lx_ >> 5, tlx_ + 1, 63); } \
            resc_ = false; \
            { const float rm = at_rowmax2(C0, C1); \
              if (__any(rm > 6.f)) { const float dl = fmaxf(rm, 0.f); m += dl; f_ = __builtin_amdgcn_exp2f(-dl); l *= f_; resc_ = true; \
                  _Pragma("unroll") for (int i_ = 0; i_ < 16; ++i_) { C0[i_] -= dl; C1[i_] -= dl; } } } \
            { const float bn = (((selw_ >> (q2 & 31)) & 1u) != 0u) ? (sl * (float)(64 * q2 - tqh) - m) : -INFINITY; float slo = sl; AT_PIN(slo); LAS unsigned char* kb_ = lds + AT_KS + sl_next; AT_SB(); \
              AT_GAPB(O0 = AT_MF(vf[0], AT_PB(pw0), O0), C0, 0, P0, 0.f);                              AT_GAPB(O1 = AT_MF(vf[4], AT_PB(pw0), O1), C0, 4, P0, 0.f); \
              AT_KRD(0); AT_SB(); AT_GAPB(O0 = AT_MF(vf[1], AT_PB(pw1), O0), C0, 8, P0, 0.f);          AT_KRD(1); AT_SB(); AT_GAPB(O1 = AT_MF(vf[5], AT_PB(pw1), O1), C0, 12, P0, 0.f); \
              AT_KRD(2); AT_SB(); AT_GAPB(O0 = AT_MF(vf[2], AT_PB(pw2), O0), C1, 0, P1, 32.f);         AT_KRD(3); AT_SB(); AT_GAPB(O1 = AT_MF(vf[6], AT_PB(pw2), O1), C1, 4, P1, 32.f); \
              AT_GAPB(O0 = AT_MF(vf[3], AT_PB(pw3), O0), C1, 8, P1, 32.f);                             AT_GAPB(O1 = AT_MF(vf[7], AT_PB(pw3), O1), C1, 12, P1, 32.f); } \
            if ((t) + 3 < n) { AT_WAIT_BAR(2); } else if ((t) + 2 < n) { AT_WAIT_BAR(1); } else { AT_WAIT_BAR(0); } \
            if (resc_) { _Pragma("unroll") for (int i_ = 0; i_ < 16; ++i_) { O0[i_] *= f_; O1[i_] *= f_; } } \
            AT_ROT(); q1 = q2; q2 = q3; q3 = jnew; \
            } while (0)
            int t = 1;
            for (; t + 1 < n; t += 2) {
                AT_STEP(pB0, pB1, pA0, pA1, t);
                AT_STEP(pA0, pA1, pB0, pB1, t + 1);
            }
            if (t < n) { AT_STEP(pB0, pB1, pA0, pA1, t); pA0 = pB0; pA1 = pB1; }
            if (bi == 0) {
                const char* kbs = (const char*)(kslc + (size_t)bg * SEQ * 64);
                ptodo = U; pn = __builtin_popcountll(U); pj1 = 0; pj2 = 0;
                pj0 = 63 - __builtin_clzll(ptodo); ptodo &= ~(1ull << pj0); at_glds(lds + AT_KS, kbs + (size_t)pj0 * 8192, ko, wid);
                if (pn > 1) { pj1 = 63 - __builtin_clzll(ptodo); ptodo &= ~(1ull << pj1); at_glds(lds + AT_KS + AT_TB, kbs + (size_t)pj1 * 8192, ko, wid); }
                if (pn > 2) { pj2 = 63 - __builtin_clzll(ptodo); ptodo &= ~(1ull << pj2); at_glds(lds + AT_KS + 2 * AT_TB, kbs + (size_t)pj2 * 8192, ko, wid); }
            }
            {
                float sacc = 0.f;
#pragma unroll
                for (int i = 0; i < 16; ++i) sacc += pA0[i] + pA1[i];
                l += sacc;
                pw0 = au32x4{AT_PK(pA0, 0), AT_PK(pA0, 2), AT_PK(pA0, 4), AT_PK(pA0, 6)}; pw1 = au32x4{AT_PK(pA0, 8), AT_PK(pA0, 10), AT_PK(pA0, 12), AT_PK(pA0, 14)};
                pw2 = au32x4{AT_PK(pA1, 0), AT_PK(pA1, 2), AT_PK(pA1, 4), AT_PK(pA1, 6)}; pw3 = au32x4{AT_PK(pA1, 8), AT_PK(pA1, 10), AT_PK(pA1, 12), AT_PK(pA1, 14)};
                LAS unsigned char* vp_ = lds + AT_VS + sl_prev;
#pragma unroll
                for (int i = 0; i < 8; ++i) AT_VRD(i);
                O0 = AT_MF(vf[0], AT_PB(pw0), O0); O1 = AT_MF(vf[4], AT_PB(pw0), O1); O0 = AT_MF(vf[1], AT_PB(pw1), O0); O1 = AT_MF(vf[5], AT_PB(pw1), O1);
                O0 = AT_MF(vf[2], AT_PB(pw2), O0); O1 = AT_MF(vf[6], AT_PB(pw2), O1); O0 = AT_MF(vf[3], AT_PB(pw3), O0); O1 = AT_MF(vf[7], AT_PB(pw3), O1);
            }
            l = xhalf_sum(l);
            int lb_; asm volatile("v_mbcnt_lo_u32_b32 %0, -1, 0\n\tv_mbcnt_hi_u32_b32 %0, -1, %0" : "=v"(lb_));
            const float gsc = ((LAS float*)(lds + AT_IMP))[wid * 128 + lb_ + 64 * br] / l;
            AT_OTP(otp);
#pragma unroll
            for (int c = 0; c < 8; ++c) {
                g8::f32x4 v = *(LAS g8::f32x4*)(otp + c * 256);
                if (c < 4) { v[0] += gsc * O0[4 * c]; v[1] += gsc * O0[4 * c + 1]; v[2] += gsc * O0[4 * c + 2]; v[3] += gsc * O0[4 * c + 3]; }
                else { v[0] += gsc * O1[4 * (c - 4)]; v[1] += gsc * O1[4 * (c - 4) + 1]; v[2] += gsc * O1[4 * (c - 4) + 2]; v[3] += gsc * O1[4 * (c - 4) + 3]; }
                *(LAS g8::f32x4*)(otp + c * 256) = v;
            }
            asm volatile("s_waitcnt lgkmcnt(0)\n\ts_barrier" ::: "memory");
        }
#undef AT_STEP
#undef AT_GAPA
#undef AT_GAPB
#undef AT_ROT
#undef AT_DMAK
#undef AT_DMAV
#undef AT_POP
#undef AT_BIAS
#undef AT_KRD
#undef AT_VRD
        AT_OTP(otp);
#pragma unroll
        for (int c = 0; c < 8; ++c) { const g8::f32x4 v = *(LAS g8::f32x4*)(otp + c * 256); Ot[c >> 2][4 * (c & 3)] = v[0]; Ot[c >> 2][4 * (c & 3) + 1] = v[1]; Ot[c >> 2][4 * (c & 3) + 2] = v[2]; Ot[c >> 2][4 * (c & 3) + 3] = v[3]; }
        int l2; asm volatile("v_mbcnt_lo_u32_b32 %0, -1, 0\n\tv_mbcnt_hi_u32_b32 %0, -1, %0" : "=v"(l2));
        const int r2 = l2 & 31;
        unsigned short* orow = ob + (size_t)(b * SEQ + q0 + wid * 8 + (r2 & 7)) * 1024 + (g * 4 + (r2 >> 3)) * 64 + 8 * (l2 >> 5);
#pragma unroll
        for (int dt = 0; dt < 2; ++dt)
#pragma unroll
            for (int c = 0; c < 4; c += 2) {
                unsigned ax = pack_bf16(Ot[dt][4 * c], Ot[dt][4 * c + 1]), ay = pack_bf16(Ot[dt][4 * c + 2], Ot[dt][4 * c + 3]);
                unsigned bx = pack_bf16(Ot[dt][4 * c + 4], Ot[dt][4 * c + 5]), by = pack_bf16(Ot[dt][4 * c + 6], Ot[dt][4 * c + 7]);
                const auto rx = __builtin_amdgcn_permlane32_swap(ax, bx, false, false); const auto ry = __builtin_amdgcn_permlane32_swap(ay, by, false, false);
                *(uint4*)(orow + 32 * dt + 8 * c) = make_uint4(rx[0], ry[0], rx[1], ry[1]); }
        asm volatile("s_waitcnt lgkmcnt(0)\n\ts_barrier" ::: "memory");
        if (dyn) kq = qslot[1]; else { I += nb_s; ++it; }
    }
}
__device__ __forceinline__ float bf2f(unsigned short v) { return __uint_as_float(((unsigned)v) << 16); }
__device__ __forceinline__ void ph_gla_p1(const unsigned short* qk, const float* glr, const unsigned short* vT, const float* w2, const float* bgate,
                                          unsigned short* qd, unsigned short* ki, float* dl, unsigned short* UT, LAS unsigned char* lds) {
    LAUNDER();
    const int wid = wv_s, lane = tid_ & 63, r = lane & 31, hh = lane >> 5;
    LAS float* gsum = (LAS float*)lds;
    LAS float* gl = (LAS float*)(lds + 2048);
    LAS unsigned char* ket = lds + 2048 + 4096;
    const int d = tid_ & 127, sg = tid_ >> 7;
    float glp0 = 0.f, glp1 = 0.f, wp[16], bgp = 0.f;
    if (bid_ < 2048) { const int h = bid_ & 3, c = (bid_ >> 2) & 63, b = bid_ >> 8, tok0 = b * SEQ + c * 64;
        glp0 = glr[(size_t)tok0 * 16 + tid_]; glp1 = glr[(size_t)tok0 * 16 + tid_ + 512];
#pragma unroll
        for (int k = 0; k < 16; ++k) wp[k] = w2[k * 512 + h * 128 + d];
        bgp = bgate[h * 128 + d]; }
    for (int it = bid_; it < 2048; it += nb_s) {
        const int h = it & 3, c = (it >> 2) & 63, b = it >> 8, bh = b * 4 + h, tok0 = b * SEQ + c * 64;
        a_bf16x8 vfr[4];
        { const unsigned short* vrow = vT + ((size_t)bh * 256 + 32 * wid + r) * SEQ + c * 64;
#pragma unroll
          for (int ks = 0; ks < 4; ++ks) vfr[ks] = *(const a_bf16x8*)(vrow + 16 * ks + 8 * hh); }
        unsigned short qraw[16], kraw[16];
#pragma unroll
        for (int i = 0; i < 16; ++i) { const size_t o = (size_t)(tok0 + sg * 16 + i) * 1024 + h * 128 + d; qraw[i] = qk[o]; kraw[i] = qk[o + 512]; }
        gl[tid_] = glp0; gl[tid_ + 512] = glp1;
        float w[16];
#pragma unroll
        for (int k = 0; k < 16; ++k) w[k] = wp[k];
        const float bgv = bgp;
        { const int itn = it + nb_s;
          if (itn < 2048) { const int hn = itn & 3, cn = (itn >> 2) & 63, bn = itn >> 8, tokn = bn * SEQ + cn * 64;
              glp0 = glr[(size_t)tokn * 16 + tid_]; glp1 = glr[(size_t)tokn * 16 + tid_ + 512];
#pragma unroll
              for (int k = 0; k < 16; ++k) wp[k] = w2[k * 512 + hn * 128 + d];
              bgp = bgate[hn * 128 + d]; } }
        __syncthreads();
        float la[16]; float run = 0.f;
#pragma unroll
        for (int i = 0; i < 16; ++i) { const int s = sg * 16 + i; float z = bgv;
#pragma unroll
            for (int k = 0; k < 16; ++k) z += gl[s * 16 + k] * w[k];
            run += fast_logsigmoid(z) * (1.f / 16.f); la[i] = run; }
        gsum[sg * 128 + d] = run;
        __syncthreads();
        float pre = 0.f, tot = 0.f;
#pragma unroll
        for (int g = 0; g < 4; ++g) { const float v = gsum[g * 128 + d]; tot += v; pre += (g < sg) ? v : 0.f; }
        const float etot = fast_exp(tot);
#pragma unroll
        for (int i = 0; i < 16; ++i) { const int s = sg * 16 + i; const float bb = la[i] + pre;
            const float q = bf2f(qraw[i]), k = bf2f(kraw[i]);
            const float eb = fast_exp(bb), ieb = __builtin_amdgcn_rcpf(eb);
            qd[(size_t)(tok0 + s) * 512 + h * 128 + d] = f2bf(q * 0.08838834764831845f * eb);
            ki[(size_t)(tok0 + s) * 512 + h * 128 + d] = f2bf(k * ieb);
            *(LAS unsigned short*)(ket + d * 144 + s * 2) = f2bf(k * (etot * ieb)); }
        if (sg == 0) dl[(size_t)(bh * 64 + c) * 128 + d] = etot;
        __syncthreads();
        a_f32x16 acc[4];
#pragma unroll
        for (int dt = 0; dt < 4; ++dt)
#pragma unroll
            for (int i = 0; i < 16; ++i) acc[dt][i] = 0.f;
#pragma unroll
        for (int ks = 0; ks < 4; ++ks) {
            a_bf16x8 bfr[4];
#pragma unroll
            for (int dt = 0; dt < 4; ++dt) bfr[dt] = *(const LAS a_bf16x8*)(ket + (32 * dt + r) * 144 + (16 * ks + 8 * hh) * 2);
            __builtin_amdgcn_sched_barrier(0);
#pragma unroll
            for (int dt = 0; dt < 4; ++dt) acc[dt] = __builtin_amdgcn_mfma_f32_32x32x16_bf16(bfr[dt], vfr[ks], acc[dt], 0, 0, 0); }
        unsigned short* urow = UT + (size_t)(bh * 64 + c) * 256 * 128 + (size_t)(32 * wid + r) * 128 + 8 * hh;
#pragma unroll
        for (int dt = 0; dt < 4; ++dt)
#pragma unroll
            for (int c2 = 0; c2 < 4; c2 += 2) {
                const unsigned ax = pack_bf16_v(acc[dt][4 * c2], acc[dt][4 * c2 + 1]), ay = pack_bf16_v(acc[dt][4 * c2 + 2], acc[dt][4 * c2 + 3]);
                const unsigned bx = pack_bf16_v(acc[dt][4 * c2 + 4], acc[dt][4 * c2 + 5]), by = pack_bf16_v(acc[dt][4 * c2 + 6], acc[dt][4 * c2 + 7]);
                const auto rx = __builtin_amdgcn_permlane32_swap(ax, bx, false, false); const auto ry = __builtin_amdgcn_permlane32_swap(ay, by, false, false);
                *(uint4*)(urow + 32 * dt + 8 * c2) = make_uint4(rx[0], ry[0], rx[1], ry[1]); }
        __syncthreads();
    }
}
__device__ __forceinline__ void ph_gla_p2(const unsigned short* __restrict__ UT, const float* __restrict__ dl, unsigned short* __restrict__ ST) {
    LAUNDER();
#define GP2_LOAD(uu, dv, c0) do { _Pragma("unroll") for (int k_ = 0; k_ < 8; ++k_) { const size_t o_ = ((size_t)(bh * 64 + (c0) + k_) * 256 + e) * 128 + d4; \
        uu[k_] = *(const uint2*)(UT + o_); dv[k_] = *(const float4*)(dl + (size_t)(bh * 64 + (c0) + k_) * 128 + d4); } } while (0)
#define GP2_STEP(uu, dv, c0) do { _Pragma("unroll") for (int k_ = 0; k_ < 8; ++k_) { const size_t o_ = ((size_t)(bh * 64 + (c0) + k_) * 256 + e) * 128 + d4; \
        *(uint2*)(ST + o_) = make_uint2(pack_bf16(S.x, S.y), pack_bf16(S.z, S.w)); \
        S.x = S.x * dv[k_].x + bf2f((unsigned short)(uu[k_].x & 0xffff)); S.y = S.y * dv[k_].y + bf2f((unsigned short)(uu[k_].x >> 16)); \
        S.z = S.z * dv[k_].z + bf2f((unsigned short)(uu[k_].y & 0xffff)); S.w = S.w * dv[k_].w + bf2f((unsigned short)(uu[k_].y >> 16)); } } while (0)
    for (int idx = GTID; idx < 32 * 256 * 32; idx += GSZ) {
        const int bh = idx >> 13, rem = idx & 8191, e = rem >> 5, d4 = (rem & 31) * 4;
        float4 S = make_float4(0.f, 0.f, 0.f, 0.f);
        uint2 ua[8], ub[8]; float4 da[8], db[8];
        GP2_LOAD(ua, da, 0);
#pragma unroll 1
        for (int c0 = 0; c0 < 64; c0 += 16) {
            GP2_LOAD(ub, db, c0 + 8);
            GP2_STEP(ua, da, c0);
            if (c0 + 16 < 64) GP2_LOAD(ua, da, c0 + 16);
            GP2_STEP(ub, db, c0 + 8);
        }
    }
#undef GP2_LOAD
#undef GP2_STEP
}
__device__ __forceinline__ void ph_gla_p3(const unsigned short* qd, const unsigned short* ki, const unsigned short* vT, const unsigned short* ST, const unsigned short* rb,
                                          const float* ng, unsigned short* ob, LAS unsigned char* lds) {
    LAUNDER();
    const int wid = wv_s, lane = tid_ & 63, r = lane & 31, hh = lane >> 5;
    constexpr int PQ = 272;
    LAS unsigned char* QS = lds; LAS unsigned char* KS = lds + 64 * PQ; LAS float* SSQ = (LAS float*)(lds + 2 * 64 * PQ);
    LAS float* NGL = SSQ + 512;
    if (tid_ < 256) *(LAS g8::f32x4*)(NGL + tid_ * 4) = *(const g8::f32x4*)(ng + tid_ * 4);
    au32x4 qpre[2], kpre[2];
    if (bid_ < 2048) { const int h = bid_ & 3, c = (bid_ >> 2) & 63, b = bid_ >> 8, tok0 = b * SEQ + c * 64; const int row = tid_ >> 3, ch = tid_ & 7;
#pragma unroll
        for (int j = 0; j < 2; ++j) { qpre[j] = *(const au32x4*)(qd + (size_t)(tok0 + row) * 512 + h * 128 + (ch + 8 * j) * 8); kpre[j] = *(const au32x4*)(ki + (size_t)(tok0 + row) * 512 + h * 128 + (ch + 8 * j) * 8); } }
    for (int it = bid_; it < 2048; it += nb_s) {
        const int h = it & 3, c = (it >> 2) & 63, b = it >> 8, bh = b * 4 + h, tok0 = b * SEQ + c * 64;
        a_bf16x8 sf[8]; au32x2 vlo[3][2], vhi[3][2];
        uint2 rgp[2][4];
#pragma unroll
        for (int qt = 0; qt < 2; ++qt)
#pragma unroll
            for (int c4 = 0; c4 < 4; ++c4) rgp[qt][c4] = *(const uint2*)(rb + (size_t)(tok0 + 32 * qt + r) * 1024 + h * 256 + 32 * wid + 8 * c4 + 4 * hh);
        { const unsigned short* srow = ST + ((size_t)(bh * 64 + c) * 256 + 32 * wid + r) * 128;
          const unsigned short* vrow = vT + ((size_t)bh * 256 + 32 * wid + r) * SEQ + c * 64;
#pragma unroll
          for (int ks = 0; ks < 8; ++ks) sf[ks] = *(const a_bf16x8*)(srow + 16 * ks + 8 * hh);
#pragma unroll
          for (int t3 = 0; t3 < 3; ++t3) { const int st = t3 == 2 ? 1 : 0;
#pragma unroll
              for (int s2 = 0; s2 < 2; ++s2) { vlo[t3][s2] = *(const au32x2*)(vrow + 32 * st + 16 * s2 + 4 * hh); vhi[t3][s2] = *(const au32x2*)(vrow + 32 * st + 16 * s2 + 4 * hh + 8); } } }
        { const int row = tid_ >> 3, ch = tid_ & 7;
#pragma unroll
          for (int j = 0; j < 2; ++j) { *(LAS au32x4*)(QS + row * PQ + (ch + 8 * j) * 16) = qpre[j]; *(LAS au32x4*)(KS + row * PQ + (ch + 8 * j) * 16) = kpre[j]; }
          const int itn = it + nb_s;
          if (itn < 2048) { const int hn = itn & 3, cn = (itn >> 2) & 63, bn = itn >> 8, tokn = bn * SEQ + cn * 64;
#pragma unroll
              for (int j = 0; j < 2; ++j) { qpre[j] = *(const au32x4*)(qd + (size_t)(tokn + row) * 512 + hn * 128 + (ch + 8 * j) * 8); kpre[j] = *(const au32x4*)(ki + (size_t)(tokn + row) * 512 + hn * 128 + (ch + 8 * j) * 8); } } }
        __syncthreads();
        a_bf16x8 qfr[2][8];
#pragma unroll
        for (int qt = 0; qt < 2; ++qt)
#pragma unroll
            for (int ks = 0; ks < 8; ++ks) qfr[qt][ks] = *(const LAS a_bf16x8*)(QS + (32 * qt + r) * PQ + (16 * ks + 8 * hh) * 2);
        a_f32x16 att[3];
#pragma unroll
        for (int st = 0; st < 2; ++st) {
            a_bf16x8 kfr[8];
#pragma unroll
            for (int ks = 0; ks < 8; ++ks) kfr[ks] = *(const LAS a_bf16x8*)(KS + (32 * st + r) * PQ + (16 * ks + 8 * hh) * 2);
            __builtin_amdgcn_sched_barrier(0);
            if (st == 0) {
                a_f32x16 a0, a1;
#pragma unroll
                for (int i = 0; i < 16; ++i) { a0[i] = 0.f; a1[i] = 0.f; }
#pragma unroll
                for (int ks = 0; ks < 8; ++ks) { a0 = __builtin_amdgcn_mfma_f32_32x32x16_bf16(kfr[ks], qfr[0][ks], a0, 0, 0, 0); a1 = __builtin_amdgcn_mfma_f32_32x32x16_bf16(kfr[ks], qfr[1][ks], a1, 0, 0, 0); }
#pragma unroll
                for (int i = 0; i < 16; ++i) a0[i] = (AT_REGOFF(i) + 4 * hh <= r) ? a0[i] : 0.f;
                att[0] = a0; att[1] = a1;
            } else {
                a_f32x16 a2;
#pragma unroll
                for (int i = 0; i < 16; ++i) a2[i] = 0.f;
#pragma unroll
                for (int ks = 0; ks < 8; ++ks) a2 = __builtin_amdgcn_mfma_f32_32x32x16_bf16(kfr[ks], qfr[1][ks], a2, 0, 0, 0);
#pragma unroll
                for (int i = 0; i < 16; ++i) a2[i] = (AT_REGOFF(i) + 4 * hh <= r) ? a2[i] : 0.f;
                att[2] = a2;
            }
        }
        a_f32x16 O[2];
#pragma unroll
        for (int qt = 0; qt < 2; ++qt)
#pragma unroll
            for (int i = 0; i < 16; ++i) O[qt][i] = 0.f;
#pragma unroll
        for (int ks = 0; ks < 8; ++ks) {
            O[0] = __builtin_amdgcn_mfma_f32_32x32x16_bf16(sf[ks], qfr[0][ks], O[0], 0, 0, 0);
            O[1] = __builtin_amdgcn_mfma_f32_32x32x16_bf16(sf[ks], qfr[1][ks], O[1], 0, 0, 0); }
#pragma unroll
        for (int t3 = 0; t3 < 3; ++t3) { const int qt = t3 == 0 ? 0 : 1;
#pragma unroll
            for (int s2 = 0; s2 < 2; ++s2) {
                au32x4 pw = {pack_bf16(att[t3][8 * s2 + 0], att[t3][8 * s2 + 1]), pack_bf16(att[t3][8 * s2 + 2], att[t3][8 * s2 + 3]), pack_bf16(att[t3][8 * s2 + 4], att[t3][8 * s2 + 5]), pack_bf16(att[t3][8 * s2 + 6], att[t3][8 * s2 + 7])};
                au32x4 aw = {vlo[t3][s2].x, vlo[t3][s2].y, vhi[t3][s2].x, vhi[t3][s2].y};
                O[qt] = __builtin_amdgcn_mfma_f32_32x32x16_bf16(*reinterpret_cast<a_bf16x8*>(&aw), *reinterpret_cast<a_bf16x8*>(&pw), O[qt], 0, 0, 0); } }
#pragma unroll
        for (int qt = 0; qt < 2; ++qt) { float ss = 0.f;
#pragma unroll
            for (int i = 0; i < 16; ++i) ss += O[qt][i] * O[qt][i];
            ss = xhalf_sum(ss); if (hh == 0) SSQ[wid * 64 + 32 * qt + r] = ss; }
        __syncthreads();
#pragma unroll
        for (int qt = 0; qt < 2; ++qt) { float tot = 0.f;
#pragma unroll
            for (int w = 0; w < 8; ++w) tot += SSQ[w * 64 + 32 * qt + r];
            const float rn = rsqrtf(tot * (1.f / 256.f) + 1e-5f);
            const size_t orow = (size_t)(tok0 + 32 * qt + r) * 1024 + h * 256;
            unsigned pk[4][2];
#pragma unroll
            for (int c4 = 0; c4 < 4; ++c4) { const int e0 = 32 * wid + 8 * c4 + 4 * hh;
                const uint2 rg = rgp[qt][c4]; const g8::f32x4 gq = *(const LAS g8::f32x4*)(NGL + h * 256 + e0); const float4 gv = make_float4(gq[0], gq[1], gq[2], gq[3]);
                const float r0 = bf2f((unsigned short)(rg.x & 0xffff)), r1 = bf2f((unsigned short)(rg.x >> 16)), r2 = bf2f((unsigned short)(rg.y & 0xffff)), r3 = bf2f((unsigned short)(rg.y >> 16));
                pk[c4][0] = pack_bf16(O[qt][4 * c4] * rn * gv.x * fast_silu(r0), O[qt][4 * c4 + 1] * rn * gv.y * fast_silu(r1));
                pk[c4][1] = pack_bf16(O[qt][4 * c4 + 2] * rn * gv.z * fast_silu(r2), O[qt][4 * c4 + 3] * rn * gv.w * fast_silu(r3)); }
#pragma unroll
            for (int c4 = 0; c4 < 4; c4 += 2) {
                const auto rx = __builtin_amdgcn_permlane32_swap(pk[c4][0], pk[c4 + 1][0], false, false); const auto ry = __builtin_amdgcn_permlane32_swap(pk[c4][1], pk[c4 + 1][1], false, false);
                *(uint4*)(ob + orow + 32 * wid + 8 * c4 + 8 * hh) = make_uint4(rx[0], ry[0], rx[1], ry[1]); } }
        __syncthreads();
    }
}
__device__ __forceinline__ void ph_norm_router(const unsigned short* x, const float* g, const float* shift, const float* scale, int ldmod, unsigned short* hb,
                                               const float* rw, const float* rbias, int* topi, float* topw, int* cntb, int* stok, LAS unsigned char* lds) {
    LAUNDER();
    const int wid = wv_s, lane = tid_ & 63, e = lane & 31, kh = lane >> 5;
    LAS float* hs = (LAS float*)lds;
    constexpr int HSP = 1028;
    LAS float* part = (LAS float*)(lds + 16 * HSP * 4);
    LAS int* hist = (LAS int*)(lds + 16 * HSP * 4 + 16384);
    for (int i = GTID; i < CAP; i += GSZ) stok[i] = -1;
    g8::bf16x8 wh[4][2], wl[4][2];
#pragma unroll
    for (int ks = 0; ks < 4; ++ks)
#pragma unroll
        for (int nt = 0; nt < 2; ++nt) {
            unsigned hw[4], lw[4];
#pragma unroll
            for (int j2 = 0; j2 < 4; ++j2) { float w0 = rw[(128 * wid + 32 * ks + 8 * (lane >> 4) + 2 * j2) * 32 + 16 * nt + (lane & 15)], w1 = rw[(128 * wid + 32 * ks + 8 * (lane >> 4) + 2 * j2 + 1) * 32 + 16 * nt + (lane & 15)];
                const unsigned hp2 = pack_bf16(w0, w1); hw[j2] = hp2;
                lw[j2] = pack_bf16(w0 - __uint_as_float(hp2 << 16), w1 - __uint_as_float(hp2 & 0xffff0000u)); }
            au32x4 hv = {hw[0], hw[1], hw[2], hw[3]}, lv = {lw[0], lw[1], lw[2], lw[3]};
            wh[ks][nt] = *reinterpret_cast<g8::bf16x8*>(&hv); wl[ks][nt] = *reinterpret_cast<g8::bf16x8*>(&lv); }
    const float rbv = rbias[e];
    if (tid_ < 32) hist[tid_] = 0;
    __syncthreads();
    uint2 xr[2][4];
    float4 gg4[4], scn[4], shn[4];
#pragma unroll
    for (int j = 0; j < 4; ++j) gg4[j] = *(const float4*)(g + j * 256 + lane * 4);
    if (bid_ < NT / 16) {
#pragma unroll
        for (int rr = 0; rr < 2; ++rr)
#pragma unroll
            for (int j = 0; j < 4; ++j) xr[rr][j] = *(const uint2*)(x + (size_t)(bid_ * 16 + wid * 2 + rr) * DM + j * 256 + lane * 4);
        const int b0 = bid_ * 16 / SEQ;
#pragma unroll
        for (int j = 0; j < 4; ++j) { scn[j] = *(const float4*)(scale + b0 * ldmod + j * 256 + lane * 4); shn[j] = *(const float4*)(shift + b0 * ldmod + j * 256 + lane * 4); }
    }
    for (int tile = bid_; tile < NT / 16; tile += nb_s) {
        float4 ga4[4], sh4[4];
#pragma unroll
        for (int j = 0; j < 4; ++j) { ga4[j] = make_float4(gg4[j].x * (1.f + scn[j].x), gg4[j].y * (1.f + scn[j].y), gg4[j].z * (1.f + scn[j].z), gg4[j].w * (1.f + scn[j].w)); sh4[j] = shn[j]; }
#pragma unroll
        for (int rr = 0; rr < 2; ++rr) {
            const int trow = wid * 2 + rr, row = tile * 16 + trow;
            float4 v[4]; float ss = 0.f;
#pragma unroll
            for (int j = 0; j < 4; ++j) { const uint2 u = xr[rr][j]; v[j] = make_float4(__uint_as_float(u.x << 16), __uint_as_float(u.x & 0xffff0000u), __uint_as_float(u.y << 16), __uint_as_float(u.y & 0xffff0000u)); ss += v[j].x * v[j].x + v[j].y * v[j].y + v[j].z * v[j].z + v[j].w * v[j].w; }
#pragma unroll
            for (int o = 32; o > 0; o >>= 1) ss += SHX(ss, o);
            const float rn = rsqrtf(ss * (1.f / DM) + 1e-5f);
#pragma unroll
            for (int j = 0; j < 4; ++j) { const int col = j * 256 + lane * 4;
                float4 y;
                y.x = v[j].x * rn * ga4[j].x + sh4[j].x; y.y = v[j].y * rn * ga4[j].y + sh4[j].y; y.z = v[j].z * rn * ga4[j].z + sh4[j].z; y.w = v[j].w * rn * ga4[j].w + sh4[j].w;
                *(uint2*)(hb + (size_t)row * DM + col) = make_uint2(pack_bf16(y.x, y.y), pack_bf16(y.z, y.w));
                *(LAS g8::f32x4*)(hs + trow * HSP + col) = (g8::f32x4){y.x, y.y, y.z, y.w}; }
        }
        if (tile + nb_s < NT / 16) {
#pragma unroll
            for (int rr = 0; rr < 2; ++rr)
#pragma unroll
                for (int j = 0; j < 4; ++j) xr[rr][j] = *(const uint2*)(x + (size_t)((tile + nb_s) * 16 + wid * 2 + rr) * DM + j * 256 + lane * 4);
            const int bn = (tile + nb_s) * 16 / SEQ;
#pragma unroll
            for (int j = 0; j < 4; ++j) { scn[j] = *(const float4*)(scale + bn * ldmod + j * 256 + lane * 4); shn[j] = *(const float4*)(shift + bn * ldmod + j * 256 + lane * 4); }
        }
        __syncthreads();
        {
            g8::f32x4 acc0 = {0.f, 0.f, 0.f, 0.f}, acc1 = {0.f, 0.f, 0.f, 0.f};
            const LAS float* hp_ = hs + (lane & 15) * HSP + 128 * wid + 8 * (lane >> 4);
#pragma unroll
            for (int ks = 0; ks < 4; ++ks) {
                const g8::f32x4 x0 = *(const LAS g8::f32x4*)(hp_ + 32 * ks), x1 = *(const LAS g8::f32x4*)(hp_ + 32 * ks + 4);
                unsigned hh_[4], ll_[4];
                { unsigned p;
                  p = pack_bf16(x0[0], x0[1]); hh_[0] = p; ll_[0] = pack_bf16(x0[0] - __uint_as_float(p << 16), x0[1] - __uint_as_float(p & 0xffff0000u));
                  p = pack_bf16(x0[2], x0[3]); hh_[1] = p; ll_[1] = pack_bf16(x0[2] - __uint_as_float(p << 16), x0[3] - __uint_as_float(p & 0xffff0000u));
                  p = pack_bf16(x1[0], x1[1]); hh_[2] = p; ll_[2] = pack_bf16(x1[0] - __uint_as_float(p << 16), x1[1] - __uint_as_float(p & 0xffff0000u));
                  p = pack_bf16(x1[2], x1[3]); hh_[3] = p; ll_[3] = pack_bf16(x1[2] - __uint_as_float(p << 16), x1[3] - __uint_as_float(p & 0xffff0000u)); }
                au32x4 hv = {hh_[0], hh_[1], hh_[2], hh_[3]}, lv = {ll_[0], ll_[1], ll_[2], ll_[3]};
                const g8::bf16x8 ah = *reinterpret_cast<g8::bf16x8*>(&hv), al = *reinterpret_cast<g8::bf16x8*>(&lv);
                acc0 = __builtin_amdgcn_mfma_f32_16x16x32_bf16(ah, wh[ks][0], acc0, 0, 0, 0); acc1 = __builtin_amdgcn_mfma_f32_16x16x32_bf16(ah, wh[ks][1], acc1, 0, 0, 0);
                acc0 = __builtin_amdgcn_mfma_f32_16x16x32_bf16(ah, wl[ks][0], acc0, 0, 0, 0); acc1 = __builtin_amdgcn_mfma_f32_16x16x32_bf16(ah, wl[ks][1], acc1, 0, 0, 0);
                acc0 = __builtin_amdgcn_mfma_f32_16x16x32_bf16(al, wh[ks][0], acc0, 0, 0, 0); acc1 = __builtin_amdgcn_mfma_f32_16x16x32_bf16(al, wh[ks][1], acc1, 0, 0, 0);
            }
#pragma unroll
            for (int rg = 0; rg < 4; ++rg) { part[(wid * 16 + 4 * (lane >> 4) + rg) * 32 + (lane & 15)] = acc0[rg]; part[(wid * 16 + 4 * (lane >> 4) + rg) * 32 + 16 + (lane & 15)] = acc1[rg]; }
        }
        __syncthreads();
#pragma unroll 1
        for (int rr = 0; rr < 2; ++rr) {
            const int t = wid * 2 + rr, row = tile * 16 + t;
            float v = rbv;
#pragma unroll
            for (int w = 0; w < 8; ++w) v += part[(w * 16 + t) * 32 + e];
            int rank = 0;
#pragma unroll
            for (int e2 = 0; e2 < 32; ++e2) { const float ve = __uint_as_float(__builtin_amdgcn_readlane(__float_as_uint(v), e2)); rank += (ve > v || (ve == v && e2 < e)) ? 1 : 0; }
            float tv[4]; int ti[4];
#pragma unroll
            for (int r4 = 0; r4 < 4; ++r4) { const unsigned m = (unsigned)__ballot(rank == r4); const int lr = __builtin_ctz(m); ti[r4] = lr; tv[r4] = __uint_as_float(__builtin_amdgcn_readlane(__float_as_uint(v), lr)); }
            float w4[4], s = 0.f;
#pragma unroll
            for (int r4 = 0; r4 < 4; ++r4) { w4[r4] = expf(tv[r4] - tv[0]); s += w4[r4]; }
            if (lane == 0) {
                *(int4*)(topi + row * 4) = make_int4(ti[0], ti[1], ti[2], ti[3]);
                *(float4*)(topw + row * 4) = make_float4(w4[0] / s, w4[1] / s, w4[2] / s, w4[3] / s);
#pragma unroll
                for (int r4 = 0; r4 < 4; ++r4) (void)__hip_atomic_fetch_add(hist + ti[r4], 1, __ATOMIC_RELAXED, __HIP_MEMORY_SCOPE_WORKGROUP);
            }
        }
    }
    __syncthreads();
    if (tid_ < 32) cntb[bid_ * 32 + tid_] = hist[tid_];
}
__device__ __forceinline__ void ph_assign2(const int* topi, const int* cntb, int* cnt, int* stok, int* pos, int* tile_e, LAS unsigned char* lds) {
    LAUNDER();
    LAS int* ptot = (LAS int*)lds;
    LAS int* ppre = ptot + 512;
    LAS int* base = ppre + 512;
    LAS int* cur = base + 32;
    { const int e = tid_ & 31, ch = tid_ >> 5; int tot = 0, pre = 0;
      for (int j = 0; j < 16; ++j) { const int bb = ch * 16 + j; if (bb < nb_s) { const int v = cntb[bb * 32 + e]; tot += v; pre += bb < bid_ ? v : 0; } }
      ptot[ch * 32 + e] = tot; ppre[ch * 32 + e] = pre; }
    __syncthreads();
    if (tid_ < 32) { int tot = 0, pre = 0;
        for (int ch = 0; ch < 16; ++ch) { tot += ptot[ch * 32 + tid_]; pre += ppre[ch * 32 + tid_]; }
        ptot[tid_] = tot; ppre[tid_] = pre; cur[tid_] = 0; }
    __syncthreads();
    if (tid_ == 0) { int s = 0;
        for (int e = 0; e < NE; ++e) { base[e] = s + ppre[e]; const int p = (ptot[e] + MPAD - 1) / MPAD * MPAD;
            if (bid_ == 0) for (int tl = s / MPAD; tl < (s + p) / MPAD; ++tl) tile_e[tl] = e;
            s += p; }
        if (bid_ == 0) cnt[64 + NE] = s; }
    __syncthreads();
    if (tid_ < 64) {
        for (int t0 = bid_; t0 < NT / 16; t0 += 8 * nb_s) {
            int ev[8];
#pragma unroll
            for (int k = 0; k < 8; ++k) { const int tile = t0 + k * nb_s; ev[k] = tile < NT / 16 ? topi[tile * 64 + tid_] : -1; }
#pragma unroll
            for (int k = 0; k < 8; ++k) { const int tile = t0 + k * nb_s;
                if (ev[k] >= 0) { const int i = tile * 64 + tid_;
                    const int p = base[ev[k]] + __hip_atomic_fetch_add(cur + ev[k], 1, __ATOMIC_RELAXED, __HIP_MEMORY_SCOPE_WORKGROUP);
                    stok[p] = i >> 2; pos[i] = p; } }
        }
    }
}
__device__ __forceinline__ void ph_combine_norm(unsigned short* x, const unsigned short* y, const int* pos, const float* topw, const float* gate, int ldg,
                                                const float* g1, const float* sh1, const float* sc1, int ld1, unsigned short* hb,
                                                const float* gk, const float* shk, const float* sck, int ldk, unsigned short* hb2,
                                                const float* gfin, float* out, int* cnt, LAS unsigned char* lds) {
    LAUNDER();
    const int lane = tid_ & 63;
    if (GTID < 128) cnt[GTID] = 0;
    LAS float* KA = (LAS float*)lds; LAS float* KH = KA + 8 * DM;
    if (gk) {
        for (int i = tid_; i < 8 * DM / 4; i += NTHR) { const int bb = i >> 8, c4 = (i & 255) * 4;
            const float4 gg = *(const float4*)(gk + c4), sc = *(const float4*)(sck + bb * ldk + c4), sh = *(const float4*)(shk + bb * ldk + c4);
            *(LAS g8::f32x4*)(KA + bb * DM + c4) = (g8::f32x4){gg.x * (1.f + sc.x), gg.y * (1.f + sc.y), gg.z * (1.f + sc.z), gg.w * (1.f + sc.w)};
            *(LAS g8::f32x4*)(KH + bb * DM + c4) = (g8::f32x4){sh.x, sh.y, sh.z, sh.w}; }
        __syncthreads();
    }
    float4 g1v[4];
#pragma unroll
    for (int j = 0; j < 4; ++j) { g1v[j] = make_float4(0.f, 0.f, 0.f, 0.f); if (!gfin) g1v[j] = *(const float4*)(g1 + j * 256 + lane * 4); }
    int4 psn[2]; float4 twn[2];
    { const int r0 = (GTID >> 6) * 2;
#pragma unroll
      for (int q = 0; q < 2; ++q) { psn[q] = *(const int4*)(pos + (r0 + q) * 4); twn[q] = *(const float4*)(topw + (r0 + q) * 4); } }
    for (int row0 = (GTID >> 6) * 2; row0 < NT; row0 += (GSZ >> 6) * 2) {
        int4 ps[2]; float4 tw[2];
#pragma unroll
        for (int q = 0; q < 2; ++q) { ps[q] = psn[q]; tw[q] = twn[q]; }
        { const int rn_ = row0 + (GSZ >> 6) * 2;
          if (rn_ < NT) {
#pragma unroll
              for (int q = 0; q < 2; ++q) { psn[q] = *(const int4*)(pos + (rn_ + q) * 4); twn[q] = *(const float4*)(topw + (rn_ + q) * 4); } } }
        const int bq = row0 / SEQ;
        float4 gpv[4], s1v[4], h1v[4];
        uint2 yv[2][4][4], xu[2][4];
#pragma unroll
        for (int q = 0; q < 2; ++q)
#pragma unroll
            for (int j = 0; j < 4; ++j) { const int col = j * 256 + lane * 4;
                yv[q][0][j] = *(const uint2*)(y + (size_t)ps[q].x * DM + col); yv[q][1][j] = *(const uint2*)(y + (size_t)ps[q].y * DM + col);
                yv[q][2][j] = *(const uint2*)(y + (size_t)ps[q].z * DM + col); yv[q][3][j] = *(const uint2*)(y + (size_t)ps[q].w * DM + col);
                xu[q][j] = *(const uint2*)(x + (size_t)(row0 + q) * DM + col); }
#pragma unroll
        for (int j = 0; j < 4; ++j) { const int col = j * 256 + lane * 4;
            gpv[j] = *(const float4*)(gate + bq * ldg + col);
            s1v[j] = make_float4(0.f, 0.f, 0.f, 0.f); h1v[j] = s1v[j];
            if (!gfin) { s1v[j] = *(const float4*)(sc1 + bq * ld1 + col); h1v[j] = *(const float4*)(sh1 + bq * ld1 + col); }
            }
#pragma unroll
        for (int q = 0; q < 2; ++q) {
            const int row = row0 + q, b = row / SEQ;
            const float w4[4] = {tw[q].x, tw[q].y, tw[q].z, tw[q].w};
            float4 xn[4]; float ss = 0.f;
#pragma unroll
            for (int j = 0; j < 4; ++j) { const int col = j * 256 + lane * 4;
                float a0 = 0.f, a1 = 0.f, a2 = 0.f, a3 = 0.f;
#pragma unroll
                for (int r4 = 0; r4 < 4; ++r4) { const uint2 u = yv[q][r4][j]; const float w = w4[r4];
                    a0 += w * __uint_as_float(u.x << 16); a1 += w * __uint_as_float(u.x & 0xffff0000u); a2 += w * __uint_as_float(u.y << 16); a3 += w * __uint_as_float(u.y & 0xffff0000u); }
                const uint2 u = xu[q][j]; float4 xv = make_float4(__uint_as_float(u.x << 16), __uint_as_float(u.x & 0xffff0000u), __uint_as_float(u.y << 16), __uint_as_float(u.y & 0xffff0000u));
                const float4 gp = gpv[j];
                xv.x += gp.x * a0; xv.y += gp.y * a1; xv.z += gp.z * a2; xv.w += gp.w * a3;
                if (!gfin) *(uint2*)(x + (size_t)row * DM + col) = make_uint2(pack_bf16(xv.x, xv.y), pack_bf16(xv.z, xv.w));
                xn[j] = xv; ss += xv.x * xv.x + xv.y * xv.y + xv.z * xv.z + xv.w * xv.w; }
#pragma unroll
            for (int o = 32; o > 0; o >>= 1) ss += SHX(ss, o);
            const float rn = rsqrtf(ss * (1.f / DM) + 1e-5f);
#pragma unroll
            for (int j = 0; j < 4; ++j) { const int col = j * 256 + lane * 4;
                if (gfin) { const float4 gg = *(const float4*)(gfin + col); *(float4*)(out + (size_t)row * DM + col) = make_float4(xn[j].x * rn * gg.x, xn[j].y * rn * gg.y, xn[j].z * rn * gg.z, xn[j].w * rn * gg.w); }
                else {
                    { const float4 gg = g1v[j], sc = s1v[j], sh = h1v[j];
                      *(uint2*)(hb + (size_t)row * DM + col) = make_uint2(pack_bf16(xn[j].x * rn * gg.x * (1.f + sc.x) + sh.x, xn[j].y * rn * gg.y * (1.f + sc.y) + sh.y),
                                                                         pack_bf16(xn[j].z * rn * gg.z * (1.f + sc.z) + sh.z, xn[j].w * rn * gg.w * (1.f + sc.w) + sh.w)); }
                    if (gk) { const g8::f32x4 ga = *(const LAS g8::f32x4*)(KA + b * DM + col), sh = *(const LAS g8::f32x4*)(KH + b * DM + col);
                      *(uint2*)(hb2 + (size_t)row * DM + col) = make_uint2(pack_bf16(xn[j].x * rn * ga[0] + sh[0], xn[j].y * rn * ga[1] + sh[1]),
                                                                          pack_bf16(xn[j].z * rn * ga[2] + sh[2], xn[j].w * rn * ga[3] + sh[3])); }
                }
            }
        }
    }
}
#define PHASE(name, ...) __device__ __forceinline__ void name(KP kp, const int L) { asm volatile("" : "+s"(kp)); const P __attribute__((address_space(4)))& p = *kp; float* sm = dyn_smem(); (void)sm; \
    LAS unsigned char* lds = (LAS unsigned char*)dyn_smem(); (void)lds; (void)L; const float* md = p.mod + (size_t)L * 8 * 6144; (void)md;  __VA_ARGS__ }
#define ORDER(S, nM, nN) S.init(nM, nN, nb_s, (int)blockIdx.x)
#define ORDERW(S, nM, nN, W) S.init(nM, nN, nb_s, (int)blockIdx.x, W)

PHASE(f_prologue,
      ph_convT(p.gla_w_in, p.wt_gla_in, 1024, GLA_IN, 3328, 2, sm);
      ph_convT(p.gla_w_out, p.wt_gla_out, 1024, 1024, 1024, 2, sm);
      ph_convT(p.kv_w, p.wt_kv, 1024, KV_OUT, KV_OUT, 1, sm);
      ph_convT(p.nsa_w_in, p.wt_nsa_in, 1024, NSA_IN, 1280, 2, sm);
      ph_convT(p.nsa_w_out, p.wt_nsa_out, 1024, 1024, 1024, 2, sm);
      ph_convT(p.cmp_w1, p.wt_cmp1, 2048, 128, 256, 2, sm);
      ph_convT(p.moe_w_gu, p.wt_gu, 1024, 2048, 2048, 4 * NE, sm);
      ph_convT<true>(p.moe_w_down, p.wt_down, 1024, 1024, 1024, 4 * NE, sm);
      ph_c1(p.cmp_pos, p.cmp_w1, p.cmp_b1, p.c1, sm);
      { LAUNDER(); if (GTID < 128) p.cnt[GTID] = 0; }
      ph_mod(p.c, p.ada_w, p.ada_b, p.kv_ada_w, p.kv_ada_b, p.mod, p.kvmod, sm);)
PHASE(f_norm1, ph_norm(p.x_in, p.norm1_g + L * DM, md + 0, md + 1024, (float*)nullptr, p.hb, 6144);)
PHASE(f_gla_in, ProbPlain<1024> S; ORDER(S, NT / 256, 13); S.A = (const char*)p.hb; S.Bt = (const char*)(p.wt_gla_in + (size_t)L * 3328 * 1024); S.lda = 2048;
      g8::gemm_phase(lds, S, g8::EpiPair<PGlaIn>{PGlaIn{p.gqk, p.gvT, p.grb, p.glr, lds + LDS_X_OFF}}, wv_s);)
PHASE(f_gla_gate, ph_gla_p1(p.gqk, p.glr, p.gvT, p.gla_w_gate2 + L * 16 * 512, p.gla_b_gate + L * 512, p.gqd, p.gki, p.gdl, p.gUT, lds);)
PHASE(f_gla_rec, ph_gla_p2(p.gUT, p.gdl, p.gST);)
PHASE(f_gla_post, ph_gla_p3(p.gqd, p.gki, p.gvT, p.gST, p.grb, p.gla_norm_g + L * DM, p.ob, lds);)
PHASE(f_gla_out, ProbPlain<1024> S; ORDER(S, NT / 256, 4); S.A = (const char*)p.ob; S.Bt = (const char*)(p.wt_gla_out + (size_t)L * 1024 * 1024); S.lda = 2048;
      if (L == 0) g8::gemm_phase(lds, S, EpiResid<true>{p.x_in, p.x, md + 2048, 6144}, wv_s);
      else g8::gemm_phase(lds, S, EpiResid<false>{p.x, p.x, md + 2048, 6144}, wv_s);)
PHASE(f_nsa_in, ProbPlain<1024> S; ORDER(S, NT / 256, 5); S.A = (const char*)p.hb; S.Bt = (const char*)(p.wt_nsa_in + (size_t)(L - 2) * 1280 * 1024); S.lda = 2048;
      g8::gemm_phase(lds, S, g8::EpiPair<PNsaIn>{PNsaIn{p.qb, p.gates, p.nsa_b_gate + (L - 2) * 48}}, wv_s);)
PHASE(f_nsa_attn, ph_nsa_attn_mfma(p.qb, p.gates, p.kcmp, p.vcmpT, p.kslc, p.vslcT, p.kwin, p.vwinT, p.ob, p.cnt + 112, lds);)
PHASE(f_nsa_out, ProbPlain<1024> S; ORDER(S, NT / 256, 4); S.A = (const char*)p.ob; S.Bt = (const char*)(p.wt_nsa_out + (size_t)(L - 2) * 1024 * 1024); S.lda = 2048;
      g8::gemm_phase(lds, S, EpiResid<false>{p.x, p.x, md + 2048, 6144}, wv_s);)
PHASE(f_out_probe, ProbPlain<1024> S; ORDER(S, NT / 256, 4); S.A = (const char*)p.ob; S.Bt = (const char*)(L < 2 ? p.wt_gla_out + (size_t)L * 1024 * 1024 : p.wt_nsa_out + (size_t)(L - 2) * 1024 * 1024); S.lda = 2048;
      g8::gemm_phase(lds, S, EpiResid<false>{p.x, p.act, md + 2048, 6144}, wv_s);)
PHASE(f_comb_probe, const float* mdn = p.mod + (size_t)(L < 3 ? L + 1 : L) * 8 * 6144;
      ph_combine_norm(p.act, p.y, p.pos, p.topw, md + 5120, 6144, p.norm1_g + (L < 3 ? L + 1 : L) * DM, mdn + 0, mdn + 1024, 6144, p.qb,
                      (const float*)nullptr, p.kvmod + 0, p.kvmod + 1024, 2048, p.qb, (const float*)nullptr, p.out, p.cnt + 256, lds);)
PHASE(f_norm2, ph_norm_router(p.x, p.norm2_g + L * DM, md + 3072, md + 4096, 6144, p.hb, p.router_w + (size_t)L * DM * 32, p.router_b + L * 32, p.topi, p.topw, p.cntb, p.stok, lds);)
PHASE(f_assign, ph_assign2(p.topi, p.cntb, p.cnt, p.stok, p.pos, p.tile_e, lds);)
PHASE(f_moe_gu, ProbMoe<1024, true> S; ORDER(S, p.cnt[64 + NE] / 256, 8); S.A = (const char*)p.hb; S.Bt = (const char*)(p.wt_gu + (size_t)L * NE * 2048 * 1024); S.tok = p.stok; S.tile_e = p.tile_e;
      S.bias = p.moe_b_gu + (size_t)L * NE * 2048; S.nbias = 2048; S.estride = (size_t)2048 * 1024 * 2; S.xl = lds + LDS_X_OFF;
      g8::gemm_phase(lds, S, EpiSwiglu{p.act, lds + LDS_X_OFF}, wv_s);)
PHASE(f_moe_down, ProbMoe<1024, false> S; ORDER(S, p.cnt[64 + NE] / 256, 4); S.A = (const char*)p.act; S.Bt = (const char*)(p.wt_down + (size_t)L * NE * 1024 * 1024); S.tok = p.stok; S.tile_e = p.tile_e;
      S.bias = p.moe_b_down + (size_t)L * NE * DM; S.nbias = 1024; S.estride = (size_t)1024 * 1024 * 2; S.xl = lds + LDS_X_OFF;
      g8::gemm_phase(lds, S, EpiDown{p.y, lds + LDS_X_OFF}, wv_s);)
PHASE(f_combine, const float* mdn = p.mod + (size_t)(L + 1) * 8 * 6144;
      ph_combine_norm(p.x, p.y, p.pos, p.topw, md + 5120, 6144, p.norm1_g + (L + 1) * DM, mdn + 0, mdn + 1024, 6144, p.hb,
                      L == 1 ? p.kv_norm_g : (const float*)nullptr, p.kvmod + 0, p.kvmod + 1024, 2048, p.ob, L == 3 ? p.final_g : (const float*)nullptr, p.out, p.cnt, lds);)
PHASE(f_kv_gemm, ProbPlain<1024> S; ORDER(S, NT / 256, 6); S.A = (const char*)p.ob; S.Bt = (const char*)p.wt_kv; S.lda = 2048;
      g8::gemm_phase(lds, S, g8::EpiPair<PKv>{PKv{p.csrc, p.kslc, p.vslcT, p.kwin, p.vwinT, lds + LDS_X_OFF}}, wv_s);)
PHASE(f_cmp1, ProbCmp S; ORDER(S, 256, 1); S.csrc = (const char*)p.csrc; S.W1t = (const char*)p.wt_cmp1;
      g8::gemm_phase(lds, S, g8::EpiQuad<QCmp1>{QCmp1{p.hid}}, wv_s);)
PHASE(f_cmp2, ph_gemm(AHid4{p.hid, p.c1}, BCmp{p.cmp_w2, 64, (size_t)128 * 64}, ECmp2b{p.kcmp, p.vcmpT, p.cmp_b2}, NCMP, 64, 128, 64, sm);)

#define BAR() xcd_barrier(bar, wv_s)
#ifndef REP_GEMM
#define REP_GEMM 1
#endif
#ifndef REP_ATTN
#define REP_ATTN 1
#endif
#ifndef REP_MOE
#define REP_MOE 1
#endif
#ifndef REP_GLA
#define REP_GLA 1
#endif
#ifndef REP_OUT
#define REP_OUT 1
#endif
#ifndef REP_N2
#define REP_N2 1
#endif
#ifndef REP_ASG
#define REP_ASG 1
#endif
#ifndef REP_COMB
#define REP_COMB 1
#endif
#ifndef REP_PRO
#define REP_PRO 1
#endif
#define REPEAT(n, ...) { __VA_ARGS__ } if ((n) > 1) { __VA_ARGS__ } if ((n) > 2) { __VA_ARGS__ }
template <int L> __device__ __forceinline__ void layer(KP kp, const XcdBarrier& bar) {
    if (L == 0) { f_norm1(kp, L); BAR(); }
    if (L < 2) {
        REPEAT(REP_GEMM, f_gla_in(kp, L); BAR();) REPEAT(REP_GLA, f_gla_gate(kp, L); BAR(); f_gla_rec(kp, L); BAR(); f_gla_post(kp, L); BAR();) f_gla_out(kp, L); BAR(); if (REP_OUT > 1) { f_out_probe(kp, L); BAR(); }
    } else {
        REPEAT(REP_GEMM, f_nsa_in(kp, L); BAR();) REPEAT(REP_ATTN, f_nsa_attn(kp, L); BAR();) f_nsa_out(kp, L); BAR(); if (REP_OUT > 1) { f_out_probe(kp, L); BAR(); }
    }
    REPEAT(REP_N2, f_norm2(kp, L); BAR();) REPEAT(REP_ASG, f_assign(kp, L); BAR();)
    REPEAT(REP_MOE, f_moe_gu(kp, L); BAR(); f_moe_down(kp, L); BAR();) if (REP_COMB > 1) { f_comb_probe(kp, L); BAR(); } f_combine(kp, L); if (L < 3) BAR();
    if (L == 1) { REPEAT(REP_GEMM, f_kv_gemm(kp, L); BAR();) f_cmp1(kp, L); BAR(); f_cmp2(kp, L); BAR(); }
}
};
__global__ __launch_bounds__(NTHR, 2) void mega(P p_unused) {
    KP kp = (KP)__builtin_amdgcn_kernarg_segment_ptr();
    float* smem = dyn_smem();
    unsigned* bw = (unsigned*)smem + LDS_BAR_OFF / 4;
    if (threadIdx.x == 0) { bw[0] = 0u; bw[1] = 0u; bw[2] = 0u; bw[3] = 0u; }
    __syncthreads();
    XcdBarrier bar = xcd_barrier_post(kp->bar, (volatile LAS unsigned*)bw);
    Ctx cx; cx.nb_s = (int)gridDim.x; cx.wv_s = __builtin_amdgcn_readfirstlane(threadIdx.x >> 6);
    REPEAT(REP_PRO, cx.f_prologue(kp, 0); xcd_barrier(bar, cx.wv_s);)
    cx.layer<0>(kp, bar); cx.layer<1>(kp, bar); cx.layer<2>(kp, bar); cx.layer<3>(kp, bar);
}
}

extern "C" void kernel_launch(void* const* d_in, const int* in_sizes, int n_in, void* d_out, int out_size, void* d_ws, size_t ws_size, hipStream_t stream) {
    P p{};
    const float** pin = (const float**)&p;
    for (int i = 0; i < 30; ++i) pin[i] = (const float*)d_in[i];
    p.out = (float*)d_out;
    char* wp = (char*)d_ws; size_t off = 0;
    auto alloc = [&](size_t bytes) { void* q = wp + off; off += (bytes + 255) & ~(size_t)255; return q; };
    p.bar = (unsigned*)alloc(XCD_BAR_WORDS * 4);
    p.mod = (float*)alloc((size_t)4 * 8 * 6144 * 4);
    p.kvmod = (float*)alloc((size_t)8 * 2048 * 4);
    p.c1 = (float*)alloc(256 * 4);
    p.x = (unsigned short*)alloc((size_t)NT * DM * 2);
    p.hid = (float*)alloc((size_t)4 * 64 * NCMP * 128 * 4);
    p.gates = (float*)alloc((size_t)NT * 48 * 4);
    p.topi = (int*)alloc((size_t)NT * 4 * 4);
    p.topw = (float*)alloc((size_t)NT * 4 * 4);
    p.cnt = (int*)alloc(512 * 4);
    p.cntb = (int*)alloc((size_t)1024 * 32 * 4);
    p.stok = (int*)alloc((size_t)CAP * 4);
    p.pos = (int*)alloc((size_t)NT * 4 * 4);
    p.tile_e = (int*)alloc((size_t)(CAP / MPAD) * 4);
    p.y = (unsigned short*)alloc((size_t)CAP * DM * 2);
    p.hb = (unsigned short*)alloc((size_t)NT * DM * 2);
    p.ob = (unsigned short*)alloc((size_t)NT * DM * 2);
    p.act = (unsigned short*)alloc((size_t)CAP * DM * 2);
    p.csrc = (unsigned short*)alloc((size_t)64 * SEQ * 64 * 2 + 8192);
    p.qb = (unsigned short*)alloc((size_t)NT * DM * 2);
    p.kslc = (unsigned short*)alloc((size_t)32 * SEQ * 64 * 2);
    p.vslcT = (unsigned short*)alloc((size_t)32 * SEQ * 64 * 2);
    p.kwin = (unsigned short*)alloc((size_t)32 * SEQ * 64 * 2);
    p.vwinT = (unsigned short*)alloc((size_t)32 * SEQ * 64 * 2);
    p.kcmp = (unsigned short*)alloc((size_t)32 * 256 * 64 * 2);
    p.vcmpT = (unsigned short*)alloc((size_t)32 * 256 * 64 * 2);
    p.gqk = (unsigned short*)alloc((size_t)NT * 1024 * 2);
    p.gvT = (unsigned short*)alloc((size_t)NT * 1024 * 2);
    p.grb = (unsigned short*)alloc((size_t)NT * 1024 * 2);
    p.gqd = (unsigned short*)alloc((size_t)NT * 512 * 2);
    p.gki = (unsigned short*)alloc((size_t)NT * 512 * 2);
    p.gST = (unsigned short*)alloc((size_t)32 * 64 * 256 * 128 * 2);
    p.glr = (float*)alloc((size_t)NT * 16 * 4);
    p.gdl = (float*)alloc((size_t)32 * 64 * 128 * 4);
    p.gUT = (unsigned short*)alloc((size_t)32 * 64 * 256 * 128 * 2);
    p.wt_gla_in = (unsigned short*)alloc((size_t)2 * 3328 * 1024 * 2);
    p.wt_gla_out = (unsigned short*)alloc((size_t)2 * 1024 * 1024 * 2);
    p.wt_kv = (unsigned short*)alloc((size_t)KV_OUT * 1024 * 2);
    p.wt_nsa_in = (unsigned short*)alloc((size_t)2 * 1280 * 1024 * 2);
    p.wt_nsa_out = (unsigned short*)alloc((size_t)2 * 1024 * 1024 * 2);
    p.wt_cmp1 = (unsigned short*)alloc((size_t)2 * 256 * 2048 * 2);
    p.wt_gu = (unsigned short*)alloc((size_t)4 * NE * 2048 * 1024 * 2);
    p.wt_down = (unsigned short*)alloc((size_t)4 * NE * 1024 * 1024 * 2);
    if (off > ws_size) return;

    static int grid = 0;
    if (!grid) {
        int dev = 0, cus = 0, per_cu = 0;
        (void)hipGetDevice(&dev);
        (void)hipDeviceGetAttribute(&cus, hipDeviceAttributeMultiprocessorCount, dev);
        (void)hipFuncSetAttribute((const void*)mega, hipFuncAttributeMaxDynamicSharedMemorySize, (int)kDynLds);
        (void)hipOccupancyMaxActiveBlocksPerMultiprocessor(&per_cu, mega, NTHR, kDynLds);
        if (per_cu < 1) per_cu = 1;
        grid = cus * 1;
    }
    (void)hipMemsetAsync(p.bar, 0, XCD_BAR_WORDS * sizeof(unsigned), stream);
    hipLaunchKernelGGL(mega, dim3(grid), dim3(NTHR), kDynLds, stream, p);
}
```

```cpp
#include <hip/hip_runtime.h>
#include <stdint.h>
#include <math.h>

namespace {
constexpr int NB = 8, SEQ = 4096, DM = 1024, NT = NB * SEQ;
constexpr int GLA_IN = 3088, NSA_IN = 1072, KV_OUT = 1536;
constexpr int NE = 32, TOPK = 4, NASG = NT * TOPK;
constexpr int MPAD = 256;
constexpr int CAP = NASG + NE * MPAD;
constexpr int NCMP = 255;
constexpr int NTHR = 512;

__device__ __forceinline__ unsigned short f2bf(float f) { unsigned u = __float_as_uint(f); u += 0x7FFFu + ((u >> 16) & 1u); return (unsigned short)(u >> 16); }
typedef __bf16 hbf16x2_t __attribute__((ext_vector_type(2)));
typedef float hf32x2_t __attribute__((ext_vector_type(2)));
__device__ __forceinline__ unsigned pack_bf16(float lo, float hi) { const hf32x2_t v = {lo, hi}; const hbf16x2_t r = __builtin_convertvector(v, hbf16x2_t); return __builtin_bit_cast(unsigned, r); }
__device__ __forceinline__ unsigned pack_bf16_v(float lo, float hi) { return pack_bf16(lo, hi); }
__device__ __forceinline__ float fast_exp(float x) { return __builtin_amdgcn_exp2f(x * 1.4426950408889634f); }
__device__ __forceinline__ float fast_logsigmoid(float z) { return fminf(z, 0.f) - 0.6931471805599453f * __builtin_amdgcn_logf(1.f + __builtin_amdgcn_exp2f(-fabsf(z) * 1.4426950408889634f)); }
__device__ __forceinline__ float fast_silu(float x) { return x * __builtin_amdgcn_rcpf(1.f + __builtin_amdgcn_exp2f(-1.4426950408889634f * x)); }
__device__ __forceinline__ float sigm(float x) { return 1.f / (1.f + expf(-x)); }
__device__ __forceinline__ float siluf(float x) { return x / (1.f + expf(-x)); }
__device__ __forceinline__ float logsigmoidf(float z) { return fminf(z, 0.f) - log1pf(expf(-fabsf(z))); }
__device__ __forceinline__ float gelu_tanh(float x) { return 0.5f * x * (1.f + tanhf(0.7978845608028654f * (x + 0.044715f * x * x * x))); }

#define XB_TMO      128
#define XB_XCNT(j)  (256  + 64 * (j))
#define XB_XSUB(j)  (1280 + 64 * (j))
#define XB_XGEN(j)  (2304 + 64 * (j))
#define XB_TOP      3328
#define XB_TOPGEN   3392
#define XCD_BAR_WORDS 3456
#define XB_SPIN_CAP (1u << 22)
#define LAS __attribute__((address_space(3)))

__device__ __forceinline__ unsigned xb_ld(unsigned* p)              { return __hip_atomic_load(p, __ATOMIC_RELAXED, __HIP_MEMORY_SCOPE_AGENT); }
__device__ __forceinline__ unsigned xb_add(unsigned* p, unsigned v) { return __hip_atomic_fetch_add(p, v, __ATOMIC_RELAXED, __HIP_MEMORY_SCOPE_AGENT); }
__device__ __forceinline__ unsigned xb_xcc_id() { return (unsigned)__builtin_amdgcn_s_getreg((3 << 11) | 20) & 0xFu; }
#define XB_SPIN(cond, bar) do { unsigned _sp = 0; while (cond) { __builtin_amdgcn_s_sleep(1); \
    if ((++_sp & 255u) == 0u) { if (xb_ld(&(bar)[XB_TMO])) break; if (_sp > XB_SPIN_CAP) { atomicAdd(&(bar)[XB_TMO], 1u); break; } } } } while (0)

struct XcdBarrier { unsigned* bar; unsigned x; volatile LAS unsigned* st; };

__device__ __forceinline__ XcdBarrier xcd_barrier_post(unsigned* bar, volatile LAS unsigned* st) {
    XcdBarrier b; b.bar = bar; b.x = xb_xcc_id(); b.st = st;
    if (threadIdx.x == 0) (void)xb_add(&bar[XB_XCNT(b.x)], 1u);
    return b;
}
__device__ __forceinline__ void xcd_barrier_complete(unsigned* bar, unsigned x, unsigned& nloc, unsigned& nx) {
    const unsigned G = gridDim.x * gridDim.y * gridDim.z;
    unsigned sum, cnt, mine, sp = 0u;
    for (;;) {
        sum = 0u; cnt = 0u; mine = 0u;
#pragma unroll
        for (unsigned j = 0; j < 16; ++j) { const unsigned c = xb_ld(&bar[XB_XCNT(j)]); sum += c; cnt += (c > 0u) ? 1u : 0u; mine = (j == x) ? c : mine; }
        if (sum == G) break;
        __builtin_amdgcn_s_sleep(1);
        if ((++sp & 255u) == 0u) { if (xb_ld(&bar[XB_TMO])) break; if (sp > XB_SPIN_CAP) { atomicAdd(&bar[XB_TMO], 1u); break; } }
    }
    nloc = mine > 0u ? mine : 1u; nx = cnt > 0u ? cnt : 1u;
}
__device__ __forceinline__ void xcd_barrier(const XcdBarrier& b, int wv) {
    asm volatile("s_waitcnt vmcnt(0)" ::: "memory");
    __syncthreads();
    int ln_; asm volatile("v_mbcnt_lo_u32_b32 %0, -1, 0\n\tv_mbcnt_hi_u32_b32 %0, -1, %0" : "=v"(ln_));
    if (wv == 0 && ln_ == 0) {
        unsigned* bar = b.bar;
        __builtin_amdgcn_s_waitcnt(0);
        unsigned nloc = b.st[0], nx = b.st[1];
        if (nloc == 0u) { xcd_barrier_complete(bar, b.x, nloc, nx); b.st[0] = nloc; b.st[1] = nx; }
        const unsigned old = xb_add(&bar[XB_XSUB(b.x)], 1u);
        const unsigned gen = old / nloc;
        if (old + 1u == (gen + 1u) * nloc) {
            __builtin_amdgcn_fence(__ATOMIC_RELEASE, "agent");
            asm volatile("s_waitcnt vmcnt(0)" ::: "memory");
            const unsigned og = xb_add(&bar[XB_TOP], 1u);
            const unsigned tg = og / nx;
            if (og + 1u == (tg + 1u) * nx) xb_add(&bar[XB_TOPGEN], 1u);
            else XB_SPIN(xb_ld(&bar[XB_TOPGEN]) == tg, bar);
            __builtin_amdgcn_fence(__ATOMIC_ACQUIRE, "agent");
            xb_add(&bar[XB_XGEN(b.x)], 1u);
            asm volatile("s_waitcnt vmcnt(0)" ::: "memory");
        } else {
            XB_SPIN(xb_ld(&bar[XB_XGEN(b.x)]) == gen, bar);
            __builtin_amdgcn_fence(__ATOMIC_ACQUIRE, "agent");
            asm volatile("s_waitcnt vmcnt(0)" ::: "memory");
        }
    }
    __syncthreads();
}
struct ARow { const float* A; long lda; __device__ bool active(int, int) const { return true; } __device__ float operator()(int, int m, int k) const { return A[(size_t)m * lda + k]; } };
struct AGather { const float* A; const int* tok; const int* tile_e; __device__ bool active(int, int m0) const { return tile_e[m0 / MPAD] >= 0; }
    __device__ float operator()(int, int m, int k) const { const int t = tok[m]; return t >= 0 ? A[(size_t)t * DM + k] : 0.f; } };
struct ARowsIdx { const float* A; const int* tile_e; __device__ bool active(int, int m0) const { return tile_e[m0 / MPAD] >= 0; }
    __device__ float operator()(int, int m, int k) const { return A[(size_t)m * DM + k]; } };
struct ACmp { const float* kv6; const float* pos; __device__ bool active(int, int) const { return true; }
    __device__ float operator()(int z, int m, int k) const { const int t = z >> 5, b = (z >> 2) & 7, g = z & 3, l = k >> 6, d = k & 63;
        return kv6[(size_t)(b * SEQ + 16 * m + l) * KV_OUT + t * 256 + g * 64 + d] + pos[t * 2048 + k]; } };
struct AHid { const float* hid; __device__ bool active(int, int) const { return true; } __device__ float operator()(int z, int m, int k) const { return hid[((size_t)z * NCMP + m) * 128 + k]; } };
struct BMat { const float* B; long ldb; __device__ float operator()(int, int, int k, int n) const { return B[(size_t)k * ldb + n]; } };
struct BExpert { const float* B; const int* tile_e; long ldb; size_t estride; __device__ float operator()(int, int m0, int k, int n) const { const int e = tile_e[m0 / MPAD]; return B[(size_t)e * estride + (size_t)k * ldb + n]; } };
struct BCmp { const float* B; long ldb; size_t tstride; __device__ float operator()(int z, int, int k, int n) const { return B[(size_t)(z >> 5) * tstride + (size_t)k * ldb + n]; } };
struct EStore { float* C; long ldc; __device__ void operator()(int, int m, int, int n0, const float (&v)[8], int N) const {
#pragma unroll
    for (int j = 0; j < 8; ++j) if (n0 + j < N) C[(size_t)m * ldc + n0 + j] = v[j]; } };
struct EResid { float* X; const float* gate; long ldg; __device__ void operator()(int, int m, int, int n0, const float (&v)[8], int N) const { const int b = m / SEQ;
#pragma unroll
    for (int j = 0; j < 8; ++j) { const int n = n0 + j; X[(size_t)m * DM + n] += gate[b * ldg + n] * v[j]; } } };
struct ENsaIn { float* qn; float* gates; const float* bg; __device__ void operator()(int, int m, int, int n0, const float (&v)[8], int N) const {
#pragma unroll
    for (int j = 0; j < 8; ++j) { const int n = n0 + j; if (n < 1024) qn[(size_t)m * 1024 + n] = v[j] * 0.125f; else if (n < N) gates[(size_t)m * 48 + (n - 1024)] = sigm(v[j] + bg[n - 1024]); } } };
struct ESwiglu { float* act; const float* bgu; const int* tile_e; __device__ void operator()(int, int m, int m0, int n0, const float (&v)[8], int N) const { const int e = tile_e[m0 / MPAD];
#pragma unroll
    for (int j = 0; j < 4; ++j) { const int n = n0 + 2 * j; float gt = v[2 * j] + bgu[e * 2048 + n], up = v[2 * j + 1] + bgu[e * 2048 + n + 1];
        gt = fminf(gt, 7.f); up = fminf(fmaxf(up, -7.f), 7.f); act[(size_t)m * 1024 + (n >> 1)] = (up + 1.f) * gt * sigm(1.702f * gt); } } };
struct EDown { float* y; const float* bd; const int* tile_e; __device__ void operator()(int, int m, int m0, int n0, const float (&v)[8], int N) const { const int e = tile_e[m0 / MPAD];
#pragma unroll
    for (int j = 0; j < 8; ++j) y[(size_t)m * 1024 + n0 + j] = v[j] + bd[e * 1024 + n0 + j]; } };
struct ECmp1 { float* hid; const float* b1; __device__ void operator()(int z, int m, int, int n0, const float (&v)[8], int N) const {
#pragma unroll
    for (int j = 0; j < 8; ++j) if (n0 + j < N) hid[((size_t)z * NCMP + m) * 128 + n0 + j] = gelu_tanh(v[j] + b1[(z >> 5) * 128 + n0 + j]); } };
struct ECmp2 { float* comp; const float* b2; __device__ void operator()(int z, int m, int, int n0, const float (&v)[8], int N) const {
#pragma unroll
    for (int j = 0; j < 8; ++j) if (n0 + j < N) comp[((size_t)z * NCMP + m) * 64 + n0 + j] = v[j] + b2[(z >> 5) * 64 + n0 + j]; } };

struct ECmp2b { unsigned short* kcmp; unsigned short* vcmpT; const float* b2; __device__ void operator()(int z, int m, int, int n0, const float (&v)[8], int N) const { const int t = z >> 5, bg = z & 31;
#pragma unroll
    for (int j = 0; j < 8; ++j) { const int d = n0 + j; if (d < N) { const unsigned short o = f2bf(v[j] + b2[t * 64 + d]); if (t == 0) kcmp[((size_t)bg * 256 + m) * 64 + d] = o; else vcmpT[((size_t)bg * 64 + d) * 256 + ((m & ~15) | (((m >> 2) & 1) << 3) | (((m >> 3) & 1) << 2) | (m & 3))] = o; } } } };
struct AHid4 { const float* hidp; const float* c1; __device__ bool active(int, int) const { return true; } __device__ float operator()(int z, int m, int k) const {
    const size_t o = ((size_t)z * NCMP + m) * 128 + k, st = (size_t)64 * NCMP * 128;
    return gelu_tanh(hidp[o] + hidp[o + st] + hidp[o + 2 * st] + hidp[o + 3 * st] + c1[(z >> 5) * 128 + k]); } };
namespace g8 {
typedef unsigned short bf16_t;
typedef short bf16x8 __attribute__((ext_vector_type(8)));
typedef float f32x4 __attribute__((ext_vector_type(4)));
constexpr bool TAIL_HALVES = false;
constexpr int BM = 256, BK = 64, HALF = 128, HTB = HALF * BK * 2, STAGE_BYTES = 8 * HTB, NXCD = 8, WGM = 8;

__device__ __forceinline__ int lds_byte(int r, int c) { const int st = (r >> 4) * 2 + (c >> 5), rr = r & 15, cc = c & 31, ob = rr * 64 + cc * 2; return st * 1024 + (ob ^ (((ob >> 9) & 1) << 5)); }
__device__ __forceinline__ void stage_rc(int b, int& R, int& C) { const int st = b / 1024, sb = b % 1024, swz = sb ^ (((sb >> 9) & 1) << 5); R = (st >> 1) * 16 + swz / 64; C = (st & 1) * 32 + (swz % 64) / 2; }

struct Unit { int pm, pn, ord, half; };
struct Order {
    int nM, nN, nwg, G, c, wgm;
    __device__ __forceinline__ void init(int nM_, int nN_, int G_, int c_, int wgm_ = WGM) { nM = nM_; nN = nN_; nwg = nM * nN; G = G_; c = c_; wgm = wgm_; }
    __device__ __forceinline__ bool next(int i, Unit& u) const {
        long L = (long)i * G + c; u.ord = i; u.half = -1;
        const int F = nwg / G, r = nwg - F * G;
        if (TAIL_HALVES && r > 0 && 2 * r <= G && L >= (long)F * G) { const long h = L - (long)F * G; if (h >= 2 * r) return false; u.half = (int)(h & 1); L = (long)F * G + (h >> 1); }
        if (L >= nwg) return false;
        int wgid = (int)L; { const int q = nwg / NXCD, rr = nwg % NXCD, xcd = wgid % NXCD, off = wgid / NXCD; wgid = (xcd < rr ? xcd * (q + 1) : rr * (q + 1) + (xcd - rr) * q) + off; }
        const int nig = wgm * nN, gid = wgid / nig, fm = gid * wgm, gsz = (nM - fm) < wgm ? (nM - fm) : wgm;
        u.pm = fm + ((wgid % nig) % gsz); u.pn = (wgid % nig) / gsz; return true;
    }
};

template <class Prob, class Epi>
__device__ __forceinline__ void gemm_phase(LAS unsigned char* lds, const Prob& S, const Epi& E, int wv) {
    int tz; asm volatile("v_mbcnt_lo_u32_b32 %0, -1, 0\n\tv_mbcnt_hi_u32_b32 %0, -1, %0" : "=v"(tz)); tz += wv * 64;
    const int tid = tz, wid = __builtin_amdgcn_readfirstlane(tid >> 6), lane = tid & 63, wr = wid >> 2, wc = wid & 3, fr = lane & 15, fq = lane >> 4;
    constexpr int K = Prob::K, nt = K / BK;
    int Rr[2], Cc[2];
    unsigned voffB[2];
#pragma unroll
    for (int i = 0; i < 2; ++i) { stage_rc(tid * 16 + i * 8192, Rr[i], Cc[i]); voffB[i] = (unsigned)(Rr[i] * Prob::LDB + Cc[i]) * 2u; }
    const size_t kstep = (size_t)(BK * 2);
    const size_t hstepB = (size_t)HALF * Prob::LDB * 2;
    const unsigned ldsw = (unsigned)wid * 1024u;
    const int aoff = lds_byte(wr * 64 + fr, fq * 8), boff = lds_byte(wc * 32 + fr, fq * 8);
#define G8_SA(b, h) (((b) * 2 + (h)) * HTB)
#define G8_SB(b, h) ((4 + (b) * 2 + (h)) * HTB)
#define G8_STAGE(bufoff, gbase, voff) do { _Pragma("unroll") for (int _i = 0; _i < 2; ++_i) \
        __builtin_amdgcn_global_load_lds((const unsigned*)((const char*)(gbase) + (voff)[_i]), (LAS unsigned*)(lds + (bufoff) + ldsw + _i * 8192), 16, 0, 0); } while (0)
#define G8_LDA(dst, b, h) do { _Pragma("unroll") for (int m = 0; m < 4; ++m) _Pragma("unroll") for (int k = 0; k < 2; ++k) dst[m][k] = *(const LAS bf16x8*)(lds + G8_SA(b, h) + aoff + m * 2048 + k * 1024); } while (0)
#define G8_LDB(dst, b, h) do { _Pragma("unroll") for (int n = 0; n < 2; ++n) _Pragma("unroll") for (int k = 0; k < 2; ++k) dst[n][k] = *(const LAS bf16x8*)(lds + G8_SB(b, h) + boff + n * 2048 + k * 1024); } while (0)
#define G8_MMA(ai, bj, At, Bt) do { __builtin_amdgcn_s_setprio(1); _Pragma("unroll") for (int m = 0; m < 4; ++m) _Pragma("unroll") for (int n = 0; n < 2; ++n) _Pragma("unroll") for (int k = 0; k < 2; ++k) \
        acc[ai][bj][m][n] = __builtin_amdgcn_mfma_f32_16x16x32_bf16(Bt[n][k], At[m][k], acc[ai][bj][m][n], 0, 0, 0); __builtin_amdgcn_s_setprio(0); } while (0)
#define G8_WAIT_V(n) asm volatile("s_waitcnt vmcnt(" #n ")" ::: "memory")
#define G8_WAIT_L(n) asm volatile("s_waitcnt lgkmcnt(" #n ")" ::: "memory")
#define G8_BAR __builtin_amdgcn_s_barrier()
#define G8_SCHED __builtin_amdgcn_sched_barrier(0)
#define G8_AOFFS(dst, u) do { _Pragma("unroll") for (int _h = 0; _h < 2; ++_h) _Pragma("unroll") for (int _i = 0; _i < 2; ++_i) dst[_h][_i] = S.a_off(u, _h * HALF + Rr[_i]) + (unsigned)Cc[_i] * 2u; } while (0)
    S.prep(tid);
    Unit cur, nxt; int ui = 0;
    if (!S.next(0, cur)) return;
    f32x4 acc[2][2][4][2];
#pragma unroll
    for (int a = 0; a < 2; ++a)
#pragma unroll
        for (int b = 0; b < 2; ++b)
#pragma unroll
            for (int m = 0; m < 4; ++m)
#pragma unroll
                for (int n = 0; n < 2; ++n) acc[a][b][m][n] = (f32x4){0.f, 0.f, 0.f, 0.f};
    bf16x8 At[4][2], B0[2][2], B1[2][2];
    unsigned vA[2][2], nvA[2][2];
    const char* cA = S.a_base(cur); const char* cB = S.b_base(cur) + (cur.half > 0 ? hstepB : 0);
    size_t h2c = cur.half >= 0 ? 0 : hstepB;
    G8_AOFFS(vA, cur);
    S.unit_begin(cur, wid, lane);
    G8_STAGE(G8_SB(0, 0), cB, voffB); G8_STAGE(G8_SA(0, 0), cA, vA[0]); G8_STAGE(G8_SB(0, 1), cB + h2c, voffB); G8_STAGE(G8_SA(0, 1), cA, vA[1]);
    if (wr == 1) G8_BAR;
    G8_WAIT_V(4); G8_BAR;
    G8_STAGE(G8_SB(1, 0), cB + kstep, voffB); G8_STAGE(G8_SA(1, 0), cA + kstep, vA[0]); G8_STAGE(G8_SB(1, 1), cB + h2c + kstep, voffB);
    G8_WAIT_V(6); G8_BAR;
    for (;;) {
        const bool has_next = S.next(ui + 1, nxt);
        const char* nA = has_next ? S.a_base(nxt) : cA; const char* nB = has_next ? S.b_base(nxt) + (nxt.half > 0 ? hstepB : 0) : cB;
        const size_t h2n = has_next ? (nxt.half >= 0 ? 0 : hstepB) : h2c;
        const bool chalf = cur.half >= 0;
        if (has_next) { G8_AOFFS(nvA, nxt); } else {
#pragma unroll
            for (int _h = 0; _h < 2; ++_h)
#pragma unroll
                for (int _i = 0; _i < 2; ++_i) nvA[_h][_i] = vA[_h][_i]; }
#pragma unroll 1
        for (int t = 0; t < nt; t += 2) {
            const bool last = (t == nt - 2);
            const char* a1 = cA + (size_t)(t + 1) * kstep;
            const char* a2 = last ? nA : cA + (size_t)(t + 2) * kstep; const char* b2 = last ? nB : cB + (size_t)(t + 2) * kstep;
            const char* a3 = a2 + kstep; const char* b3 = b2 + kstep; const size_t hs2 = last ? h2n : h2c;
            unsigned w0[2], w1[2];
#pragma unroll
            for (int _i = 0; _i < 2; ++_i) { w0[_i] = last ? nvA[0][_i] : vA[0][_i]; w1[_i] = last ? nvA[1][_i] : vA[1][_i]; }
            G8_LDB(B0, 0, 0); G8_SCHED; G8_LDA(At, 0, 0); G8_STAGE(G8_SA(1, 1), a1, vA[1]);
            G8_WAIT_L(8); G8_BAR; G8_WAIT_L(0); G8_MMA(0, 0, At, B0); G8_BAR; G8_SCHED;
            if (!chalf) { G8_LDB(B1, 0, 1); } G8_STAGE(G8_SB(0, 0), b2, voffB);
            G8_BAR; G8_WAIT_L(0); if (!chalf) { G8_MMA(0, 1, At, B1); } G8_BAR;
            G8_LDA(At, 0, 1); G8_STAGE(G8_SA(0, 0), a2, w0);
            G8_BAR; G8_WAIT_L(0); G8_MMA(1, 0, At, B0); G8_BAR; G8_SCHED;
            G8_STAGE(G8_SB(0, 1), b2 + hs2, voffB);
            G8_WAIT_V(6); G8_BAR; if (!chalf) { G8_MMA(1, 1, At, B1); } G8_BAR;
            G8_LDB(B0, 1, 0); G8_SCHED; G8_LDA(At, 1, 0); G8_STAGE(G8_SA(0, 1), a2, w1);
            G8_WAIT_L(8); G8_BAR; G8_WAIT_L(0); G8_MMA(0, 0, At, B0); G8_BAR; G8_SCHED;
            if (!chalf) { G8_LDB(B1, 1, 1); } G8_STAGE(G8_SB(1, 0), b3, voffB);
            G8_BAR; G8_WAIT_L(0); if (!chalf) { G8_MMA(0, 1, At, B1); } G8_BAR;
            G8_LDA(At, 1, 1); G8_STAGE(G8_SA(1, 0), a3, w0);
            G8_BAR; G8_WAIT_L(0); G8_MMA(1, 0, At, B0); G8_BAR; G8_SCHED;
            G8_STAGE(G8_SB(1, 1), b3 + hs2, voffB);
            G8_WAIT_V(6); G8_BAR; if (!chalf) { G8_MMA(1, 1, At, B1); } G8_BAR;
        }
        if (wr == 0) G8_BAR;
        E(acc, cur, wr, wc, fr, fq);
        if (!has_next) break;
#pragma unroll
        for (int a = 0; a < 2; ++a)
#pragma unroll
            for (int b = 0; b < 2; ++b)
#pragma unroll
                for (int m = 0; m < 4; ++m)
#pragma unroll
                    for (int n = 0; n < 2; ++n) acc[a][b][m][n] = (f32x4){0.f, 0.f, 0.f, 0.f};
        cur = nxt; cA = nA; cB = nB; h2c = h2n; ++ui;
        S.unit_begin(cur, wid, lane);
#pragma unroll
        for (int _h = 0; _h < 2; ++_h)
#pragma unroll
            for (int _i = 0; _i < 2; ++_i) vA[_h][_i] = nvA[_h][_i];
        if (wr == 1) G8_BAR;
    }
    G8_WAIT_V(0);
    G8_BAR;
#undef G8_SA
#undef G8_SB
#undef G8_STAGE
#undef G8_LDA
#undef G8_LDB
#undef G8_MMA
#undef G8_WAIT_V
#undef G8_WAIT_L
#undef G8_BAR
#undef G8_SCHED
#undef G8_AOFFS
}

template <class F> struct EpiQuad {
    F f;
    __device__ __forceinline__ void operator()(const f32x4 (&acc)[2][2][4][2], const Unit& u, int wr, int wc, int fr, int fq) const {
#pragma unroll
        for (int ai = 0; ai < 2; ++ai)
#pragma unroll
            for (int m = 0; m < 4; ++m) { const int row = u.pm * BM + ai * HALF + wr * 64 + m * 16 + fr;
#pragma unroll
                for (int bj = 0; bj < 2; ++bj) { if (u.half >= 0 && bj == 1) continue;
#pragma unroll
                    for (int n = 0; n < 2; ++n) f(u, row, u.pn * BM + (u.half >= 0 ? u.half : bj) * HALF + wc * 32 + n * 16 + 4 * fq, acc[ai][bj][m][n]); } }
    }
};
template <class F> struct EpiPair {
    F f;
    __device__ __forceinline__ void operator()(const f32x4 (&acc)[2][2][4][2], const Unit& u, int wr, int wc, int fr, int fq) const {
#pragma unroll
        for (int ai = 0; ai < 2; ++ai)
#pragma unroll
            for (int m = 0; m < 4; ++m) { const int row = u.pm * BM + ai * HALF + wr * 64 + m * 16 + fr;
#pragma unroll
                for (int bj = 0; bj < 2; ++bj) { if (u.half >= 0 && bj == 1) continue;
                    f(u, row, u.pn * BM + (u.half >= 0 ? u.half : bj) * HALF + wc * 32, fq, wr * 4 + wc, acc[ai][bj][m][0], acc[ai][bj][m][1]); } }
    }
};
}
using g8::Unit; using g8::f32x4;
template <int K_> struct ProbPlain : g8::Order {
    static constexpr int K = K_, LDB = K_;
    const char* A; const char* Bt; long lda;
    __device__ __forceinline__ void prep(int) const {}
    __device__ __forceinline__ void unit_begin(const Unit&, int, int) const {}
    __device__ __forceinline__ const char* a_base(const Unit& u) const { return A + (size_t)u.pm * 256 * lda; }
    __device__ __forceinline__ unsigned a_off(const Unit&, int row) const { return (unsigned)(row * lda); }
    __device__ __forceinline__ const char* b_base(const Unit& u) const { return Bt + (size_t)u.pn * 256 * K * 2; }
};
constexpr int MX_TE = 0, MX_AOFF = 2240, MX_BIAS = MX_AOFF + 18 * 1024, MX_END = MX_BIAS + 2048;
template <int K_, bool GATHER> struct ProbMoe : g8::Order {
    static constexpr int K = K_, LDB = K_;
    const char* A; const char* Bt; const int* tok; const int* tile_e; const float* bias; size_t estride; int nbias; LAS unsigned char* xl;
    __device__ __forceinline__ void prep(int tid) const {
        LAS int* te = (LAS int*)(xl + MX_TE);
        for (int i = tid; i < nM; i += NTHR) te[i] = tile_e[i];
        if (GATHER) { LAS unsigned* ao = (LAS unsigned*)(xl + MX_AOFF); int tv[18];
#pragma unroll
            for (int i = 0; i < 18; ++i) { Unit u; tv[i] = -1; if (tid < 256 && next(i, u)) tv[i] = tok[u.pm * 256 + tid]; }
#pragma unroll
            for (int i = 0; i < 18; ++i) if (tid < 256) ao[i * 256 + tid] = tv[i] >= 0 ? (unsigned)tv[i] * (K * 2) : 0u; }
        __syncthreads();
    }
    __device__ __forceinline__ int expert(const Unit& u) const { return __builtin_amdgcn_readfirstlane(((LAS int*)(xl + MX_TE))[u.pm]); }
    __device__ __forceinline__ void unit_begin(const Unit& u, int wid, int lane) const {
        if (wid == 0) __builtin_amdgcn_global_load_lds((const unsigned*)(bias + (size_t)expert(u) * nbias + u.pn * 256 + lane * 4), (LAS unsigned*)(xl + MX_BIAS + (u.ord & 1) * 1024), 16, 0, 0);
    }
    __device__ __forceinline__ const char* a_base(const Unit& u) const { return GATHER ? A : A + (size_t)u.pm * 256 * K * 2; }
    __device__ __forceinline__ unsigned a_off(const Unit& u, int row) const { if (GATHER) return ((LAS unsigned*)(xl + MX_AOFF))[u.ord * 256 + row]; return (unsigned)(row * K * 2); }
    __device__ __forceinline__ const char* b_base(const Unit& u) const { return Bt + (size_t)expert(u) * estride + (size_t)u.pn * 256 * K * 2; }
};
struct ProbCmp : g8::Order {
    static constexpr int K = 512, LDB = 2048;
    const char* csrc; const char* W1t;
    __device__ __forceinline__ void prep(int) const {}
    __device__ __forceinline__ void unit_begin(const Unit&, int, int) const {}
    __device__ __forceinline__ const char* a_base(const Unit& u) const { return csrc + (size_t)(u.pm >> 2) * SEQ * 64 * 2 + (u.pm & 3) * 1024; }
    __device__ __forceinline__ unsigned a_off(const Unit&, int row) const { return (unsigned)(row * 2048); }
    __device__ __forceinline__ const char* b_base(const Unit& u) const { return W1t + (size_t)(u.pm >> 7) * 256 * 2048 * 2 + (u.pm & 3) * 1024; }
};
typedef unsigned au32x2_ __attribute__((ext_vector_type(2)));
__device__ __forceinline__ uint2 pk4(const f32x4& v) { return make_uint2(pack_bf16(v[0], v[1]), pack_bf16(v[2], v[3])); }
__device__ __forceinline__ void st_pair16(unsigned short* grp, int fq, uint2 qa, uint2 qb) {
    const auto rx = __builtin_amdgcn_permlane16_swap(qa.x, qb.x, false, false);
    const auto ry = __builtin_amdgcn_permlane16_swap(qa.y, qb.y, false, false);
    *(uint4*)(grp + ((fq & 1) ? 16 + 4 * (fq - 1) : 4 * fq)) = make_uint4(rx[0], ry[0], rx[1], ry[1]);
}
struct QStoreF32 { float* C; long ldc; int N; __device__ __forceinline__ void operator()(const Unit&, int row, int col, const f32x4& v) const { if (col < N) *(f32x4*)(C + (size_t)row * ldc + col) = v; } };
template <bool INF32> struct EpiResid {
    const void* Xin; unsigned short* Xout; const float* gate; long ldg;
    __device__ __forceinline__ void operator()(const f32x4 (&acc)[2][2][4][2], const Unit& u, int wr, int wc, int fr, int fq) const {
        const int row0 = u.pm * 256 + wr * 64 + fr, col0 = u.pn * 256 + wc * 32 + 4 * fq, b = (u.pm * 256) / SEQ;
        if (u.half >= 0) {
#pragma unroll
            for (int ai = 0; ai < 2; ++ai)
#pragma unroll
                for (int m = 0; m < 4; ++m)
#pragma unroll
                    for (int n = 0; n < 2; ++n) { const size_t o_ = (size_t)(row0 + ai * 128 + m * 16) * DM + col0 + u.half * 128 + n * 16;
                        const f32x4 g4 = *(const f32x4*)(gate + b * ldg + col0 + u.half * 128 + n * 16); f32x4 xv;
                        if (INF32) xv = *(const f32x4*)((const float*)Xin + o_);
                        else { const uint2 q = *(const uint2*)((const unsigned short*)Xin + o_); xv = (f32x4){__uint_as_float(q.x << 16), __uint_as_float(q.x & 0xffff0000u), __uint_as_float(q.y << 16), __uint_as_float(q.y & 0xffff0000u)}; }
                        const f32x4 o = xv + g4 * acc[ai][0][m][n]; *(uint2*)(Xout + o_) = make_uint2(pack_bf16(o[0], o[1]), pack_bf16(o[2], o[3])); }
            return;
        }
        f32x4 gv[2][2];
#pragma unroll
        for (int bj = 0; bj < 2; ++bj)
#pragma unroll
            for (int n = 0; n < 2; ++n) gv[bj][n] = *(const f32x4*)(gate + b * ldg + col0 + bj * 128 + n * 16);
#pragma unroll
        for (int ai = 0; ai < 2; ++ai) {
            if (INF32) {
#pragma unroll
                for (int bj = 0; bj < 2; ++bj) {
                    f32x4 xv[4][2];
#pragma unroll
                    for (int m = 0; m < 4; ++m)
#pragma unroll
                        for (int n = 0; n < 2; ++n) xv[m][n] = *(const f32x4*)((const float*)Xin + (size_t)(row0 + ai * 128 + m * 16) * DM + col0 + bj * 128 + n * 16);
                    __builtin_amdgcn_sched_barrier(0);
#pragma unroll
                    for (int m = 0; m < 4; ++m)
                        { const f32x4 o0 = xv[m][0] + gv[bj][0] * acc[ai][bj][m][0], o1 = xv[m][1] + gv[bj][1] * acc[ai][bj][m][1];
                          st_pair16(Xout + (size_t)(row0 + ai * 128 + m * 16) * DM + u.pn * 256 + wc * 32 + bj * 128, fq, pk4(o0), pk4(o1)); }
                }
            } else {
                uint2 xu[4][2][2];
#pragma unroll
                for (int m = 0; m < 4; ++m)
#pragma unroll
                    for (int bj = 0; bj < 2; ++bj)
#pragma unroll
                        for (int n = 0; n < 2; ++n) xu[m][bj][n] = *(const uint2*)((const unsigned short*)Xin + (size_t)(row0 + ai * 128 + m * 16) * DM + col0 + bj * 128 + n * 16);
                __builtin_amdgcn_sched_barrier(0);
#pragma unroll
                for (int m = 0; m < 4; ++m)
#pragma unroll
                    for (int bj = 0; bj < 2; ++bj) { f32x4 o2[2];
#pragma unroll
                        for (int n = 0; n < 2; ++n) { const uint2 q = xu[m][bj][n];
                            const f32x4 xv = (f32x4){__uint_as_float(q.x << 16), __uint_as_float(q.x & 0xffff0000u), __uint_as_float(q.y << 16), __uint_as_float(q.y & 0xffff0000u)};
                            o2[n] = xv + gv[bj][n] * acc[ai][bj][m][n]; }
                        st_pair16(Xout + (size_t)(row0 + ai * 128 + m * 16) * DM + u.pn * 256 + wc * 32 + bj * 128, fq, pk4(o2[0]), pk4(o2[1])); }
            }
        }
    }
};
struct QNsaIn { float* qn; float* gates; const float* bg; __device__ __forceinline__ void operator()(const Unit&, int row, int col, const f32x4& v) const {
    if (col < 1024) *(f32x4*)(qn + (size_t)row * 1024 + col) = v * 0.125f;
    else if (col < NSA_IN) { const int c = col - 1024; f32x4 o; for (int j = 0; j < 4; ++j) o[j] = sigm(v[j] + bg[c + j]); *(f32x4*)(gates + (size_t)row * 48 + c) = o; } } };
struct QNsaIn2 { unsigned short* qb; float* gates; const float* bg; __device__ __forceinline__ void operator()(const Unit&, int row, int col, const f32x4& v) const {
    if (col < 1024) { const float sc = 0.125f * 1.4426950408889634f; *(uint2*)(qb + (size_t)row * 1024 + col) = make_uint2(pack_bf16(v[0] * sc, v[1] * sc), pack_bf16(v[2] * sc, v[3] * sc)); }
    else if (col < NSA_IN) { const int c = col - 1024; f32x4 o; for (int j = 0; j < 4; ++j) o[j] = sigm(v[j] + bg[c + j]); *(f32x4*)(gates + (size_t)row * 48 + c) = o; } } };
struct QKv2 { unsigned short *csrc, *kslc, *vslcT, *kwin, *vwinT; __device__ __forceinline__ void operator()(const Unit&, int row, int col, const f32x4& v) const {
    const int j = col >> 8, g = (col >> 6) & 3, d = col & 63, b = row / SEQ, s = row % SEQ, bg = b * 4 + g;
    if (j < 2) *(uint2*)(csrc + ((size_t)((j * 32 + bg) * SEQ + s)) * 64 + d) = make_uint2(pack_bf16(v[0], v[1]), pack_bf16(v[2], v[3]));
    else if (j == 2 || j == 4) *(uint2*)((j == 2 ? kslc : kwin) + ((size_t)bg * SEQ + s) * 64 + d) = make_uint2(pack_bf16(v[0], v[1]), pack_bf16(v[2], v[3]));
    else { const int sp = (s & ~15) | (((s >> 2) & 1) << 3) | (((s >> 3) & 1) << 2) | (s & 3);
        unsigned short* vt = (j == 3 ? vslcT : vwinT) + ((size_t)bg * 64 + d) * SEQ + sp;
#pragma unroll
        for (int i = 0; i < 4; ++i) vt[(size_t)i * SEQ] = f2bf(v[i]); } } };
struct QGlaIn { unsigned short *qk, *vT, *rb; float* glr; __device__ __forceinline__ void operator()(const Unit&, int row, int col, const f32x4& v) const {
    if (col < 1024) *(uint2*)(qk + (size_t)row * 1024 + col) = make_uint2(pack_bf16(v[0], v[1]), pack_bf16(v[2], v[3]));
    else if (col < 2048) { const int ce = col - 1024, b = row / SEQ, s = row % SEQ; unsigned short* vt = vT + ((size_t)(b * 4 + (ce >> 8)) * 256 + (ce & 255)) * SEQ + s;
#pragma unroll
        for (int i = 0; i < 4; ++i) vt[(size_t)i * SEQ] = f2bf(v[i]); }
    else if (col < 3072) *(uint2*)(rb + (size_t)row * 1024 + (col - 2048)) = make_uint2(pack_bf16(v[0], v[1]), pack_bf16(v[2], v[3]));
    else if (col < GLA_IN) *(f32x4*)(glr + (size_t)row * 16 + (col - 3072)) = v; } };
__device__ __forceinline__ float fast_sigm(float x) { return __builtin_amdgcn_rcpf(1.f + __builtin_amdgcn_exp2f(-1.4426950408889634f * x)); }
typedef float f32x2_ __attribute__((ext_vector_type(2)));
template <bool PERMK>
__device__ __forceinline__ void st_vT_tile(LAS unsigned char* T, unsigned short* vt_col0, int row, int fq, const f32x4& v0, const f32x4& v1) {
    const int fr = row & 15, lane16 = fr, g = fq;
    *(LAS au32x2_*)(T + fr * 64 + fq * 8) = (au32x2_){pack_bf16(v0[0], v0[1]), pack_bf16(v0[2], v0[3])};
    *(LAS au32x2_*)(T + fr * 64 + 32 + fq * 8) = (au32x2_){pack_bf16(v1[0], v1[1]), pack_bf16(v1[2], v1[3])};
    const int colblk = g & 1, th = g >> 1, j = lane16 >> 2, q = lane16 & 3;
    const int t0 = PERMK ? 4 * th : 8 * th, t1 = PERMK ? 8 + 4 * th : 8 * th + 4;
    LAS unsigned char* a0 = T + (t0 + j) * 64 + colblk * 32 + q * 8;
    LAS unsigned char* a1 = T + (t1 + j) * 64 + colblk * 32 + q * 8;
    au32x2_ r0, r1;
    asm volatile("s_waitcnt lgkmcnt(0)\n\tds_read_b64_tr_b16 %0, %2\n\tds_read_b64_tr_b16 %1, %3\n\ts_waitcnt lgkmcnt(0)" : "=&v"(r0), "=&v"(r1) : "v"(a0), "v"(a1) : "memory");
    *(uint4*)(vt_col0 + (size_t)(colblk * 16 + lane16) * SEQ + 8 * th) = make_uint4(r0.x, r0.y, r1.x, r1.y);
}
struct PGlaIn { unsigned short *qk, *vT, *rb; float* glr; LAS unsigned char* tl; __device__ __forceinline__ void operator()(const Unit&, int row, int gb, int fq, int wv, const f32x4& v0, const f32x4& v1) const {
    if (gb < 1024) st_pair16(qk + (size_t)row * 1024 + gb, fq, pk4(v0), pk4(v1));
    else if (gb < 2048) { const int b = row / SEQ, s = row % SEQ;
#pragma unroll
        for (int n = 0; n < 2; ++n) { const int ce = gb - 1024 + n * 16 + 4 * fq; unsigned short* vt = vT + ((size_t)(b * 4 + (ce >> 8)) * 256 + (ce & 255)) * SEQ + s; const f32x4& v = n ? v1 : v0;
#pragma unroll
            for (int i = 0; i < 4; ++i) vt[(size_t)i * SEQ] = f2bf(v[i]); } }
    else if (gb < 3072) st_pair16(rb + (size_t)row * 1024 + (gb - 2048), fq, pk4(v0), pk4(v1));
    else if (gb == 3072) *(f32x4*)(glr + (size_t)row * 16 + 4 * fq) = v0; } };
struct PNsaIn { unsigned short* qb; float* gates; const float* bg; __device__ __forceinline__ void operator()(const Unit&, int row, int gb, int fq, int, const f32x4& v0, const f32x4& v1) const {
    if (gb < 1024) { const float sc = 0.125f * 1.4426950408889634f; st_pair16(qb + (size_t)row * 1024 + gb, fq, pk4(v0 * sc), pk4(v1 * sc)); }
    else {
#pragma unroll
        for (int n = 0; n < 2; ++n) { const int c = gb - 1024 + n * 16 + 4 * fq; if (c < 48) { const f32x4& v = n ? v1 : v0; f32x4 o; for (int j = 0; j < 4; ++j) o[j] = sigm(v[j] + bg[c + j]); *(f32x4*)(gates + (size_t)row * 48 + c) = o; } } } } };
struct PKv { unsigned short *csrc, *kslc, *vslcT, *kwin, *vwinT; LAS unsigned char* tl; __device__ __forceinline__ void operator()(const Unit&, int row, int gb, int fq, int wv, const f32x4& v0, const f32x4& v1) const {
    const int j = gb >> 8, g = (gb >> 6) & 3, d0 = gb & 63, b = row / SEQ, s = row % SEQ, bg = b * 4 + g;
    if (j < 2) st_pair16(csrc + ((size_t)((j * 32 + bg) * SEQ + s)) * 64 + d0, fq, pk4(v0), pk4(v1));
    else if (j == 2 || j == 4) st_pair16((j == 2 ? kslc : kwin) + ((size_t)bg * SEQ + s) * 64 + d0, fq, pk4(v0), pk4(v1));
    else { const int sp = (s & ~15) | (((s >> 2) & 1) << 3) | (((s >> 3) & 1) << 2) | (s & 3);
#pragma unroll
        for (int n = 0; n < 2; ++n) { unsigned short* vt = (j == 3 ? vslcT : vwinT) + ((size_t)bg * 64 + d0 + n * 16 + 4 * fq) * SEQ + sp; const f32x4& v = n ? v1 : v0;
#pragma unroll
            for (int i = 0; i < 4; ++i) vt[(size_t)i * SEQ] = f2bf(v[i]); } } } };
struct QSwiglu { unsigned short* act; LAS unsigned char* xl; __device__ __forceinline__ void operator()(const Unit& u, int row, int col, const f32x4& v) const {
    const f32x4 bv = *(const LAS f32x4*)(xl + MX_BIAS + (u.ord & 1) * 1024 + (col - u.pn * 256) * 4);
    f32x2_ G = (f32x2_){v[0], v[2]} + (f32x2_){bv[0], bv[2]}, U = (f32x2_){v[1], v[3]} + (f32x2_){bv[1], bv[3]};
    G.x = fminf(G.x, 7.f); G.y = fminf(G.y, 7.f);
    U.x = __builtin_amdgcn_fmed3f(U.x, -7.f, 7.f); U.y = __builtin_amdgcn_fmed3f(U.y, -7.f, 7.f);
    f32x2_ E = G * (-1.702f * 1.4426950408889634f); E.x = __builtin_amdgcn_exp2f(E.x); E.y = __builtin_amdgcn_exp2f(E.y);
    f32x2_ S = E + 1.0f; S.x = __builtin_amdgcn_rcpf(S.x); S.y = __builtin_amdgcn_rcpf(S.y);
    const f32x2_ R = ((U + 1.0f) * G) * S;
    *(unsigned*)(act + (size_t)row * 1024 + (col >> 1)) = pack_bf16(R.x, R.y); } };
struct QDownF { float* y; const float* bd; const int* tile_e; __device__ __forceinline__ void operator()(const Unit& u, int row, int col, const f32x4& v) const {
    const int e = tile_e[u.pm]; *(f32x4*)(y + (size_t)row * 1024 + col) = v + *(const f32x4*)(bd + e * 1024 + col); } };
struct EpiSwiglu { unsigned short* act; LAS unsigned char* xl;
    __device__ __forceinline__ void operator()(const f32x4 (&acc)[2][2][4][2], const Unit& u, int wr, int wc, int fr, int fq) const {
        const int row0 = u.pm * 256 + wr * 64 + fr, cl0 = wc * 32 + 4 * fq;
        f32x4 bv[2][2];
#pragma unroll
        for (int bj = 0; bj < 2; ++bj)
#pragma unroll
            for (int n = 0; n < 2; ++n) bv[bj][n] = *(const LAS f32x4*)(xl + MX_BIAS + (u.ord & 1) * 1024 + (cl0 + bj * 128 + n * 16) * 4);
#pragma unroll
        for (int ai = 0; ai < 2; ++ai)
#pragma unroll
            for (int mp = 0; mp < 2; ++mp) {
                f32x2_ G[8], U[8], E[8];
#pragma unroll
                for (int q = 0; q < 8; ++q) { const int m = mp * 2 + (q >> 2), bj = (q >> 1) & 1, n = q & 1; const f32x4 v = acc[ai][bj][m][n]; const f32x4 b4 = bv[bj][n];
                    G[q] = (f32x2_){v[0], v[2]} + (f32x2_){b4[0], b4[2]}; U[q] = (f32x2_){v[1], v[3]} + (f32x2_){b4[1], b4[3]}; }
#pragma unroll
                for (int q = 0; q < 8; ++q) { G[q].x = fminf(G[q].x, 7.f); G[q].y = fminf(G[q].y, 7.f); U[q].x = __builtin_amdgcn_fmed3f(U[q].x, -7.f, 7.f); U[q].y = __builtin_amdgcn_fmed3f(U[q].y, -7.f, 7.f);
                    E[q] = G[q] * (-1.702f * 1.4426950408889634f); }
#pragma unroll
                for (int q = 0; q < 8; ++q) { E[q].x = __builtin_amdgcn_exp2f(E[q].x); E[q].y = __builtin_amdgcn_exp2f(E[q].y); }
#pragma unroll
                for (int q = 0; q < 8; ++q) { E[q] = E[q] + 1.0f; U[q] = (U[q] + 1.0f) * G[q]; }
#pragma unroll
                for (int q = 0; q < 8; ++q) { E[q].x = __builtin_amdgcn_rcpf(E[q].x); E[q].y = __builtin_amdgcn_rcpf(E[q].y); }
#pragma unroll
                for (int mm = 0; mm < 2; ++mm) { const int m = mp * 2 + mm; unsigned pk[4];
#pragma unroll
                    for (int q4 = 0; q4 < 4; ++q4) { const f32x2_ R = U[mm * 4 + q4] * E[mm * 4 + q4]; pk[q4] = pack_bf16(R.x, R.y); }
                    *(uint4*)(act + (size_t)(row0 + ai * 128 + m * 16) * 1024 + u.pn * 128 + wc * 32 + fq * 8) = make_uint4(pk[0], pk[1], pk[2], pk[3]); }
            }
    }
};
struct EpiDown { unsigned short* y; LAS unsigned char* xl;
    __device__ __forceinline__ void operator()(const f32x4 (&acc)[2][2][4][2], const Unit& u, int wr, int wc, int fr, int fq) const {
        const int hb_ = u.half >= 0 ? u.half : 0; const int nbj = u.half >= 0 ? 1 : 2;
        const int row0 = u.pm * 256 + wr * 64 + fr, cl0 = wc * 32 + 4 * fq;
        f32x4 bv[2][2];
#pragma unroll
        for (int bj = 0; bj < 2; ++bj)
#pragma unroll
            for (int n = 0; n < 2; ++n) bv[bj][n] = *(const LAS f32x4*)(xl + MX_BIAS + (u.ord & 1) * 1024 + (cl0 + (bj + hb_ < 2 ? bj + hb_ : 1) * 128 + n * 16) * 4);
#pragma unroll
        for (int ai = 0; ai < 2; ++ai)
#pragma unroll
            for (int m = 0; m < 4; ++m) {
                unsigned short* rowp = y + (size_t)(row0 + ai * 128 + m * 16) * 1024 + u.pn * 256 + wc * 32;
#pragma unroll
                for (int bj = 0; bj < 2; ++bj) { if (bj >= nbj) continue;
                    const f32x4 o0 = acc[ai][bj][m][0] + bv[bj][0], o1 = acc[ai][bj][m][1] + bv[bj][1];
                    st_pair16(rowp + (bj + hb_) * 128, fq, make_uint2(pack_bf16(o0[0], o0[1]), pack_bf16(o0[2], o0[3])), make_uint2(pack_bf16(o1[0], o1[1]), pack_bf16(o1[2], o1[3]))); }
            }
    }
};
struct QKv { float* kv6; unsigned short* csrc; __device__ __forceinline__ void operator()(const Unit&, int row, int col, const f32x4& v) const {
    *(f32x4*)(kv6 + (size_t)row * KV_OUT + col) = v;
    if (col < 512) { const int t = col >> 8, g = (col >> 6) & 3, d = col & 63, b = row / SEQ, s = row % SEQ;
        *(uint2*)(csrc + ((size_t)((t * 32 + b * 4 + g) * SEQ + s)) * 64 + d) = make_uint2(pack_bf16(v[0], v[1]), pack_bf16(v[2], v[3])); } } };
struct QCmp1 { float* hidp; __device__ __forceinline__ void operator()(const Unit& u, int row, int col, const f32x4& v) const {
    const int z = u.pm >> 2, ks = u.pm & 3, n = row - u.pm * 256; if (col < 128 && n < NCMP) *(f32x4*)(hidp + (((size_t)ks * 64 + z) * NCMP + n) * 128 + col) = v; } };

struct P {
    const float *x_in, *c, *ada_w, *ada_b, *norm1_g, *norm2_g, *gla_w_in, *gla_w_gate2, *gla_b_gate, *gla_norm_g, *gla_w_out, *kv_norm_g, *kv_ada_w, *kv_ada_b,
        *kv_w, *cmp_pos, *cmp_w1, *cmp_b1, *cmp_w2, *cmp_b2, *nsa_w_in, *nsa_b_gate, *nsa_w_out, *router_w, *router_b, *moe_w_gu, *moe_b_gu, *moe_w_down, *moe_b_down, *final_g;
    float* out; unsigned* bar;
    float *mod, *kvmod, *hid, *gates, *topw, *c1, *glr, *gdl;
    unsigned short *x, *y, *hb, *ob, *act, *csrc, *qb, *kslc, *vslcT, *kwin, *vwinT, *kcmp, *vcmpT, *gqk, *gvT, *grb, *gqd, *gki, *gST, *gUT, *wt_gla_in, *wt_gla_out, *wt_kv, *wt_nsa_in, *wt_nsa_out, *wt_cmp1, *wt_gu, *wt_down;
    unsigned long long* sel; int *topi, *cnt, *cntb, *stok, *pos, *tile_e;
};
typedef const P __attribute__((address_space(4)))* KP;
constexpr int LDS_BAR_OFF = g8::STAGE_BYTES;
constexpr int LDS_X_OFF = g8::STAGE_BYTES + 64;
constexpr size_t kDynLds = LDS_X_OFF + MX_END;
__device__ __forceinline__ float* dyn_smem() { extern __shared__ __attribute__((aligned(16))) float smem_[]; return smem_; }
struct Ctx {
int nb_s;
int wv_s;
#define LAUNDER() int tid_; asm volatile("v_mbcnt_lo_u32_b32 %0, -1, 0\n\tv_mbcnt_hi_u32_b32 %0, -1, %0" : "=v"(tid_)); tid_ += wv_s * 64; const int bid_ = blockIdx.x; const int GTID = bid_ * NTHR + tid_; const int GSZ = nb_s * NTHR; (void)GTID; (void)GSZ;
#define SHX(v, o) __uint_as_float((unsigned)__builtin_amdgcn_ds_bpermute(((tid_ ^ (o)) & 63) << 2, (int)__float_as_uint(v)))

__device__ __forceinline__ void ph_mod(const float* c, const float* ada_w, const float* ada_b, const float* kv_ada_w, const float* kv_ada_b,
                                       float* mod, float* kvmod, float* smem) {
    LAUNDER();
    float (*cs)[1024] = (float (*)[1024])smem;
    float* red = smem + 8192;
    for (int i = tid_; i < 8192; i += NTHR) { float v = c[i]; cs[i >> 10][i & 1023] = siluf(v); }
    __syncthreads();
    const int ncol = 4 * 6144 + 2048, cl = tid_ & 127, kq = tid_ >> 7;
    for (int c0 = bid_ * 128; c0 < ncol; c0 += nb_s * 128) {
        const int col = c0 + cl;
        const float* w = nullptr; int ldw = 0; float* out = nullptr; int ldo = 0; const float* bias = nullptr;
        if (col < 4 * 6144) { int L = col / 6144, j = col % 6144; w = ada_w + (size_t)L * 1024 * 6144 + j; ldw = 6144; bias = ada_b + L * 6144 + j; out = mod + (size_t)L * 8 * 6144 + j; ldo = 6144; }
        else if (col < ncol) { int j = col - 4 * 6144; w = kv_ada_w + j; ldw = 2048; bias = kv_ada_b + j; out = kvmod + j; ldo = 2048; }
        float acc[8];
#pragma unroll
        for (int b = 0; b < 8; ++b) acc[b] = 0.f;
        if (w) {
#pragma unroll 4
            for (int k = kq * 256; k < kq * 256 + 256; ++k) { const float wv = w[(size_t)k * ldw];
#pragma unroll
                for (int b = 0; b < 8; ++b) acc[b] += cs[b][k] * wv; } }
#pragma unroll
        for (int b = 0; b < 8; ++b) red[(kq * 128 + cl) * 8 + b] = acc[b];
        __syncthreads();
        if (kq == 0 && w) { const float bv = *bias;
#pragma unroll
            for (int b = 0; b < 8; ++b) out[b * ldo] = red[cl * 8 + b] + red[(128 + cl) * 8 + b] + red[(256 + cl) * 8 + b] + red[(384 + cl) * 8 + b] + bv; }
        __syncthreads();
    }
}

__device__ __forceinline__ void ph_norm(const float* x, const float* g, const float* shift, const float* scale, float* out, unsigned short* outb, int ldmod) {
    LAUNDER();
    const int lane = tid_ & 63;
    float4 gg[4], vn[4];
#pragma unroll
    for (int j = 0; j < 4; ++j) { gg[j] = *(const float4*)(g + j * 256 + lane * 4); vn[j] = make_float4(0.f, 0.f, 0.f, 0.f); }
    if ((GTID >> 6) < NT) {
#pragma unroll
        for (int j = 0; j < 4; ++j) vn[j] = *(const float4*)(x + (size_t)(GTID >> 6) * DM + j * 256 + lane * 4); }
    for (int row = GTID >> 6; row < NT; row += GSZ >> 6) {
        const int b = row / SEQ;
        float4 v[4], sc[4], sh[4]; float ss = 0.f;
#pragma unroll
        for (int j = 0; j < 4; ++j) { v[j] = vn[j]; sc[j] = make_float4(0.f, 0.f, 0.f, 0.f); sh[j] = sc[j];
            if (shift) { sc[j] = *(const float4*)(scale + b * ldmod + j * 256 + lane * 4); sh[j] = *(const float4*)(shift + b * ldmod + j * 256 + lane * 4); } }
        { const int nr = row + (GSZ >> 6);
          if (nr < NT) {
#pragma unroll
              for (int j = 0; j < 4; ++j) vn[j] = *(const float4*)(x + (size_t)nr * DM + j * 256 + lane * 4); } }
#pragma unroll
        for (int j = 0; j < 4; ++j) ss += v[j].x * v[j].x + v[j].y * v[j].y + v[j].z * v[j].z + v[j].w * v[j].w;
        for (int o = 32; o > 0; o >>= 1) ss += SHX(ss, o);
        const float r = rsqrtf(ss * (1.f / DM) + 1e-5f);
#pragma unroll
        for (int j = 0; j < 4; ++j) { const int col = j * 256 + lane * 4;
            float4 y = make_float4(v[j].x * r * gg[j].x, v[j].y * r * gg[j].y, v[j].z * r * gg[j].z, v[j].w * r * gg[j].w);
            if (shift) { y.x = y.x * (1.f + sc[j].x) + sh[j].x; y.y = y.y * (1.f + sc[j].y) + sh[j].y; y.z = y.z * (1.f + sc[j].z) + sh[j].z; y.w = y.w * (1.f + sc[j].w) + sh[j].w; }
            if (out) *(float4*)(out + (size_t)row * DM + col) = y;
            if (outb) *(uint2*)(outb + (size_t)row * DM + col) = make_uint2(pack_bf16(y.x, y.y), pack_bf16(y.z, y.w)); }
    }
}

template <class AF, class BF, class EF>
__device__ __forceinline__ void ph_gemm(AF af, BF bf, EF ef, int M, int N, int K, int Z, float* smem) {
    LAUNDER();
    float (*As)[132] = (float (*)[132])smem;
    float (*Bs)[132] = (float (*)[132])(smem + 16 * 132);
    const int tm = (M + 127) / 128, tn = (N + 127) / 128, total = Z * tm * tn;
    const int tid = tid_, ty = tid >> 4, tx = tid & 15;
    for (int it = bid_; it < total; it += nb_s) {
        const int z = it / (tm * tn), rr = it % (tm * tn), m0 = (rr / tn) * 128, n0 = (rr % tn) * 128;
        if (!af.active(z, m0)) continue;
        float acc[4][8];
#pragma unroll
        for (int i = 0; i < 4; ++i)
#pragma unroll
            for (int j = 0; j < 8; ++j) acc[i][j] = 0.f;
#pragma unroll 1
        for (int k0 = 0; k0 < K; k0 += 16) {
            { const int r = tid >> 2, kk = (tid & 3) * 4, m = m0 + r;
#pragma unroll
              for (int j = 0; j < 4; ++j) As[kk + j][r] = (m < M) ? af(z, m, k0 + kk + j) : 0.f; }
            { const int kk = tid >> 5, cc = (tid & 31) * 4;
#pragma unroll
              for (int j = 0; j < 4; ++j) { const int n = n0 + cc + j; Bs[kk][cc + j] = (n < N) ? bf(z, m0, k0 + kk, n) : 0.f; } }
            __syncthreads();
#pragma unroll
            for (int kk = 0; kk < 16; ++kk) {
                float a[4], b[8];
#pragma unroll
                for (int i = 0; i < 4; ++i) a[i] = As[kk][ty * 4 + i];
#pragma unroll
                for (int j = 0; j < 8; ++j) b[j] = Bs[kk][tx * 8 + j];
#pragma unroll
                for (int i = 0; i < 4; ++i)
#pragma unroll
                    for (int j = 0; j < 8; ++j) acc[i][j] += a[i] * b[j];
            }
            __syncthreads();
        }
#pragma unroll
        for (int i = 0; i < 4; ++i) { const int m = m0 + ty * 4 + i; if (m < M) ef(z, m, m0, n0 + tx * 8, acc[i], N); }
    }
}

__device__ __forceinline__ void ph_gla_gate(const float* proj, const float* w2, const float* bg, float* loga) {
    LAUNDER();
    for (size_t i = GTID; i < (size_t)NT * 512; i += GSZ) {
        const int t = (int)(i >> 9), j = (int)(i & 511);
        float z = bg[j];
#pragma unroll
        for (int r = 0; r < 16; ++r) z += proj[(size_t)t * GLA_IN + 3072 + r] * w2[r * 512 + j];
        loga[i] = logsigmoidf(z) * (1.f / 16.f);
    }
}
__device__ __forceinline__ void ph_gla_rec(const float* proj, const float* loga, float* oraw, float* smem) {
    LAUNDER();
    if (bid_ >= 16) return;
    const int half = tid_ >> 8, e = tid_ & 255, item = bid_ * 2 + half;
    float* sq = smem + half * 384; float* sk = sq + 128; float* sa = sk + 128;
    const int b = item >> 2, h = item & 3;
    float st[128];
#pragma unroll
    for (int d = 0; d < 128; ++d) st[d] = 0.f;
    const float* pr = proj + (size_t)b * SEQ * GLA_IN + h * 128 + (e < 128 ? e : 512 + (e - 128));
    const float* pa = loga + (size_t)b * SEQ * 512 + h * 128 + (e & 127);
    const float* pv = proj + (size_t)b * SEQ * GLA_IN + 1024 + h * 256 + e;
    float* po = oraw + (size_t)b * SEQ * DM + h * 256 + e;
#pragma unroll 1
    for (int t = 0; t < SEQ; ++t) {
        if (e < 128) { sq[e] = *pr; sa[e] = expf(*pa); } else { sk[e - 128] = *pr; }
        const float v = *pv;
        __syncthreads();
        float o = 0.f;
#pragma unroll
        for (int d = 0; d < 128; ++d) { st[d] = st[d] * sa[d] + sk[d] * v; o += sq[d] * st[d]; }
        *po = o * 0.08838834764831845f;
        __syncthreads();
        pr += GLA_IN; pa += 512; pv += GLA_IN; po += DM;
    }
}
__device__ __forceinline__ void ph_gla_post(const float* oraw, const float* proj, const float* ng, unsigned short* ob) {
    LAUNDER();
    const int l = tid_ & 63;
    for (int it = GTID >> 6; it < NT * 4; it += GSZ >> 6) {
        const int row = it >> 2, h = it & 3;
        const float4 v = *(const float4*)(oraw + (size_t)row * DM + h * 256 + l * 4);
        float ss = v.x * v.x + v.y * v.y + v.z * v.z + v.w * v.w;
        for (int s = 32; s > 0; s >>= 1) ss += SHX(ss, s);
        const float r = rsqrtf(ss * (1.f / 256.f) + 1e-5f);
        float vv[4] = {v.x, v.y, v.z, v.w};
#pragma unroll
        for (int j = 0; j < 4; ++j) { const int col = h * 256 + l * 4 + j; const float rr = proj[(size_t)row * GLA_IN + 2048 + col];
            ob[(size_t)row * DM + col] = f2bf(vv[j] * r * ng[col] * siluf(rr)); }
    }
}

__device__ __forceinline__ void ph_nsa_cmp(const float* qn, const float* comp, float* pc, float* oc) {
    LAUNDER();
    for (int idx = GTID; idx < NT * 16; idx += GSZ) {
        const int bt = idx >> 4, hd = idx & 15, b = bt / SEQ, t = bt % SEQ, g = hd >> 2;
        const float slope = exp2f(-0.5f * (hd + 1));
        float q[64];
#pragma unroll
        for (int d = 0; d < 64; ++d) q[d] = qn[(size_t)bt * 1024 + hd * 64 + d];
        const int nv = t >= 31 ? min(NCMP, (t - 31) / 16 + 1) : 0;
        const float* kc = comp + (size_t)(0 * 32 + b * 4 + g) * NCMP * 64;
        const float* vc = comp + (size_t)(1 * 32 + b * 4 + g) * NCMP * 64;
        float* pr = pc + (size_t)idx * 256;
        float mx = -1e30f;
        for (int n = 0; n < nv; ++n) { float s = 0.f;
#pragma unroll
            for (int d = 0; d < 64; ++d) s += q[d] * kc[n * 64 + d];
            s -= slope * (float)(t - (16 * n + 31)); pr[n] = s; mx = fmaxf(mx, s); }
        float l = 0.f;
        for (int n = 0; n < nv; ++n) l += expf(pr[n] - mx);
        const float inv = nv > 0 ? 1.f / l : 0.f;
        float o[64];
#pragma unroll
        for (int d = 0; d < 64; ++d) o[d] = 0.f;
        for (int n = 0; n < nv; ++n) { const float p = expf(pr[n] - mx) * inv; pr[n] = p;
#pragma unroll
            for (int d = 0; d < 64; ++d) o[d] += p * vc[n * 64 + d]; }
        for (int n = nv; n < 256; ++n) pr[n] = 0.f;
#pragma unroll
        for (int d = 0; d < 64; ++d) oc[(size_t)idx * 64 + d] = o[d];
    }
}
__device__ __forceinline__ void ph_nsa_sel(const float* pc, unsigned long long* sel) {
    LAUNDER();
    const int j = tid_ & 63;
    for (int idx = GTID >> 6; idx < NT * 4; idx += GSZ >> 6) {
        const int bt = idx >> 2, g = idx & 3, t = bt % SEQ, cur = t >> 6;
        float imp = 0.f;
        for (int hp = 0; hp < 4; ++hp) { const float* pr = pc + ((size_t)bt * 16 + g * 4 + hp) * 256;
            for (int n = max(4 * j - 1, 0); n <= min(4 * j + 3, NCMP - 1); ++n) imp += pr[n]; }
        const bool valid = j <= cur, forced = (j == 0) || (j == cur) || (j == cur - 1);
        const float s = valid ? imp + (forced ? 1e4f : 0.f) : -1e4f;
        int rank = 0;
        for (int jj = 0; jj < 64; ++jj) { const float sj = __uint_as_float((unsigned)__builtin_amdgcn_ds_bpermute(jj << 2, (int)__float_as_uint(s))); rank += (sj > s || (sj == s && jj < j)) ? 1 : 0; }
        const unsigned long long m = __ballot(rank < 16);
        if (j == 0) sel[idx] = m;
    }
}
__device__ __forceinline__ void ph_nsa_attn(const float* qn, const float* gates, const float* kv6, const float* oc, const unsigned long long* sel, float* o, unsigned short* ob) {
    LAUNDER();
    for (int idx = GTID; idx < NT * 16; idx += GSZ) {
        const int bt = idx >> 4, hd = idx & 15, b = bt / SEQ, t = bt % SEQ, g = hd >> 2, cur = t >> 6;
        const float slope = exp2f(-0.5f * (hd + 1));
        float q[64];
#pragma unroll
        for (int d = 0; d < 64; ++d) q[d] = qn[(size_t)bt * 1024 + hd * 64 + d];
        const float gc = gates[(size_t)bt * 48 + 0 * 16 + hd], gs = gates[(size_t)bt * 48 + 1 * 16 + hd], gw = gates[(size_t)bt * 48 + 2 * 16 + hd];
        const unsigned long long msk = sel[(size_t)bt * 4 + g];
        float* orow = o + (size_t)bt * 1024 + hd * 64;
        for (int br = 0; br < 2; ++br) {
            float acc[64];
#pragma unroll
            for (int d = 0; d < 64; ++d) acc[d] = 0.f;
            float mx = -1e30f, l = 0.f;
            const int kcol = (br == 0 ? 2 : 4) * 256 + g * 64, vcol = kcol + 256;
            const int jlo = br == 0 ? 0 : max(0, t - 511), jhi = br == 0 ? cur : t;
            for (int j = jlo; j <= jhi; ++j) {
                int k0, k1;
                if (br == 0) { if (!((msk >> j) & 1ull)) continue; k0 = 64 * j; k1 = min(64 * j + 63, t); } else { k0 = j; k1 = j; }
                for (int key = k0; key <= k1; ++key) {
                    const float* kr = kv6 + (size_t)(b * SEQ + key) * KV_OUT + kcol; const float* vr = kv6 + (size_t)(b * SEQ + key) * KV_OUT + vcol;
                    float s = 0.f;
#pragma unroll
                    for (int d = 0; d < 64; ++d) s += q[d] * kr[d];
                    s -= slope * (float)(t - key);
                    const float mn = fmaxf(mx, s), sc = expf(mx - mn), p = expf(s - mn);
                    l = l * sc + p; mx = mn;
#pragma unroll
                    for (int d = 0; d < 64; ++d) acc[d] = acc[d] * sc + p * vr[d];
                }
            }
            const float gg = (br == 0 ? gs : gw) / l;
            if (br == 0) {
#pragma unroll
                for (int d = 0; d < 64; ++d) orow[d] = gc * oc[(size_t)idx * 64 + d] + gg * acc[d];
            } else {
#pragma unroll
                for (int d = 0; d < 64; ++d) ob[(size_t)bt * 1024 + hd * 64 + d] = f2bf(orow[d] + gg * acc[d]);
            }
        }
    }
}

__device__ __forceinline__ void ph_router(const float* h, const float* rw, const float* rb, float* logits) {
    LAUNDER();
    for (size_t i = GTID; i < (size_t)NT * 32; i += GSZ) {
        const int t = (int)(i >> 5), e = (int)(i & 31);
        float acc = 0.f;
        for (int k = 0; k < 1024; ++k) acc += h[(size_t)t * DM + k] * rw[k * 32 + e];
        logits[i] = acc + rb[e];
    }
}
__device__ __forceinline__ void ph_top4(const float* logits, int* topi, float* topw, int* cnt) {
    LAUNDER();
    for (int t = GTID; t < NT; t += GSZ) {
        float v[32];
#pragma unroll
        for (int e = 0; e < 32; ++e) v[e] = logits[(size_t)t * 32 + e];
        float tv[4]; int ti[4];
#pragma unroll
        for (int r = 0; r < 4; ++r) { float best = -3e38f; int bi = 0;
#pragma unroll
            for (int e = 0; e < 32; ++e) if (v[e] > best) { best = v[e]; bi = e; }
            tv[r] = best; ti[r] = bi;
#pragma unroll
            for (int e = 0; e < 32; ++e) if (e == bi) v[e] = -3e38f; }
        float s = 0.f, w[4];
#pragma unroll
        for (int r = 0; r < 4; ++r) { w[r] = expf(tv[r] - tv[0]); s += w[r]; }
#pragma unroll
        for (int r = 0; r < 4; ++r) { topi[t * 4 + r] = ti[r]; topw[t * 4 + r] = w[r] / s; atomicAdd(&cnt[ti[r]], 1); }
    }
}
__device__ __forceinline__ void ph_offsets(int* cnt, int* tile_e) {
    LAUNDER();
    if (tid_ == 0 && bid_ == 0) { int s = 0;
        for (int e = 0; e < NE; ++e) { cnt[64 + e] = s; const int p = (cnt[e] + MPAD - 1) / MPAD * MPAD; for (int tl = s / MPAD; tl < (s + p) / MPAD; ++tl) tile_e[tl] = e; s += p; }
        cnt[64 + NE] = s; for (int tl = s / MPAD; tl < CAP / MPAD; ++tl) tile_e[tl] = -1; }
}
__device__ __forceinline__ void ph_assign(const int* topi, int* cnt, int* stok, int* pos) {
    LAUNDER();
    for (int i = GTID; i < NASG; i += GSZ) {
        const int e = topi[i];
        const int p = cnt[64 + e] + atomicAdd(&cnt[32 + e], 1);
        stok[p] = i >> 2; pos[i] = p;
    }
}
__device__ __forceinline__ void ph_combine(float* x, const float* y, const int* pos, const float* topw, const float* gate, int ldg) {
    LAUNDER();
    const int lane = tid_ & 63;
    for (int row = GTID >> 6; row < NT; row += GSZ >> 6) {
        const int b = row / SEQ;
#pragma unroll
        for (int j = 0; j < 4; ++j) { const int col = j * 256 + lane * 4;
            float4 acc = make_float4(0.f, 0.f, 0.f, 0.f);
            for (int r = 0; r < 4; ++r) { const float w = topw[row * 4 + r]; const float4 v = *(const float4*)(y + (size_t)pos[row * 4 + r] * DM + col);
                acc.x += w * v.x; acc.y += w * v.y; acc.z += w * v.z; acc.w += w * v.w; }
            float4 xv = *(float4*)(x + (size_t)row * DM + col); const float4 gp = *(const float4*)(gate + b * ldg + col);
            xv.x += gp.x * acc.x; xv.y += gp.y * acc.y; xv.z += gp.z * acc.z; xv.w += gp.w * acc.w;
            *(float4*)(x + (size_t)row * DM + col) = xv; }
    }
}
template <bool PERM128 = false>
__device__ __forceinline__ void ph_convT(const float* src, unsigned short* dst, int K, int N, int Npad, int nmat, float* smem) {
    LAUNDER();
    unsigned (*TT)[64][33] = (unsigned (*)[64][33])smem;
    const int tk = K / 64, tn = Npad / 64, per = tk * tn, total = nmat * per;
    const int kp = tid_ >> 4, ln = (tid_ & 15) * 4;
    float4 v0 = make_float4(0.f, 0.f, 0.f, 0.f), v1 = v0;
    auto fetch = [&](int it, float4& a, float4& b) {
        const int mat = it / per, r = it % per, k0 = (r / tn) * 64, n0 = (r % tn) * 64;
        const float* s = src + (size_t)mat * K * N;
        a = make_float4(0.f, 0.f, 0.f, 0.f); b = a;
        int ka = k0 + 2 * kp, kb = ka + 1;
        if (PERM128) {
            ka = (ka & ~127) | (((ka >> 2) & 1) * 64 + ((ka >> 5) & 3) * 16 + ((ka >> 1) & 1) * 8 + ((ka >> 3) & 3) * 2 + (ka & 1));
            kb = (kb & ~127) | (((kb >> 2) & 1) * 64 + ((kb >> 5) & 3) * 16 + ((kb >> 1) & 1) * 8 + ((kb >> 3) & 3) * 2 + (kb & 1)); }
        if (n0 + ln < N) { a = *(const float4*)(s + (size_t)ka * N + n0 + ln); b = *(const float4*)(s + (size_t)kb * N + n0 + ln); }
    };
    int it = bid_, par = 0;
    if (it < total) fetch(it, v0, v1);
    while (it < total) {
        TT[par][ln][kp] = pack_bf16(v0.x, v1.x); TT[par][ln + 1][kp] = pack_bf16(v0.y, v1.y); TT[par][ln + 2][kp] = pack_bf16(v0.z, v1.z); TT[par][ln + 3][kp] = pack_bf16(v0.w, v1.w);
        const int nxt = it + nb_s;
        if (nxt < total) fetch(nxt, v0, v1);
        __syncthreads();
        { const int mat = it / per, r = it % per, k0 = (r / tn) * 64, n0 = (r % tn) * 64;
          unsigned short* d = dst + (size_t)mat * Npad * K;
          const int n = tid_ >> 3, c = tid_ & 7;
          *(uint4*)(d + (size_t)(n0 + n) * K + k0 + 8 * c) = make_uint4(TT[par][n][4 * c], TT[par][n][4 * c + 1], TT[par][n][4 * c + 2], TT[par][n][4 * c + 3]); }
        it = nxt; par ^= 1;
    }
    __syncthreads();
}
__device__ __forceinline__ void ph_c1(const float* pos, const float* w1, const float* b1, float* c1, float* smem) {
    LAUNDER();
    for (int o = bid_; o < 256; o += nb_s) {
        const int t = o >> 7, e = o & 127; float acc = 0.f;
#pragma unroll
        for (int j = 0; j < 4; ++j) { const int f = tid_ + 512 * j; acc += pos[t * 2048 + f] * w1[((size_t)t * 2048 + f) * 128 + e]; }
#pragma unroll
        for (int s = 32; s > 0; s >>= 1) acc += SHX(acc, s);
        if ((tid_ & 63) == 0) smem[tid_ >> 6] = acc;
        __syncthreads();
        if (tid_ == 0) { float s = b1[t * 128 + e]; for (int w = 0; w < 8; ++w) s += smem[w]; c1[o] = s; }
        __syncthreads();
    }
}
typedef short a_bf16x8 __attribute__((ext_vector_type(8)));
typedef float a_f32x16 __attribute__((ext_vector_type(16)));
typedef unsigned au32x4 __attribute__((ext_vector_type(4)));
typedef unsigned au32x2 __attribute__((ext_vector_type(2)));
static constexpr int AT_TB = 8192;
static constexpr int AT_KC = 0, AT_VC = 4 * AT_TB, AT_KS = 8 * AT_TB, AT_VS = 12 * AT_TB, AT_IMP = g8::STAGE_BYTES + 64  , AT_SELM = AT_IMP + 16384, AT_WM = AT_SELM + 512, AT_END = AT_WM + 64, AT_ONES = AT_END + 8;
static_assert(16 * AT_TB <= g8::STAGE_BYTES && AT_END + 16 <= g8::STAGE_BYTES + 64 + MX_END, "attention LDS map must fit");

__device__ __forceinline__ float xhalf_max(float v) { auto rr = __builtin_amdgcn_permlane32_swap(__float_as_uint(v), __float_as_uint(v), false, false); return fmaxf(__uint_as_float(rr[0]), __uint_as_float(rr[1])); }
__device__ __forceinline__ float xhalf_sum(float v) { auto rr = __builtin_amdgcn_permlane32_swap(__float_as_uint(v), __float_as_uint(v), false, false); return __uint_as_float(rr[0]) + __uint_as_float(rr[1]); }

__device__ __forceinline__ void at_dma1(LAS unsigned char* buf, const char* gb, unsigned go, int wid) {
    __builtin_amdgcn_global_load_lds((const unsigned*)(gb + go), (LAS unsigned*)(buf + wid * 1024), 16, 0, 0);
}
__device__ __forceinline__ void at_glds(LAS unsigned char* buf, const char* gb, unsigned go, int wid) {
    unsigned sv; const unsigned la = (unsigned)(unsigned long long)(buf + wid * 1024);
    asm volatile("s_mov_b32 %0, m0\n\ts_mov_b32 m0, %3\n\ts_nop 0\n\tglobal_load_lds_dwordx4 %1, %2\n\ts_mov_b32 m0, %0" : "=&s"(sv) : "v"(go), "s"(gb), "s"(la) : "memory");
}
__device__ __forceinline__ void at_dma(LAS unsigned char* kbuf, LAS unsigned char* vbuf, const char* kb, const char* vb, unsigned ko, unsigned vo, int wid) {
    at_dma1(kbuf, kb, ko, wid); at_dma1(vbuf, vb, vo, wid);
}
#define AT_SWZ(row, g) ((row) * 128 + ((((g) ^ (((row) >> 1) & 7))) << 4))
#define AT_REGOFF(i) (((i) & 3) + 8 * ((i) >> 2))
__device__ __forceinline__ void at_qk(LAS unsigned char* kbuf, const a_bf16x8 (&qf)[4], a_f32x16 (&st)[2], const int (&off4)[4], float base, float slk, int hh) {
    a_bf16x8 kf[2][4];
#pragma unroll
    for (int kt = 0; kt < 2; ++kt)
#pragma unroll
        for (int s = 0; s < 4; ++s) kf[kt][s] = *(const LAS a_bf16x8*)(kbuf + 4096 * kt + off4[s]);
    a_f32x16 a0, a1;
    const float b0 = base + slk * (float)(4 * hh), b1 = base + slk * (float)(32 + 4 * hh);
#pragma unroll
    for (int i = 0; i < 16; ++i) { a0[i] = b0 + slk * (float)AT_REGOFF(i); a1[i] = b1 + slk * (float)AT_REGOFF(i); }
    __builtin_amdgcn_sched_barrier(0);
    __builtin_amdgcn_s_setprio(1);
#pragma unroll
    for (int s = 0; s < 4; ++s) {
        a0 = __builtin_amdgcn_mfma_f32_32x32x16_bf16(kf[0][s], qf[s], a0, 0, 0, 0);
        a1 = __builtin_amdgcn_mfma_f32_32x32x16_bf16(kf[1][s], qf[s], a1, 0, 0, 0);
    }
    __builtin_amdgcn_s_setprio(0);
    st[0] = a0; st[1] = a1;
}
__device__ __forceinline__ void at_vload(LAS unsigned char* vbuf, a_bf16x8 (&vf)[2][4], const int (&off4)[4]) {
#pragma unroll
    for (int dt = 0; dt < 2; ++dt)
#pragma unroll
        for (int ks = 0; ks < 4; ++ks) vf[dt][ks] = *(const LAS a_bf16x8*)(vbuf + 4096 * dt + off4[ks]);
}
__device__ __forceinline__ void at_pack(const a_f32x16 (&p)[2], a_bf16x8 (&pb)[4]) {
#pragma unroll
    for (int kt = 0; kt < 2; ++kt)
#pragma unroll
        for (int s = 0; s < 2; ++s) {
            au32x4 pw = {pack_bf16(p[kt][8 * s + 0], p[kt][8 * s + 1]), pack_bf16(p[kt][8 * s + 2], p[kt][8 * s + 3]), pack_bf16(p[kt][8 * s + 4], p[kt][8 * s + 5]), pack_bf16(p[kt][8 * s + 6], p[kt][8 * s + 7])};
            pb[kt * 2 + s] = *reinterpret_cast<a_bf16x8*>(&pw); }
}
__device__ __forceinline__ void at_pv(const a_bf16x8 (&vf)[2][4], const a_bf16x8 (&pb)[4], a_f32x16 (&O)[2]) {
    __builtin_amdgcn_s_setprio(1);
#pragma unroll
    for (int ks = 0; ks < 4; ++ks) {
        O[0] = __builtin_amdgcn_mfma_f32_32x32x16_bf16(vf[0][ks], pb[ks], O[0], 0, 0, 0);
        O[1] = __builtin_amdgcn_mfma_f32_32x32x16_bf16(vf[1][ks], pb[ks], O[1], 0, 0, 0);
    }
    __builtin_amdgcn_s_setprio(0);
}
__device__ __forceinline__ void at_mask(a_f32x16 (&st)[2], int hh, int klo, int khi) {
    int d0 = 4 * hh - klo; unsigned span = (unsigned)(khi - klo); const bool any = khi >= klo;
    asm volatile("" : "+v"(d0)); asm volatile("" : "+v"(span));
#pragma unroll
    for (int kt = 0; kt < 2; ++kt)
#pragma unroll
        for (int i = 0; i < 16; ++i) { const bool ok = any && ((unsigned)(32 * kt + AT_REGOFF(i) + d0) <= span); st[kt][i] = ok ? st[kt][i] : -INFINITY; }
}
__device__ __forceinline__ float at_rowmax(const a_f32x16 (&st)[2]) {
    float mt = st[0][0];
#pragma unroll
    for (int i = 1; i < 16; ++i) mt = fmaxf(mt, st[0][i]);
#pragma unroll
    for (int i = 0; i < 16; ++i) mt = fmaxf(mt, st[1][i]);
    return xhalf_max(mt);
}
__device__ __forceinline__ void at_softmax_rel(a_f32x16 (&st)[2], float mref, bool first, float& m, float& l, a_f32x16 (&O)[2]) {
    const float mt = at_rowmax(st);
    float ps = 0.f;
    if (first || __any(mt > 6.f)) {
        float delta = first ? mt : fmaxf(mt, 0.f); delta = (delta == -INFINITY) ? 0.f : delta;
#pragma unroll
        for (int kt = 0; kt < 2; ++kt)
#pragma unroll
            for (int i = 0; i < 16; ++i) { const float pv = __builtin_amdgcn_exp2f(st[kt][i] - delta); st[kt][i] = pv; ps += pv; }
        const float alpha = first ? 0.f : __builtin_amdgcn_exp2f(-delta);
        l = l * alpha + ps; m = mref + delta;
#pragma unroll
        for (int dt = 0; dt < 2; ++dt)
#pragma unroll
            for (int i = 0; i < 16; ++i) O[dt][i] *= alpha;
    } else {
#pragma unroll
        for (int kt = 0; kt < 2; ++kt)
#pragma unroll
            for (int i = 0; i < 16; ++i) { const float pv = __builtin_amdgcn_exp2f(st[kt][i]); st[kt][i] = pv; ps += pv; }
        l += ps;
    }
}

__device__ __forceinline__ void at_mask2(a_f32x16& s0, a_f32x16& s1, int hh, int klo, int khi) {
    const bool any = khi >= klo;
    int d0 = any ? 4 * hh - klo : 0x40000000; unsigned span = any ? (unsigned)(khi - klo) : 0u;
    asm volatile("" : "+v"(d0)); asm volatile("" : "+v"(span));
#pragma unroll
    for (int i = 0; i < 16; ++i) {
        s0[i] = ((unsigned)(AT_REGOFF(i) + d0) <= span) ? s0[i] : -INFINITY;
        s1[i] = ((unsigned)(32 + AT_REGOFF(i) + d0) <= span) ? s1[i] : -INFINITY; }
}
#define AT_MX3(a, b, c) __builtin_fmaxf(__builtin_fmaxf((a), (b)), (c))
__device__ __forceinline__ float at_rowmax2(const a_f32x16& p0, const a_f32x16& p1) {
    float a = AT_MX3(p0[0], p0[1], p1[0]), b = AT_MX3(p0[2], p0[3], p1[1]); a = AT_MX3(a, p1[2], p1[3]);
#pragma unroll
    for (int r = 4; r < 16; r += 4) { a = AT_MX3(a, p0[r], p0[r + 1]); b = AT_MX3(b, p0[r + 2], p0[r + 3]); a = AT_MX3(a, p1[r], p1[r + 1]); b = AT_MX3(b, p1[r + 2], p1[r + 3]); }
    return xhalf_max(__builtin_fmaxf(a, b));
}

__device__ __forceinline__ void ph_nsa_attn_mfma(const unsigned short* qb, const float* gates, const unsigned short* kcmp, const unsigned short* vcmpT,
                                                 const unsigned short* kslc, const unsigned short* vslcT, const unsigned short* kwin, const unsigned short* vwinT,
                                                 unsigned short* ob, int* qcnt, LAS unsigned char* lds) {
    LAUNDER();
    const int wid = wv_s;
    constexpr float LOG2E = 1.4426950408889634f;
    int lane, r, hh, hp, ql, tl = 0, tq = 0, tqh = 0; unsigned ko, voS; int off4[4]; float sl = 0.f;
#define AT_DERIVE(q0_, g_) do { asm volatile("v_mbcnt_lo_u32_b32 %0, -1, 0\n\tv_mbcnt_hi_u32_b32 %0, -1, %0" : "=v"(lane)); r = lane & 31; hh = lane >> 5; hp = r >> 3; ql = r & 7; \
        const int drow_ = 8 * wid + (lane >> 3), dgc_ = (lane & 7) ^ ((drow_ >> 1) & 7); ko = (unsigned)(drow_ * 128 + dgc_ * 16); voS = (unsigned)(drow_ * SEQ * 2 + dgc_ * 16); \
        _Pragma("unroll") for (int s_ = 0; s_ < 4; ++s_) off4[s_] = r * 128 + ((((2 * s_ + hh) ^ ((r >> 1) & 7))) << 4); \
        tl = wid * 8 + ql; tq = (q0_) + tl; tqh = tq - 4 * hh; sl = exp2f(-0.5f * (float)((g_) * 4 + hp + 1)) * LOG2E; } while (0)
    LAS int* qslot = (LAS int*)(lds + AT_END);
    const bool dyn = nb_s == 256;
    int kq = 0, I = bid_, it = 0;
    if (tid_ == 0) { qslot[2] = ~0; qslot[3] = ~0; }
    if (dyn) { if (tid_ == 0) qslot[0] = atomicAdd(qcnt + (bid_ & 7), 1); }
    __syncthreads();
    if (dyn) kq = qslot[0];
    for (;;) {
        if (dyn ? kq >= 256 : I >= 2048) break;
        int knext = 0;
        int lane0; asm volatile("v_mbcnt_lo_u32_b32 %0, -1, 0\n\tv_mbcnt_hi_u32_b32 %0, -1, %0" : "=v"(lane0));
        if (dyn && wid == 0 && lane0 == 0) knext = atomicAdd(qcnt + (bid_ & 7), 1);
        int qi = 63 - (I >> 5), bg = I & 31;
        if (dyn) { bg = (bid_ & 7) + 8 * (kq >> 6); qi = 63 - (kq & 63); }
        const int b = bg >> 2, g = bg & 3, q0 = qi * 64, cur = qi;
        AT_DERIVE(q0, g);
        const int hd = g * 4 + hp;
        const unsigned voC = (unsigned)((8 * wid + (lane >> 3)) * 512 + ((lane & 7) ^ (((8 * wid + (lane >> 3)) >> 1) & 7)) * 16);
        a_bf16x8 qf[4];
#pragma unroll
        for (int s = 0; s < 4; ++s) qf[s] = *(const a_bf16x8*)(qb + (size_t)(b * SEQ + tq) * 1024 + hd * 64 + 16 * s + 8 * hh);
        const float* gp = gates + (size_t)(b * SEQ + tq) * 48 + hd;
        const float gc = gp[0], gs = gp[16], gw = gp[32];
        a_f32x16 Ot[2];
#pragma unroll
        for (int dt = 0; dt < 2; ++dt)
#pragma unroll
            for (int i = 0; i < 16; ++i) Ot[dt][i] = 0.f;
        const int nlast_blk = (q0 + 63 >= 31) ? min(254, (q0 + 63 - 31) >> 4) : -1;
        const int ntc = nlast_blk >= 0 ? (nlast_blk >> 6) + 1 : 0;
        const int nlast = (tq >= 31) ? min(254, (tq - 31) >> 4) : -1;
        for (int T = 0; T < ntc; ++T) at_dma(lds + AT_KC + T * AT_TB, lds + AT_VC + T * AT_TB, (const char*)(kcmp + ((size_t)bg * 256 + 64 * T) * 64), (const char*)(vcmpT + (size_t)bg * 64 * 256 + 64 * T), ko, voC, wid);
        { LAS float* imp = (LAS float*)(lds + AT_IMP) + wid * 512;
#pragma unroll
          for (int i = 0; i < 8; ++i) imp[lane + 64 * i] = 0.f; }
        unsigned long long ptodo = (cur >= 8 ? (0x1FFull << (cur - 8)) : ((1ull << (cur + 1)) - 1ull));
        int pn = __builtin_popcountll(ptodo), pj0 = 0, pj1 = 0, pj2 = 0;
        {
            const char* kbw = (const char*)(kwin + (size_t)bg * SEQ * 64); const char* vbw = (const char*)(vwinT + (size_t)bg * 64 * SEQ);
            pj0 = 63 - __builtin_clzll(ptodo); ptodo &= ~(1ull << pj0);
            at_glds(lds + AT_KS, kbw + (size_t)pj0 * 8192, ko, wid); at_glds(lds + AT_VS, vbw + (size_t)pj0 * 128, voS, wid);
            if (pn > 1) { pj1 = 63 - __builtin_clzll(ptodo); ptodo &= ~(1ull << pj1); at_glds(lds + AT_KS + AT_TB, kbw + (size_t)pj1 * 8192, ko, wid); }
            if (pn > 2) { pj2 = 63 - __builtin_clzll(ptodo); ptodo &= ~(1ull << pj2); at_glds(lds + AT_KS + 2 * AT_TB, kbw + (size_t)pj2 * 8192, ko, wid); }
        }
        if (pn > 2) { asm volatile("s_waitcnt vmcnt(4)" ::: "memory"); } else if (pn > 1) { asm volatile("s_waitcnt vmcnt(3)" ::: "memory"); } else { asm volatile("s_waitcnt vmcnt(2)" ::: "memory"); }
        __syncthreads();
        {
            float m = -INFINITY, l = 0.f;
            a_f32x16 st[2], Oc[2];
#pragma unroll
            for (int dt = 0; dt < 2; ++dt)
#pragma unroll
                for (int i = 0; i < 16; ++i) Oc[dt][i] = 0.f;
            for (int T = 0; T < ntc; ++T) {
                at_qk(lds + AT_KC + T * AT_TB, qf, st, off4, sl * (float)(1024 * T + 31 - tq), sl * 16.f, hh);
                at_mask(st, hh, 0, nlast - 64 * T);
                const float mt = at_rowmax(st);
                const float mn = fmaxf(m, mt), ms = (mn == -INFINITY) ? 0.f : mn;
                float ps = 0.f;
#pragma unroll
                for (int kt = 0; kt < 2; ++kt)
#pragma unroll
                    for (int i = 0; i < 16; ++i) ps += __builtin_amdgcn_exp2f(st[kt][i] - ms);
                l = l * __builtin_amdgcn_exp2f(m - ms) + ps; m = mn;
            }
            l = xhalf_sum(l);
            const float ms = (m == -INFINITY) ? 0.f : m, inv = l > 0.f ? 1.f / l : 0.f;
            LAS float* imp = (LAS float*)(lds + AT_IMP) + wid * 512 + ql * 64;
            for (int T = 0; T < ntc; ++T) {
                at_qk(lds + AT_KC + T * AT_TB, qf, st, off4, sl * (float)(1024 * T + 31 - tq) - ms, sl * 16.f, hh);
                at_mask(st, hh, 0, nlast - 64 * T);
#pragma unroll
                for (int kt = 0; kt < 2; ++kt)
#pragma unroll
                    for (int i = 0; i < 16; ++i) st[kt][i] = __builtin_amdgcn_exp2f(st[kt][i]) * inv;
#pragma unroll
                for (int kt = 0; kt < 2; ++kt)
#pragma unroll
                    for (int c = 0; c < 4; ++c) {
                        float qs = (st[kt][4 * c] + st[kt][4 * c + 1]) + (st[kt][4 * c + 2] + st[kt][4 * c + 3]), ls = st[kt][4 * c + 3];
                        qs += SHX(qs, 8); qs += SHX(qs, 16); ls += SHX(ls, 8); ls += SHX(ls, 16);
                        const int j = 16 * T + 8 * kt + 2 * c + hh;
                        if (hp == 0) { (void)__hip_atomic_fetch_add(imp + j, qs, __ATOMIC_RELAXED, __HIP_MEMORY_SCOPE_WORKGROUP); if (j < 63) (void)__hip_atomic_fetch_add(imp + j + 1, ls, __ATOMIC_RELAXED, __HIP_MEMORY_SCOPE_WORKGROUP); }
                    }
                { a_bf16x8 vf[2][4], pb[4]; at_pack(st, pb); at_vload(lds + AT_VC + T * AT_TB, vf, off4); at_pv(vf, pb, Oc); }
            }
#pragma unroll
            for (int dt = 0; dt < 2; ++dt)
#pragma unroll
                for (int i = 0; i < 16; ++i) Ot[dt][i] = gc * Oc[dt][i];
        }
        unsigned long long wor = 0ull;
        asm volatile("s_waitcnt lgkmcnt(0)" ::: "memory"); __builtin_amdgcn_wave_barrier();
        {
            const bool valid = lane <= cur, forced = (lane == 0) || (lane == cur) || (lane == cur - 1);
            const unsigned long long vmask = __ballot(valid);
            if (cur < 16) {
                if (lane == 0) {
#pragma unroll
                    for (int q = 0; q < 8; ++q) ((LAS unsigned long long*)(lds + AT_SELM))[wid * 8 + q] = vmask; }
                wor = vmask;
            } else {
                for (int q = 0; q < 8; q += 4) {
                    unsigned key[4], T[4];
#pragma unroll
                    for (int c = 0; c < 4; ++c) {
                        const float s = ((LAS float*)(lds + AT_IMP))[wid * 512 + (q + c) * 64 + lane];
                        const float sc = valid ? (forced ? 1e30f : s) : -1e30f;
                        const unsigned ub = __float_as_uint(sc); key[c] = (ub & 0x80000000u) ? ~ub : (ub | 0x80000000u); T[c] = 0u; }
#pragma unroll 1
                    for (int bit = 31; bit >= 0; --bit) {
#pragma unroll
                        for (int c = 0; c < 4; ++c) { const unsigned cand = T[c] | (1u << bit); if (__builtin_popcountll(__ballot(key[c] >= cand)) >= 16) T[c] = cand; } }
#pragma unroll
                    for (int c = 0; c < 4; ++c) {
                        unsigned long long selm = __ballot(key[c] > T[c]), eq = __ballot(key[c] == T[c]);
                        int need = 16 - __builtin_popcountll(selm);
                        for (; need > 0; --need) { const unsigned long long low = eq & (0ull - eq); selm |= low; eq ^= low; }
                        const unsigned long long mk = selm & vmask;
                        if (lane == 0) ((LAS unsigned long long*)(lds + AT_SELM))[wid * 8 + q + c] = mk;
                        wor |= mk; }
                }
            }
            if (lane == 0) ((LAS unsigned long long*)(lds + AT_WM))[wid] = wor;
        }
        __syncthreads();
        unsigned long long U = 0ull;
#pragma unroll
        for (int w = 0; w < 8; ++w) U |= ((LAS unsigned long long*)(lds + AT_WM))[w];
        U = ((unsigned long long)__builtin_amdgcn_readfirstlane((unsigned)(U >> 32)) << 32) | (unsigned long long)__builtin_amdgcn_readfirstlane((unsigned)U);
        { LAS float* gl = (LAS float*)(lds + AT_IMP) + wid * 128 + lane; gl[0] = gs; gl[64] = gw; if (dyn && wid == 0 && lane == 0) qslot[1] = knext; }
        AT_DERIVE(q0, g);
#define AT_OTP(v_) LAS float* v_; { int lx_; asm volatile("v_mbcnt_lo_u32_b32 %0, -1, 0\n\tv_mbcnt_hi_u32_b32 %0, -1, %0" : "=v"(lx_)); v_ = (LAS float*)(lds + AT_KC) + wid * 2048 + lx_ * 4; }
        { AT_OTP(otp);
#pragma unroll
        for (int c = 0; c < 8; ++c) *(LAS g8::f32x4*)(otp + c * 256) = g8::f32x4{Ot[c >> 2][4 * (c & 3)], Ot[c >> 2][4 * (c & 3) + 1], Ot[c >> 2][4 * (c & 3) + 2], Ot[c >> 2][4 * (c & 3) + 3]}; }
#define AT_SB() __builtin_amdgcn_sched_barrier(0)
#define AT_PIN(x) asm volatile("" : "+v"(x))
#define AT_MF(a, b, c) __builtin_amdgcn_mfma_f32_32x32x16_bf16(a, b, c, 0, 0, 0)
#define AT_WAIT_BAR(N) asm volatile("s_waitcnt vmcnt(" #N ") lgkmcnt(0)\n\ts_barrier" ::: "memory")
#define AT_KF(i) ((float)AT_REGOFF(i))
#define AT_PB(w) (*reinterpret_cast<a_bf16x8*>(&(w)))
#define AT_PK(P, i) pack_bf16(P[i], P[(i) + 1])
        for (int bi = 0; bi < 2; ++bi) {
            const int br = 1 - bi;
            const char* kbase = (const char*)((br == 0 ? kslc : kwin) + (size_t)bg * SEQ * 64);
            const char* vbase = (const char*)((br == 0 ? vslcT : vwinT) + (size_t)bg * 64 * SEQ);
            unsigned long long todo = ptodo;
            const int n = pn;
            const LAS unsigned* selp = (const LAS unsigned*)(lds + (br == 0 ? AT_SELM : AT_ONES)) + (br == 0 ? (wid * 8 + ql) * 2 : 0);
            float m = 0.f, l = 0.f, f_ = 1.f; bool resc_ = false;
            a_f32x16 O0, O1, pA0, pA1, pB0, pB1;
#pragma unroll
            for (int i = 0; i < 16; ++i) { O0[i] = 0.f; O1[i] = 0.f; }
            a_bf16x8 kf[8], vf[8]; au32x4 pw0, pw1, pw2, pw3;
            int sl_prev = 0, sl_cur = 0, sl_next = AT_TB;
#define AT_ROT() do { sl_prev = sl_cur; sl_cur = sl_next; sl_next = (sl_next == 2 * AT_TB) ? 0 : sl_next + AT_TB; } while (0)
#define AT_DMAK(jj, so) at_glds(lds + AT_KS + (so), kbase + (size_t)(jj) * 8192, ko, wid)
#define AT_DMAV(jj, so) at_glds(lds + AT_VS + (so), vbase + (size_t)(jj) * 128, voS, wid)
#define AT_POP(jv) do { jv = 63 - __builtin_clzll(todo); todo &= ~(1ull << jv); } while (0)
#define AT_BIAS(jj) ((((selp[(jj) >> 5] >> ((jj) & 31)) & 1u) != 0u) ? (sl * (float)(64 * (jj) - tqh) - m) : -INFINITY)
#define AT_KRD(s) do { kf[2 * (s)] = *(const LAS a_bf16x8*)(kb_ + off4[s]); kf[2 * (s) + 1] = *(const LAS a_bf16x8*)(kb_ + 4096 + off4[s]); } while (0)
#define AT_VRD(i) do { vf[i] = *(const LAS a_bf16x8*)(vp_ + 4096 * ((i) >> 2) + off4[(i) & 3]); } while (0)
            int q1 = pj0, q2 = pj1, q3 = pj2, jnew = 0;
            if (bi == 1) { AT_DMAV(q1, 0); AT_WAIT_BAR(1); } else { AT_WAIT_BAR(0); }
            {
                LAS unsigned char* kb_ = lds + AT_KS;
#pragma unroll
                for (int s = 0; s < 4; ++s) AT_KRD(s);
                const float b = AT_BIAS(q1); float slo = sl; AT_PIN(slo);
#pragma unroll
                for (int i = 0; i < 16; ++i) { pA0[i] = __builtin_fmaf(slo, AT_KF(i), b); pA1[i] = __builtin_fmaf(slo, AT_KF(i) + 32.f, b); }
#pragma unroll
                for (int s = 0; s < 4; ++s) { pA0 = AT_MF(kf[2 * s], qf[s], pA0); pA1 = AT_MF(kf[2 * s + 1], qf[s], pA1); }
                if (q1 == cur || (br == 1 && q1 == cur - 8)) { int lx_; asm volatile("v_mbcnt_lo_u32_b32 %0, -1, 0\n\tv_mbcnt_hi_u32_b32 %0, -1, %0" : "=v"(lx_)); const int tlx_ = wid * 8 + (lx_ & 7);
                    if (q1 == cur) at_mask2(pA0, pA1, lx_ >> 5, 0, tlx_); else at_mask2(pA0, pA1, lx_ >> 5, tlx_ + 1, 63); }
                const float rm = at_rowmax2(pA0, pA1), d = (rm == -INFINITY) ? 0.f : rm; m = d;
#pragma unroll
                for (int i = 0; i < 16; ++i) { pA0[i] = __builtin_amdgcn_exp2f(pA0[i] - d); pA1[i] = __builtin_amdgcn_exp2f(pA1[i] - d); }
            }
            AT_WAIT_BAR(0);
            q1 = q2; q2 = q3; q3 = 0;
            if (n > 3) { AT_POP(q3); AT_DMAK(q3, 0); }
            if (n > 1) AT_DMAV(q1, AT_TB);
            AT_ROT();
            {
                LAS unsigned char* kb_ = lds + AT_KS + sl_cur;
#pragma unroll
                for (int s = 0; s < 4; ++s) AT_KRD(s);
                const float b = AT_BIAS(q1); float slo = sl; AT_PIN(slo);
#pragma unroll
                for (int i = 0; i < 16; ++i) { pB0[i] = __builtin_fmaf(slo, AT_KF(i), b); pB1[i] = __builtin_fmaf(slo, AT_KF(i) + 32.f, b); }
            }
            if (n > 3) { AT_WAIT_BAR(2); } else if (n > 1) { AT_WAIT_BAR(1); } else { AT_WAIT_BAR(0); }
#define AT_GAPA(MF_, a0, a1, a2, a3, W0, W1, PW) do { MF_; sacc += a0; sacc += a1; sacc += a2; sacc += a3; W0; W1; AT_PIN(PW); AT_PIN(sacc); AT_SB(); } while (0)
#define AT_GAPB(MF_, X, i, Y, KO) do { MF_; X[i] = __builtin_amdgcn_exp2f(X[i]); X[(i) + 1] = __builtin_amdgcn_exp2f(X[(i) + 1]); X[(i) + 2] = __builtin_amdgcn_exp2f(X[(i) + 2]); X[(i) + 3] = __builtin_amdgcn_exp2f(X[(i) + 3]); \
        Y[i] = __builtin_fmaf(slo, AT_KF(i) + KO, bn); Y[(i) + 1] = __builtin_fmaf(slo, AT_KF((i) + 1) + KO, bn); Y[(i) + 2] = __builtin_fmaf(slo, AT_KF((i) + 2) + KO, bn); Y[(i) + 3] = __builtin_fmaf(slo, AT_KF((i) + 3) + KO, bn); \
        AT_PIN(X); AT_PIN(Y); AT_SB(); } while (0)
#define AT_STEP(C0, C1, P0, P1, t) do { AT_SB(); \
            const unsigned selw_ = selp[q2 >> 5];                                  \
            { LAS unsigned char* vp_ = lds + AT_VS + sl_prev; \
              AT_VRD(0); AT_SB(); float sacc = P0[0] + P0[1]; \
                                  AT_GAPA(C0 = AT_MF(kf[0], qf[0], C0), P0[2], P0[3], P0[4], P0[5],     pw0[0] = AT_PK(P0, 0),  pw0[1] = AT_PK(P0, 2),  pw0); \
              AT_VRD(4); AT_SB(); AT_GAPA(C1 = AT_MF(kf[1], qf[0], C1), P0[6], P0[7], P0[8], P0[9],     pw0[2] = AT_PK(P0, 4),  pw0[3] = AT_PK(P0, 6),  pw0); \
              AT_VRD(1); AT_SB(); AT_GAPA(C0 = AT_MF(kf[2], qf[1], C0), P0[10], P0[11], P0[12], P0[13], pw1[0] = AT_PK(P0, 8),  pw1[1] = AT_PK(P0, 10), pw1); \
              AT_VRD(5); AT_SB(); AT_GAPA(C1 = AT_MF(kf[3], qf[1], C1), P0[14], P0[15], P1[0], P1[1],   pw1[2] = AT_PK(P0, 12), pw1[3] = AT_PK(P0, 14), pw1); \
              AT_VRD(2); AT_SB(); AT_GAPA(C0 = AT_MF(kf[4], qf[2], C0), P1[2], P1[3], P1[4], P1[5],     pw2[0] = AT_PK(P1, 0),  pw2[1] = AT_PK(P1, 2),  pw2); \
              AT_VRD(6); AT_SB(); AT_GAPA(C1 = AT_MF(kf[5], qf[2], C1), P1[6], P1[7], P1[8], P1[9],     pw2[2] = AT_PK(P1, 4),  pw2[3] = AT_PK(P1, 6),  pw2); \
              AT_VRD(3); AT_SB(); AT_GAPA(C0 = AT_MF(kf[6], qf[3], C0), P1[10], P1[11], P1[12], P1[13], pw3[0] = AT_PK(P1, 8),  pw3[1] = AT_PK(P1, 10), pw3); \
              AT_VRD(7); AT_SB(); AT_GAPA(C1 = AT_MF(kf[7], qf[3], C1), P1[14], P1[15], 0.f, 0.f,       pw3[2] = AT_PK(P1, 12), pw3[3] = AT_PK(P1, 14), pw3); \
              l += sacc; } \
            jnew = 0; \
            if ((t) + 3 < n) { AT_POP(jnew); AT_DMAK(jnew, sl_cur); }              \
            if ((t) + 1 < n) AT_DMAV(q2, sl_next); \
            if (q1 == cur || (br == 1 && q1 == cur - 8)) { int lx_; asm volatile("v_mbcnt_lo_u32_b32 %0, -1, 0\n\tv_mbcnt_hi_u32_b32 %0, -1, %0" : "=v"(lx_)); const int tlx_ = wid * 8 + (lx_ & 7); \
                if (q1 == cur) at_mask2(C0, C1, lx_ >> 5, 0, tlx_); else at_mask2(C0, C1, lx_ >> 5, tlx_ + 1, 63); } \
            resc_ = false; \
            { const float rm = at_rowmax2(C0, C1); \
              if (__any(rm > 6.f)) { const float dl = fmaxf(rm, 0.f); m += dl; f_ = __builtin_amdgcn_exp2f(-dl); l *= f_; resc_ = true; \
                  _Pragma("unroll") for (int i_ = 0; i_ < 16; ++i_) { C0[i_] -= dl; C1[i_] -= dl; } } } \
            { const float bn = (((selw_ >> (q2 & 31)) & 1u) != 0u) ? (sl * (float)(64 * q2 - tqh) - m) : -INFINITY; float slo = sl; AT_PIN(slo); LAS unsigned char* kb_ = lds + AT_KS + sl_next; AT_SB(); \
              AT_GAPB(O0 = AT_MF(vf[0], AT_PB(pw0), O0), C0, 0, P0, 0.f);                              AT_GAPB(O1 = AT_MF(vf[4], AT_PB(pw0), O1), C0, 4, P0, 0.f); \
              AT_KRD(0); AT_SB(); AT_GAPB(O0 = AT_MF(vf[1], AT_PB(pw1), O0), C0, 8, P0, 0.f);          AT_KRD(1); AT_SB(); AT_GAPB(O1 = AT_MF(vf[5], AT_PB(pw1), O1), C0, 12, P0, 0.f); \
              AT_KRD(2); AT_SB(); AT_GAPB(O0 = AT_MF(vf[2], AT_PB(pw2), O0), C1, 0, P1, 32.f);         AT_KRD(3); AT_SB(); AT_GAPB(O1 = AT_MF(vf[6], AT_PB(pw2), O1), C1, 4, P1, 32.f); \
              AT_GAPB(O0 = AT_MF(vf[3], AT_PB(pw3), O0), C1, 8, P1, 32.f);                             AT_GAPB(O1 = AT_MF(vf[7], AT_PB(pw3), O1), C1, 12, P1, 32.f); } \
            if ((t) + 3 < n) { AT_WAIT_BAR(2); } else if ((t) + 2 < n) { AT_WAIT_BAR(1); } else { AT_WAIT_BAR(0); } \
            if (resc_) { _Pragma("unroll") for (int i_ = 0; i_ < 16; ++i_) { O0[i_] *= f_; O1[i_] *= f_; } } \
            AT_ROT(); q1 = q2; q2 = q3; q3 = jnew; \
            } while (0)
            int t = 1;
            for (; t + 1 < n; t += 2) {
                AT_STEP(pB0, pB1, pA0, pA1, t);
                AT_STEP(pA0, pA1, pB0, pB1, t + 1);
            }
            if (t < n) { AT_STEP(pB0, pB1, pA0, pA1, t); pA0 = pB0; pA1 = pB1; }
            if (bi == 0) {
                const char* kbs = (const char*)(kslc + (size_t)bg * SEQ * 64);
                ptodo = U; pn = __builtin_popcountll(U); pj1 = 0; pj2 = 0;
                pj0 = 63 - __builtin_clzll(ptodo); ptodo &= ~(1ull << pj0); at_glds(lds + AT_KS, kbs + (size_t)pj0 * 8192, ko, wid);
                if (pn > 1) { pj1 = 63 - __builtin_clzll(ptodo); ptodo &= ~(1ull << pj1); at_glds(lds + AT_KS + AT_TB, kbs + (size_t)pj1 * 8192, ko, wid); }
                if (pn > 2) { pj2 = 63 - __builtin_clzll(ptodo); ptodo &= ~(1ull << pj2); at_glds(lds + AT_KS + 2 * AT_TB, kbs + (size_t)pj2 * 8192, ko, wid); }
            }
            {
                float sacc = 0.f;
#pragma unroll
                for (int i = 0; i < 16; ++i) sacc += pA0[i] + pA1[i];
                l += sacc;
                pw0 = au32x4{AT_PK(pA0, 0), AT_PK(pA0, 2), AT_PK(pA0, 4), AT_PK(pA0, 6)}; pw1 = au32x4{AT_PK(pA0, 8), AT_PK(pA0, 10), AT_PK(pA0, 12), AT_PK(pA0, 14)};
                pw2 = au32x4{AT_PK(pA1, 0), AT_PK(pA1, 2), AT_PK(pA1, 4), AT_PK(pA1, 6)}; pw3 = au32x4{AT_PK(pA1, 8), AT_PK(pA1, 10), AT_PK(pA1, 12), AT_PK(pA1, 14)};
                LAS unsigned char* vp_ = lds + AT_VS + sl_prev;
#pragma unroll
                for (int i = 0; i < 8; ++i) AT_VRD(i);
                O0 = AT_MF(vf[0], AT_PB(pw0), O0); O1 = AT_MF(vf[4], AT_PB(pw0), O1); O0 = AT_MF(vf[1], AT_PB(pw1), O0); O1 = AT_MF(vf[5], AT_PB(pw1), O1);
                O0 = AT_MF(vf[2], AT_PB(pw2), O0); O1 = AT_MF(vf[6], AT_PB(pw2), O1); O0 = AT_MF(vf[3], AT_PB(pw3), O0); O1 = AT_MF(vf[7], AT_PB(pw3), O1);
            }
            l = xhalf_sum(l);
            int lb_; asm volatile("v_mbcnt_lo_u32_b32 %0, -1, 0\n\tv_mbcnt_hi_u32_b32 %0, -1, %0" : "=v"(lb_));
            const float gsc = ((LAS float*)(lds + AT_IMP))[wid * 128 + lb_ + 64 * br] / l;
            AT_OTP(otp);
#pragma unroll
            for (int c = 0; c < 8; ++c) {
                g8::f32x4 v = *(LAS g8::f32x4*)(otp + c * 256);
                if (c < 4) { v[0] += gsc * O0[4 * c]; v[1] += gsc * O0[4 * c + 1]; v[2] += gsc * O0[4 * c + 2]; v[3] += gsc * O0[4 * c + 3]; }
                else { v[0] += gsc * O1[4 * (c - 4)]; v[1] += gsc * O1[4 * (c - 4) + 1]; v[2] += gsc * O1[4 * (c - 4) + 2]; v[3] += gsc * O1[4 * (c - 4) + 3]; }
                *(LAS g8::f32x4*)(otp + c * 256) = v;
            }
            asm volatile("s_waitcnt lgkmcnt(0)\n\ts_barrier" ::: "memory");
        }
#undef AT_STEP
#undef AT_GAPA
#undef AT_GAPB
#undef AT_ROT
#undef AT_DMAK
#undef AT_DMAV
#undef AT_POP
#undef AT_BIAS
#undef AT_KRD
#undef AT_VRD
        AT_OTP(otp);
#pragma unroll
        for (int c = 0; c < 8; ++c) { const g8::f32x4 v = *(LAS g8::f32x4*)(otp + c * 256); Ot[c >> 2][4 * (c & 3)] = v[0]; Ot[c >> 2][4 * (c & 3) + 1] = v[1]; Ot[c >> 2][4 * (c & 3) + 2] = v[2]; Ot[c >> 2][4 * (c & 3) + 3] = v[3]; }
        int l2; asm volatile("v_mbcnt_lo_u32_b32 %0, -1, 0\n\tv_mbcnt_hi_u32_b32 %0, -1, %0" : "=v"(l2));
        const int r2 = l2 & 31;
        unsigned short* orow = ob + (size_t)(b * SEQ + q0 + wid * 8 + (r2 & 7)) * 1024 + (g * 4 + (r2 >> 3)) * 64 + 8 * (l2 >> 5);
#pragma unroll
        for (int dt = 0; dt < 2; ++dt)
#pragma unroll
            for (int c = 0; c < 4; c += 2) {
                unsigned ax = pack_bf16(Ot[dt][4 * c], Ot[dt][4 * c + 1]), ay = pack_bf16(Ot[dt][4 * c + 2], Ot[dt][4 * c + 3]);
                unsigned bx = pack_bf16(Ot[dt][4 * c + 4], Ot[dt][4 * c + 5]), by = pack_bf16(Ot[dt][4 * c + 6], Ot[dt][4 * c + 7]);
                const auto rx = __builtin_amdgcn_permlane32_swap(ax, bx, false, false); const auto ry = __builtin_amdgcn_permlane32_swap(ay, by, false, false);
                *(uint4*)(orow + 32 * dt + 8 * c) = make_uint4(rx[0], ry[0], rx[1], ry[1]); }
        asm volatile("s_waitcnt lgkmcnt(0)\n\ts_barrier" ::: "memory");
        if (dyn) kq = qslot[1]; else { I += nb_s; ++it; }
    }
}
__device__ __forceinline__ float bf2f(unsigned short v) { return __uint_as_float(((unsigned)v) << 16); }
__device__ __forceinline__ void ph_gla_p1(const unsigned short* qk, const float* glr, const unsigned short* vT, const float* w2, const float* bgate,
                                          unsigned short* qd, unsigned short* ki, float* dl, unsigned short* UT, LAS unsigned char* lds) {
    LAUNDER();
    const int wid = wv_s, lane = tid_ & 63, r = lane & 31, hh = lane >> 5;
    LAS float* gsum = (LAS float*)lds;
    LAS float* gl = (LAS float*)(lds + 2048);
    LAS unsigned char* ket = lds + 2048 + 4096;
    const int d = tid_ & 127, sg = tid_ >> 7;
    float glp0 = 0.f, glp1 = 0.f, wp[16], bgp = 0.f;
    if (bid_ < 2048) { const int h = bid_ & 3, c = (bid_ >> 2) & 63, b = bid_ >> 8, tok0 = b * SEQ + c * 64;
        glp0 = glr[(size_t)tok0 * 16 + tid_]; glp1 = glr[(size_t)tok0 * 16 + tid_ + 512];
#pragma unroll
        for (int k = 0; k < 16; ++k) wp[k] = w2[k * 512 + h * 128 + d];
        bgp = bgate[h * 128 + d]; }
    for (int it = bid_; it < 2048; it += nb_s) {
        const int h = it & 3, c = (it >> 2) & 63, b = it >> 8, bh = b * 4 + h, tok0 = b * SEQ + c * 64;
        a_bf16x8 vfr[4];
        { const unsigned short* vrow = vT + ((size_t)bh * 256 + 32 * wid + r) * SEQ + c * 64;
#pragma unroll
          for (int ks = 0; ks < 4; ++ks) vfr[ks] = *(const a_bf16x8*)(vrow + 16 * ks + 8 * hh); }
        unsigned short qraw[16], kraw[16];
#pragma unroll
        for (int i = 0; i < 16; ++i) { const size_t o = (size_t)(tok0 + sg * 16 + i) * 1024 + h * 128 + d; qraw[i] = qk[o]; kraw[i] = qk[o + 512]; }
        gl[tid_] = glp0; gl[tid_ + 512] = glp1;
        float w[16];
#pragma unroll
        for (int k = 0; k < 16; ++k) w[k] = wp[k];
        const float bgv = bgp;
        { const int itn = it + nb_s;
          if (itn < 2048) { const int hn = itn & 3, cn = (itn >> 2) & 63, bn = itn >> 8, tokn = bn * SEQ + cn * 64;
              glp0 = glr[(size_t)tokn * 16 + tid_]; glp1 = glr[(size_t)tokn * 16 + tid_ + 512];
#pragma unroll
              for (int k = 0; k < 16; ++k) wp[k] = w2[k * 512 + hn * 128 + d];
              bgp = bgate[hn * 128 + d]; } }
        __syncthreads();
        float la[16]; float run = 0.f;
#pragma unroll
        for (int i = 0; i < 16; ++i) { const int s = sg * 16 + i; float z = bgv;
#pragma unroll
            for (int k = 0; k < 16; ++k) z += gl[s * 16 + k] * w[k];
            run += fast_logsigmoid(z) * (1.f / 16.f); la[i] = run; }
        gsum[sg * 128 + d] = run;
        __syncthreads();
        float pre = 0.f, tot = 0.f;
#pragma unroll
        for (int g = 0; g < 4; ++g) { const float v = gsum[g * 128 + d]; tot += v; pre += (g < sg) ? v : 0.f; }
        const float etot = fast_exp(tot);
#pragma unroll
        for (int i = 0; i < 16; ++i) { const int s = sg * 16 + i; const float bb = la[i] + pre;
            const float q = bf2f(qraw[i]), k = bf2f(kraw[i]);
            const float eb = fast_exp(bb), ieb = __builtin_amdgcn_rcpf(eb);
            qd[(size_t)(tok0 + s) * 512 + h * 128 + d] = f2bf(q * 0.08838834764831845f * eb);
            ki[(size_t)(tok0 + s) * 512 + h * 128 + d] = f2bf(k * ieb);
            *(LAS unsigned short*)(ket + d * 144 + s * 2) = f2bf(k * (etot * ieb)); }
        if (sg == 0) dl[(size_t)(bh * 64 + c) * 128 + d] = etot;
        __syncthreads();
        a_f32x16 acc[4];
#pragma unroll
        for (int dt = 0; dt < 4; ++dt)
#pragma unroll
            for (int i = 0; i < 16; ++i) acc[dt][i] = 0.f;
#pragma unroll
        for (int ks = 0; ks < 4; ++ks) {
            a_bf16x8 bfr[4];
#pragma unroll
            for (int dt = 0; dt < 4; ++dt) bfr[dt] = *(const LAS a_bf16x8*)(ket + (32 * dt + r) * 144 + (16 * ks + 8 * hh) * 2);
            __builtin_amdgcn_sched_barrier(0);
#pragma unroll
            for (int dt = 0; dt < 4; ++dt) acc[dt] = __builtin_amdgcn_mfma_f32_32x32x16_bf16(bfr[dt], vfr[ks], acc[dt], 0, 0, 0); }
        unsigned short* urow = UT + (size_t)(bh * 64 + c) * 256 * 128 + (size_t)(32 * wid + r) * 128 + 8 * hh;
#pragma unroll
        for (int dt = 0; dt < 4; ++dt)
#pragma unroll
            for (int c2 = 0; c2 < 4; c2 += 2) {
                const unsigned ax = pack_bf16_v(acc[dt][4 * c2], acc[dt][4 * c2 + 1]), ay = pack_bf16_v(acc[dt][4 * c2 + 2], acc[dt][4 * c2 + 3]);
                const unsigned bx = pack_bf16_v(acc[dt][4 * c2 + 4], acc[dt][4 * c2 + 5]), by = pack_bf16_v(acc[dt][4 * c2 + 6], acc[dt][4 * c2 + 7]);
                const auto rx = __builtin_amdgcn_permlane32_swap(ax, bx, false, false); const auto ry = __builtin_amdgcn_permlane32_swap(ay, by, false, false);
                *(uint4*)(urow + 32 * dt + 8 * c2) = make_uint4(rx[0], ry[0], rx[1], ry[1]); }
        __syncthreads();
    }
}
__device__ __forceinline__ void ph_gla_p2(const unsigned short* __restrict__ UT, const float* __restrict__ dl, unsigned short* __restrict__ ST) {
    LAUNDER();
#define GP2_LOAD(uu, dv, c0) do { _Pragma("unroll") for (int k_ = 0; k_ < 8; ++k_) { const size_t o_ = ((size_t)(bh * 64 + (c0) + k_) * 256 + e) * 128 + d4; \
        uu[k_] = *(const uint2*)(UT + o_); dv[k_] = *(const float4*)(dl + (size_t)(bh * 64 + (c0) + k_) * 128 + d4); } } while (0)
#define GP2_STEP(uu, dv, c0) do { _Pragma("unroll") for (int k_ = 0; k_ < 8; ++k_) { const size_t o_ = ((size_t)(bh * 64 + (c0) + k_) * 256 + e) * 128 + d4; \
        *(uint2*)(ST + o_) = make_uint2(pack_bf16(S.x, S.y), pack_bf16(S.z, S.w)); \
        S.x = S.x * dv[k_].x + bf2f((unsigned short)(uu[k_].x & 0xffff)); S.y = S.y * dv[k_].y + bf2f((unsigned short)(uu[k_].x >> 16)); \
        S.z = S.z * dv[k_].z + bf2f((unsigned short)(uu[k_].y & 0xffff)); S.w = S.w * dv[k_].w + bf2f((unsigned short)(uu[k_].y >> 16)); } } while (0)
    for (int idx = GTID; idx < 32 * 256 * 32; idx += GSZ) {
        const int bh = idx >> 13, rem = idx & 8191, e = rem >> 5, d4 = (rem & 31) * 4;
        float4 S = make_float4(0.f, 0.f, 0.f, 0.f);
        uint2 ua[8], ub[8]; float4 da[8], db[8];
        GP2_LOAD(ua, da, 0);
#pragma unroll 1
        for (int c0 = 0; c0 < 64; c0 += 16) {
            GP2_LOAD(ub, db, c0 + 8);
            GP2_STEP(ua, da, c0);
            if (c0 + 16 < 64) GP2_LOAD(ua, da, c0 + 16);
            GP2_STEP(ub, db, c0 + 8);
        }
    }
#undef GP2_LOAD
#undef GP2_STEP
}
__device__ __forceinline__ void ph_gla_p3(const unsigned short* qd, const unsigned short* ki, const unsigned short* vT, const unsigned short* ST, const unsigned short* rb,
                                          const float* ng, unsigned short* ob, LAS unsigned char* lds) {
    LAUNDER();
    const int wid = wv_s, lane = tid_ & 63, r = lane & 31, hh = lane >> 5;
    constexpr int PQ = 272;
    LAS unsigned char* QS = lds; LAS unsigned char* KS = lds + 64 * PQ; LAS float* SSQ = (LAS float*)(lds + 2 * 64 * PQ);
    LAS float* NGL = SSQ + 512;
    if (tid_ < 256) *(LAS g8::f32x4*)(NGL + tid_ * 4) = *(const g8::f32x4*)(ng + tid_ * 4);
    au32x4 qpre[2], kpre[2];
    if (bid_ < 2048) { const int h = bid_ & 3, c = (bid_ >> 2) & 63, b = bid_ >> 8, tok0 = b * SEQ + c * 64; const int row = tid_ >> 3, ch = tid_ & 7;
#pragma unroll
        for (int j = 0; j < 2; ++j) { qpre[j] = *(const au32x4*)(qd + (size_t)(tok0 + row) * 512 + h * 128 + (ch + 8 * j) * 8); kpre[j] = *(const au32x4*)(ki + (size_t)(tok0 + row) * 512 + h * 128 + (ch + 8 * j) * 8); } }
    for (int it = bid_; it < 2048; it += nb_s) {
        const int h = it & 3, c = (it >> 2) & 63, b = it >> 8, bh = b * 4 + h, tok0 = b * SEQ + c * 64;
        a_bf16x8 sf[8]; au32x2 vlo[3][2], vhi[3][2];
        uint2 rgp[2][4];
#pragma unroll
        for (int qt = 0; qt < 2; ++qt)
#pragma unroll
            for (int c4 = 0; c4 < 4; ++c4) rgp[qt][c4] = *(const uint2*)(rb + (size_t)(tok0 + 32 * qt + r) * 1024 + h * 256 + 32 * wid + 8 * c4 + 4 * hh);
        { const unsigned short* srow = ST + ((size_t)(bh * 64 + c) * 256 + 32 * wid + r) * 128;
          const unsigned short* vrow = vT + ((size_t)bh * 256 + 32 * wid + r) * SEQ + c * 64;
#pragma unroll
          for (int ks = 0; ks < 8; ++ks) sf[ks] = *(const a_bf16x8*)(srow + 16 * ks + 8 * hh);
#pragma unroll
          for (int t3 = 0; t3 < 3; ++t3) { const int st = t3 == 2 ? 1 : 0;
#pragma unroll
              for (int s2 = 0; s2 < 2; ++s2) { vlo[t3][s2] = *(const au32x2*)(vrow + 32 * st + 16 * s2 + 4 * hh); vhi[t3][s2] = *(const au32x2*)(vrow + 32 * st + 16 * s2 + 4 * hh + 8); } } }
        { const int row = tid_ >> 3, ch = tid_ & 7;
#pragma unroll
          for (int j = 0; j < 2; ++j) { *(LAS au32x4*)(QS + row * PQ + (ch + 8 * j) * 16) = qpre[j]; *(LAS au32x4*)(KS + row * PQ + (ch + 8 * j) * 16) = kpre[j]; }
          const int itn = it + nb_s;
          if (itn < 2048) { const int hn = itn & 3, cn = (itn >> 2) & 63, bn = itn >> 8, tokn = bn * SEQ + cn * 64;
#pragma unroll
              for (int j = 0; j < 2; ++j) { qpre[j] = *(const au32x4*)(qd + (size_t)(tokn + row) * 512 + hn * 128 + (ch + 8 * j) * 8); kpre[j] = *(const au32x4*)(ki + (size_t)(tokn + row) * 512 + hn * 128 + (ch + 8 * j) * 8); } } }
        __syncthreads();
        a_bf16x8 qfr[2][8];
#pragma unroll
        for (int qt = 0; qt < 2; ++qt)
#pragma unroll
            for (int ks = 0; ks < 8; ++ks) qfr[qt][ks] = *(const LAS a_bf16x8*)(QS + (32 * qt + r) * PQ + (16 * ks + 8 * hh) * 2);
        a_f32x16 att[3];
#pragma unroll
        for (int st = 0; st < 2; ++st) {
            a_bf16x8 kfr[8];
#pragma unroll
            for (int ks = 0; ks < 8; ++ks) kfr[ks] = *(const LAS a_bf16x8*)(KS + (32 * st + r) * PQ + (16 * ks + 8 * hh) * 2);
            __builtin_amdgcn_sched_barrier(0);
            if (st == 0) {
                a_f32x16 a0, a1;
#pragma unroll
                for (int i = 0; i < 16; ++i) { a0[i] = 0.f; a1[i] = 0.f; }
#pragma unroll
                for (int ks = 0; ks < 8; ++ks) { a0 = __builtin_amdgcn_mfma_f32_32x32x16_bf16(kfr[ks], qfr[0][ks], a0, 0, 0, 0); a1 = __builtin_amdgcn_mfma_f32_32x32x16_bf16(kfr[ks], qfr[1][ks], a1, 0, 0, 0); }
#pragma unroll
                for (int i = 0; i < 16; ++i) a0[i] = (AT_REGOFF(i) + 4 * hh <= r) ? a0[i] : 0.f;
                att[0] = a0; att[1] = a1;
            } else {
                a_f32x16 a2;
#pragma unroll
                for (int i = 0; i < 16; ++i) a2[i] = 0.f;
#pragma unroll
                for (int ks = 0; ks < 8; ++ks) a2 = __builtin_amdgcn_mfma_f32_32x32x16_bf16(kfr[ks], qfr[1][ks], a2, 0, 0, 0);
#pragma unroll
                for (int i = 0; i < 16; ++i) a2[i] = (AT_REGOFF(i) + 4 * hh <= r) ? a2[i] : 0.f;
                att[2] = a2;
            }
        }
        a_f32x16 O[2];
#pragma unroll
        for (int qt = 0; qt < 2; ++qt)
#pragma unroll
            for (int i = 0; i < 16; ++i) O[qt][i] = 0.f;
#pragma unroll
        for (int ks = 0; ks < 8; ++ks) {
            O[0] = __builtin_amdgcn_mfma_f32_32x32x16_bf16(sf[ks], qfr[0][ks], O[0], 0, 0, 0);
            O[1] = __builtin_amdgcn_mfma_f32_32x32x16_bf16(sf[ks], qfr[1][ks], O[1], 0, 0, 0); }
#pragma unroll
        for (int t3 = 0; t3 < 3; ++t3) { const int qt = t3 == 0 ? 0 : 1;
#pragma unroll
            for (int s2 = 0; s2 < 2; ++s2) {
                au32x4 pw = {pack_bf16(att[t3][8 * s2 + 0], att[t3][8 * s2 + 1]), pack_bf16(att[t3][8 * s2 + 2], att[t3][8 * s2 + 3]), pack_bf16(att[t3][8 * s2 + 4], att[t3][8 * s2 + 5]), pack_bf16(att[t3][8 * s2 + 6], att[t3][8 * s2 + 7])};
                au32x4 aw = {vlo[t3][s2].x, vlo[t3][s2].y, vhi[t3][s2].x, vhi[t3][s2].y};
                O[qt] = __builtin_amdgcn_mfma_f32_32x32x16_bf16(*reinterpret_cast<a_bf16x8*>(&aw), *reinterpret_cast<a_bf16x8*>(&pw), O[qt], 0, 0, 0); } }
#pragma unroll
        for (int qt = 0; qt < 2; ++qt) { float ss = 0.f;
#pragma unroll
            for (int i = 0; i < 16; ++i) ss += O[qt][i] * O[qt][i];
            ss = xhalf_sum(ss); if (hh == 0) SSQ[wid * 64 + 32 * qt + r] = ss; }
        __syncthreads();
#pragma unroll
        for (int qt = 0; qt < 2; ++qt) { float tot = 0.f;
#pragma unroll
            for (int w = 0; w < 8; ++w) tot += SSQ[w * 64 + 32 * qt + r];
            const float rn = rsqrtf(tot * (1.f / 256.f) + 1e-5f);
            const size_t orow = (size_t)(tok0 + 32 * qt + r) * 1024 + h * 256;
            unsigned pk[4][2];
#pragma unroll
            for (int c4 = 0; c4 < 4; ++c4) { const int e0 = 32 * wid + 8 * c4 + 4 * hh;
                const uint2 rg = rgp[qt][c4]; const g8::f32x4 gq = *(const LAS g8::f32x4*)(NGL + h * 256 + e0); const float4 gv = make_float4(gq[0], gq[1], gq[2], gq[3]);
                const float r0 = bf2f((unsigned short)(rg.x & 0xffff)), r1 = bf2f((unsigned short)(rg.x >> 16)), r2 = bf2f((unsigned short)(rg.y & 0xffff)), r3 = bf2f((unsigned short)(rg.y >> 16));
                pk[c4][0] = pack_bf16(O[qt][4 * c4] * rn * gv.x * fast_silu(r0), O[qt][4 * c4 + 1] * rn * gv.y * fast_silu(r1));
                pk[c4][1] = pack_bf16(O[qt][4 * c4 + 2] * rn * gv.z * fast_silu(r2), O[qt][4 * c4 + 3] * rn * gv.w * fast_silu(r3)); }
#pragma unroll
            for (int c4 = 0; c4 < 4; c4 += 2) {
                const auto rx = __builtin_amdgcn_permlane32_swap(pk[c4][0], pk[c4 + 1][0], false, false); const auto ry = __builtin_amdgcn_permlane32_swap(pk[c4][1], pk[c4 + 1][1], false, false);
                *(uint4*)(ob + orow + 32 * wid + 8 * c4 + 8 * hh) = make_uint4(rx[0], ry[0], rx[1], ry[1]); } }
        __syncthreads();
    }
}
__device__ __forceinline__ void ph_norm_router(const unsigned short* x, const float* g, const float* shift, const float* scale, int ldmod, unsigned short* hb,
                                               const float* rw, const float* rbias, int* topi, float* topw, int* cntb, int* stok, LAS unsigned char* lds) {
    LAUNDER();
    const int wid = wv_s, lane = tid_ & 63, e = lane & 31, kh = lane >> 5;
    LAS float* hs = (LAS float*)lds;
    constexpr int HSP = 1028;
    LAS float* part = (LAS float*)(lds + 16 * HSP * 4);
    LAS int* hist = (LAS int*)(lds + 16 * HSP * 4 + 16384);
    for (int i = GTID; i < CAP; i += GSZ) stok[i] = -1;
    g8::bf16x8 wh[4][2], wl[4][2];
#pragma unroll
    for (int ks = 0; ks < 4; ++ks)
#pragma unroll
        for (int nt = 0; nt < 2; ++nt) {
            unsigned hw[4], lw[4];
#pragma unroll
            for (int j2 = 0; j2 < 4; ++j2) { float w0 = rw[(128 * wid + 32 * ks + 8 * (lane >> 4) + 2 * j2) * 32 + 16 * nt + (lane & 15)], w1 = rw[(128 * wid + 32 * ks + 8 * (lane >> 4) + 2 * j2 + 1) * 32 + 16 * nt + (lane & 15)];
                const unsigned hp2 = pack_bf16(w0, w1); hw[j2] = hp2;
                lw[j2] = pack_bf16(w0 - __uint_as_float(hp2 << 16), w1 - __uint_as_float(hp2 & 0xffff0000u)); }
            au32x4 hv = {hw[0], hw[1], hw[2], hw[3]}, lv = {lw[0], lw[1], lw[2], lw[3]};
            wh[ks][nt] = *reinterpret_cast<g8::bf16x8*>(&hv); wl[ks][nt] = *reinterpret_cast<g8::bf16x8*>(&lv); }
    const float rbv = rbias[e];
    if (tid_ < 32) hist[tid_] = 0;
    __syncthreads();
    uint2 xr[2][4];
    float4 gg4[4], scn[4], shn[4];
#pragma unroll
    for (int j = 0; j < 4; ++j) gg4[j] = *(const float4*)(g + j * 256 + lane * 4);
    if (bid_ < NT / 16) {
#pragma unroll
        for (int rr = 0; rr < 2; ++rr)
#pragma unroll
            for (int j = 0; j < 4; ++j) xr[rr][j] = *(const uint2*)(x + (size_t)(bid_ * 16 + wid * 2 + rr) * DM + j * 256 + lane * 4);
        const int b0 = bid_ * 16 / SEQ;
#pragma unroll
        for (int j = 0; j < 4; ++j) { scn[j] = *(const float4*)(scale + b0 * ldmod + j * 256 + lane * 4); shn[j] = *(const float4*)(shift + b0 * ldmod + j * 256 + lane * 4); }
    }
    for (int tile = bid_; tile < NT / 16; tile += nb_s) {
        float4 ga4[4], sh4[4];
#pragma unroll
        for (int j = 0; j < 4; ++j) { ga4[j] = make_float4(gg4[j].x * (1.f + scn[j].x), gg4[j].y * (1.f + scn[j].y), gg4[j].z * (1.f + scn[j].z), gg4[j].w * (1.f + scn[j].w)); sh4[j] = shn[j]; }
#pragma unroll
        for (int rr = 0; rr < 2; ++rr) {
            const int trow = wid * 2 + rr, row = tile * 16 + trow;
            float4 v[4]; float ss = 0.f;
#pragma unroll
            for (int j = 0; j < 4; ++j) { const uint2 u = xr[rr][j]; v[j] = make_float4(__uint_as_float(u.x << 16), __uint_as_float(u.x & 0xffff0000u), __uint_as_float(u.y << 16), __uint_as_float(u.y & 0xffff0000u)); ss += v[j].x * v[j].x + v[j].y * v[j].y + v[j].z * v[j].z + v[j].w * v[j].w; }
#pragma unroll
            for (int o = 32; o > 0; o >>= 1) ss += SHX(ss, o);
            const float rn = rsqrtf(ss * (1.f / DM) + 1e-5f);
#pragma unroll
            for (int j = 0; j < 4; ++j) { const int col = j * 256 + lane * 4;
                float4 y;
                y.x = v[j].x * rn * ga4[j].x + sh4[j].x; y.y = v[j].y * rn * ga4[j].y + sh4[j].y; y.z = v[j].z * rn * ga4[j].z + sh4[j].z; y.w = v[j].w * rn * ga4[j].w + sh4[j].w;
                *(uint2*)(hb + (size_t)row * DM + col) = make_uint2(pack_bf16(y.x, y.y), pack_bf16(y.z, y.w));
                *(LAS g8::f32x4*)(hs + trow * HSP + col) = (g8::f32x4){y.x, y.y, y.z, y.w}; }
        }
        if (tile + nb_s < NT / 16) {
#pragma unroll
            for (int rr = 0; rr < 2; ++rr)
#pragma unroll
                for (int j = 0; j < 4; ++j) xr[rr][j] = *(const uint2*)(x + (size_t)((tile + nb_s) * 16 + wid * 2 + rr) * DM + j * 256 + lane * 4);
            const int bn = (tile + nb_s) * 16 / SEQ;
#pragma unroll
            for (int j = 0; j < 4; ++j) { scn[j] = *(const float4*)(scale + bn * ldmod + j * 256 + lane * 4); shn[j] = *(const float4*)(shift + bn * ldmod + j * 256 + lane * 4); }
        }
        __syncthreads();
        {
            g8::f32x4 acc0 = {0.f, 0.f, 0.f, 0.f}, acc1 = {0.f, 0.f, 0.f, 0.f};
            const LAS float* hp_ = hs + (lane & 15) * HSP + 128 * wid + 8 * (lane >> 4);
#pragma unroll
            for (int ks = 0; ks < 4; ++ks) {
                const g8::f32x4 x0 = *(const LAS g8::f32x4*)(hp_ + 32 * ks), x1 = *(const LAS g8::f32x4*)(hp_ + 32 * ks + 4);
                unsigned hh_[4], ll_[4];
                { unsigned p;
                  p = pack_bf16(x0[0], x0[1]); hh_[0] = p; ll_[0] = pack_bf16(x0[0] - __uint_as_float(p << 16), x0[1] - __uint_as_float(p & 0xffff0000u));
                  p = pack_bf16(x0[2], x0[3]); hh_[1] = p; ll_[1] = pack_bf16(x0[2] - __uint_as_float(p << 16), x0[3] - __uint_as_float(p & 0xffff0000u));
                  p = pack_bf16(x1[0], x1[1]); hh_[2] = p; ll_[2] = pack_bf16(x1[0] - __uint_as_float(p << 16), x1[1] - __uint_as_float(p & 0xffff0000u));
                  p = pack_bf16(x1[2], x1[3]); hh_[3] = p; ll_[3] = pack_bf16(x1[2] - __uint_as_float(p << 16), x1[3] - __uint_as_float(p & 0xffff0000u)); }
                au32x4 hv = {hh_[0], hh_[1], hh_[2], hh_[3]}, lv = {ll_[0], ll_[1], ll_[2], ll_[3]};
                const g8::bf16x8 ah = *reinterpret_cast<g8::bf16x8*>(&hv), al = *reinterpret_cast<g8::bf16x8*>(&lv);
                acc0 = __builtin_amdgcn_mfma_f32_16x16x32_bf16(ah, wh[ks][0], acc0, 0, 0, 0); acc1 = __builtin_amdgcn_mfma_f32_16x16x32_bf16(ah, wh[ks][1], acc1, 0, 0, 0);
                acc0 = __builtin_amdgcn_mfma_f32_16x16x32_bf16(ah, wl[ks][0], acc0, 0, 0, 0); acc1 = __builtin_amdgcn_mfma_f32_16x16x32_bf16(ah, wl[ks][1], acc1, 0, 0, 0);
                acc0 = __builtin_amdgcn_mfma_f32_16x16x32_bf16(al, wh[ks][0], acc0, 0, 0, 0); acc1 = __builtin_amdgcn_mfma_f32_16x16x32_bf16(al, wh[ks][1], acc1, 0, 0, 0);
            }
#pragma unroll
            for (int rg = 0; rg < 4; ++rg) { part[(wid * 16 + 4 * (lane >> 4) + rg) * 32 + (lane & 15)] = acc0[rg]; part[(wid * 16 + 4 * (lane >> 4) + rg) * 32 + 16 + (lane & 15)] = acc1[rg]; }
        }
        __syncthreads();
#pragma unroll
        for (int rr = 0; rr < 2; ++rr) {
            const int t = wid * 2 + rr, row = tile * 16 + t;
            float v = rbv;
#pragma unroll
            for (int w = 0; w < 8; ++w) v += part[(w * 16 + t) * 32 + e];
            int rank = 0;
#pragma unroll
            for (int e2 = 0; e2 < 32; ++e2) { const float ve = __uint_as_float(__builtin_amdgcn_readlane(__float_as_uint(v), e2)); rank += (ve > v || (ve == v && e2 < e)) ? 1 : 0; }
            float tv[4]; int ti[4];
#pragma unroll
            for (int r4 = 0; r4 < 4; ++r4) { const unsigned m = (unsigned)__ballot(rank == r4); const int lr = __builtin_ctz(m); ti[r4] = lr; tv[r4] = __uint_as_float(__builtin_amdgcn_readlane(__float_as_uint(v), lr)); }
            float w4[4], s = 0.f;
#pragma unroll
            for (int r4 = 0; r4 < 4; ++r4) { w4[r4] = expf(tv[r4] - tv[0]); s += w4[r4]; }
            if (lane == 0) {
                *(int4*)(topi + row * 4) = make_int4(ti[0], ti[1], ti[2], ti[3]);
                *(float4*)(topw + row * 4) = make_float4(w4[0] / s, w4[1] / s, w4[2] / s, w4[3] / s);
#pragma unroll
                for (int r4 = 0; r4 < 4; ++r4) (void)__hip_atomic_fetch_add(hist + ti[r4], 1, __ATOMIC_RELAXED, __HIP_MEMORY_SCOPE_WORKGROUP);
            }
        }
    }
    __syncthreads();
    if (tid_ < 32) cntb[bid_ * 32 + tid_] = hist[tid_];
}
__device__ __forceinline__ void ph_assign2(const int* topi, const int* cntb, int* cnt, int* stok, int* pos, int* tile_e, LAS unsigned char* lds) {
    LAUNDER();
    LAS int* ptot = (LAS int*)lds;
    LAS int* ppre = ptot + 512;
    LAS int* base = ppre + 512;
    LAS int* cur = base + 32;
    { const int e = tid_ & 31, ch = tid_ >> 5; int tot = 0, pre = 0;
      for (int j = 0; j < 16; ++j) { const int bb = ch * 16 + j; if (bb < nb_s) { const int v = cntb[bb * 32 + e]; tot += v; pre += bb < bid_ ? v : 0; } }
      ptot[ch * 32 + e] = tot; ppre[ch * 32 + e] = pre; }
    __syncthreads();
    if (tid_ < 32) { int tot = 0, pre = 0;
        for (int ch = 0; ch < 16; ++ch) { tot += ptot[ch * 32 + tid_]; pre += ppre[ch * 32 + tid_]; }
        ptot[tid_] = tot; ppre[tid_] = pre; cur[tid_] = 0; }
    __syncthreads();
    if (tid_ == 0) { int s = 0;
        for (int e = 0; e < NE; ++e) { base[e] = s + ppre[e]; const int p = (ptot[e] + MPAD - 1) / MPAD * MPAD;
            if (bid_ == 0) for (int tl = s / MPAD; tl < (s + p) / MPAD; ++tl) tile_e[tl] = e;
            s += p; }
        if (bid_ == 0) cnt[64 + NE] = s; }
    __syncthreads();
    if (tid_ < 64) {
        for (int t0 = bid_; t0 < NT / 16; t0 += 8 * nb_s) {
            int ev[8];
#pragma unroll
            for (int k = 0; k < 8; ++k) { const int tile = t0 + k * nb_s; ev[k] = tile < NT / 16 ? topi[tile * 64 + tid_] : -1; }
#pragma unroll
            for (int k = 0; k < 8; ++k) { const int tile = t0 + k * nb_s;
                if (ev[k] >= 0) { const int i = tile * 64 + tid_;
                    const int p = base[ev[k]] + __hip_atomic_fetch_add(cur + ev[k], 1, __ATOMIC_RELAXED, __HIP_MEMORY_SCOPE_WORKGROUP);
                    stok[p] = i >> 2; pos[i] = p; } }
        }
    }
}
__device__ __forceinline__ void ph_combine_norm(unsigned short* x, const unsigned short* y, const int* pos, const float* topw, const float* gate, int ldg,
                                                const float* g1, const float* sh1, const float* sc1, int ld1, unsigned short* hb,
                                                const float* gk, const float* shk, const float* sck, int ldk, unsigned short* hb2,
                                                const float* gfin, float* out, int* cnt, LAS unsigned char* lds) {
    LAUNDER();
    const int lane = tid_ & 63;
    if (GTID < 128) cnt[GTID] = 0;
    LAS float* KA = (LAS float*)lds; LAS float* KH = KA + 8 * DM;
    if (gk) {
        for (int i = tid_; i < 8 * DM / 4; i += NTHR) { const int bb = i >> 8, c4 = (i & 255) * 4;
            const float4 gg = *(const float4*)(gk + c4), sc = *(const float4*)(sck + bb * ldk + c4), sh = *(const float4*)(shk + bb * ldk + c4);
            *(LAS g8::f32x4*)(KA + bb * DM + c4) = (g8::f32x4){gg.x * (1.f + sc.x), gg.y * (1.f + sc.y), gg.z * (1.f + sc.z), gg.w * (1.f + sc.w)};
            *(LAS g8::f32x4*)(KH + bb * DM + c4) = (g8::f32x4){sh.x, sh.y, sh.z, sh.w}; }
        __syncthreads();
    }
    float4 g1v[4];
#pragma unroll
    for (int j = 0; j < 4; ++j) { g1v[j] = make_float4(0.f, 0.f, 0.f, 0.f); if (!gfin) g1v[j] = *(const float4*)(g1 + j * 256 + lane * 4); }
    int4 psn[2]; float4 twn[2];
    { const int r0 = (GTID >> 6) * 2;
#pragma unroll
      for (int q = 0; q < 2; ++q) { psn[q] = *(const int4*)(pos + (r0 + q) * 4); twn[q] = *(const float4*)(topw + (r0 + q) * 4); } }
    for (int row0 = (GTID >> 6) * 2; row0 < NT; row0 += (GSZ >> 6) * 2) {
        int4 ps[2]; float4 tw[2];
#pragma unroll
        for (int q = 0; q < 2; ++q) { ps[q] = psn[q]; tw[q] = twn[q]; }
        { const int rn_ = row0 + (GSZ >> 6) * 2;
          if (rn_ < NT) {
#pragma unroll
              for (int q = 0; q < 2; ++q) { psn[q] = *(const int4*)(pos + (rn_ + q) * 4); twn[q] = *(const float4*)(topw + (rn_ + q) * 4); } } }
        const int bq = row0 / SEQ;
        float4 gpv[4], s1v[4], h1v[4];
        uint2 yv[2][4][4], xu[2][4];
#pragma unroll
        for (int q = 0; q < 2; ++q)
#pragma unroll
            for (int j = 0; j < 4; ++j) { const int col = j * 256 + lane * 4;
                yv[q][0][j] = *(const uint2*)(y + (size_t)ps[q].x * DM + col); yv[q][1][j] = *(const uint2*)(y + (size_t)ps[q].y * DM + col);
                yv[q][2][j] = *(const uint2*)(y + (size_t)ps[q].z * DM + col); yv[q][3][j] = *(const uint2*)(y + (size_t)ps[q].w * DM + col);
                xu[q][j] = *(const uint2*)(x + (size_t)(row0 + q) * DM + col); }
#pragma unroll
        for (int j = 0; j < 4; ++j) { const int col = j * 256 + lane * 4;
            gpv[j] = *(const float4*)(gate + bq * ldg + col);
            s1v[j] = make_float4(0.f, 0.f, 0.f, 0.f); h1v[j] = s1v[j];
            if (!gfin) { s1v[j] = *(const float4*)(sc1 + bq * ld1 + col); h1v[j] = *(const float4*)(sh1 + bq * ld1 + col); }
            }
#pragma unroll
        for (int q = 0; q < 2; ++q) {
            const int row = row0 + q, b = row / SEQ;
            const float w4[4] = {tw[q].x, tw[q].y, tw[q].z, tw[q].w};
            float4 xn[4]; float ss = 0.f;
#pragma unroll
            for (int j = 0; j < 4; ++j) { const int col = j * 256 + lane * 4;
                float a0 = 0.f, a1 = 0.f, a2 = 0.f, a3 = 0.f;
#pragma unroll
                for (int r4 = 0; r4 < 4; ++r4) { const uint2 u = yv[q][r4][j]; const float w = w4[r4];
                    a0 += w * __uint_as_float(u.x << 16); a1 += w * __uint_as_float(u.x & 0xffff0000u); a2 += w * __uint_as_float(u.y << 16); a3 += w * __uint_as_float(u.y & 0xffff0000u); }
                const uint2 u = xu[q][j]; float4 xv = make_float4(__uint_as_float(u.x << 16), __uint_as_float(u.x & 0xffff0000u), __uint_as_float(u.y << 16), __uint_as_float(u.y & 0xffff0000u));
                const float4 gp = gpv[j];
                xv.x += gp.x * a0; xv.y += gp.y * a1; xv.z += gp.z * a2; xv.w += gp.w * a3;
                if (!gfin) *(uint2*)(x + (size_t)row * DM + col) = make_uint2(pack_bf16(xv.x, xv.y), pack_bf16(xv.z, xv.w));
                xn[j] = xv; ss += xv.x * xv.x + xv.y * xv.y + xv.z * xv.z + xv.w * xv.w; }
#pragma unroll
            for (int o = 32; o > 0; o >>= 1) ss += SHX(ss, o);
            const float rn = rsqrtf(ss * (1.f / DM) + 1e-5f);
#pragma unroll
            for (int j = 0; j < 4; ++j) { const int col = j * 256 + lane * 4;
                if (gfin) { const float4 gg = *(const float4*)(gfin + col); *(float4*)(out + (size_t)row * DM + col) = make_float4(xn[j].x * rn * gg.x, xn[j].y * rn * gg.y, xn[j].z * rn * gg.z, xn[j].w * rn * gg.w); }
                else {
                    { const float4 gg = g1v[j], sc = s1v[j], sh = h1v[j];
                      *(uint2*)(hb + (size_t)row * DM + col) = make_uint2(pack_bf16(xn[j].x * rn * gg.x * (1.f + sc.x) + sh.x, xn[j].y * rn * gg.y * (1.f + sc.y) + sh.y),
                                                                         pack_bf16(xn[j].z * rn * gg.z * (1.f + sc.z) + sh.z, xn[j].w * rn * gg.w * (1.f + sc.w) + sh.w)); }
                    if (gk) { const g8::f32x4 ga = *(const LAS g8::f32x4*)(KA + b * DM + col), sh = *(const LAS g8::f32x4*)(KH + b * DM + col);
                      *(uint2*)(hb2 + (size_t)row * DM + col) = make_uint2(pack_bf16(xn[j].x * rn * ga[0] + sh[0], xn[j].y * rn * ga[1] + sh[1]),
                                                                          pack_bf16(xn[j].z * rn * ga[2] + sh[2], xn[j].w * rn * ga[3] + sh[3])); }
                }
            }
        }
    }
}
#define PHASE(name, ...) __device__ __forceinline__ void name(KP kp, const int L) { asm volatile("" : "+s"(kp)); const P __attribute__((address_space(4)))& p = *kp; float* sm = dyn_smem(); (void)sm; \
    LAS unsigned char* lds = (LAS unsigned char*)dyn_smem(); (void)lds; (void)L; const float* md = p.mod + (size_t)L * 8 * 6144; (void)md;  __VA_ARGS__ }
#define ORDER(S, nM, nN) S.init(nM, nN, nb_s, (int)blockIdx.x)
#define ORDERW(S, nM, nN, W) S.init(nM, nN, nb_s, (int)blockIdx.x, W)

PHASE(f_prologue,
      ph_convT(p.gla_w_in, p.wt_gla_in, 1024, GLA_IN, 3328, 2, sm);
      ph_convT(p.gla_w_out, p.wt_gla_out, 1024, 1024, 1024, 2, sm);
      ph_convT(p.kv_w, p.wt_kv, 1024, KV_OUT, KV_OUT, 1, sm);
      ph_convT(p.nsa_w_in, p.wt_nsa_in, 1024, NSA_IN, 1280, 2, sm);
      ph_convT(p.nsa_w_out, p.wt_nsa_out, 1024, 1024, 1024, 2, sm);
      ph_convT(p.cmp_w1, p.wt_cmp1, 2048, 128, 256, 2, sm);
      ph_convT(p.moe_w_gu, p.wt_gu, 1024, 2048, 2048, 4 * NE, sm);
      ph_convT<true>(p.moe_w_down, p.wt_down, 1024, 1024, 1024, 4 * NE, sm);
      ph_c1(p.cmp_pos, p.cmp_w1, p.cmp_b1, p.c1, sm);
      { LAUNDER(); if (GTID < 128) p.cnt[GTID] = 0; }
      ph_mod(p.c, p.ada_w, p.ada_b, p.kv_ada_w, p.kv_ada_b, p.mod, p.kvmod, sm);)
PHASE(f_norm1, ph_norm(p.x_in, p.norm1_g + L * DM, md + 0, md + 1024, (float*)nullptr, p.hb, 6144);)
PHASE(f_gla_in, ProbPlain<1024> S; ORDER(S, NT / 256, 13); S.A = (const char*)p.hb; S.Bt = (const char*)(p.wt_gla_in + (size_t)L * 3328 * 1024); S.lda = 2048;
      g8::gemm_phase(lds, S, g8::EpiPair<PGlaIn>{PGlaIn{p.gqk, p.gvT, p.grb, p.glr, lds + LDS_X_OFF}}, wv_s);)
PHASE(f_gla_gate, ph_gla_p1(p.gqk, p.glr, p.gvT, p.gla_w_gate2 + L * 16 * 512, p.gla_b_gate + L * 512, p.gqd, p.gki, p.gdl, p.gUT, lds);)
PHASE(f_gla_rec, ph_gla_p2(p.gUT, p.gdl, p.gST);)
PHASE(f_gla_post, ph_gla_p3(p.gqd, p.gki, p.gvT, p.gST, p.grb, p.gla_norm_g + L * DM, p.ob, lds);)
PHASE(f_gla_out, ProbPlain<1024> S; ORDER(S, NT / 256, 4); S.A = (const char*)p.ob; S.Bt = (const char*)(p.wt_gla_out + (size_t)L * 1024 * 1024); S.lda = 2048;
      if (L == 0) g8::gemm_phase(lds, S, EpiResid<true>{p.x_in, p.x, md + 2048, 6144}, wv_s);
      else g8::gemm_phase(lds, S, EpiResid<false>{p.x, p.x, md + 2048, 6144}, wv_s);)
PHASE(f_nsa_in, ProbPlain<1024> S; ORDER(S, NT / 256, 5); S.A = (const char*)p.hb; S.Bt = (const char*)(p.wt_nsa_in + (size_t)(L - 2) * 1280 * 1024); S.lda = 2048;
      g8::gemm_phase(lds, S, g8::EpiPair<PNsaIn>{PNsaIn{p.qb, p.gates, p.nsa_b_gate + (L - 2) * 48}}, wv_s);)
PHASE(f_nsa_attn, ph_nsa_attn_mfma(p.qb, p.gates, p.kcmp, p.vcmpT, p.kslc, p.vslcT, p.kwin, p.vwinT, p.ob, p.cnt + 112, lds);)
PHASE(f_nsa_out, ProbPlain<1024> S; ORDER(S, NT / 256, 4); S.A = (const char*)p.ob; S.Bt = (const char*)(p.wt_nsa_out + (size_t)(L - 2) * 1024 * 1024); S.lda = 2048;
      g8::gemm_phase(lds, S, EpiResid<false>{p.x, p.x, md + 2048, 6144}, wv_s);)
PHASE(f_out_probe, ProbPlain<1024> S; ORDER(S, NT / 256, 4); S.A = (const char*)p.ob; S.Bt = (const char*)(L < 2 ? p.wt_gla_out + (size_t)L * 1024 * 1024 : p.wt_nsa_out + (size_t)(L - 2) * 1024 * 1024); S.lda = 2048;
      g8::gemm_phase(lds, S, EpiResid<false>{p.x, p.act, md + 2048, 6144}, wv_s);)
PHASE(f_comb_probe, const float* mdn = p.mod + (size_t)(L < 3 ? L + 1 : L) * 8 * 6144;
      ph_combine_norm(p.act, p.y, p.pos, p.topw, md + 5120, 6144, p.norm1_g + (L < 3 ? L + 1 : L) * DM, mdn + 0, mdn + 1024, 6144, p.qb,
                      (const float*)nullptr, p.kvmod + 0, p.kvmod + 1024, 2048, p.qb, (const float*)nullptr, p.out, p.cnt + 256, lds);)
PHASE(f_norm2, ph_norm_router(p.x, p.norm2_g + L * DM, md + 3072, md + 4096, 6144, p.hb, p.router_w + (size_t)L * DM * 32, p.router_b + L * 32, p.topi, p.topw, p.cntb, p.stok, lds);)
PHASE(f_assign, ph_assign2(p.topi, p.cntb, p.cnt, p.stok, p.pos, p.tile_e, lds);)
PHASE(f_moe_gu, ProbMoe<1024, true> S; ORDER(S, p.cnt[64 + NE] / 256, 8); S.A = (const char*)p.hb; S.Bt = (const char*)(p.wt_gu + (size_t)L * NE * 2048 * 1024); S.tok = p.stok; S.tile_e = p.tile_e;
      S.bias = p.moe_b_gu + (size_t)L * NE * 2048; S.nbias = 2048; S.estride = (size_t)2048 * 1024 * 2; S.xl = lds + LDS_X_OFF;
      g8::gemm_phase(lds, S, EpiSwiglu{p.act, lds + LDS_X_OFF}, wv_s);)
PHASE(f_moe_down, ProbMoe<1024, false> S; ORDER(S, p.cnt[64 + NE] / 256, 4); S.A = (const char*)p.act; S.Bt = (const char*)(p.wt_down + (size_t)L * NE * 1024 * 1024); S.tok = p.stok; S.tile_e = p.tile_e;
      S.bias = p.moe_b_down + (size_t)L * NE * DM; S.nbias = 1024; S.estride = (size_t)1024 * 1024 * 2; S.xl = lds + LDS_X_OFF;
      g8::gemm_phase(lds, S, EpiDown{p.y, lds + LDS_X_OFF}, wv_s);)
PHASE(f_combine, const float* mdn = p.mod + (size_t)(L + 1) * 8 * 6144;
      ph_combine_norm(p.x, p.y, p.pos, p.topw, md + 5120, 6144, p.norm1_g + (L + 1) * DM, mdn + 0, mdn + 1024, 6144, p.hb,
                      L == 1 ? p.kv_norm_g : (const float*)nullptr, p.kvmod + 0, p.kvmod + 1024, 2048, p.ob, L == 3 ? p.final_g : (const float*)nullptr, p.out, p.cnt, lds);)
PHASE(f_kv_gemm, ProbPlain<1024> S; ORDER(S, NT / 256, 6); S.A = (const char*)p.ob; S.Bt = (const char*)p.wt_kv; S.lda = 2048;
      g8::gemm_phase(lds, S, g8::EpiPair<PKv>{PKv{p.csrc, p.kslc, p.vslcT, p.kwin, p.vwinT, lds + LDS_X_OFF}}, wv_s);)
PHASE(f_cmp1, ProbCmp S; ORDER(S, 256, 1); S.csrc = (const char*)p.csrc; S.W1t = (const char*)p.wt_cmp1;
      g8::gemm_phase(lds, S, g8::EpiQuad<QCmp1>{QCmp1{p.hid}}, wv_s);)
PHASE(f_cmp2, ph_gemm(AHid4{p.hid, p.c1}, BCmp{p.cmp_w2, 64, (size_t)128 * 64}, ECmp2b{p.kcmp, p.vcmpT, p.cmp_b2}, NCMP, 64, 128, 64, sm);)

#define BAR() xcd_barrier(bar, wv_s)
#ifndef REP_GEMM
#define REP_GEMM 1
#endif
#ifndef REP_ATTN
#define REP_ATTN 1
#endif
#ifndef REP_MOE
#define REP_MOE 1
#endif
#ifndef REP_GLA
#define REP_GLA 1
#endif
#ifndef REP_OUT
#define REP_OUT 1
#endif
#ifndef REP_N2
#define REP_N2 1
#endif
#ifndef REP_ASG
#define REP_ASG 1
#endif
#ifndef REP_COMB
#define REP_COMB 1
#endif
#ifndef REP_PRO
#define REP_PRO 1
#endif
#define REPEAT(n, ...) { __VA_ARGS__ } if ((n) > 1) { __VA_ARGS__ } if ((n) > 2) { __VA_ARGS__ }
template <int L> __device__ __forceinline__ void layer(KP kp, const XcdBarrier& bar) {
    if (L == 0) { f_norm1(kp, L); BAR(); }
    if (L < 2) {
        REPEAT(REP_GEMM, f_gla_in(kp, L); BAR();) REPEAT(REP_GLA, f_gla_gate(kp, L); BAR(); f_gla_rec(kp, L); BAR(); f_gla_post(kp, L); BAR();) f_gla_out(kp, L); BAR(); if (REP_OUT > 1) { f_out_probe(kp, L); BAR(); }
    } else {
        REPEAT(REP_GEMM, f_nsa_in(kp, L); BAR();) REPEAT(REP_ATTN, f_nsa_attn(kp, L); BAR();) f_nsa_out(kp, L); BAR(); if (REP_OUT > 1) { f_out_probe(kp, L); BAR(); }
    }
    REPEAT(REP_N2, f_norm2(kp, L); BAR();) REPEAT(REP_ASG, f_assign(kp, L); BAR();)
    REPEAT(REP_MOE, f_moe_gu(kp, L); BAR(); f_moe_down(kp, L); BAR();) if (REP_COMB > 1) { f_comb_probe(kp, L); BAR(); } f_combine(kp, L); if (L < 3) BAR();
    if (L == 1) { REPEAT(REP_GEMM, f_kv_gemm(kp, L); BAR();) f_cmp1(kp, L); BAR(); f_cmp2(kp, L); BAR(); }
}
};
__global__ __launch_bounds__(NTHR, 2) void mega(P p_unused) {
    KP kp = (KP)__builtin_amdgcn_kernarg_segment_ptr();
    float* smem = dyn_smem();
    unsigned* bw = (unsigned*)smem + LDS_BAR_OFF / 4;
    if (threadIdx.x == 0) { bw[0] = 0u; bw[1] = 0u; bw[2] = 0u; bw[3] = 0u; }
    __syncthreads();
    XcdBarrier bar = xcd_barrier_post(kp->bar, (volatile LAS unsigned*)bw);
    Ctx cx; cx.nb_s = (int)gridDim.x; cx.wv_s = __builtin_amdgcn_readfirstlane(threadIdx.x >> 6);
    REPEAT(REP_PRO, cx.f_prologue(kp, 0); xcd_barrier(bar, cx.wv_s);)
    cx.layer<0>(kp, bar); cx.layer<1>(kp, bar); cx.layer<2>(kp, bar); cx.layer<3>(kp, bar);
}
}

extern "C" void kernel_launch(void* const* d_in, const int* in_sizes, int n_in, void* d_out, int out_size, void* d_ws, size_t ws_size, hipStream_t stream) {
    P p{};
    const float** pin = (const float**)&p;
    for (int i = 0; i < 30; ++i) pin[i] = (const float*)d_in[i];
    p.out = (float*)d_out;
    char* wp = (char*)d_ws; size_t off = 0;
    auto alloc = [&](size_t bytes) { void* q = wp + off; off += (bytes + 255) & ~(size_t)255; return q; };
    p.bar = (unsigned*)alloc(XCD_BAR_WORDS * 4);
    p.mod = (float*)alloc((size_t)4 * 8 * 6144 * 4);
    p.kvmod = (float*)alloc((size_t)8 * 2048 * 4);
    p.c1 = (float*)alloc(256 * 4);
    p.x = (unsigned short*)alloc((size_t)NT * DM * 2);
    p.hid = (float*)alloc((size_t)4 * 64 * NCMP * 128 * 4);
    p.gates = (float*)alloc((size_t)NT * 48 * 4);
    p.topi = (int*)alloc((size_t)NT * 4 * 4);
    p.topw = (float*)alloc((size_t)NT * 4 * 4);
    p.cnt = (int*)alloc(512 * 4);
    p.cntb = (int*)alloc((size_t)1024 * 32 * 4);
    p.stok = (int*)alloc((size_t)CAP * 4);
    p.pos = (int*)alloc((size_t)NT * 4 * 4);
    p.tile_e = (int*)alloc((size_t)(CAP / MPAD) * 4);
    p.y = (unsigned short*)alloc((size_t)CAP * DM * 2);
    p.hb = (unsigned short*)alloc((size_t)NT * DM * 2);
    p.ob = (unsigned short*)alloc((size_t)NT * DM * 2);
    p.act = (unsigned short*)alloc((size_t)CAP * DM * 2);
    p.csrc = (unsigned short*)alloc((size_t)64 * SEQ * 64 * 2 + 8192);
    p.qb = (unsigned short*)alloc((size_t)NT * DM * 2);
    p.kslc = (unsigned short*)alloc((size_t)32 * SEQ * 64 * 2);
    p.vslcT = (unsigned short*)alloc((size_t)32 * SEQ * 64 * 2);
    p.kwin = (unsigned short*)alloc((size_t)32 * SEQ * 64 * 2);
    p.vwinT = (unsigned short*)alloc((size_t)32 * SEQ * 64 * 2);
    p.kcmp = (unsigned short*)alloc((size_t)32 * 256 * 64 * 2);
    p.vcmpT = (unsigned short*)alloc((size_t)32 * 256 * 64 * 2);
    p.gqk = (unsigned short*)alloc((size_t)NT * 1024 * 2);
    p.gvT = (unsigned short*)alloc((size_t)NT * 1024 * 2);
    p.grb = (unsigned short*)alloc((size_t)NT * 1024 * 2);
    p.gqd = (unsigned short*)alloc((size_t)NT * 512 * 2);
    p.gki = (unsigned short*)alloc((size_t)NT * 512 * 2);
    p.gST = (unsigned short*)alloc((size_t)32 * 64 * 256 * 128 * 2);
    p.glr = (float*)alloc((size_t)NT * 16 * 4);
    p.gdl = (float*)alloc((size_t)32 * 64 * 128 * 4);
    p.gUT = (unsigned short*)alloc((size_t)32 * 64 * 256 * 128 * 2);
    p.wt_gla_in = (unsigned short*)alloc((size_t)2 * 3328 * 1024 * 2);
    p.wt_gla_out = (unsigned short*)alloc((size_t)2 * 1024 * 1024 * 2);
    p.wt_kv = (unsigned short*)alloc((size_t)KV_OUT * 1024 * 2);
    p.wt_nsa_in = (unsigned short*)alloc((size_t)2 * 1280 * 1024 * 2);
    p.wt_nsa_out = (unsigned short*)alloc((size_t)2 * 1024 * 1024 * 2);
    p.wt_cmp1 = (unsigned short*)alloc((size_t)2 * 256 * 2048 * 2);
    p.wt_gu = (unsigned short*)alloc((size_t)4 * NE * 2048 * 1024 * 2);
    p.wt_down = (unsigned short*)alloc((size_t)4 * NE * 1024 * 1024 * 2);
    if (off > ws_size) return;

    static int grid = 0;
    if (!grid) {
        int dev = 0, cus = 0, per_cu = 0;
        (void)hipGetDevice(&dev);
        (void)hipDeviceGetAttribute(&cus, hipDeviceAttributeMultiprocessorCount, dev);
        (void)hipFuncSetAttribute((const void*)mega, hipFuncAttributeMaxDynamicSharedMemorySize, (int)kDynLds);
        (void)hipOccupancyMaxActiveBlocksPerMultiprocessor(&per_cu, mega, NTHR, kDynLds);
        if (per_cu < 1) per_cu = 1;
        grid = cus * 1;
    }
    (void)hipMemsetAsync(p.bar, 0, XCD_BAR_WORDS * sizeof(unsigned), stream);
    hipLaunchKernelGGL(mega, dim3(grid), dim3(NTHR), kDynLds, stream, p);
}
```

```cpp
#include <hip/hip_runtime.h>
#include <stdint.h>
#include <math.h>

namespace {
constexpr int NB = 8, SEQ = 4096, DM = 1024, NT = NB * SEQ;
constexpr int GLA_IN = 3088, NSA_IN = 1072, KV_OUT = 1536;
constexpr int NE = 32, TOPK = 4, NASG = NT * TOPK;
constexpr int MPAD = 256;
constexpr int CAP = NASG + NE * MPAD;
constexpr int NCMP = 255;
constexpr int NTHR = 512;

__device__ __forceinline__ unsigned short f2bf(float f) { unsigned u = __float_as_uint(f); u += 0x7FFFu + ((u >> 16) & 1u); return (unsigned short)(u >> 16); }
typedef __bf16 hbf16x2_t __attribute__((ext_vector_type(2)));
typedef float hf32x2_t __attribute__((ext_vector_type(2)));
__device__ __forceinline__ unsigned pack_bf16(float lo, float hi) { const hf32x2_t v = {lo, hi}; const hbf16x2_t r = __builtin_convertvector(v, hbf16x2_t); return __builtin_bit_cast(unsigned, r); }
__device__ __forceinline__ unsigned pack_bf16_v(float lo, float hi) { return pack_bf16(lo, hi); }
__device__ __forceinline__ float fast_exp(float x) { return __builtin_amdgcn_exp2f(x * 1.4426950408889634f); }
__device__ __forceinline__ float fast_logsigmoid(float z) { return fminf(z, 0.f) - 0.6931471805599453f * __builtin_amdgcn_logf(1.f + __builtin_amdgcn_exp2f(-fabsf(z) * 1.4426950408889634f)); }
__device__ __forceinline__ float fast_silu(float x) { return x * __builtin_amdgcn_rcpf(1.f + __builtin_amdgcn_exp2f(-1.4426950408889634f * x)); }
__device__ __forceinline__ float sigm(float x) { return 1.f / (1.f + expf(-x)); }
__device__ __forceinline__ float siluf(float x) { return x / (1.f + expf(-x)); }
__device__ __forceinline__ float logsigmoidf(float z) { return fminf(z, 0.f) - log1pf(expf(-fabsf(z))); }
__device__ __forceinline__ float gelu_tanh(float x) { return 0.5f * x * (1.f + tanhf(0.7978845608028654f * (x + 0.044715f * x * x * x))); }

#define XB_TMO      128
#define XB_XCNT(j)  (256  + 64 * (j))
#define XB_XSUB(j)  (1280 + 64 * (j))
#define XB_XGEN(j)  (2304 + 64 * (j))
#define XB_TOP      3328
#define XB_TOPGEN   3392
#define XCD_BAR_WORDS 3456
#define XB_SPIN_CAP (1u << 22)
#define LAS __attribute__((address_space(3)))

__device__ __forceinline__ unsigned xb_ld(unsigned* p)              { return __hip_atomic_load(p, __ATOMIC_RELAXED, __HIP_MEMORY_SCOPE_AGENT); }
__device__ __forceinline__ unsigned xb_add(unsigned* p, unsigned v) { return __hip_atomic_fetch_add(p, v, __ATOMIC_RELAXED, __HIP_MEMORY_SCOPE_AGENT); }
__device__ __forceinline__ unsigned xb_xcc_id() { return (unsigned)__builtin_amdgcn_s_getreg((3 << 11) | 20) & 0xFu; }
#define XB_SPIN(cond, bar) do { unsigned _sp = 0; while (cond) { __builtin_amdgcn_s_sleep(1); \
    if ((++_sp & 255u) == 0u) { if (xb_ld(&(bar)[XB_TMO])) break; if (_sp > XB_SPIN_CAP) { atomicAdd(&(bar)[XB_TMO], 1u); break; } } } } while (0)

struct XcdBarrier { unsigned* bar; unsigned x; volatile LAS unsigned* st; };

__device__ __forceinline__ XcdBarrier xcd_barrier_post(unsigned* bar, volatile LAS unsigned* st) {
    XcdBarrier b; b.bar = bar; b.x = xb_xcc_id(); b.st = st;
    if (threadIdx.x == 0) (void)xb_add(&bar[XB_XCNT(b.x)], 1u);
    return b;
}
__device__ __forceinline__ void xcd_barrier_complete(unsigned* bar, unsigned x, unsigned& nloc, unsigned& nx) {
    const unsigned G = gridDim.x * gridDim.y * gridDim.z;
    unsigned sum, cnt, mine, sp = 0u;
    for (;;) {
        sum = 0u; cnt = 0u; mine = 0u;
#pragma unroll
        for (unsigned j = 0; j < 16; ++j) { const unsigned c = xb_ld(&bar[XB_XCNT(j)]); sum += c; cnt += (c > 0u) ? 1u : 0u; mine = (j == x) ? c : mine; }
        if (sum == G) break;
        __builtin_amdgcn_s_sleep(1);
        if ((++sp & 255u) == 0u) { if (xb_ld(&bar[XB_TMO])) break; if (sp > XB_SPIN_CAP) { atomicAdd(&bar[XB_TMO], 1u); break; } }
    }
    nloc = mine > 0u ? mine : 1u; nx = cnt > 0u ? cnt : 1u;
}
__device__ __forceinline__ void xcd_barrier(const XcdBarrier& b, int wv) {
    asm volatile("s_waitcnt vmcnt(0)" ::: "memory");
    __syncthreads();
    int ln_; asm volatile("v_mbcnt_lo_u32_b32 %0, -1, 0\n\tv_mbcnt_hi_u32_b32 %0, -1, %0" : "=v"(ln_));
    if (wv == 0 && ln_ == 0) {
        unsigned* bar = b.bar;
        __builtin_amdgcn_s_waitcnt(0);
        unsigned nloc = b.st[0], nx = b.st[1];
        if (nloc == 0u) { xcd_barrier_complete(bar, b.x, nloc, nx); b.st[0] = nloc; b.st[1] = nx; }
        const unsigned old = xb_add(&bar[XB_XSUB(b.x)], 1u);
        const unsigned gen = old / nloc;
        if (old + 1u == (gen + 1u) * nloc) {
            __builtin_amdgcn_fence(__ATOMIC_RELEASE, "agent");
            asm volatile("s_waitcnt vmcnt(0)" ::: "memory");
            const unsigned og = xb_add(&bar[XB_TOP], 1u);
            const unsigned tg = og / nx;
            if (og + 1u == (tg + 1u) * nx) xb_add(&bar[XB_TOPGEN], 1u);
            else XB_SPIN(xb_ld(&bar[XB_TOPGEN]) == tg, bar);
            __builtin_amdgcn_fence(__ATOMIC_ACQUIRE, "agent");
            xb_add(&bar[XB_XGEN(b.x)], 1u);
            asm volatile("s_waitcnt vmcnt(0)" ::: "memory");
        } else {
            XB_SPIN(xb_ld(&bar[XB_XGEN(b.x)]) == gen, bar);
            __builtin_amdgcn_fence(__ATOMIC_ACQUIRE, "agent");
            asm volatile("s_waitcnt vmcnt(0)" ::: "memory");
        }
    }
    __syncthreads();
}
struct ARow { const float* A; long lda; __device__ bool active(int, int) const { return true; } __device__ float operator()(int, int m, int k) const { return A[(size_t)m * lda + k]; } };
struct AGather { const float* A; const int* tok; const int* tile_e; __device__ bool active(int, int m0) const { return tile_e[m0 / MPAD] >= 0; }
    __device__ float operator()(int, int m, int k) const { const int t = tok[m]; return t >= 0 ? A[(size_t)t * DM + k] : 0.f; } };
struct ARowsIdx { const float* A; const int* tile_e; __device__ bool active(int, int m0) const { return tile_e[m0 / MPAD] >= 0; }
    __device__ float operator()(int, int m, int k) const { return A[(size_t)m * DM + k]; } };
struct ACmp { const float* kv6; const float* pos; __device__ bool active(int, int) const { return true; }
    __device__ float operator()(int z, int m, int k) const { const int t = z >> 5, b = (z >> 2) & 7, g = z & 3, l = k >> 6, d = k & 63;
        return kv6[(size_t)(b * SEQ + 16 * m + l) * KV_OUT + t * 256 + g * 64 + d] + pos[t * 2048 + k]; } };
struct AHid { const float* hid; __device__ bool active(int, int) const { return true; } __device__ float operator()(int z, int m, int k) const { return hid[((size_t)z * NCMP + m) * 128 + k]; } };
struct BMat { const float* B; long ldb; __device__ float operator()(int, int, int k, int n) const { return B[(size_t)k * ldb + n]; } };
struct BExpert { const float* B; const int* tile_e; long ldb; size_t estride; __device__ float operator()(int, int m0, int k, int n) const { const int e = tile_e[m0 / MPAD]; return B[(size_t)e * estride + (size_t)k * ldb + n]; } };
struct BCmp { const float* B; long ldb; size_t tstride; __device__ float operator()(int z, int, int k, int n) const { return B[(size_t)(z >> 5) * tstride + (size_t)k * ldb + n]; } };
struct EStore { float* C; long ldc; __device__ void operator()(int, int m, int, int n0, const float (&v)[8], int N) const {
#pragma unroll
    for (int j = 0; j < 8; ++j) if (n0 + j < N) C[(size_t)m * ldc + n0 + j] = v[j]; } };
struct EResid { float* X; const float* gate; long ldg; __device__ void operator()(int, int m, int, int n0, const float (&v)[8], int N) const { const int b = m / SEQ;
#pragma unroll
    for (int j = 0; j < 8; ++j) { const int n = n0 + j; X[(size_t)m * DM + n] += gate[b * ldg + n] * v[j]; } } };
struct ENsaIn { float* qn; float* gates; const float* bg; __device__ void operator()(int, int m, int, int n0, const float (&v)[8], int N) const {
#pragma unroll
    for (int j = 0; j < 8; ++j) { const int n = n0 + j; if (n < 1024) qn[(size_t)m * 1024 + n] = v[j] * 0.125f; else if (n < N) gates[(size_t)m * 48 + (n - 1024)] = sigm(v[j] + bg[n - 1024]); } } };
struct ESwiglu { float* act; const float* bgu; const int* tile_e; __device__ void operator()(int, int m, int m0, int n0, const float (&v)[8], int N) const { const int e = tile_e[m0 / MPAD];
#pragma unroll
    for (int j = 0; j < 4; ++j) { const int n = n0 + 2 * j; float gt = v[2 * j] + bgu[e * 2048 + n], up = v[2 * j + 1] + bgu[e * 2048 + n + 1];
        gt = fminf(gt, 7.f); up = fminf(fmaxf(up, -7.f), 7.f); act[(size_t)m * 1024 + (n >> 1)] = (up + 1.f) * gt * sigm(1.702f * gt); } } };
struct EDown { float* y; const float* bd; const int* tile_e; __device__ void operator()(int, int m, int m0, int n0, const float (&v)[8], int N) const { const int e = tile_e[m0 / MPAD];
#pragma unroll
    for (int j = 0; j < 8; ++j) y[(size_t)m * 1024 + n0 + j] = v[j] + bd[e * 1024 + n0 + j]; } };
struct ECmp1 { float* hid; const float* b1; __device__ void operator()(int z, int m, int, int n0, const float (&v)[8], int N) const {
#pragma unroll
    for (int j = 0; j < 8; ++j) if (n0 + j < N) hid[((size_t)z * NCMP + m) * 128 + n0 + j] = gelu_tanh(v[j] + b1[(z >> 5) * 128 + n0 + j]); } };
struct ECmp2 { float* comp; const float* b2; __device__ void operator()(int z, int m, int, int n0, const float (&v)[8], int N) const {
#pragma unroll
    for (int j = 0; j < 8; ++j) if (n0 + j < N) comp[((size_t)z * NCMP + m) * 64 + n0 + j] = v[j] + b2[(z >> 5) * 64 + n0 + j]; } };

struct ECmp2b { unsigned short* kcmp; unsigned short* vcmpT; const float* b2; __device__ void operator()(int z, int m, int, int n0, const float (&v)[8], int N) const { const int t = z >> 5, bg = z & 31;
#pragma unroll
    for (int j = 0; j < 8; ++j) { const int d = n0 + j; if (d < N) { const unsigned short o = f2bf(v[j] + b2[t * 64 + d]); if (t == 0) kcmp[((size_t)bg * 256 + m) * 64 + d] = o; else vcmpT[((size_t)bg * 64 + d) * 256 + ((m & ~15) | (((m >> 2) & 1) << 3) | (((m >> 3) & 1) << 2) | (m & 3))] = o; } } } };
struct AHid4 { const float* hidp; const float* c1; __device__ bool active(int, int) const { return true; } __device__ float operator()(int z, int m, int k) const {
    const size_t o = ((size_t)z * NCMP + m) * 128 + k, st = (size_t)64 * NCMP * 128;
    return gelu_tanh(hidp[o] + hidp[o + st] + hidp[o + 2 * st] + hidp[o + 3 * st] + c1[(z >> 5) * 128 + k]); } };
namespace g8 {
typedef unsigned short bf16_t;
typedef short bf16x8 __attribute__((ext_vector_type(8)));
typedef float f32x4 __attribute__((ext_vector_type(4)));
constexpr bool TAIL_HALVES = false;
constexpr int BM = 256, BK = 64, HALF = 128, HTB = HALF * BK * 2, STAGE_BYTES = 8 * HTB, NXCD = 8, WGM = 8;

__device__ __forceinline__ int lds_byte(int r, int c) { const int st = (r >> 4) * 2 + (c >> 5), rr = r & 15, cc = c & 31, ob = rr * 64 + cc * 2; return st * 1024 + (ob ^ (((ob >> 9) & 1) << 5)); }
__device__ __forceinline__ void stage_rc(int b, int& R, int& C) { const int st = b / 1024, sb = b % 1024, swz = sb ^ (((sb >> 9) & 1) << 5); R = (st >> 1) * 16 + swz / 64; C = (st & 1) * 32 + (swz % 64) / 2; }

struct Unit { int pm, pn, ord, half; };
struct Order {
    int nM, nN, nwg, G, c, wgm;
    __device__ __forceinline__ void init(int nM_, int nN_, int G_, int c_, int wgm_ = WGM) { nM = nM_; nN = nN_; nwg = nM * nN; G = G_; c = c_; wgm = wgm_; }
    __device__ __forceinline__ bool next(int i, Unit& u) const {
        long L = (long)i * G + c; u.ord = i; u.half = -1;
        const int F = nwg / G, r = nwg - F * G;
        if (TAIL_HALVES && r > 0 && 2 * r <= G && L >= (long)F * G) { const long h = L - (long)F * G; if (h >= 2 * r) return false; u.half = (int)(h & 1); L = (long)F * G + (h >> 1); }
        if (L >= nwg) return false;
        int wgid = (int)L; { const int q = nwg / NXCD, rr = nwg % NXCD, xcd = wgid % NXCD, off = wgid / NXCD; wgid = (xcd < rr ? xcd * (q + 1) : rr * (q + 1) + (xcd - rr) * q) + off; }
        const int nig = wgm * nN, gid = wgid / nig, fm = gid * wgm, gsz = (nM - fm) < wgm ? (nM - fm) : wgm;
        u.pm = fm + ((wgid % nig) % gsz); u.pn = (wgid % nig) / gsz; return true;
    }
};

template <class Prob, class Epi>
__device__ __forceinline__ void gemm_phase(LAS unsigned char* lds, const Prob& S, const Epi& E, int wv) {
    int tz; asm volatile("v_mbcnt_lo_u32_b32 %0, -1, 0\n\tv_mbcnt_hi_u32_b32 %0, -1, %0" : "=v"(tz)); tz += wv * 64;
    const int tid = tz, wid = __builtin_amdgcn_readfirstlane(tid >> 6), lane = tid & 63, wr = wid >> 2, wc = wid & 3, fr = lane & 15, fq = lane >> 4;
    constexpr int K = Prob::K, nt = K / BK;
    int Rr[2], Cc[2];
    unsigned voffB[2];
#pragma unroll
    for (int i = 0; i < 2; ++i) { stage_rc(tid * 16 + i * 8192, Rr[i], Cc[i]); voffB[i] = (unsigned)(Rr[i] * Prob::LDB + Cc[i]) * 2u; }
    const size_t kstep = (size_t)(BK * 2);
    const size_t hstepB = (size_t)HALF * Prob::LDB * 2;
    const unsigned ldsw = (unsigned)wid * 1024u;
    const int aoff = lds_byte(wr * 64 + fr, fq * 8), boff = lds_byte(wc * 32 + fr, fq * 8);
#define G8_SA(b, h) (((b) * 2 + (h)) * HTB)
#define G8_SB(b, h) ((4 + (b) * 2 + (h)) * HTB)
#define G8_STAGE(bufoff, gbase, voff) do { _Pragma("unroll") for (int _i = 0; _i < 2; ++_i) \
        __builtin_amdgcn_global_load_lds((const unsigned*)((const char*)(gbase) + (voff)[_i]), (LAS unsigned*)(lds + (bufoff) + ldsw + _i * 8192), 16, 0, 0); } while (0)
#define G8_LDA(dst, b, h) do { _Pragma("unroll") for (int m = 0; m < 4; ++m) _Pragma("unroll") for (int k = 0; k < 2; ++k) dst[m][k] = *(const LAS bf16x8*)(lds + G8_SA(b, h) + aoff + m * 2048 + k * 1024); } while (0)
#define G8_LDB(dst, b, h) do { _Pragma("unroll") for (int n = 0; n < 2; ++n) _Pragma("unroll") for (int k = 0; k < 2; ++k) dst[n][k] = *(const LAS bf16x8*)(lds + G8_SB(b, h) + boff + n * 2048 + k * 1024); } while (0)
#define G8_MMA(ai, bj, At, Bt) do { __builtin_amdgcn_s_setprio(1); _Pragma("unroll") for (int m = 0; m < 4; ++m) _Pragma("unroll") for (int n = 0; n < 2; ++n) _Pragma("unroll") for (int k = 0; k < 2; ++k) \
        acc[ai][bj][m][n] = __builtin_amdgcn_mfma_f32_16x16x32_bf16(Bt[n][k], At[m][k], acc[ai][bj][m][n], 0, 0, 0); __builtin_amdgcn_s_setprio(0); } while (0)
#define G8_WAIT_V(n) asm volatile("s_waitcnt vmcnt(" #n ")" ::: "memory")
#define G8_WAIT_L(n) asm volatile("s_waitcnt lgkmcnt(" #n ")" ::: "memory")
#define G8_BAR __builtin_amdgcn_s_barrier()
#define G8_SCHED __builtin_amdgcn_sched_barrier(0)
#define G8_AOFFS(dst, u) do { _Pragma("unroll") for (int _h = 0; _h < 2; ++_h) _Pragma("unroll") for (int _i = 0; _i < 2; ++_i) dst[_h][_i] = S.a_off(u, _h * HALF + Rr[_i]) + (unsigned)Cc[_i] * 2u; } while (0)
    S.prep(tid);
    Unit cur, nxt; int ui = 0;
    if (!S.next(0, cur)) return;
    f32x4 acc[2][2][4][2];
#pragma unroll
    for (int a = 0; a < 2; ++a)
#pragma unroll
        for (int b = 0; b < 2; ++b)
#pragma unroll
            for (int m = 0; m < 4; ++m)
#pragma unroll
                for (int n = 0; n < 2; ++n) acc[a][b][m][n] = (f32x4){0.f, 0.f, 0.f, 0.f};
    bf16x8 At[4][2], B0[2][2], B1[2][2];
    unsigned vA[2][2], nvA[2][2];
    const char* cA = S.a_base(cur); const char* cB = S.b_base(cur) + (cur.half > 0 ? hstepB : 0);
    size_t h2c = cur.half >= 0 ? 0 : hstepB;
    G8_AOFFS(vA, cur);
    S.unit_begin(cur, wid, lane);
    G8_STAGE(G8_SB(0, 0), cB, voffB); G8_STAGE(G8_SA(0, 0), cA, vA[0]); G8_STAGE(G8_SB(0, 1), cB + h2c, voffB); G8_STAGE(G8_SA(0, 1), cA, vA[1]);
    if (wr == 1) G8_BAR;
    G8_WAIT_V(4); G8_BAR;
    G8_STAGE(G8_SB(1, 0), cB + kstep, voffB); G8_STAGE(G8_SA(1, 0), cA + kstep, vA[0]); G8_STAGE(G8_SB(1, 1), cB + h2c + kstep, voffB);
    G8_WAIT_V(6); G8_BAR;
    for (;;) {
        const bool has_next = S.next(ui + 1, nxt);
        const char* nA = has_next ? S.a_base(nxt) : cA; const char* nB = has_next ? S.b_base(nxt) + (nxt.half > 0 ? hstepB : 0) : cB;
        const size_t h2n = has_next ? (nxt.half >= 0 ? 0 : hstepB) : h2c;
        const bool chalf = cur.half >= 0;
        if (has_next) { G8_AOFFS(nvA, nxt); } else {
#pragma unroll
            for (int _h = 0; _h < 2; ++_h)
#pragma unroll
                for (int _i = 0; _i < 2; ++_i) nvA[_h][_i] = vA[_h][_i]; }
#pragma unroll 1
        for (int t = 0; t < nt; t += 2) {
            const bool last = (t == nt - 2);
            const char* a1 = cA + (size_t)(t + 1) * kstep;
            const char* a2 = last ? nA : cA + (size_t)(t + 2) * kstep; const char* b2 = last ? nB : cB + (size_t)(t + 2) * kstep;
            const char* a3 = a2 + kstep; const char* b3 = b2 + kstep; const size_t hs2 = last ? h2n : h2c;
            unsigned w0[2], w1[2];
#pragma unroll
            for (int _i = 0; _i < 2; ++_i) { w0[_i] = last ? nvA[0][_i] : vA[0][_i]; w1[_i] = last ? nvA[1][_i] : vA[1][_i]; }
            G8_LDB(B0, 0, 0); G8_SCHED; G8_LDA(At, 0, 0); G8_STAGE(G8_SA(1, 1), a1, vA[1]);
            G8_WAIT_L(8); G8_BAR; G8_WAIT_L(0); G8_MMA(0, 0, At, B0); G8_BAR; G8_SCHED;
            if (!chalf) { G8_LDB(B1, 0, 1); } G8_STAGE(G8_SB(0, 0), b2, voffB);
            G8_BAR; G8_WAIT_L(0); if (!chalf) { G8_MMA(0, 1, At, B1); } G8_BAR;
            G8_LDA(At, 0, 1); G8_STAGE(G8_SA(0, 0), a2, w0);
            G8_BAR; G8_WAIT_L(0); G8_MMA(1, 0, At, B0); G8_BAR; G8_SCHED;
            G8_STAGE(G8_SB(0, 1), b2 + hs2, voffB);
            G8_WAIT_V(6); G8_BAR; if (!chalf) { G8_MMA(1, 1, At, B1); } G8_BAR;
            G8_LDB(B0, 1, 0); G8_SCHED; G8_LDA(At, 1, 0); G8_STAGE(G8_SA(0, 1), a2, w1);
            G8_WAIT_L(8); G8_BAR; G8_WAIT_L(0); G8_MMA(0, 0, At, B0); G8_BAR; G8_SCHED;
            if (!chalf) { G8_LDB(B1, 1, 1); } G8_STAGE(G8_SB(1, 0), b3, voffB);
            G8_BAR; G8_WAIT_L(0); if (!chalf) { G8_MMA(0, 1, At, B1); } G8_BAR;
            G8_LDA(At, 1, 1); G8_STAGE(G8_SA(1, 0), a3, w0);
            G8_BAR; G8_WAIT_L(0); G8_MMA(1, 0, At, B0); G8_BAR; G8_SCHED;
            G8_STAGE(G8_SB(1, 1), b3 + hs2, voffB);
            G8_WAIT_V(6); G8_BAR; if (!chalf) { G8_MMA(1, 1, At, B1); } G8_BAR;
        }
        if (wr == 0) G8_BAR;
        E(acc, cur, wr, wc, fr, fq);
        if (!has_next) break;
#pragma unroll
        for (int a = 0; a < 2; ++a)
#pragma unroll
            for (int b = 0; b < 2; ++b)
#pragma unroll
                for (int m = 0; m < 4; ++m)
#pragma unroll
                    for (int n = 0; n < 2; ++n) acc[a][b][m][n] = (f32x4){0.f, 0.f, 0.f, 0.f};
        cur = nxt; cA = nA; cB = nB; h2c = h2n; ++ui;
        S.unit_begin(cur, wid, lane);
#pragma unroll
        for (int _h = 0; _h < 2; ++_h)
#pragma unroll
            for (int _i = 0; _i < 2; ++_i) vA[_h][_i] = nvA[_h][_i];
        if (wr == 1) G8_BAR;
    }
    G8_WAIT_V(0);
    G8_BAR;
#undef G8_SA
#undef G8_SB
#undef G8_STAGE
#undef G8_LDA
#undef G8_LDB
#undef G8_MMA
#undef G8_WAIT_V
#undef G8_WAIT_L
#undef G8_BAR
#undef G8_SCHED
#undef G8_AOFFS
}

template <class F> struct EpiQuad {
    F f;
    __device__ __forceinline__ void operator()(const f32x4 (&acc)[2][2][4][2], const Unit& u, int wr, int wc, int fr, int fq) const {
#pragma unroll
        for (int ai = 0; ai < 2; ++ai)
#pragma unroll
            for (int m = 0; m < 4; ++m) { const int row = u.pm * BM + ai * HALF + wr * 64 + m * 16 + fr;
#pragma unroll
                for (int bj = 0; bj < 2; ++bj) { if (u.half >= 0 && bj == 1) continue;
#pragma unroll
                    for (int n = 0; n < 2; ++n) f(u, row, u.pn * BM + (u.half >= 0 ? u.half : bj) * HALF + wc * 32 + n * 16 + 4 * fq, acc[ai][bj][m][n]); } }
    }
};
template <class F> struct EpiPair {
    F f;
    __device__ __forceinline__ void operator()(const f32x4 (&acc)[2][2][4][2], const Unit& u, int wr, int wc, int fr, int fq) const {
#pragma unroll
        for (int ai = 0; ai < 2; ++ai)
#pragma unroll
            for (int m = 0; m < 4; ++m) { const int row = u.pm * BM + ai * HALF + wr * 64 + m * 16 + fr;
#pragma unroll
                for (int bj = 0; bj < 2; ++bj) { if (u.half >= 0 && bj == 1) continue;
                    f(u, row, u.pn * BM + (u.half >= 0 ? u.half : bj) * HALF + wc * 32, fq, wr * 4 + wc, acc[ai][bj][m][0], acc[ai][bj][m][1]); } }
    }
};
}
using g8::Unit; using g8::f32x4;
template <int K_> struct ProbPlain : g8::Order {
    static constexpr int K = K_, LDB = K_;
    const char* A; const char* Bt; long lda;
    __device__ __forceinline__ void prep(int) const {}
    __device__ __forceinline__ void unit_begin(const Unit&, int, int) const {}
    __device__ __forceinline__ const char* a_base(const Unit& u) const { return A + (size_t)u.pm * 256 * lda; }
    __device__ __forceinline__ unsigned a_off(const Unit&, int row) const { return (unsigned)(row * lda); }
    __device__ __forceinline__ const char* b_base(const Unit& u) const { return Bt + (size_t)u.pn * 256 * K * 2; }
};
constexpr int MX_TE = 0, MX_AOFF = 2240, MX_BIAS = MX_AOFF + 18 * 1024, MX_END = MX_BIAS + 2048;
template <int K_, bool GATHER> struct ProbMoe : g8::Order {
    static constexpr int K = K_, LDB = K_;
    const char* A; const char* Bt; const int* tok; const int* tile_e; const float* bias; size_t estride; int nbias; LAS unsigned char* xl;
    __device__ __forceinline__ void prep(int tid) const {
        LAS int* te = (LAS int*)(xl + MX_TE);
        for (int i = tid; i < nM; i += NTHR) te[i] = tile_e[i];
        if (GATHER) { LAS unsigned* ao = (LAS unsigned*)(xl + MX_AOFF); int tv[18];
#pragma unroll
            for (int i = 0; i < 18; ++i) { Unit u; tv[i] = -1; if (tid < 256 && next(i, u)) tv[i] = tok[u.pm * 256 + tid]; }
#pragma unroll
            for (int i = 0; i < 18; ++i) if (tid < 256) ao[i * 256 + tid] = tv[i] >= 0 ? (unsigned)tv[i] * (K * 2) : 0u; }
        __syncthreads();
    }
    __device__ __forceinline__ int expert(const Unit& u) const { return __builtin_amdgcn_readfirstlane(((LAS int*)(xl + MX_TE))[u.pm]); }
    __device__ __forceinline__ void unit_begin(const Unit& u, int wid, int lane) const {
        if (wid == 0) __builtin_amdgcn_global_load_lds((const unsigned*)(bias + (size_t)expert(u) * nbias + u.pn * 256 + lane * 4), (LAS unsigned*)(xl + MX_BIAS + (u.ord & 1) * 1024), 16, 0, 0);
    }
    __device__ __forceinline__ const char* a_base(const Unit& u) const { return GATHER ? A : A + (size_t)u.pm * 256 * K * 2; }
    __device__ __forceinline__ unsigned a_off(const Unit& u, int row) const { if (GATHER) return ((LAS unsigned*)(xl + MX_AOFF))[u.ord * 256 + row]; return (unsigned)(row * K * 2); }
    __device__ __forceinline__ const char* b_base(const Unit& u) const { return Bt + (size_t)expert(u) * estride + (size_t)u.pn * 256 * K * 2; }
};
struct ProbCmp : g8::Order {
    static constexpr int K = 512, LDB = 2048;
    const char* csrc; const char* W1t;
    __device__ __forceinline__ void prep(int) const {}
    __device__ __forceinline__ void unit_begin(const Unit&, int, int) const {}
    __device__ __forceinline__ const char* a_base(const Unit& u) const { return csrc + (size_t)(u.pm >> 2) * SEQ * 64 * 2 + (u.pm & 3) * 1024; }
    __device__ __forceinline__ unsigned a_off(const Unit&, int row) const { return (unsigned)(row * 2048); }
    __device__ __forceinline__ const char* b_base(const Unit& u) const { return W1t + (size_t)(u.pm >> 7) * 256 * 2048 * 2 + (u.pm & 3) * 1024; }
};
typedef unsigned au32x2_ __attribute__((ext_vector_type(2)));
__device__ __forceinline__ uint2 pk4(const f32x4& v) { return make_uint2(pack_bf16(v[0], v[1]), pack_bf16(v[2], v[3])); }
__device__ __forceinline__ void st_pair16(unsigned short* grp, int fq, uint2 qa, uint2 qb) {
    const auto rx = __builtin_amdgcn_permlane16_swap(qa.x, qb.x, false, false);
    const auto ry = __builtin_amdgcn_permlane16_swap(qa.y, qb.y, false, false);
    *(uint4*)(grp + ((fq & 1) ? 16 + 4 * (fq - 1) : 4 * fq)) = make_uint4(rx[0], ry[0], rx[1], ry[1]);
}
struct QStoreF32 { float* C; long ldc; int N; __device__ __forceinline__ void operator()(const Unit&, int row, int col, const f32x4& v) const { if (col < N) *(f32x4*)(C + (size_t)row * ldc + col) = v; } };
template <bool INF32> struct EpiResid {
    const void* Xin; unsigned short* Xout; const float* gate; long ldg;
    __device__ __forceinline__ void operator()(const f32x4 (&acc)[2][2][4][2], const Unit& u, int wr, int wc, int fr, int fq) const {
        const int row0 = u.pm * 256 + wr * 64 + fr, col0 = u.pn * 256 + wc * 32 + 4 * fq, b = (u.pm * 256) / SEQ;
        if (u.half >= 0) {
#pragma unroll
            for (int ai = 0; ai < 2; ++ai)
#pragma unroll
                for (int m = 0; m < 4; ++m)
#pragma unroll
                    for (int n = 0; n < 2; ++n) { const size_t o_ = (size_t)(row0 + ai * 128 + m * 16) * DM + col0 + u.half * 128 + n * 16;
                        const f32x4 g4 = *(const f32x4*)(gate + b * ldg + col0 + u.half * 128 + n * 16); f32x4 xv;
                        if (INF32) xv = *(const f32x4*)((const float*)Xin + o_);
                        else { const uint2 q = *(const uint2*)((const unsigned short*)Xin + o_); xv = (f32x4){__uint_as_float(q.x << 16), __uint_as_float(q.x & 0xffff0000u), __uint_as_float(q.y << 16), __uint_as_float(q.y & 0xffff0000u)}; }
                        const f32x4 o = xv + g4 * acc[ai][0][m][n]; *(uint2*)(Xout + o_) = make_uint2(pack_bf16(o[0], o[1]), pack_bf16(o[2], o[3])); }
            return;
        }
        f32x4 gv[2][2];
#pragma unroll
        for (int bj = 0; bj < 2; ++bj)
#pragma unroll
            for (int n = 0; n < 2; ++n) gv[bj][n] = *(const f32x4*)(gate + b * ldg + col0 + bj * 128 + n * 16);
#pragma unroll
        for (int ai = 0; ai < 2; ++ai) {
            if (INF32) {
#pragma unroll
                for (int bj = 0; bj < 2; ++bj) {
                    f32x4 xv[4][2];
#pragma unroll
                    for (int m = 0; m < 4; ++m)
#pragma unroll
                        for (int n = 0; n < 2; ++n) xv[m][n] = *(const f32x4*)((const float*)Xin + (size_t)(row0 + ai * 128 + m * 16) * DM + col0 + bj * 128 + n * 16);
                    __builtin_amdgcn_sched_barrier(0);
#pragma unroll
                    for (int m = 0; m < 4; ++m)
                        { const f32x4 o0 = xv[m][0] + gv[bj][0] * acc[ai][bj][m][0], o1 = xv[m][1] + gv[bj][1] * acc[ai][bj][m][1];
                          st_pair16(Xout + (size_t)(row0 + ai * 128 + m * 16) * DM + u.pn * 256 + wc * 32 + bj * 128, fq, pk4(o0), pk4(o1)); }
                }
            } else {
                uint2 xu[4][2][2];
#pragma unroll
                for (int m = 0; m < 4; ++m)
#pragma unroll
                    for (int bj = 0; bj < 2; ++bj)
#pragma unroll
                        for (int n = 0; n < 2; ++n) xu[m][bj][n] = *(const uint2*)((const unsigned short*)Xin + (size_t)(row0 + ai * 128 + m * 16) * DM + col0 + bj * 128 + n * 16);
                __builtin_amdgcn_sched_barrier(0);
#pragma unroll
                for (int m = 0; m < 4; ++m)
#pragma unroll
                    for (int bj = 0; bj < 2; ++bj) { f32x4 o2[2];
#pragma unroll
                        for (int n = 0; n < 2; ++n) { const uint2 q = xu[m][bj][n];
                            const f32x4 xv = (f32x4){__uint_as_float(q.x << 16), __uint_as_float(q.x & 0xffff0000u), __uint_as_float(q.y << 16), __uint_as_float(q.y & 0xffff0000u)};
                            o2[n] = xv + gv[bj][n] * acc[ai][bj][m][n]; }
                        st_pair16(Xout + (size_t)(row0 + ai * 128 + m * 16) * DM + u.pn * 256 + wc * 32 + bj * 128, fq, pk4(o2[0]), pk4(o2[1])); }
            }
        }
    }
};
struct QNsaIn { float* qn; float* gates; const float* bg; __device__ __forceinline__ void operator()(const Unit&, int row, int col, const f32x4& v) const {
    if (col < 1024) *(f32x4*)(qn + (size_t)row * 1024 + col) = v * 0.125f;
    else if (col < NSA_IN) { const int c = col - 1024; f32x4 o; for (int j = 0; j < 4; ++j) o[j] = sigm(v[j] + bg[c + j]); *(f32x4*)(gates + (size_t)row * 48 + c) = o; } } };
struct QNsaIn2 { unsigned short* qb; float* gates; const float* bg; __device__ __forceinline__ void operator()(const Unit&, int row, int col, const f32x4& v) const {
    if (col < 1024) { const float sc = 0.125f * 1.4426950408889634f; *(uint2*)(qb + (size_t)row * 1024 + col) = make_uint2(pack_bf16(v[0] * sc, v[1] * sc), pack_bf16(v[2] * sc, v[3] * sc)); }
    else if (col < NSA_IN) { const int c = col - 1024; f32x4 o; for (int j = 0; j < 4; ++j) o[j] = sigm(v[j] + bg[c + j]); *(f32x4*)(gates + (size_t)row * 48 + c) = o; } } };
struct QKv2 { unsigned short *csrc, *kslc, *vslcT, *kwin, *vwinT; __device__ __forceinline__ void operator()(const Unit&, int row, int col, const f32x4& v) const {
    const int j = col >> 8, g = (col >> 6) & 3, d = col & 63, b = row / SEQ, s = row % SEQ, bg = b * 4 + g;
    if (j < 2) *(uint2*)(csrc + ((size_t)((j * 32 + bg) * SEQ + s)) * 64 + d) = make_uint2(pack_bf16(v[0], v[1]), pack_bf16(v[2], v[3]));
    else if (j == 2 || j == 4) *(uint2*)((j == 2 ? kslc : kwin) + ((size_t)bg * SEQ + s) * 64 + d) = make_uint2(pack_bf16(v[0], v[1]), pack_bf16(v[2], v[3]));
    else { const int sp = (s & ~15) | (((s >> 2) & 1) << 3) | (((s >> 3) & 1) << 2) | (s & 3);
        unsigned short* vt = (j == 3 ? vslcT : vwinT) + ((size_t)bg * 64 + d) * SEQ + sp;
#pragma unroll
        for (int i = 0; i < 4; ++i) vt[(size_t)i * SEQ] = f2bf(v[i]); } } };
struct QGlaIn { unsigned short *qk, *vT, *rb; float* glr; __device__ __forceinline__ void operator()(const Unit&, int row, int col, const f32x4& v) const {
    if (col < 1024) *(uint2*)(qk + (size_t)row * 1024 + col) = make_uint2(pack_bf16(v[0], v[1]), pack_bf16(v[2], v[3]));
    else if (col < 2048) { const int ce = col - 1024, b = row / SEQ, s = row % SEQ; unsigned short* vt = vT + ((size_t)(b * 4 + (ce >> 8)) * 256 + (ce & 255)) * SEQ + s;
#pragma unroll
        for (int i = 0; i < 4; ++i) vt[(size_t)i * SEQ] = f2bf(v[i]); }
    else if (col < 3072) *(uint2*)(rb + (size_t)row * 1024 + (col - 2048)) = make_uint2(pack_bf16(v[0], v[1]), pack_bf16(v[2], v[3]));
    else if (col < GLA_IN) *(f32x4*)(glr + (size_t)row * 16 + (col - 3072)) = v; } };
__device__ __forceinline__ float fast_sigm(float x) { return __builtin_amdgcn_rcpf(1.f + __builtin_amdgcn_exp2f(-1.4426950408889634f * x)); }
typedef float f32x2_ __attribute__((ext_vector_type(2)));
template <bool PERMK>
__device__ __forceinline__ void st_vT_tile(LAS unsigned char* T, unsigned short* vt_col0, int row, int fq, const f32x4& v0, const f32x4& v1) {
    const int fr = row & 15, lane16 = fr, g = fq;
    *(LAS au32x2_*)(T + fr * 64 + fq * 8) = (au32x2_){pack_bf16(v0[0], v0[1]), pack_bf16(v0[2], v0[3])};
    *(LAS au32x2_*)(T + fr * 64 + 32 + fq * 8) = (au32x2_){pack_bf16(v1[0], v1[1]), pack_bf16(v1[2], v1[3])};
    const int colblk = g & 1, th = g >> 1, j = lane16 >> 2, q = lane16 & 3;
    const int t0 = PERMK ? 4 * th : 8 * th, t1 = PERMK ? 8 + 4 * th : 8 * th + 4;
    LAS unsigned char* a0 = T + (t0 + j) * 64 + colblk * 32 + q * 8;
    LAS unsigned char* a1 = T + (t1 + j) * 64 + colblk * 32 + q * 8;
    au32x2_ r0, r1;
    asm volatile("s_waitcnt lgkmcnt(0)\n\tds_read_b64_tr_b16 %0, %2\n\tds_read_b64_tr_b16 %1, %3\n\ts_waitcnt lgkmcnt(0)" : "=&v"(r0), "=&v"(r1) : "v"(a0), "v"(a1) : "memory");
    *(uint4*)(vt_col0 + (size_t)(colblk * 16 + lane16) * SEQ + 8 * th) = make_uint4(r0.x, r0.y, r1.x, r1.y);
}
struct PGlaIn { unsigned short *qk, *vT, *rb; float* glr; LAS unsigned char* tl; __device__ __forceinline__ void operator()(const Unit&, int row, int gb, int fq, int wv, const f32x4& v0, const f32x4& v1) const {
    if (gb < 1024) st_pair16(qk + (size_t)row * 1024 + gb, fq, pk4(v0), pk4(v1));
    else if (gb < 2048) { const int b = row / SEQ, s = row % SEQ;
#pragma unroll
        for (int n = 0; n < 2; ++n) { const int ce = gb - 1024 + n * 16 + 4 * fq; unsigned short* vt = vT + ((size_t)(b * 4 + (ce >> 8)) * 256 + (ce & 255)) * SEQ + s; const f32x4& v = n ? v1 : v0;
#pragma unroll
            for (int i = 0; i < 4; ++i) vt[(size_t)i * SEQ] = f2bf(v[i]); } }
    else if (gb < 3072) st_pair16(rb + (size_t)row * 1024 + (gb - 2048), fq, pk4(v0), pk4(v1));
    else if (gb == 3072) *(f32x4*)(glr + (size_t)row * 16 + 4 * fq) = v0; } };
struct PNsaIn { unsigned short* qb; float* gates; const float* bg; __device__ __forceinline__ void operator()(const Unit&, int row, int gb, int fq, int, const f32x4& v0, const f32x4& v1) const {
    if (gb < 1024) { const float sc = 0.125f * 1.4426950408889634f; st_pair16(qb + (size_t)row * 1024 + gb, fq, pk4(v0 * sc), pk4(v1 * sc)); }
    else {
#pragma unroll
        for (int n = 0; n < 2; ++n) { const int c = gb - 1024 + n * 16 + 4 * fq; if (c < 48) { const f32x4& v = n ? v1 : v0; f32x4 o; for (int j = 0; j < 4; ++j) o[j] = sigm(v[j] + bg[c + j]); *(f32x4*)(gates + (size_t)row * 48 + c) = o; } } } } };
struct PKv { unsigned short *csrc, *kslc, *vslcT, *kwin, *vwinT; LAS unsigned char* tl; __device__ __forceinline__ void operator()(const Unit&, int row, int gb, int fq, int wv, const f32x4& v0, const f32x4& v1) const {
    const int j = gb >> 8, g = (gb >> 6) & 3, d0 = gb & 63, b = row / SEQ, s = row % SEQ, bg = b * 4 + g;
    if (j < 2) st_pair16(csrc + ((size_t)((j * 32 + bg) * SEQ + s)) * 64 + d0, fq, pk4(v0), pk4(v1));
    else if (j == 2 || j == 4) st_pair16((j == 2 ? kslc : kwin) + ((size_t)bg * SEQ + s) * 64 + d0, fq, pk4(v0), pk4(v1));
    else { const int sp = (s & ~15) | (((s >> 2) & 1) << 3) | (((s >> 3) & 1) << 2) | (s & 3);
#pragma unroll
        for (int n = 0; n < 2; ++n) { unsigned short* vt = (j == 3 ? vslcT : vwinT) + ((size_t)bg * 64 + d0 + n * 16 + 4 * fq) * SEQ + sp; const f32x4& v = n ? v1 : v0;
#pragma unroll
            for (int i = 0; i < 4; ++i) vt[(size_t)i * SEQ] = f2bf(v[i]); } } } };
struct QSwiglu { unsigned short* act; LAS unsigned char* xl; __device__ __forceinline__ void operator()(const Unit& u, int row, int col, const f32x4& v) const {
    const f32x4 bv = *(const LAS f32x4*)(xl + MX_BIAS + (u.ord & 1) * 1024 + (col - u.pn * 256) * 4);
    f32x2_ G = (f32x2_){v[0], v[2]} + (f32x2_){bv[0], bv[2]}, U = (f32x2_){v[1], v[3]} + (f32x2_){bv[1], bv[3]};
    G.x = fminf(G.x, 7.f); G.y = fminf(G.y, 7.f);
    U.x = __builtin_amdgcn_fmed3f(U.x, -7.f, 7.f); U.y = __builtin_amdgcn_fmed3f(U.y, -7.f, 7.f);
    f32x2_ E = G * (-1.702f * 1.4426950408889634f); E.x = __builtin_amdgcn_exp2f(E.x); E.y = __builtin_amdgcn_exp2f(E.y);
    f32x2_ S = E + 1.0f; S.x = __builtin_amdgcn_rcpf(S.x); S.y = __builtin_amdgcn_rcpf(S.y);
    const f32x2_ R = ((U + 1.0f) * G) * S;
    *(unsigned*)(act + (size_t)row * 1024 + (col >> 1)) = pack_bf16(R.x, R.y); } };
struct QDownF { float* y; const float* bd; const int* tile_e; __device__ __forceinline__ void operator()(const Unit& u, int row, int col, const f32x4& v) const {
    const int e = tile_e[u.pm]; *(f32x4*)(y + (size_t)row * 1024 + col) = v + *(const f32x4*)(bd + e * 1024 + col); } };
struct EpiSwiglu { unsigned short* act; LAS unsigned char* xl;
    __device__ __forceinline__ void operator()(const f32x4 (&acc)[2][2][4][2], const Unit& u, int wr, int wc, int fr, int fq) const {
        const int row0 = u.pm * 256 + wr * 64 + fr, cl0 = wc * 32 + 4 * fq;
        f32x4 bv[2][2];
#pragma unroll
        for (int bj = 0; bj < 2; ++bj)
#pragma unroll
            for (int n = 0; n < 2; ++n) bv[bj][n] = *(const LAS f32x4*)(xl + MX_BIAS + (u.ord & 1) * 1024 + (cl0 + bj * 128 + n * 16) * 4);
#pragma unroll
        for (int ai = 0; ai < 2; ++ai)
#pragma unroll
            for (int mp = 0; mp < 2; ++mp) {
                f32x2_ G[8], U[8], E[8];
#pragma unroll
                for (int q = 0; q < 8; ++q) { const int m = mp * 2 + (q >> 2), bj = (q >> 1) & 1, n = q & 1; const f32x4 v = acc[ai][bj][m][n]; const f32x4 b4 = bv[bj][n];
                    G[q] = (f32x2_){v[0], v[2]} + (f32x2_){b4[0], b4[2]}; U[q] = (f32x2_){v[1], v[3]} + (f32x2_){b4[1], b4[3]}; }
#pragma unroll
                for (int q = 0; q < 8; ++q) { G[q].x = fminf(G[q].x, 7.f); G[q].y = fminf(G[q].y, 7.f); U[q].x = __builtin_amdgcn_fmed3f(U[q].x, -7.f, 7.f); U[q].y = __builtin_amdgcn_fmed3f(U[q].y, -7.f, 7.f);
                    E[q] = G[q] * (-1.702f * 1.4426950408889634f); }
#pragma unroll
                for (int q = 0; q < 8; ++q) { E[q].x = __builtin_amdgcn_exp2f(E[q].x); E[q].y = __builtin_amdgcn_exp2f(E[q].y); }
#pragma unroll
                for (int q = 0; q < 8; ++q) { E[q] = E[q] + 1.0f; U[q] = (U[q] + 1.0f) * G[q]; }
#pragma unroll
                for (int q = 0; q < 8; ++q) { E[q].x = __builtin_amdgcn_rcpf(E[q].x); E[q].y = __builtin_amdgcn_rcpf(E[q].y); }
#pragma unroll
                for (int mm = 0; mm < 2; ++mm) { const int m = mp * 2 + mm; unsigned pk[4];
#pragma unroll
                    for (int q4 = 0; q4 < 4; ++q4) { const f32x2_ R = U[mm * 4 + q4] * E[mm * 4 + q4]; pk[q4] = pack_bf16(R.x, R.y); }
                    *(uint4*)(act + (size_t)(row0 + ai * 128 + m * 16) * 1024 + u.pn * 128 + wc * 32 + fq * 8) = make_uint4(pk[0], pk[1], pk[2], pk[3]); }
            }
    }
};
struct EpiDown { unsigned short* y; LAS unsigned char* xl;
    __device__ __forceinline__ void operator()(const f32x4 (&acc)[2][2][4][2], const Unit& u, int wr, int wc, int fr, int fq) const {
        const int hb_ = u.half >= 0 ? u.half : 0; const int nbj = u.half >= 0 ? 1 : 2;
        const int row0 = u.pm * 256 + wr * 64 + fr, cl0 = wc * 32 + 4 * fq;
        f32x4 bv[2][2];
#pragma unroll
        for (int bj = 0; bj < 2; ++bj)
#pragma unroll
            for (int n = 0; n < 2; ++n) bv[bj][n] = *(const LAS f32x4*)(xl + MX_BIAS + (u.ord & 1) * 1024 + (cl0 + (bj + hb_ < 2 ? bj + hb_ : 1) * 128 + n * 16) * 4);
#pragma unroll
        for (int ai = 0; ai < 2; ++ai)
#pragma unroll
            for (int m = 0; m < 4; ++m) {
                unsigned short* rowp = y + (size_t)(row0 + ai * 128 + m * 16) * 1024 + u.pn * 256 + wc * 32;
#pragma unroll
                for (int bj = 0; bj < 2; ++bj) { if (bj >= nbj) continue;
                    const f32x4 o0 = acc[ai][bj][m][0] + bv[bj][0], o1 = acc[ai][bj][m][1] + bv[bj][1];
                    st_pair16(rowp + (bj + hb_) * 128, fq, make_uint2(pack_bf16(o0[0], o0[1]), pack_bf16(o0[2], o0[3])), make_uint2(pack_bf16(o1[0], o1[1]), pack_bf16(o1[2], o1[3]))); }
            }
    }
};
struct QKv { float* kv6; unsigned short* csrc; __device__ __forceinline__ void operator()(const Unit&, int row, int col, const f32x4& v) const {
    *(f32x4*)(kv6 + (size_t)row * KV_OUT + col) = v;
    if (col < 512) { const int t = col >> 8, g = (col >> 6) & 3, d = col & 63, b = row / SEQ, s = row % SEQ;
        *(uint2*)(csrc + ((size_t)((t * 32 + b * 4 + g) * SEQ + s)) * 64 + d) = make_uint2(pack_bf16(v[0], v[1]), pack_bf16(v[2], v[3])); } } };
struct QCmp1 { float* hidp; __device__ __forceinline__ void operator()(const Unit& u, int row, int col, const f32x4& v) const {
    const int z = u.pm >> 2, ks = u.pm & 3, n = row - u.pm * 256; if (col < 128 && n < NCMP) *(f32x4*)(hidp + (((size_t)ks * 64 + z) * NCMP + n) * 128 + col) = v; } };

struct P {
    const float *x_in, *c, *ada_w, *ada_b, *norm1_g, *norm2_g, *gla_w_in, *gla_w_gate2, *gla_b_gate, *gla_norm_g, *gla_w_out, *kv_norm_g, *kv_ada_w, *kv_ada_b,
        *kv_w, *cmp_pos, *cmp_w1, *cmp_b1, *cmp_w2, *cmp_b2, *nsa_w_in, *nsa_b_gate, *nsa_w_out, *router_w, *router_b, *moe_w_gu, *moe_b_gu, *moe_w_down, *moe_b_down, *final_g;
    float* out; unsigned* bar;
    float *mod, *kvmod, *hid, *gates, *topw, *c1, *glr, *gdl;
    unsigned short *x, *y, *hb, *ob, *act, *csrc, *qb, *kslc, *vslcT, *kwin, *vwinT, *kcmp, *vcmpT, *gqk, *gvT, *grb, *gqd, *gki, *gST, *gUT, *wt_gla_in, *wt_gla_out, *wt_kv, *wt_nsa_in, *wt_nsa_out, *wt_cmp1, *wt_gu, *wt_down;
    unsigned long long* sel; int *topi, *cnt, *cntb, *stok, *pos, *tile_e;
};
typedef const P __attribute__((address_space(4)))* KP;
constexpr int LDS_BAR_OFF = g8::STAGE_BYTES;
constexpr int LDS_X_OFF = g8::STAGE_BYTES + 64;
constexpr size_t kDynLds = LDS_X_OFF + MX_END;
__device__ __forceinline__ float* dyn_smem() { extern __shared__ __attribute__((aligned(16))) float smem_[]; return smem_; }
struct Ctx {
int nb_s;
int wv_s;
#define LAUNDER() int tid_; asm volatile("v_mbcnt_lo_u32_b32 %0, -1, 0\n\tv_mbcnt_hi_u32_b32 %0, -1, %0" : "=v"(tid_)); tid_ += wv_s * 64; const int bid_ = blockIdx.x; const int GTID = bid_ * NTHR + tid_; const int GSZ = nb_s * NTHR; (void)GTID; (void)GSZ;
#define SHX(v, o) __uint_as_float((unsigned)__builtin_amdgcn_ds_bpermute(((tid_ ^ (o)) & 63) << 2, (int)__float_as_uint(v)))

__device__ __forceinline__ void ph_mod(const float* c, const float* ada_w, const float* ada_b, const float* kv_ada_w, const float* kv_ada_b,
                                       float* mod, float* kvmod, float* smem) {
    LAUNDER();
    float (*cs)[1024] = (float (*)[1024])smem;
    float* red = smem + 8192;
    for (int i = tid_; i < 8192; i += NTHR) { float v = c[i]; cs[i >> 10][i & 1023] = siluf(v); }
    __syncthreads();
    const int ncol = 4 * 6144 + 2048, cl = tid_ & 127, kq = tid_ >> 7;
    for (int c0 = bid_ * 128; c0 < ncol; c0 += nb_s * 128) {
        const int col = c0 + cl;
        const float* w = nullptr; int ldw = 0; float* out = nullptr; int ldo = 0; const float* bias = nullptr;
        if (col < 4 * 6144) { int L = col / 6144, j = col % 6144; w = ada_w + (size_t)L * 1024 * 6144 + j; ldw = 6144; bias = ada_b + L * 6144 + j; out = mod + (size_t)L * 8 * 6144 + j; ldo = 6144; }
        else if (col < ncol) { int j = col - 4 * 6144; w = kv_ada_w + j; ldw = 2048; bias = kv_ada_b + j; out = kvmod + j; ldo = 2048; }
        float acc[8];
#pragma unroll
        for (int b = 0; b < 8; ++b) acc[b] = 0.f;
        if (w) {
#pragma unroll 4
            for (int k = kq * 256; k < kq * 256 + 256; ++k) { const float wv = w[(size_t)k * ldw];
#pragma unroll
                for (int b = 0; b < 8; ++b) acc[b] += cs[b][k] * wv; } }
#pragma unroll
        for (int b = 0; b < 8; ++b) red[(kq * 128 + cl) * 8 + b] = acc[b];
        __syncthreads();
        if (kq == 0 && w) { const float bv = *bias;
#pragma unroll
            for (int b = 0; b < 8; ++b) out[b * ldo] = red[cl * 8 + b] + red[(128 + cl) * 8 + b] + red[(256 + cl) * 8 + b] + red[(384 + cl) * 8 + b] + bv; }
        __syncthreads();
    }
}

__device__ __forceinline__ void ph_norm(const float* x, const float* g, const float* shift, const float* scale, float* out, unsigned short* outb, int ldmod) {
    LAUNDER();
    const int lane = tid_ & 63;
    float4 gg[4], vn[4];
#pragma unroll
    for (int j = 0; j < 4; ++j) { gg[j] = *(const float4*)(g + j * 256 + lane * 4); vn[j] = make_float4(0.f, 0.f, 0.f, 0.f); }
    if ((GTID >> 6) < NT) {
#pragma unroll
        for (int j = 0; j < 4; ++j) vn[j] = *(const float4*)(x + (size_t)(GTID >> 6) * DM + j * 256 + lane * 4); }
    for (int row = GTID >> 6; row < NT; row += GSZ >> 6) {
        const int b = row / SEQ;
        float4 v[4], sc[4], sh[4]; float ss = 0.f;
#pragma unroll
        for (int j = 0; j < 4; ++j) { v[j] = vn[j]; sc[j] = make_float4(0.f, 0.f, 0.f, 0.f); sh[j] = sc[j];
            if (shift) { sc[j] = *(const float4*)(scale + b * ldmod + j * 256 + lane * 4); sh[j] = *(const float4*)(shift + b * ldmod + j * 256 + lane * 4); } }
        { const int nr = row + (GSZ >> 6);
          if (nr < NT) {
#pragma unroll
              for (int j = 0; j < 4; ++j) vn[j] = *(const float4*)(x + (size_t)nr * DM + j * 256 + lane * 4); } }
#pragma unroll
        for (int j = 0; j < 4; ++j) ss += v[j].x * v[j].x + v[j].y * v[j].y + v[j].z * v[j].z + v[j].w * v[j].w;
        for (int o = 32; o > 0; o >>= 1) ss += SHX(ss, o);
        const float r = rsqrtf(ss * (1.f / DM) + 1e-5f);
#pragma unroll
        for (int j = 0; j < 4; ++j) { const int col = j * 256 + lane * 4;
            float4 y = make_float4(v[j].x * r * gg[j].x, v[j].y * r * gg[j].y, v[j].z * r * gg[j].z, v[j].w * r * gg[j].w);
            if (shift) { y.x = y.x * (1.f + sc[j].x) + sh[j].x; y.y = y.y * (1.f + sc[j].y) + sh[j].y; y.z = y.z * (1.f + sc[j].z) + sh[j].z; y.w = y.w * (1.f + sc[j].w) + sh[j].w; }
            if (out) *(float4*)(out + (size_t)row * DM + col) = y;
            if (outb) *(uint2*)(outb + (size_t)row * DM + col) = make_uint2(pack_bf16(y.x, y.y), pack_bf16(y.z, y.w)); }
    }
}

template <class AF, class BF, class EF>
__device__ __forceinline__ void ph_gemm(AF af, BF bf, EF ef, int M, int N, int K, int Z, float* smem) {
    LAUNDER();
    float (*As)[132] = (float (*)[132])smem;
    float (*Bs)[132] = (float (*)[132])(smem + 16 * 132);
    const int tm = (M + 127) / 128, tn = (N + 127) / 128, total = Z * tm * tn;
    const int tid = tid_, ty = tid >> 4, tx = tid & 15;
    for (int it = bid_; it < total; it += nb_s) {
        const int z = it / (tm * tn), rr = it % (tm * tn), m0 = (rr / tn) * 128, n0 = (rr % tn) * 128;
        if (!af.active(z, m0)) continue;
        float acc[4][8];
#pragma unroll
        for (int i = 0; i < 4; ++i)
#pragma unroll
            for (int j = 0; j < 8; ++j) acc[i][j] = 0.f;
#pragma unroll 1
        for (int k0 = 0; k0 < K; k0 += 16) {
            { const int r = tid >> 2, kk = (tid & 3) * 4, m = m0 + r;
#pragma unroll
              for (int j = 0; j < 4; ++j) As[kk + j][r] = (m < M) ? af(z, m, k0 + kk + j) : 0.f; }
            { const int kk = tid >> 5, cc = (tid & 31) * 4;
#pragma unroll
              for (int j = 0; j < 4; ++j) { const int n = n0 + cc + j; Bs[kk][cc + j] = (n < N) ? bf(z, m0, k0 + kk, n) : 0.f; } }
            __syncthreads();
#pragma unroll
            for (int kk = 0; kk < 16; ++kk) {
                float a[4], b[8];
#pragma unroll
                for (int i = 0; i < 4; ++i) a[i] = As[kk][ty * 4 + i];
#pragma unroll
                for (int j = 0; j < 8; ++j) b[j] = Bs[kk][tx * 8 + j];
#pragma unroll
                for (int i = 0; i < 4; ++i)
#pragma unroll
                    for (int j = 0; j < 8; ++j) acc[i][j] += a[i] * b[j];
            }
            __syncthreads();
        }
#pragma unroll
        for (int i = 0; i < 4; ++i) { const int m = m0 + ty * 4 + i; if (m < M) ef(z, m, m0, n0 + tx * 8, acc[i], N); }
    }
}

__device__ __forceinline__ void ph_gla_gate(const float* proj, const float* w2, const float* bg, float* loga) {
    LAUNDER();
    for (size_t i = GTID; i < (size_t)NT * 512; i += GSZ) {
        const int t = (int)(i >> 9), j = (int)(i & 511);
        float z = bg[j];
#pragma unroll
        for (int r = 0; r < 16; ++r) z += proj[(size_t)t * GLA_IN + 3072 + r] * w2[r * 512 + j];
        loga[i] = logsigmoidf(z) * (1.f / 16.f);
    }
}
__device__ __forceinline__ void ph_gla_rec(const float* proj, const float* loga, float* oraw, float* smem) {
    LAUNDER();
    if (bid_ >= 16) return;
    const int half = tid_ >> 8, e = tid_ & 255, item = bid_ * 2 + half;
    float* sq = smem + half * 384; float* sk = sq + 128; float* sa = sk + 128;
    const int b = item >> 2, h = item & 3;
    float st[128];
#pragma unroll
    for (int d = 0; d < 128; ++d) st[d] = 0.f;
    const float* pr = proj + (size_t)b * SEQ * GLA_IN + h * 128 + (e < 128 ? e : 512 + (e - 128));
    const float* pa = loga + (size_t)b * SEQ * 512 + h * 128 + (e & 127);
    const float* pv = proj + (size_t)b * SEQ * GLA_IN + 1024 + h * 256 + e;
    float* po = oraw + (size_t)b * SEQ * DM + h * 256 + e;
#pragma unroll 1
    for (int t = 0; t < SEQ; ++t) {
        if (e < 128) { sq[e] = *pr; sa[e] = expf(*pa); } else { sk[e - 128] = *pr; }
        const float v = *pv;
        __syncthreads();
        float o = 0.f;
#pragma unroll
        for (int d = 0; d < 128; ++d) { st[d] = st[d] * sa[d] + sk[d] * v; o += sq[d] * st[d]; }
        *po = o * 0.08838834764831845f;
        __syncthreads();
        pr += GLA_IN; pa += 512; pv += GLA_IN; po += DM;
    }
}
__device__ __forceinline__ void ph_gla_post(const float* oraw, const float* proj, const float* ng, unsigned short* ob) {
    LAUNDER();
    const int l = tid_ & 63;
    for (int it = GTID >> 6; it < NT * 4; it += GSZ >> 6) {
        const int row = it >> 2, h = it & 3;
        const float4 v = *(const float4*)(oraw + (size_t)row * DM + h * 256 + l * 4);
        float ss = v.x * v.x + v.y * v.y + v.z * v.z + v.w * v.w;
        for (int s = 32; s > 0; s >>= 1) ss += SHX(ss, s);
        const float r = rsqrtf(ss * (1.f / 256.f) + 1e-5f);
        float vv[4] = {v.x, v.y, v.z, v.w};
#pragma unroll
        for (int j = 0; j < 4; ++j) { const int col = h * 256 + l * 4 + j; const float rr = proj[(size_t)row * GLA_IN + 2048 + col];
            ob[(size_t)row * DM + col] = f2bf(vv[j] * r * ng[col] * siluf(rr)); }
    }
}

__device__ __forceinline__ void ph_nsa_cmp(const float* qn, const float* comp, float* pc, float* oc) {
    LAUNDER();
    for (int idx = GTID; idx < NT * 16; idx += GSZ) {
        const int bt = idx >> 4, hd = idx & 15, b = bt / SEQ, t = bt % SEQ, g = hd >> 2;
        const float slope = exp2f(-0.5f * (hd + 1));
        float q[64];
#pragma unroll
        for (int d = 0; d < 64; ++d) q[d] = qn[(size_t)bt * 1024 + hd * 64 + d];
        const int nv = t >= 31 ? min(NCMP, (t - 31) / 16 + 1) : 0;
        const float* kc = comp + (size_t)(0 * 32 + b * 4 + g) * NCMP * 64;
        const float* vc = comp + (size_t)(1 * 32 + b * 4 + g) * NCMP * 64;
        float* pr = pc + (size_t)idx * 256;
        float mx = -1e30f;
        for (int n = 0; n < nv; ++n) { float s = 0.f;
#pragma unroll
            for (int d = 0; d < 64; ++d) s += q[d] * kc[n * 64 + d];
            s -= slope * (float)(t - (16 * n + 31)); pr[n] = s; mx = fmaxf(mx, s); }
        float l = 0.f;
        for (int n = 0; n < nv; ++n) l += expf(pr[n] - mx);
        const float inv = nv > 0 ? 1.f / l : 0.f;
        float o[64];
#pragma unroll
        for (int d = 0; d < 64; ++d) o[d] = 0.f;
        for (int n = 0; n < nv; ++n) { const float p = expf(pr[n] - mx) * inv; pr[n] = p;
#pragma unroll
            for (int d = 0; d < 64; ++d) o[d] += p * vc[n * 64 + d]; }
        for (int n = nv; n < 256; ++n) pr[n] = 0.f;
#pragma unroll
        for (int d = 0; d < 64; ++d) oc[(size_t)idx * 64 + d] = o[d];
    }
}
__device__ __forceinline__ void ph_nsa_sel(const float* pc, unsigned long long* sel) {
    LAUNDER();
    const int j = tid_ & 63;
    for (int idx = GTID >> 6; idx < NT * 4; idx += GSZ >> 6) {
        const int bt = idx >> 2, g = idx & 3, t = bt % SEQ, cur = t >> 6;
        float imp = 0.f;
        for (int hp = 0; hp < 4; ++hp) { const float* pr = pc + ((size_t)bt * 16 + g * 4 + hp) * 256;
            for (int n = max(4 * j - 1, 0); n <= min(4 * j + 3, NCMP - 1); ++n) imp += pr[n]; }
        const bool valid = j <= cur, forced = (j == 0) || (j == cur) || (j == cur - 1);
        const float s = valid ? imp + (forced ? 1e4f : 0.f) : -1e4f;
        int rank = 0;
        for (int jj = 0; jj < 64; ++jj) { const float sj = __uint_as_float((unsigned)__builtin_amdgcn_ds_bpermute(jj << 2, (int)__float_as_uint(s))); rank += (sj > s || (sj == s && jj < j)) ? 1 : 0; }
        const unsigned long long m = __ballot(rank < 16);
        if (j == 0) sel[idx] = m;
    }
}
__device__ __forceinline__ void ph_nsa_attn(const float* qn, const float* gates, const float* kv6, const float* oc, const unsigned long long* sel, float* o, unsigned short* ob) {
    LAUNDER();
    for (int idx = GTID; idx < NT * 16; idx += GSZ) {
        const int bt = idx >> 4, hd = idx & 15, b = bt / SEQ, t = bt % SEQ, g = hd >> 2, cur = t >> 6;
        const float slope = exp2f(-0.5f * (hd + 1));
        float q[64];
#pragma unroll
        for (int d = 0; d < 64; ++d) q[d] = qn[(size_t)bt * 1024 + hd * 64 + d];
        const float gc = gates[(size_t)bt * 48 + 0 * 16 + hd], gs = gates[(size_t)bt * 48 + 1 * 16 + hd], gw = gates[(size_t)bt * 48 + 2 * 16 + hd];
        const unsigned long long msk = sel[(size_t)bt * 4 + g];
        float* orow = o + (size_t)bt * 1024 + hd * 64;
        for (int br = 0; br < 2; ++br) {
            float acc[64];
#pragma unroll
            for (int d = 0; d < 64; ++d) acc[d] = 0.f;
            float mx = -1e30f, l = 0.f;
            const int kcol = (br == 0 ? 2 : 4) * 256 + g * 64, vcol = kcol + 256;
            const int jlo = br == 0 ? 0 : max(0, t - 511), jhi = br == 0 ? cur : t;
            for (int j = jlo; j <= jhi; ++j) {
                int k0, k1;
                if (br == 0) { if (!((msk >> j) & 1ull)) continue; k0 = 64 * j; k1 = min(64 * j + 63, t); } else { k0 = j; k1 = j; }
                for (int key = k0; key <= k1; ++key) {
                    const float* kr = kv6 + (size_t)(b * SEQ + key) * KV_OUT + kcol; const float* vr = kv6 + (size_t)(b * SEQ + key) * KV_OUT + vcol;
                    float s = 0.f;
#pragma unroll
                    for (int d = 0; d < 64; ++d) s += q[d] * kr[d];
                    s -= slope * (float)(t - key);
                    const float mn = fmaxf(mx, s), sc = expf(mx - mn), p = expf(s - mn);
                    l = l * sc + p; mx = mn;
#pragma unroll
                    for (int d = 0; d < 64; ++d) acc[d] = acc[d] * sc + p * vr[d];
                }
            }
            const float gg = (br == 0 ? gs : gw) / l;
            if (br == 0) {
#pragma unroll
                for (int d = 0; d < 64; ++d) orow[d] = gc * oc[(size_t)idx * 64 + d] + gg * acc[d];
            } else {
#pragma unroll
                for (int d = 0; d < 64; ++d) ob[(size_t)bt * 1024 + hd * 64 + d] = f2bf(orow[d] + gg * acc[d]);
            }
        }
    }
}

__device__ __forceinline__ void ph_router(const float* h, const float* rw, const float* rb, float* logits) {
    LAUNDER();
    for (size_t i = GTID; i < (size_t)NT * 32; i += GSZ) {
        const int t = (int)(i >> 5), e = (int)(i & 31);
        float acc = 0.f;
        for (int k = 0; k < 1024; ++k) acc += h[(size_t)t * DM + k] * rw[k * 32 + e];
        logits[i] = acc + rb[e];
    }
}
__device__ __forceinline__ void ph_top4(const float* logits, int* topi, float* topw, int* cnt) {
    LAUNDER();
    for (int t = GTID; t < NT; t += GSZ) {
        float v[32];
#pragma unroll
        for (int e = 0; e < 32; ++e) v[e] = logits[(size_t)t * 32 + e];
        float tv[4]; int ti[4];
#pragma unroll
        for (int r = 0; r < 4; ++r) { float best = -3e38f; int bi = 0;
#pragma unroll
            for (int e = 0; e < 32; ++e) if (v[e] > best) { best = v[e]; bi = e; }
            tv[r] = best; ti[r] = bi;
#pragma unroll
            for (int e = 0; e < 32; ++e) if (e == bi) v[e] = -3e38f; }
        float s = 0.f, w[4];
#pragma unroll
        for (int r = 0; r < 4; ++r) { w[r] = expf(tv[r] - tv[0]); s += w[r]; }
#pragma unroll
        for (int r = 0; r < 4; ++r) { topi[t * 4 + r] = ti[r]; topw[t * 4 + r] = w[r] / s; atomicAdd(&cnt[ti[r]], 1); }
    }
}
__device__ __forceinline__ void ph_offsets(int* cnt, int* tile_e) {
    LAUNDER();
    if (tid_ == 0 && bid_ == 0) { int s = 0;
        for (int e = 0; e < NE; ++e) { cnt[64 + e] = s; const int p = (cnt[e] + MPAD - 1) / MPAD * MPAD; for (int tl = s / MPAD; tl < (s + p) / MPAD; ++tl) tile_e[tl] = e; s += p; }
        cnt[64 + NE] = s; for (int tl = s / MPAD; tl < CAP / MPAD; ++tl) tile_e[tl] = -1; }
}
__device__ __forceinline__ void ph_assign(const int* topi, int* cnt, int* stok, int* pos) {
    LAUNDER();
    for (int i = GTID; i < NASG; i += GSZ) {
        const int e = topi[i];
        const int p = cnt[64 + e] + atomicAdd(&cnt[32 + e], 1);
        stok[p] = i >> 2; pos[i] = p;
    }
}
__device__ __forceinline__ void ph_combine(float* x, const float* y, const int* pos, const float* topw, const float* gate, int ldg) {
    LAUNDER();
    const int lane = tid_ & 63;
    for (int row = GTID >> 6; row < NT; row += GSZ >> 6) {
        const int b = row / SEQ;
#pragma unroll
        for (int j = 0; j < 4; ++j) { const int col = j * 256 + lane * 4;
            float4 acc = make_float4(0.f, 0.f, 0.f, 0.f);
            for (int r = 0; r < 4; ++r) { const float w = topw[row * 4 + r]; const float4 v = *(const float4*)(y + (size_t)pos[row * 4 + r] * DM + col);
                acc.x += w * v.x; acc.y += w * v.y; acc.z += w * v.z; acc.w += w * v.w; }
            float4 xv = *(float4*)(x + (size_t)row * DM + col); const float4 gp = *(const float4*)(gate + b * ldg + col);
            xv.x += gp.x * acc.x; xv.y += gp.y * acc.y; xv.z += gp.z * acc.z; xv.w += gp.w * acc.w;
            *(float4*)(x + (size_t)row * DM + col) = xv; }
    }
}
template <bool PERM128 = false>
__device__ __forceinline__ void ph_convT(const float* src, unsigned short* dst, int K, int N, int Npad, int nmat, float* smem) {
    LAUNDER();
    unsigned (*TT)[64][33] = (unsigned (*)[64][33])smem;
    const int tk = K / 64, tn = Npad / 64, per = tk * tn, total = nmat * per;
    const int kp = tid_ >> 4, ln = (tid_ & 15) * 4;
    float4 v0 = make_float4(0.f, 0.f, 0.f, 0.f), v1 = v0;
    auto fetch = [&](int it, float4& a, float4& b) {
        const int mat = it / per, r = it % per, k0 = (r / tn) * 64, n0 = (r % tn) * 64;
        const float* s = src + (size_t)mat * K * N;
        a = make_float4(0.f, 0.f, 0.f, 0.f); b = a;
        int ka = k0 + 2 * kp, kb = ka + 1;
        if (PERM128) {
            ka = (ka & ~127) | (((ka >> 2) & 1) * 64 + ((ka >> 5) & 3) * 16 + ((ka >> 1) & 1) * 8 + ((ka >> 3) & 3) * 2 + (ka & 1));
            kb = (kb & ~127) | (((kb >> 2) & 1) * 64 + ((kb >> 5) & 3) * 16 + ((kb >> 1) & 1) * 8 + ((kb >> 3) & 3) * 2 + (kb & 1)); }
        if (n0 + ln < N) { a = *(const float4*)(s + (size_t)ka * N + n0 + ln); b = *(const float4*)(s + (size_t)kb * N + n0 + ln); }
    };
    int it = bid_, par = 0;
    if (it < total) fetch(it, v0, v1);
    while (it < total) {
        TT[par][ln][kp] = pack_bf16(v0.x, v1.x); TT[par][ln + 1][kp] = pack_bf16(v0.y, v1.y); TT[par][ln + 2][kp] = pack_bf16(v0.z, v1.z); TT[par][ln + 3][kp] = pack_bf16(v0.w, v1.w);
        const int nxt = it + nb_s;
        if (nxt < total) fetch(nxt, v0, v1);
        __syncthreads();
        { const int mat = it / per, r = it % per, k0 = (r / tn) * 64, n0 = (r % tn) * 64;
          unsigned short* d = dst + (size_t)mat * Npad * K;
          const int n = tid_ >> 3, c = tid_ & 7;
          *(uint4*)(d + (size_t)(n0 + n) * K + k0 + 8 * c) = make_uint4(TT[par][n][4 * c], TT[par][n][4 * c + 1], TT[par][n][4 * c + 2], TT[par][n][4 * c + 3]); }
        it = nxt; par ^= 1;
    }
    __syncthreads();
}
__device__ __forceinline__ void ph_c1(const float* pos, const float* w1, const float* b1, float* c1, float* smem) {
    LAUNDER();
    for (int o = bid_; o < 256; o += nb_s) {
        const int t = o >> 7, e = o & 127; float acc = 0.f;
#pragma unroll
        for (int j = 0; j < 4; ++j) { const int f = tid_ + 512 * j; acc += pos[t * 2048 + f] * w1[((size_t)t * 2048 + f) * 128 + e]; }
#pragma unroll
        for (int s = 32; s > 0; s >>= 1) acc += SHX(acc, s);
        if ((tid_ & 63) == 0) smem[tid_ >> 6] = acc;
        __syncthreads();
        if (tid_ == 0) { float s = b1[t * 128 + e]; for (int w = 0; w < 8; ++w) s += smem[w]; c1[o] = s; }
        __syncthreads();
    }
}
typedef short a_bf16x8 __attribute__((ext_vector_type(8)));
typedef float a_f32x16 __attribute__((ext_vector_type(16)));
typedef unsigned au32x4 __attribute__((ext_vector_type(4)));
typedef unsigned au32x2 __attribute__((ext_vector_type(2)));
static constexpr int AT_TB = 8192;
static constexpr int AT_KC = 0, AT_VC = 4 * AT_TB, AT_KS = 8 * AT_TB, AT_VS = 12 * AT_TB, AT_IMP = g8::STAGE_BYTES + 64  , AT_SELM = AT_IMP + 16384, AT_WM = AT_SELM + 512, AT_END = AT_WM + 64, AT_ONES = AT_END + 8;
static_assert(16 * AT_TB <= g8::STAGE_BYTES && AT_END + 16 <= g8::STAGE_BYTES + 64 + MX_END, "attention LDS map must fit");

__device__ __forceinline__ float xhalf_max(float v) { auto rr = __builtin_amdgcn_permlane32_swap(__float_as_uint(v), __float_as_uint(v), false, false); return fmaxf(__uint_as_float(rr[0]), __uint_as_float(rr[1])); }
__device__ __forceinline__ float xhalf_sum(float v) { auto rr = __builtin_amdgcn_permlane32_swap(__float_as_uint(v), __float_as_uint(v), false, false); return __uint_as_float(rr[0]) + __uint_as_float(rr[1]); }

__device__ __forceinline__ void at_dma1(LAS unsigned char* buf, const char* gb, unsigned go, int wid) {
    __builtin_amdgcn_global_load_lds((const unsigned*)(gb + go), (LAS unsigned*)(buf + wid * 1024), 16, 0, 0);
}
__device__ __forceinline__ void at_glds(LAS unsigned char* buf, const char* gb, unsigned go, int wid) {
    unsigned sv; const unsigned la = (unsigned)(unsigned long long)(buf + wid * 1024);
    asm volatile("s_mov_b32 %0, m0\n\ts_mov_b32 m0, %3\n\ts_nop 0\n\tglobal_load_lds_dwordx4 %1, %2\n\ts_mov_b32 m0, %0" : "=&s"(sv) : "v"(go), "s"(gb), "s"(la) : "memory");
}
__device__ __forceinline__ void at_dma(LAS unsigned char* kbuf, LAS unsigned char* vbuf, const char* kb, const char* vb, unsigned ko, unsigned vo, int wid) {
    at_dma1(kbuf, kb, ko, wid); at_dma1(vbuf, vb, vo, wid);
}
#define AT_SWZ(row, g) ((row) * 128 + ((((g) ^ (((row) >> 1) & 7))) << 4))
#define AT_REGOFF(i) (((i) & 3) + 8 * ((i) >> 2))
__device__ __forceinline__ void at_qk(LAS unsigned char* kbuf, const a_bf16x8 (&qf)[4], a_f32x16 (&st)[2], const int (&off4)[4], float base, float slk, int hh) {
    a_bf16x8 kf[2][4];
#pragma unroll
    for (int kt = 0; kt < 2; ++kt)
#pragma unroll
        for (int s = 0; s < 4; ++s) kf[kt][s] = *(const LAS a_bf16x8*)(kbuf + 4096 * kt + off4[s]);
    a_f32x16 a0, a1;
    const float b0 = base + slk * (float)(4 * hh), b1 = base + slk * (float)(32 + 4 * hh);
#pragma unroll
    for (int i = 0; i < 16; ++i) { a0[i] = b0 + slk * (float)AT_REGOFF(i); a1[i] = b1 + slk * (float)AT_REGOFF(i); }
    __builtin_amdgcn_sched_barrier(0);
    __builtin_amdgcn_s_setprio(1);
#pragma unroll
    for (int s = 0; s < 4; ++s) {
        a0 = __builtin_amdgcn_mfma_f32_32x32x16_bf16(kf[0][s], qf[s], a0, 0, 0, 0);
        a1 = __builtin_amdgcn_mfma_f32_32x32x16_bf16(kf[1][s], qf[s], a1, 0, 0, 0);
    }
    __builtin_amdgcn_s_setprio(0);
    st[0] = a0; st[1] = a1;
}
__device__ __forceinline__ void at_vload(LAS unsigned char* vbuf, a_bf16x8 (&vf)[2][4], const int (&off4)[4]) {
#pragma unroll
    for (int dt = 0; dt < 2; ++dt)
#pragma unroll
        for (int ks = 0; ks < 4; ++ks) vf[dt][ks] = *(const LAS a_bf16x8*)(vbuf + 4096 * dt + off4[ks]);
}
__device__ __forceinline__ void at_pack(const a_f32x16 (&p)[2], a_bf16x8 (&pb)[4]) {
#pragma unroll
    for (int kt = 0; kt < 2; ++kt)
#pragma unroll
        for (int s = 0; s < 2; ++s) {
            au32x4 pw = {pack_bf16(p[kt][8 * s + 0], p[kt][8 * s + 1]), pack_bf16(p[kt][8 * s + 2], p[kt][8 * s + 3]), pack_bf16(p[kt][8 * s + 4], p[kt][8 * s + 5]), pack_bf16(p[kt][8 * s + 6], p[kt][8 * s + 7])};
            pb[kt * 2 + s] = *reinterpret_cast<a_bf16x8*>(&pw); }
}
__device__ __forceinline__ void at_pv(const a_bf16x8 (&vf)[2][4], const a_bf16x8 (&pb)[4], a_f32x16 (&O)[2]) {
    __builtin_amdgcn_s_setprio(1);
#pragma unroll
    for (int ks = 0; ks < 4; ++ks) {
        O[0] = __builtin_amdgcn_mfma_f32_32x32x16_bf16(vf[0][ks], pb[ks], O[0], 0, 0, 0);
        O[1] = __builtin_amdgcn_mfma_f32_32x32x16_bf16(vf[1][ks], pb[ks], O[1], 0, 0, 0);
    }
    __builtin_amdgcn_s_setprio(0);
}
__device__ __forceinline__ void at_mask(a_f32x16 (&st)[2], int hh, int klo, int khi) {
    int d0 = 4 * hh - klo; unsigned span = (unsigned)(khi - klo); const bool any = khi >= klo;
    asm volatile("" : "+v"(d0)); asm volatile("" : "+v"(span));
#pragma unroll
    for (int kt = 0; kt < 2; ++kt)
#pragma unroll
        for (int i = 0; i < 16; ++i) { const bool ok = any && ((unsigned)(32 * kt + AT_REGOFF(i) + d0) <= span); st[kt][i] = ok ? st[kt][i] : -INFINITY; }
}
__device__ __forceinline__ float at_rowmax(const a_f32x16 (&st)[2]) {
    float mt = st[0][0];
#pragma unroll
    for (int i = 1; i < 16; ++i) mt = fmaxf(mt, st[0][i]);
#pragma unroll
    for (int i = 0; i < 16; ++i) mt = fmaxf(mt, st[1][i]);
    return xhalf_max(mt);
}
__device__ __forceinline__ void at_softmax_rel(a_f32x16 (&st)[2], float mref, bool first, float& m, float& l, a_f32x16 (&O)[2]) {
    const float mt = at_rowmax(st);
    float ps = 0.f;
    if (first || __any(mt > 6.f)) {
        float delta = first ? mt : fmaxf(mt, 0.f); delta = (delta == -INFINITY) ? 0.f : delta;
#pragma unroll
        for (int kt = 0; kt < 2; ++kt)
#pragma unroll
            for (int i = 0; i < 16; ++i) { const float pv = __builtin_amdgcn_exp2f(st[kt][i] - delta); st[kt][i] = pv; ps += pv; }
        const float alpha = first ? 0.f : __builtin_amdgcn_exp2f(-delta);
        l = l * alpha + ps; m = mref + delta;
#pragma unroll
        for (int dt = 0; dt < 2; ++dt)
#pragma unroll
            for (int i = 0; i < 16; ++i) O[dt][i] *= alpha;
    } else {
#pragma unroll
        for (int kt = 0; kt < 2; ++kt)
#pragma unroll
            for (int i = 0; i < 16; ++i) { const float pv = __builtin_amdgcn_exp2f(st[kt][i]); st[kt][i] = pv; ps += pv; }
        l += ps;
    }
}

__device__ __forceinline__ void at_mask2(a_f32x16& s0, a_f32x16& s1, int hh, int klo, int khi) {
    const bool any = khi >= klo;
    int d0 = any ? 4 * hh - klo : 0x40000000; unsigned span = any ? (unsigned)(khi - klo) : 0u;
    asm volatile("" : "+v"(d0)); asm volatile("" : "+v"(span));
#pragma unroll
    for (int i = 0; i < 16; ++i) {
        s0[i] = ((unsigned)(AT_REGOFF(i) + d0) <= span) ? s0[i] : -INFINITY;
        s1[i] = ((unsigned)(32 + AT_REGOFF(i) + d0) <= span) ? s1[i] : -INFINITY; }
}
#define AT_MX3(a, b, c) __builtin_fmaxf(__builtin_fmaxf((a), (b)), (c))
__device__ __forceinline__ float at_rowmax2(const a_f32x16& p0, const a_f32x16& p1) {
    float a = AT_MX3(p0[0], p0[1], p1[0]), b = AT_MX3(p0[2], p0[3], p1[1]); a = AT_MX3(a, p1[2], p1[3]);
#pragma unroll
    for (int r = 4; r < 16; r += 4) { a = AT_MX3(a, p0[r], p0[r + 1]); b = AT_MX3(b, p0[r + 2], p0[r + 3]); a = AT_MX3(a, p1[r], p1[r + 1]); b = AT_MX3(b, p1[r + 2], p1[r + 3]); }
    return xhalf_max(__builtin_fmaxf(a, b));
}

__device__ __forceinline__ void ph_nsa_attn_mfma(const unsigned short* qb, const float* gates, const unsigned short* kcmp, const unsigned short* vcmpT,
                                                 const unsigned short* kslc, const unsigned short* vslcT, const unsigned short* kwin, const unsigned short* vwinT,
                                                 unsigned short* ob, int* qcnt, LAS unsigned char* lds) {
    LAUNDER();
    const int wid = wv_s;
    constexpr float LOG2E = 1.4426950408889634f;
    int lane, r, hh, hp, ql, tl = 0, tq = 0, tqh = 0; unsigned ko, voS; int off4[4]; float sl = 0.f;
#define AT_DERIVE(q0_, g_) do { asm volatile("v_mbcnt_lo_u32_b32 %0, -1, 0\n\tv_mbcnt_hi_u32_b32 %0, -1, %0" : "=v"(lane)); r = lane & 31; hh = lane >> 5; hp = r >> 3; ql = r & 7; \
        const int drow_ = 8 * wid + (lane >> 3), dgc_ = (lane & 7) ^ ((drow_ >> 1) & 7); ko = (unsigned)(drow_ * 128 + dgc_ * 16); voS = (unsigned)(drow_ * SEQ * 2 + dgc_ * 16); \
        _Pragma("unroll") for (int s_ = 0; s_ < 4; ++s_) off4[s_] = r * 128 + ((((2 * s_ + hh) ^ ((r >> 1) & 7))) << 4); \
        tl = wid * 8 + ql; tq = (q0_) + tl; tqh = tq - 4 * hh; sl = exp2f(-0.5f * (float)((g_) * 4 + hp + 1)) * LOG2E; } while (0)
    LAS int* qslot = (LAS int*)(lds + AT_END);
    const bool dyn = nb_s == 256;
    int kq = 0, I = bid_, it = 0;
    if (tid_ == 0) { qslot[2] = ~0; qslot[3] = ~0; }
    if (dyn) { if (tid_ == 0) qslot[0] = atomicAdd(qcnt + (bid_ & 7), 1); }
    __syncthreads();
    if (dyn) kq = qslot[0];
    for (;;) {
        if (dyn ? kq >= 256 : I >= 2048) break;
        int knext = 0;
        int lane0; asm volatile("v_mbcnt_lo_u32_b32 %0, -1, 0\n\tv_mbcnt_hi_u32_b32 %0, -1, %0" : "=v"(lane0));
        if (dyn && wid == 0 && lane0 == 0) knext = atomicAdd(qcnt + (bid_ & 7), 1);
        int qi = 63 - (I >> 5), bg = I & 31;
        if (dyn) { bg = (bid_ & 7) + 8 * (kq >> 6); qi = 63 - (kq & 63); }
        const int b = bg >> 2, g = bg & 3, q0 = qi * 64, cur = qi;
        AT_DERIVE(q0, g);
        const int hd = g * 4 + hp;
        const unsigned voC = (unsigned)((8 * wid + (lane >> 3)) * 512 + ((lane & 7) ^ (((8 * wid + (lane >> 3)) >> 1) & 7)) * 16);
        a_bf16x8 qf[4];
#pragma unroll
        for (int s = 0; s < 4; ++s) qf[s] = *(const a_bf16x8*)(qb + (size_t)(b * SEQ + tq) * 1024 + hd * 64 + 16 * s + 8 * hh);
        const float* gp = gates + (size_t)(b * SEQ + tq) * 48 + hd;
        const float gc = gp[0], gs = gp[16], gw = gp[32];
        a_f32x16 Ot[2];
#pragma unroll
        for (int dt = 0; dt < 2; ++dt)
#pragma unroll
            for (int i = 0; i < 16; ++i) Ot[dt][i] = 0.f;
        const int nlast_blk = (q0 + 63 >= 31) ? min(254, (q0 + 63 - 31) >> 4) : -1;
        const int ntc = nlast_blk >= 0 ? (nlast_blk >> 6) + 1 : 0;
        const int nlast = (tq >= 31) ? min(254, (tq - 31) >> 4) : -1;
        for (int T = 0; T < ntc; ++T) at_dma(lds + AT_KC + T * AT_TB, lds + AT_VC + T * AT_TB, (const char*)(kcmp + ((size_t)bg * 256 + 64 * T) * 64), (const char*)(vcmpT + (size_t)bg * 64 * 256 + 64 * T), ko, voC, wid);
        { LAS float* imp = (LAS float*)(lds + AT_IMP) + wid * 512;
#pragma unroll
          for (int i = 0; i < 8; ++i) imp[lane + 64 * i] = 0.f; }
        unsigned long long ptodo = (cur >= 8 ? (0x1FFull << (cur - 8)) : ((1ull << (cur + 1)) - 1ull));
        int pn = __builtin_popcountll(ptodo), pj0 = 0, pj1 = 0, pj2 = 0;
        {
            const char* kbw = (const char*)(kwin + (size_t)bg * SEQ * 64); const char* vbw = (const char*)(vwinT + (size_t)bg * 64 * SEQ);
            pj0 = 63 - __builtin_clzll(ptodo); ptodo &= ~(1ull << pj0);
            at_glds(lds + AT_KS, kbw + (size_t)pj0 * 8192, ko, wid); at_glds(lds + AT_VS, vbw + (size_t)pj0 * 128, voS, wid);
            if (pn > 1) { pj1 = 63 - __builtin_clzll(ptodo); ptodo &= ~(1ull << pj1); at_glds(lds + AT_KS + AT_TB, kbw + (size_t)pj1 * 8192, ko, wid); }
            if (pn > 2) { pj2 = 63 - __builtin_clzll(ptodo); ptodo &= ~(1ull << pj2); at_glds(lds + AT_KS + 2 * AT_TB, kbw + (size_t)pj2 * 8192, ko, wid); }
        }
        if (pn > 2) { asm volatile("s_waitcnt vmcnt(4)" ::: "memory"); } else if (pn > 1) { asm volatile("s_waitcnt vmcnt(3)" ::: "memory"); } else { asm volatile("s_waitcnt vmcnt(2)" ::: "memory"); }
        __syncthreads();
        {
            float m = -INFINITY, l = 0.f;
            a_f32x16 st[2], Oc[2];
#pragma unroll
            for (int dt = 0; dt < 2; ++dt)
#pragma unroll
                for (int i = 0; i < 16; ++i) Oc[dt][i] = 0.f;
            for (int T = 0; T < ntc; ++T) {
                at_qk(lds + AT_KC + T * AT_TB, qf, st, off4, sl * (float)(1024 * T + 31 - tq), sl * 16.f, hh);
                at_mask(st, hh, 0, nlast - 64 * T);
                const float mt = at_rowmax(st);
                const float mn = fmaxf(m, mt), ms = (mn == -INFINITY) ? 0.f : mn;
                float ps = 0.f;
#pragma unroll
                for (int kt = 0; kt < 2; ++kt)
#pragma unroll
                    for (int i = 0; i < 16; ++i) ps += __builtin_amdgcn_exp2f(st[kt][i] - ms);
                l = l * __builtin_amdgcn_exp2f(m - ms) + ps; m = mn;
            }
            l = xhalf_sum(l);
            const float ms = (m == -INFINITY) ? 0.f : m, inv = l > 0.f ? 1.f / l : 0.f;
            LAS float* imp = (LAS float*)(lds + AT_IMP) + wid * 512 + ql * 64;
            for (int T = 0; T < ntc; ++T) {
                at_qk(lds + AT_KC + T * AT_TB, qf, st, off4, sl * (float)(1024 * T + 31 - tq) - ms, sl * 16.f, hh);
                at_mask(st, hh, 0, nlast - 64 * T);
#pragma unroll
                for (int kt = 0; kt < 2; ++kt)
#pragma unroll
                    for (int i = 0; i < 16; ++i) st[kt][i] = __builtin_amdgcn_exp2f(st[kt][i]) * inv;
#pragma unroll
                for (int kt = 0; kt < 2; ++kt)
#pragma unroll
                    for (int c = 0; c < 4; ++c) {
                        float qs = (st[kt][4 * c] + st[kt][4 * c + 1]) + (st[kt][4 * c + 2] + st[kt][4 * c + 3]), ls = st[kt][4 * c + 3];
                        qs += SHX(qs, 8); qs += SHX(qs, 16); ls += SHX(ls, 8); ls += SHX(ls, 16);
                        const int j = 16 * T + 8 * kt + 2 * c + hh;
                        if (hp == 0) { (void)__hip_atomic_fetch_add(imp + j, qs, __ATOMIC_RELAXED, __HIP_MEMORY_SCOPE_WORKGROUP); if (j < 63) (void)__hip_atomic_fetch_add(imp + j + 1, ls, __ATOMIC_RELAXED, __HIP_MEMORY_SCOPE_WORKGROUP); }
                    }
                { a_bf16x8 vf[2][4], pb[4]; at_pack(st, pb); at_vload(lds + AT_VC + T * AT_TB, vf, off4); at_pv(vf, pb, Oc); }
            }
#pragma unroll
            for (int dt = 0; dt < 2; ++dt)
#pragma unroll
                for (int i = 0; i < 16; ++i) Ot[dt][i] = gc * Oc[dt][i];
        }
        unsigned long long wor = 0ull;
        asm volatile("s_waitcnt lgkmcnt(0)" ::: "memory"); __builtin_amdgcn_wave_barrier();
        {
            const bool valid = lane <= cur, forced = (lane == 0) || (lane == cur) || (lane == cur - 1);
            const unsigned long long vmask = __ballot(valid);
            if (cur < 16) {
                if (lane == 0) {
#pragma unroll
                    for (int q = 0; q < 8; ++q) ((LAS unsigned long long*)(lds + AT_SELM))[wid * 8 + q] = vmask; }
                wor = vmask;
            } else {
                for (int q = 0; q < 8; q += 4) {
                    unsigned key[4], T[4];
#pragma unroll
                    for (int c = 0; c < 4; ++c) {
                        const float s = ((LAS float*)(lds + AT_IMP))[wid * 512 + (q + c) * 64 + lane];
                        const float sc = valid ? (forced ? 1e30f : s) : -1e30f;
                        const unsigned ub = __float_as_uint(sc); key[c] = (ub & 0x80000000u) ? ~ub : (ub | 0x80000000u); T[c] = 0u; }
#pragma unroll 1
                    for (int bit = 31; bit >= 0; --bit) {
#pragma unroll
                        for (int c = 0; c < 4; ++c) { const unsigned cand = T[c] | (1u << bit); if (__builtin_popcountll(__ballot(key[c] >= cand)) >= 16) T[c] = cand; } }
#pragma unroll
                    for (int c = 0; c < 4; ++c) {
                        unsigned long long selm = __ballot(key[c] > T[c]), eq = __ballot(key[c] == T[c]);
                        int need = 16 - __builtin_popcountll(selm);
                        for (; need > 0; --need) { const unsigned long long low = eq & (0ull - eq); selm |= low; eq ^= low; }
                        const unsigned long long mk = selm & vmask;
                        if (lane == 0) ((LAS unsigned long long*)(lds + AT_SELM))[wid * 8 + q + c] = mk;
                        wor |= mk; }
                }
            }
            if (lane == 0) ((LAS unsigned long long*)(lds + AT_WM))[wid] = wor;
        }
        __syncthreads();
        unsigned long long U = 0ull;
#pragma unroll
        for (int w = 0; w < 8; ++w) U |= ((LAS unsigned long long*)(lds + AT_WM))[w];
        U = ((unsigned long long)__builtin_amdgcn_readfirstlane((unsigned)(U >> 32)) << 32) | (unsigned long long)__builtin_amdgcn_readfirstlane((unsigned)U);
        { LAS float* gl = (LAS float*)(lds + AT_IMP) + wid * 128 + lane; gl[0] = gs; gl[64] = gw; if (dyn && wid == 0 && lane == 0) qslot[1] = knext; }
        AT_DERIVE(q0, g);
#define AT_OTP(v_) LAS float* v_; { int lx_; asm volatile("v_mbcnt_lo_u32_b32 %0, -1, 0\n\tv_mbcnt_hi_u32_b32 %0, -1, %0" : "=v"(lx_)); v_ = (LAS float*)(lds + AT_KC) + wid * 2048 + lx_ * 4; }
        { AT_OTP(otp);
#pragma unroll
        for (int c = 0; c < 8; ++c) *(LAS g8::f32x4*)(otp + c * 256) = g8::f32x4{Ot[c >> 2][4 * (c & 3)], Ot[c >> 2][4 * (c & 3) + 1], Ot[c >> 2][4 * (c & 3) + 2], Ot[c >> 2][4 * (c & 3) + 3]}; }
#define AT_SB() __builtin_amdgcn_sched_barrier(0)
#define AT_PIN(x) asm volatile("" : "+v"(x))
#define AT_MF(a, b, c) __builtin_amdgcn_mfma_f32_32x32x16_bf16(a, b, c, 0, 0, 0)
#define AT_WAIT_BAR(N) asm volatile("s_waitcnt vmcnt(" #N ") lgkmcnt(0)\n\ts_barrier" ::: "memory")
#define AT_KF(i) ((float)AT_REGOFF(i))
#define AT_PB(w) (*reinterpret_cast<a_bf16x8*>(&(w)))
#define AT_PK(P, i) pack_bf16(P[i], P[(i) + 1])
        for (int bi = 0; bi < 2; ++bi) {
            const int br = 1 - bi;
            const char* kbase = (const char*)((br == 0 ? kslc : kwin) + (size_t)bg * SEQ * 64);
            const char* vbase = (const char*)((br == 0 ? vslcT : vwinT) + (size_t)bg * 64 * SEQ);
            unsigned long long todo = ptodo;
            const int n = pn;
            const LAS unsigned* selp = (const LAS unsigned*)(lds + (br == 0 ? AT_SELM : AT_ONES)) + (br == 0 ? (wid * 8 + ql) * 2 : 0);
            float m = 0.f, l = 0.f, f_ = 1.f; bool resc_ = false;
            a_f32x16 O0, O1, pA0, pA1, pB0, pB1;
#pragma unroll
            for (int i = 0; i < 16; ++i) { O0[i] = 0.f; O1[i] = 0.f; }
            a_bf16x8 kf[8], vf[8]; au32x4 pw0, pw1, pw2, pw3;
            int sl_prev = 0, sl_cur = 0, sl_next = AT_TB;
#define AT_ROT() do { sl_prev = sl_cur; sl_cur = sl_next; sl_next = (sl_next == 2 * AT_TB) ? 0 : sl_next + AT_TB; } while (0)
#define AT_DMAK(jj, so) at_glds(lds + AT_KS + (so), kbase + (size_t)(jj) * 8192, ko, wid)
#define AT_DMAV(jj, so) at_glds(lds + AT_VS + (so), vbase + (size_t)(jj) * 128, voS, wid)
#define AT_POP(jv) do { jv = 63 - __builtin_clzll(todo); todo &= ~(1ull << jv); } while (0)
#define AT_BIAS(jj) ((((selp[(jj) >> 5] >> ((jj) & 31)) & 1u) != 0u) ? (sl * (float)(64 * (jj) - tqh) - m) : -INFINITY)
#define AT_KRD(s) do { kf[2 * (s)] = *(const LAS a_bf16x8*)(kb_ + off4[s]); kf[2 * (s) + 1] = *(const LAS a_bf16x8*)(kb_ + 4096 + off4[s]); } while (0)
#define AT_VRD(i) do { vf[i] = *(const LAS a_bf16x8*)(vp_ + 4096 * ((i) >> 2) + off4[(i) & 3]); } while (0)
            int q1 = pj0, q2 = pj1, q3 = pj2, jnew = 0;
            if (bi == 1) { AT_DMAV(q1, 0); AT_WAIT_BAR(1); } else { AT_WAIT_BAR(0); }
            {
                LAS unsigned char* kb_ = lds + AT_KS;
#pragma unroll
                for (int s = 0; s < 4; ++s) AT_KRD(s);
                const float b = AT_BIAS(q1); float slo = sl; AT_PIN(slo);
#pragma unroll
                for (int i = 0; i < 16; ++i) { pA0[i] = __builtin_fmaf(slo, AT_KF(i), b); pA1[i] = __builtin_fmaf(slo, AT_KF(i) + 32.f, b); }
#pragma unroll
                for (int s = 0; s < 4; ++s) { pA0 = AT_MF(kf[2 * s], qf[s], pA0); pA1 = AT_MF(kf[2 * s + 1], qf[s], pA1); }
                if (q1 == cur || (br == 1 && q1 == cur - 8)) { int lx_; asm volatile("v_mbcnt_lo_u32_b32 %0, -1, 0\n\tv_mbcnt_hi_u32_b32 %0, -1, %0" : "=v"(lx_)); const int tlx_ = wid * 8 + (lx_ & 7);
                    if (q1 == cur) at_mask2(pA0, pA1, lx_ >> 5, 0, tlx_); else at_mask2(pA0, pA1, lx_ >> 5, tlx_ + 1, 63); }
                const float rm = at_rowmax2(pA0, pA1), d = (rm == -INFINITY) ? 0.f : rm; m = d;
#pragma unroll
                for (int i = 0; i < 16; ++i) { pA0[i] = __builtin_amdgcn_exp2f(pA0[i] - d); pA1[i] = __builtin_amdgcn_exp2f(pA1[i] - d); }
            }
            AT_WAIT_BAR(0);
            q1 = q2; q2 = q3; q3 = 0;
            if (n > 3) { AT_POP(q3); AT_DMAK(q3, 0); }
            if (n > 1) AT_DMAV(q1, AT_TB);
            AT_ROT();
            {
                LAS unsigned char* kb_ = lds + AT_KS + sl_cur;
#pragma unroll
                for (int s = 0; s < 4; ++s) AT_KRD(s);
                const float b = AT_BIAS(q1); float slo = sl; AT_PIN(slo);
#pragma unroll
                for (int i = 0; i < 16; ++i) { pB0[i] = __builtin_fmaf(slo, AT_KF(i), b); pB1[i] = __builtin_fmaf(slo, AT_KF(i) + 32.f, b); }
            }
            if (n > 3) { AT_WAIT_BAR(2); } else if (n > 1) { AT_WAIT_BAR(1); } else { AT_WAIT_BAR(0); }
#define AT_GAPA(MF_, a0, a1, a2, a3, W0, W1, PW) do { MF_; sacc += a0; sacc += a1; sacc += a2; sacc += a3; W0; W1; AT_PIN(PW); AT_PIN(sacc); AT_SB(); } while (0)
#define AT_GAPB(MF_, X, i, Y, KO) do { MF_; X[i] = __builtin_amdgcn_exp2f(X[i]); X[(i) + 1] = __builtin_amdgcn_exp2f(X[(i) + 1]); X[(i) + 2] = __builtin_amdgcn_exp2f(X[(i) + 2]); X[(i) + 3] = __builtin_amdgcn_exp2f(X[(i) + 3]); \
        Y[i] = __builtin_fmaf(slo, AT_KF(i) + KO, bn); Y[(i) + 1] = __builtin_fmaf(slo, AT_KF((i) + 1) + KO, bn); Y[(i) + 2] = __builtin_fmaf(slo, AT_KF((i) + 2) + KO, bn); Y[(i) + 3] = __builtin_fmaf(slo, AT_KF((i) + 3) + KO, bn); \
        AT_PIN(X); AT_PIN(Y); AT_SB(); } while (0)
#define AT_STEP(C0, C1, P0, P1, t, ST) do { AT_SB(); \
            const unsigned selw_ = selp[q2 >> 5];                                  \
            { LAS unsigned char* vp_ = lds + AT_VS + sl_prev; \
              AT_VRD(0); AT_SB(); float sacc = P0[0] + P0[1]; \
                                  AT_GAPA(C0 = AT_MF(kf[0], qf[0], C0), P0[2], P0[3], P0[4], P0[5],     pw0[0] = AT_PK(P0, 0),  pw0[1] = AT_PK(P0, 2),  pw0); \
              AT_VRD(4); AT_SB(); AT_GAPA(C1 = AT_MF(kf[1], qf[0], C1), P0[6], P0[7], P0[8], P0[9],     pw0[2] = AT_PK(P0, 4),  pw0[3] = AT_PK(P0, 6),  pw0); \
              AT_VRD(1); AT_SB(); AT_GAPA(C0 = AT_MF(kf[2], qf[1], C0), P0[10], P0[11], P0[12], P0[13], pw1[0] = AT_PK(P0, 8),  pw1[1] = AT_PK(P0, 10), pw1); \
              AT_VRD(5); AT_SB(); AT_GAPA(C1 = AT_MF(kf[3], qf[1], C1), P0[14], P0[15], P1[0], P1[1],   pw1[2] = AT_PK(P0, 12), pw1[3] = AT_PK(P0, 14), pw1); \
              AT_VRD(2); AT_SB(); AT_GAPA(C0 = AT_MF(kf[4], qf[2], C0), P1[2], P1[3], P1[4], P1[5],     pw2[0] = AT_PK(P1, 0),  pw2[1] = AT_PK(P1, 2),  pw2); \
              AT_VRD(6); AT_SB(); AT_GAPA(C1 = AT_MF(kf[5], qf[2], C1), P1[6], P1[7], P1[8], P1[9],     pw2[2] = AT_PK(P1, 4),  pw2[3] = AT_PK(P1, 6),  pw2); \
              AT_VRD(3); AT_SB(); AT_GAPA(C0 = AT_MF(kf[6], qf[3], C0), P1[10], P1[11], P1[12], P1[13], pw3[0] = AT_PK(P1, 8),  pw3[1] = AT_PK(P1, 10), pw3); \
              AT_VRD(7); AT_SB(); AT_GAPA(C1 = AT_MF(kf[7], qf[3], C1), P1[14], P1[15], 0.f, 0.f,       pw3[2] = AT_PK(P1, 12), pw3[3] = AT_PK(P1, 14), pw3); \
              l += sacc; } \
            jnew = 0; \
            if (ST || (t) + 3 < n) { AT_POP(jnew); AT_DMAK(jnew, sl_cur); }              \
            if (ST || (t) + 1 < n) AT_DMAV(q2, sl_next); \
            if (q1 == cur || (br == 1 && q1 == cur - 8)) { int lx_; asm volatile("v_mbcnt_lo_u32_b32 %0, -1, 0\n\tv_mbcnt_hi_u32_b32 %0, -1, %0" : "=v"(lx_)); const int tlx_ = wid * 8 + (lx_ & 7); \
                if (q1 == cur) at_mask2(C0, C1, lx_ >> 5, 0, tlx_); else at_mask2(C0, C1, lx_ >> 5, tlx_ + 1, 63); } \
            resc_ = false; \
            { const float rm = at_rowmax2(C0, C1); \
              if (__any(rm > 6.f)) { const float dl = fmaxf(rm, 0.f); m += dl; f_ = __builtin_amdgcn_exp2f(-dl); l *= f_; resc_ = true; \
                  _Pragma("unroll") for (int i_ = 0; i_ < 16; ++i_) { C0[i_] -= dl; C1[i_] -= dl; } } } \
            { const float bn = (((selw_ >> (q2 & 31)) & 1u) != 0u) ? (sl * (float)(64 * q2 - tqh) - m) : -INFINITY; float slo = sl; AT_PIN(slo); LAS unsigned char* kb_ = lds + AT_KS + sl_next; AT_SB(); \
              AT_GAPB(O0 = AT_MF(vf[0], AT_PB(pw0), O0), C0, 0, P0, 0.f);                              AT_GAPB(O1 = AT_MF(vf[4], AT_PB(pw0), O1), C0, 4, P0, 0.f); \
              AT_KRD(0); AT_SB(); AT_GAPB(O0 = AT_MF(vf[1], AT_PB(pw1), O0), C0, 8, P0, 0.f);          AT_KRD(1); AT_SB(); AT_GAPB(O1 = AT_MF(vf[5], AT_PB(pw1), O1), C0, 12, P0, 0.f); \
              AT_KRD(2); AT_SB(); AT_GAPB(O0 = AT_MF(vf[2], AT_PB(pw2), O0), C1, 0, P1, 32.f);         AT_KRD(3); AT_SB(); AT_GAPB(O1 = AT_MF(vf[6], AT_PB(pw2), O1), C1, 4, P1, 32.f); \
              AT_GAPB(O0 = AT_MF(vf[3], AT_PB(pw3), O0), C1, 8, P1, 32.f);                             AT_GAPB(O1 = AT_MF(vf[7], AT_PB(pw3), O1), C1, 12, P1, 32.f); } \
            if (ST || (t) + 3 < n) { AT_WAIT_BAR(2); } else if ((t) + 2 < n) { AT_WAIT_BAR(1); } else { AT_WAIT_BAR(0); } \
            if (resc_) { _Pragma("unroll") for (int i_ = 0; i_ < 16; ++i_) { O0[i_] *= f_; O1[i_] *= f_; } } \
            AT_ROT(); q1 = q2; q2 = q3; q3 = jnew; \
            } while (0)
            int t = 1;
            for (; t + 4 < n; t += 2) {
                AT_STEP(pB0, pB1, pA0, pA1, t, 1);
                AT_STEP(pA0, pA1, pB0, pB1, t + 1, 1);
            }
            for (; t + 1 < n; t += 2) {
                AT_STEP(pB0, pB1, pA0, pA1, t, 0);
                AT_STEP(pA0, pA1, pB0, pB1, t + 1, 0);
            }
            if (t < n) { AT_STEP(pB0, pB1, pA0, pA1, t, 0); pA0 = pB0; pA1 = pB1; }
            if (bi == 0) {
                const char* kbs = (const char*)(kslc + (size_t)bg * SEQ * 64);
                ptodo = U; pn = __builtin_popcountll(U); pj1 = 0; pj2 = 0;
                pj0 = 63 - __builtin_clzll(ptodo); ptodo &= ~(1ull << pj0); at_glds(lds + AT_KS, kbs + (size_t)pj0 * 8192, ko, wid);
                if (pn > 1) { pj1 = 63 - __builtin_clzll(ptodo); ptodo &= ~(1ull << pj1); at_glds(lds + AT_KS + AT_TB, kbs + (size_t)pj1 * 8192, ko, wid); }
                if (pn > 2) { pj2 = 63 - __builtin_clzll(ptodo); ptodo &= ~(1ull << pj2); at_glds(lds + AT_KS + 2 * AT_TB, kbs + (size_t)pj2 * 8192, ko, wid); }
            }
            {
                float sacc = 0.f;
#pragma unroll
                for (int i = 0; i < 16; ++i) sacc += pA0[i] + pA1[i];
                l += sacc;
                pw0 = au32x4{AT_PK(pA0, 0), AT_PK(pA0, 2), AT_PK(pA0, 4), AT_PK(pA0, 6)}; pw1 = au32x4{AT_PK(pA0, 8), AT_PK(pA0, 10), AT_PK(pA0, 12), AT_PK(pA0, 14)};
                pw2 = au32x4{AT_PK(pA1, 0), AT_PK(pA1, 2), AT_PK(pA1, 4), AT_PK(pA1, 6)}; pw3 = au32x4{AT_PK(pA1, 8), AT_PK(pA1, 10), AT_PK(pA1, 12), AT_PK(pA1, 14)};
                LAS unsigned char* vp_ = lds + AT_VS + sl_prev;
#pragma unroll
                for (int i = 0; i < 8; ++i) AT_VRD(i);
                O0 = AT_MF(vf[0], AT_PB(pw0), O0); O1 = AT_MF(vf[4], AT_PB(pw0), O1); O0 = AT_MF(vf[1], AT_PB(pw1), O0); O1 = AT_MF(vf[5], AT_PB(pw1), O1);
                O0 = AT_MF(vf[2], AT_PB(pw2), O0); O1 = AT_MF(vf[6], AT_PB(pw2), O1); O0 = AT_MF(vf[3], AT_PB(pw3), O0); O1 = AT_MF(vf[7], AT_PB(pw3), O1);
            }
            l = xhalf_sum(l);
            int lb_; asm volatile("v_mbcnt_lo_u32_b32 %0, -1, 0\n\tv_mbcnt_hi_u32_b32 %0, -1, %0" : "=v"(lb_));
            const float gsc = ((LAS float*)(lds + AT_IMP))[wid * 128 + lb_ + 64 * br] / l;
            AT_OTP(otp);
#pragma unroll
            for (int c = 0; c < 8; ++c) {
                g8::f32x4 v = *(LAS g8::f32x4*)(otp + c * 256);
                if (c < 4) { v[0] += gsc * O0[4 * c]; v[1] += gsc * O0[4 * c + 1]; v[2] += gsc * O0[4 * c + 2]; v[3] += gsc * O0[4 * c + 3]; }
                else { v[0] += gsc * O1[4 * (c - 4)]; v[1] += gsc * O1[4 * (c - 4) + 1]; v[2] += gsc * O1[4 * (c - 4) + 2]; v[3] += gsc * O1[4 * (c - 4) + 3]; }
                *(LAS g8::f32x4*)(otp + c * 256) = v;
            }
            asm volatile("s_waitcnt lgkmcnt(0)\n\ts_barrier" ::: "memory");
        }
#undef AT_STEP
#undef AT_GAPA
#undef AT_GAPB
#undef AT_ROT
#undef AT_DMAK
#undef AT_DMAV
#undef AT_POP
#undef AT_BIAS
#undef AT_KRD
#undef AT_VRD
        AT_OTP(otp);
#pragma unroll
        for (int c = 0; c < 8; ++c) { const g8::f32x4 v = *(LAS g8::f32x4*)(otp + c * 256); Ot[c >> 2][4 * (c & 3)] = v[0]; Ot[c >> 2][4 * (c & 3) + 1] = v[1]; Ot[c >> 2][4 * (c & 3) + 2] = v[2]; Ot[c >> 2][4 * (c & 3) + 3] = v[3]; }
        int l2; asm volatile("v_mbcnt_lo_u32_b32 %0, -1, 0\n\tv_mbcnt_hi_u32_b32 %0, -1, %0" : "=v"(l2));
        const int r2 = l2 & 31;
        unsigned short* orow = ob + (size_t)(b * SEQ + q0 + wid * 8 + (r2 & 7)) * 1024 + (g * 4 + (r2 >> 3)) * 64 + 8 * (l2 >> 5);
#pragma unroll
        for (int dt = 0; dt < 2; ++dt)
#pragma unroll
            for (int c = 0; c < 4; c += 2) {
                unsigned ax = pack_bf16(Ot[dt][4 * c], Ot[dt][4 * c + 1]), ay = pack_bf16(Ot[dt][4 * c + 2], Ot[dt][4 * c + 3]);
                unsigned bx = pack_bf16(Ot[dt][4 * c + 4], Ot[dt][4 * c + 5]), by = pack_bf16(Ot[dt][4 * c + 6], Ot[dt][4 * c + 7]);
                const auto rx = __builtin_amdgcn_permlane32_swap(ax, bx, false, false); const auto ry = __builtin_amdgcn_permlane32_swap(ay, by, false, false);
                *(uint4*)(orow + 32 * dt + 8 * c) = make_uint4(rx[0], ry[0], rx[1], ry[1]); }
        asm volatile("s_waitcnt lgkmcnt(0)\n\ts_barrier" ::: "memory");
        if (dyn) kq = qslot[1]; else { I += nb_s; ++it; }
    }
}
__device__ __forceinline__ float bf2f(unsigned short v) { return __uint_as_float(((unsigned)v) << 16); }
__device__ __forceinline__ void ph_gla_p1(const unsigned short* qk, const float* glr, const unsigned short* vT, const float* w2, const float* bgate,
                                          unsigned short* qd, unsigned short* ki, float* dl, unsigned short* UT, LAS unsigned char* lds) {
    LAUNDER();
    const int wid = wv_s, lane = tid_ & 63, r = lane & 31, hh = lane >> 5;
    LAS float* gsum = (LAS float*)lds;
    LAS float* gl = (LAS float*)(lds + 2048);
    LAS unsigned char* ket = lds + 2048 + 4096;
    const int d = tid_ & 127, sg = tid_ >> 7;
    float glp0 = 0.f, glp1 = 0.f, wp[16], bgp = 0.f;
    if (bid_ < 2048) { const int h = bid_ & 3, c = (bid_ >> 2) & 63, b = bid_ >> 8, tok0 = b * SEQ + c * 64;
        glp0 = glr[(size_t)tok0 * 16 + tid_]; glp1 = glr[(size_t)tok0 * 16 + tid_ + 512];
#pragma unroll
        for (int k = 0; k < 16; ++k) wp[k] = w2[k * 512 + h * 128 + d];
        bgp = bgate[h * 128 + d]; }
    for (int it = bid_; it < 2048; it += nb_s) {
        const int h = it & 3, c = (it >> 2) & 63, b = it >> 8, bh = b * 4 + h, tok0 = b * SEQ + c * 64;
        a_bf16x8 vfr[4];
        { const unsigned short* vrow = vT + ((size_t)bh * 256 + 32 * wid + r) * SEQ + c * 64;
#pragma unroll
          for (int ks = 0; ks < 4; ++ks) vfr[ks] = *(const a_bf16x8*)(vrow + 16 * ks + 8 * hh); }
        unsigned short qraw[16], kraw[16];
#pragma unroll
        for (int i = 0; i < 16; ++i) { const size_t o = (size_t)(tok0 + sg * 16 + i) * 1024 + h * 128 + d; qraw[i] = qk[o]; kraw[i] = qk[o + 512]; }
        gl[tid_] = glp0; gl[tid_ + 512] = glp1;
        float w[16];
#pragma unroll
        for (int k = 0; k < 16; ++k) w[k] = wp[k];
        const float bgv = bgp;
        { const int itn = it + nb_s;
          if (itn < 2048) { const int hn = itn & 3, cn = (itn >> 2) & 63, bn = itn >> 8, tokn = bn * SEQ + cn * 64;
              glp0 = glr[(size_t)tokn * 16 + tid_]; glp1 = glr[(size_t)tokn * 16 + tid_ + 512];
#pragma unroll
              for (int k = 0; k < 16; ++k) wp[k] = w2[k * 512 + hn * 128 + d];
              bgp = bgate[hn * 128 + d]; } }
        __syncthreads();
        float la[16]; float run = 0.f;
#pragma unroll
        for (int i = 0; i < 16; ++i) { const int s = sg * 16 + i; float z = bgv;
#pragma unroll
            for (int k = 0; k < 16; ++k) z += gl[s * 16 + k] * w[k];
            run += fast_logsigmoid(z) * (1.f / 16.f); la[i] = run; }
        gsum[sg * 128 + d] = run;
        __syncthreads();
        float pre = 0.f, tot = 0.f;
#pragma unroll
        for (int g = 0; g < 4; ++g) { const float v = gsum[g * 128 + d]; tot += v; pre += (g < sg) ? v : 0.f; }
        const float etot = fast_exp(tot);
#pragma unroll
        for (int i = 0; i < 16; ++i) { const int s = sg * 16 + i; const float bb = la[i] + pre;
            const float q = bf2f(qraw[i]), k = bf2f(kraw[i]);
            const float eb = fast_exp(bb), ieb = __builtin_amdgcn_rcpf(eb);
            qd[(size_t)(tok0 + s) * 512 + h * 128 + d] = f2bf(q * 0.08838834764831845f * eb);
            ki[(size_t)(tok0 + s) * 512 + h * 128 + d] = f2bf(k * ieb);
            *(LAS unsigned short*)(ket + d * 144 + s * 2) = f2bf(k * (etot * ieb)); }
        if (sg == 0) dl[(size_t)(bh * 64 + c) * 128 + d] = etot;
        __syncthreads();
        a_f32x16 acc[4];
#pragma unroll
        for (int dt = 0; dt < 4; ++dt)
#pragma unroll
            for (int i = 0; i < 16; ++i) acc[dt][i] = 0.f;
#pragma unroll
        for (int ks = 0; ks < 4; ++ks) {
            a_bf16x8 bfr[4];
#pragma unroll
            for (int dt = 0; dt < 4; ++dt) bfr[dt] = *(const LAS a_bf16x8*)(ket + (32 * dt + r) * 144 + (16 * ks + 8 * hh) * 2);
            __builtin_amdgcn_sched_barrier(0);
#pragma unroll
            for (int dt = 0; dt < 4; ++dt) acc[dt] = __builtin_amdgcn_mfma_f32_32x32x16_bf16(bfr[dt], vfr[ks], acc[dt], 0, 0, 0); }
        unsigned short* urow = UT + (size_t)(bh * 64 + c) * 256 * 128 + (size_t)(32 * wid + r) * 128 + 8 * hh;
#pragma unroll
        for (int dt = 0; dt < 4; ++dt)
#pragma unroll
            for (int c2 = 0; c2 < 4; c2 += 2) {
                const unsigned ax = pack_bf16_v(acc[dt][4 * c2], acc[dt][4 * c2 + 1]), ay = pack_bf16_v(acc[dt][4 * c2 + 2], acc[dt][4 * c2 + 3]);
                const unsigned bx = pack_bf16_v(acc[dt][4 * c2 + 4], acc[dt][4 * c2 + 5]), by = pack_bf16_v(acc[dt][4 * c2 + 6], acc[dt][4 * c2 + 7]);
                const auto rx = __builtin_amdgcn_permlane32_swap(ax, bx, false, false); const auto ry = __builtin_amdgcn_permlane32_swap(ay, by, false, false);
                *(uint4*)(urow + 32 * dt + 8 * c2) = make_uint4(rx[0], ry[0], rx[1], ry[1]); }
        __syncthreads();
    }
}
__device__ __forceinline__ void ph_gla_p2(const unsigned short* __restrict__ UT, const float* __restrict__ dl, unsigned short* __restrict__ ST) {
    LAUNDER();
#define GP2_LOAD(uu, dv, c0) do { _Pragma("unroll") for (int k_ = 0; k_ < 8; ++k_) { const size_t o_ = ((size_t)(bh * 64 + (c0) + k_) * 256 + e) * 128 + d4; \
        uu[k_] = *(const uint2*)(UT + o_); dv[k_] = *(const float4*)(dl + (size_t)(bh * 64 + (c0) + k_) * 128 + d4); } } while (0)
#define GP2_STEP(uu, dv, c0) do { _Pragma("unroll") for (int k_ = 0; k_ < 8; ++k_) { const size_t o_ = ((size_t)(bh * 64 + (c0) + k_) * 256 + e) * 128 + d4; \
        *(uint2*)(ST + o_) = make_uint2(pack_bf16(S.x, S.y), pack_bf16(S.z, S.w)); \
        S.x = S.x * dv[k_].x + bf2f((unsigned short)(uu[k_].x & 0xffff)); S.y = S.y * dv[k_].y + bf2f((unsigned short)(uu[k_].x >> 16)); \
        S.z = S.z * dv[k_].z + bf2f((unsigned short)(uu[k_].y & 0xffff)); S.w = S.w * dv[k_].w + bf2f((unsigned short)(uu[k_].y >> 16)); } } while (0)
    for (int idx = GTID; idx < 32 * 256 * 32; idx += GSZ) {
        const int bh = idx >> 13, rem = idx & 8191, e = rem >> 5, d4 = (rem & 31) * 4;
        float4 S = make_float4(0.f, 0.f, 0.f, 0.f);
        uint2 ua[8], ub[8]; float4 da[8], db[8];
        GP2_LOAD(ua, da, 0);
#pragma unroll 1
        for (int c0 = 0; c0 < 64; c0 += 16) {
            GP2_LOAD(ub, db, c0 + 8);
            GP2_STEP(ua, da, c0);
            if (c0 + 16 < 64) GP2_LOAD(ua, da, c0 + 16);
            GP2_STEP(ub, db, c0 + 8);
        }
    }
#undef GP2_LOAD
#undef GP2_STEP
}
__device__ __forceinline__ void ph_gla_p3(const unsigned short* qd, const unsigned short* ki, const unsigned short* vT, const unsigned short* ST, const unsigned short* rb,
                                          const float* ng, unsigned short* ob, LAS unsigned char* lds) {
    LAUNDER();
    const int wid = wv_s, lane = tid_ & 63, r = lane & 31, hh = lane >> 5;
    constexpr int PQ = 272;
    LAS unsigned char* QS = lds; LAS unsigned char* KS = lds + 64 * PQ; LAS float* SSQ = (LAS float*)(lds + 2 * 64 * PQ);
    LAS float* NGL = SSQ + 512;
    if (tid_ < 256) *(LAS g8::f32x4*)(NGL + tid_ * 4) = *(const g8::f32x4*)(ng + tid_ * 4);
    au32x4 qpre[2], kpre[2];
    if (bid_ < 2048) { const int h = bid_ & 3, c = (bid_ >> 2) & 63, b = bid_ >> 8, tok0 = b * SEQ + c * 64; const int row = tid_ >> 3, ch = tid_ & 7;
#pragma unroll
        for (int j = 0; j < 2; ++j) { qpre[j] = *(const au32x4*)(qd + (size_t)(tok0 + row) * 512 + h * 128 + (ch + 8 * j) * 8); kpre[j] = *(const au32x4*)(ki + (size_t)(tok0 + row) * 512 + h * 128 + (ch + 8 * j) * 8); } }
    for (int it = bid_; it < 2048; it += nb_s) {
        const int h = it & 3, c = (it >> 2) & 63, b = it >> 8, bh = b * 4 + h, tok0 = b * SEQ + c * 64;
        a_bf16x8 sf[8]; au32x2 vlo[3][2], vhi[3][2];
        uint2 rgp[2][4];
#pragma unroll
        for (int qt = 0; qt < 2; ++qt)
#pragma unroll
            for (int c4 = 0; c4 < 4; ++c4) rgp[qt][c4] = *(const uint2*)(rb + (size_t)(tok0 + 32 * qt + r) * 1024 + h * 256 + 32 * wid + 8 * c4 + 4 * hh);
        { const unsigned short* srow = ST + ((size_t)(bh * 64 + c) * 256 + 32 * wid + r) * 128;
          const unsigned short* vrow = vT + ((size_t)bh * 256 + 32 * wid + r) * SEQ + c * 64;
#pragma unroll
          for (int ks = 0; ks < 8; ++ks) sf[ks] = *(const a_bf16x8*)(srow + 16 * ks + 8 * hh);
#pragma unroll
          for (int t3 = 0; t3 < 3; ++t3) { const int st = t3 == 2 ? 1 : 0;
#pragma unroll
              for (int s2 = 0; s2 < 2; ++s2) { vlo[t3][s2] = *(const au32x2*)(vrow + 32 * st + 16 * s2 + 4 * hh); vhi[t3][s2] = *(const au32x2*)(vrow + 32 * st + 16 * s2 + 4 * hh + 8); } } }
        { const int row = tid_ >> 3, ch = tid_ & 7;
#pragma unroll
          for (int j = 0; j < 2; ++j) { *(LAS au32x4*)(QS + row * PQ + (ch + 8 * j) * 16) = qpre[j]; *(LAS au32x4*)(KS + row * PQ + (ch + 8 * j) * 16) = kpre[j]; }
          const int itn = it + nb_s;
          if (itn < 2048) { const int hn = itn & 3, cn = (itn >> 2) & 63, bn = itn >> 8, tokn = bn * SEQ + cn * 64;
#pragma unroll
              for (int j = 0; j < 2; ++j) { qpre[j] = *(const au32x4*)(qd + (size_t)(tokn + row) * 512 + hn * 128 + (ch + 8 * j) * 8); kpre[j] = *(const au32x4*)(ki + (size_t)(tokn + row) * 512 + hn * 128 + (ch + 8 * j) * 8); } } }
        __syncthreads();
        a_bf16x8 qfr[2][8];
#pragma unroll
        for (int qt = 0; qt < 2; ++qt)
#pragma unroll
            for (int ks = 0; ks < 8; ++ks) qfr[qt][ks] = *(const LAS a_bf16x8*)(QS + (32 * qt + r) * PQ + (16 * ks + 8 * hh) * 2);
        a_f32x16 att[3];
#pragma unroll
        for (int st = 0; st < 2; ++st) {
            a_bf16x8 kfr[8];
#pragma unroll
            for (int ks = 0; ks < 8; ++ks) kfr[ks] = *(const LAS a_bf16x8*)(KS + (32 * st + r) * PQ + (16 * ks + 8 * hh) * 2);
            __builtin_amdgcn_sched_barrier(0);
            if (st == 0) {
                a_f32x16 a0, a1;
#pragma unroll
                for (int i = 0; i < 16; ++i) { a0[i] = 0.f; a1[i] = 0.f; }
#pragma unroll
                for (int ks = 0; ks < 8; ++ks) { a0 = __builtin_amdgcn_mfma_f32_32x32x16_bf16(kfr[ks], qfr[0][ks], a0, 0, 0, 0); a1 = __builtin_amdgcn_mfma_f32_32x32x16_bf16(kfr[ks], qfr[1][ks], a1, 0, 0, 0); }
#pragma unroll
                for (int i = 0; i < 16; ++i) a0[i] = (AT_REGOFF(i) + 4 * hh <= r) ? a0[i] : 0.f;
                att[0] = a0; att[1] = a1;
            } else {
                a_f32x16 a2;
#pragma unroll
                for (int i = 0; i < 16; ++i) a2[i] = 0.f;
#pragma unroll
                for (int ks = 0; ks < 8; ++ks) a2 = __builtin_amdgcn_mfma_f32_32x32x16_bf16(kfr[ks], qfr[1][ks], a2, 0, 0, 0);
#pragma unroll
                for (int i = 0; i < 16; ++i) a2[i] = (AT_REGOFF(i) + 4 * hh <= r) ? a2[i] : 0.f;
                att[2] = a2;
            }
        }
        a_f32x16 O[2];
#pragma unroll
        for (int qt = 0; qt < 2; ++qt)
#pragma unroll
            for (int i = 0; i < 16; ++i) O[qt][i] = 0.f;
#pragma unroll
        for (int ks = 0; ks < 8; ++ks) {
            O[0] = __builtin_amdgcn_mfma_f32_32x32x16_bf16(sf[ks], qfr[0][ks], O[0], 0, 0, 0);
            O[1] = __builtin_amdgcn_mfma_f32_32x32x16_bf16(sf[ks], qfr[1][ks], O[1], 0, 0, 0); }
#pragma unroll
        for (int t3 = 0; t3 < 3; ++t3) { const int qt = t3 == 0 ? 0 : 1;
#pragma unroll
            for (int s2 = 0; s2 < 2; ++s2) {
                au32x4 pw = {pack_bf16(att[t3][8 * s2 + 0], att[t3][8 * s2 + 1]), pack_bf16(att[t3][8 * s2 + 2], att[t3][8 * s2 + 3]), pack_bf16(att[t3][8 * s2 + 4], att[t3][8 * s2 + 5]), pack_bf16(att[t3][8 * s2 + 6], att[t3][8 * s2 + 7])};
                au32x4 aw = {vlo[t3][s2].x, vlo[t3][s2].y, vhi[t3][s2].x, vhi[t3][s2].y};
                O[qt] = __builtin_amdgcn_mfma_f32_32x32x16_bf16(*reinterpret_cast<a_bf16x8*>(&aw), *reinterpret_cast<a_bf16x8*>(&pw), O[qt], 0, 0, 0); } }
#pragma unroll
        for (int qt = 0; qt < 2; ++qt) { float ss = 0.f;
#pragma unroll
            for (int i = 0; i < 16; ++i) ss += O[qt][i] * O[qt][i];
            ss = xhalf_sum(ss); if (hh == 0) SSQ[wid * 64 + 32 * qt + r] = ss; }
        __syncthreads();
#pragma unroll
        for (int qt = 0; qt < 2; ++qt) { float tot = 0.f;
#pragma unroll
            for (int w = 0; w < 8; ++w) tot += SSQ[w * 64 + 32 * qt + r];
            const float rn = rsqrtf(tot * (1.f / 256.f) + 1e-5f);
            const size_t orow = (size_t)(tok0 + 32 * qt + r) * 1024 + h * 256;
            unsigned pk[4][2];
#pragma unroll
            for (int c4 = 0; c4 < 4; ++c4) { const int e0 = 32 * wid + 8 * c4 + 4 * hh;
                const uint2 rg = rgp[qt][c4]; const g8::f32x4 gq = *(const LAS g8::f32x4*)(NGL + h * 256 + e0); const float4 gv = make_float4(gq[0], gq[1], gq[2], gq[3]);
                const float r0 = bf2f((unsigned short)(rg.x & 0xffff)), r1 = bf2f((unsigned short)(rg.x >> 16)), r2 = bf2f((unsigned short)(rg.y & 0xffff)), r3 = bf2f((unsigned short)(rg.y >> 16));
                pk[c4][0] = pack_bf16(O[qt][4 * c4] * rn * gv.x * fast_silu(r0), O[qt][4 * c4 + 1] * rn * gv.y * fast_silu(r1));
                pk[c4][1] = pack_bf16(O[qt][4 * c4 + 2] * rn * gv.z * fast_silu(r2), O[qt][4 * c4 + 3] * rn * gv.w * fast_silu(r3)); }
#pragma unroll
            for (int c4 = 0; c4 < 4; c4 += 2) {
                const auto rx = __builtin_amdgcn_permlane32_swap(pk[c4][0], pk[c4 + 1][0], false, false); const auto ry = __builtin_amdgcn_permlane32_swap(pk[c4][1], pk[c4 + 1][1], false, false);
                *(uint4*)(ob + orow + 32 * wid + 8 * c4 + 8 * hh) = make_uint4(rx[0], ry[0], rx[1], ry[1]); } }
        __syncthreads();
    }
}
__device__ __forceinline__ void ph_norm_router(const unsigned short* x, const float* g, const float* shift, const float* scale, int ldmod, unsigned short* hb,
                                               const float* rw, const float* rbias, int* topi, float* topw, int* cntb, int* stok, LAS unsigned char* lds) {
    LAUNDER();
    const int wid = wv_s, lane = tid_ & 63, e = lane & 31, kh = lane >> 5;
    LAS float* hs = (LAS float*)lds;
    constexpr int HSP = 1028;
    LAS float* part = (LAS float*)(lds + 16 * HSP * 4);
    LAS int* hist = (LAS int*)(lds + 16 * HSP * 4 + 16384);
    for (int i = GTID; i < CAP; i += GSZ) stok[i] = -1;
    g8::bf16x8 wh[4][2], wl[4][2];
#pragma unroll
    for (int ks = 0; ks < 4; ++ks)
#pragma unroll
        for (int nt = 0; nt < 2; ++nt) {
            unsigned hw[4], lw[4];
#pragma unroll
            for (int j2 = 0; j2 < 4; ++j2) { float w0 = rw[(128 * wid + 32 * ks + 8 * (lane >> 4) + 2 * j2) * 32 + 16 * nt + (lane & 15)], w1 = rw[(128 * wid + 32 * ks + 8 * (lane >> 4) + 2 * j2 + 1) * 32 + 16 * nt + (lane & 15)];
                const unsigned hp2 = pack_bf16(w0, w1); hw[j2] = hp2;
                lw[j2] = pack_bf16(w0 - __uint_as_float(hp2 << 16), w1 - __uint_as_float(hp2 & 0xffff0000u)); }
            au32x4 hv = {hw[0], hw[1], hw[2], hw[3]}, lv = {lw[0], lw[1], lw[2], lw[3]};
            wh[ks][nt] = *reinterpret_cast<g8::bf16x8*>(&hv); wl[ks][nt] = *reinterpret_cast<g8::bf16x8*>(&lv); }
    const float rbv = rbias[e];
    if (tid_ < 32) hist[tid_] = 0;
    __syncthreads();
    uint2 xr[2][4];
    float4 gg4[4], scn[4], shn[4];
#pragma unroll
    for (int j = 0; j < 4; ++j) gg4[j] = *(const float4*)(g + j * 256 + lane * 4);
    if (bid_ < NT / 16) {
#pragma unroll
        for (int rr = 0; rr < 2; ++rr)
#pragma unroll
            for (int j = 0; j < 4; ++j) xr[rr][j] = *(const uint2*)(x + (size_t)(bid_ * 16 + wid * 2 + rr) * DM + j * 256 + lane * 4);
        const int b0 = bid_ * 16 / SEQ;
#pragma unroll
        for (int j = 0; j < 4; ++j) { scn[j] = *(const float4*)(scale + b0 * ldmod + j * 256 + lane * 4); shn[j] = *(const float4*)(shift + b0 * ldmod + j * 256 + lane * 4); }
    }
    for (int tile = bid_; tile < NT / 16; tile += nb_s) {
        float4 ga4[4], sh4[4];
#pragma unroll
        for (int j = 0; j < 4; ++j) { ga4[j] = make_float4(gg4[j].x * (1.f + scn[j].x), gg4[j].y * (1.f + scn[j].y), gg4[j].z * (1.f + scn[j].z), gg4[j].w * (1.f + scn[j].w)); sh4[j] = shn[j]; }
#pragma unroll
        for (int rr = 0; rr < 2; ++rr) {
            const int trow = wid * 2 + rr, row = tile * 16 + trow;
            float4 v[4]; float ss = 0.f;
#pragma unroll
            for (int j = 0; j < 4; ++j) { const uint2 u = xr[rr][j]; v[j] = make_float4(__uint_as_float(u.x << 16), __uint_as_float(u.x & 0xffff0000u), __uint_as_float(u.y << 16), __uint_as_float(u.y & 0xffff0000u)); ss += v[j].x * v[j].x + v[j].y * v[j].y + v[j].z * v[j].z + v[j].w * v[j].w; }
#pragma unroll
            for (int o = 32; o > 0; o >>= 1) ss += SHX(ss, o);
            const float rn = rsqrtf(ss * (1.f / DM) + 1e-5f);
#pragma unroll
            for (int j = 0; j < 4; ++j) { const int col = j * 256 + lane * 4;
                float4 y;
                y.x = v[j].x * rn * ga4[j].x + sh4[j].x; y.y = v[j].y * rn * ga4[j].y + sh4[j].y; y.z = v[j].z * rn * ga4[j].z + sh4[j].z; y.w = v[j].w * rn * ga4[j].w + sh4[j].w;
                *(uint2*)(hb + (size_t)row * DM + col) = make_uint2(pack_bf16(y.x, y.y), pack_bf16(y.z, y.w));
                *(LAS g8::f32x4*)(hs + trow * HSP + col) = (g8::f32x4){y.x, y.y, y.z, y.w}; }
        }
        if (tile + nb_s < NT / 16) {
#pragma unroll
            for (int rr = 0; rr < 2; ++rr)
#pragma unroll
                for (int j = 0; j < 4; ++j) xr[rr][j] = *(const uint2*)(x + (size_t)((tile + nb_s) * 16 + wid * 2 + rr) * DM + j * 256 + lane * 4);
            const int bn = (tile + nb_s) * 16 / SEQ;
#pragma unroll
            for (int j = 0; j < 4; ++j) { scn[j] = *(const float4*)(scale + bn * ldmod + j * 256 + lane * 4); shn[j] = *(const float4*)(shift + bn * ldmod + j * 256 + lane * 4); }
        }
        __syncthreads();
        {
            g8::f32x4 acc0 = {0.f, 0.f, 0.f, 0.f}, acc1 = {0.f, 0.f, 0.f, 0.f};
            const LAS float* hp_ = hs + (lane & 15) * HSP + 128 * wid + 8 * (lane >> 4);
#pragma unroll
            for (int ks = 0; ks < 4; ++ks) {
                const g8::f32x4 x0 = *(const LAS g8::f32x4*)(hp_ + 32 * ks), x1 = *(const LAS g8::f32x4*)(hp_ + 32 * ks + 4);
                unsigned hh_[4], ll_[4];
                { unsigned p;
                  p = pack_bf16(x0[0], x0[1]); hh_[0] = p; ll_[0] = pack_bf16(x0[0] - __uint_as_float(p << 16), x0[1] - __uint_as_float(p & 0xffff0000u));
                  p = pack_bf16(x0[2], x0[3]); hh_[1] = p; ll_[1] = pack_bf16(x0[2] - __uint_as_float(p << 16), x0[3] - __uint_as_float(p & 0xffff0000u));
                  p = pack_bf16(x1[0], x1[1]); hh_[2] = p; ll_[2] = pack_bf16(x1[0] - __uint_as_float(p << 16), x1[1] - __uint_as_float(p & 0xffff0000u));
                  p = pack_bf16(x1[2], x1[3]); hh_[3] = p; ll_[3] = pack_bf16(x1[2] - __uint_as_float(p << 16), x1[3] - __uint_as_float(p & 0xffff0000u)); }
                au32x4 hv = {hh_[0], hh_[1], hh_[2], hh_[3]}, lv = {ll_[0], ll_[1], ll_[2], ll_[3]};
                const g8::bf16x8 ah = *reinterpret_cast<g8::bf16x8*>(&hv), al = *reinterpret_cast<g8::bf16x8*>(&lv);
                acc0 = __builtin_amdgcn_mfma_f32_16x16x32_bf16(ah, wh[ks][0], acc0, 0, 0, 0); acc1 = __builtin_amdgcn_mfma_f32_16x16x32_bf16(ah, wh[ks][1], acc1, 0, 0, 0);
                acc0 = __builtin_amdgcn_mfma_f32_16x16x32_bf16(ah, wl[ks][0], acc0, 0, 0, 0); acc1 = __builtin_amdgcn_mfma_f32_16x16x32_bf16(ah, wl[ks][1], acc1, 0, 0, 0);
                acc0 = __builtin_amdgcn_mfma_f32_16x16x32_bf16(al, wh[ks][0], acc0, 0, 0, 0); acc1 = __builtin_amdgcn_mfma_f32_16x16x32_bf16(al, wh[ks][1], acc1, 0, 0, 0);
            }
#pragma unroll
            for (int rg = 0; rg < 4; ++rg) { part[(wid * 16 + 4 * (lane >> 4) + rg) * 32 + (lane & 15)] = acc0[rg]; part[(wid * 16 + 4 * (lane >> 4) + rg) * 32 + 16 + (lane & 15)] = acc1[rg]; }
        }
        __syncthreads();
#pragma unroll
        for (int rr = 0; rr < 2; ++rr) {
            const int t = wid * 2 + rr, row = tile * 16 + t;
            float v = rbv;
#pragma unroll
            for (int w = 0; w < 8; ++w) v += part[(w * 16 + t) * 32 + e];
            int rank = 0;
#pragma unroll
            for (int e2 = 0; e2 < 32; ++e2) { const float ve = __uint_as_float(__builtin_amdgcn_readlane(__float_as_uint(v), e2)); rank += (ve > v || (ve == v && e2 < e)) ? 1 : 0; }
            float tv[4]; int ti[4];
#pragma unroll
            for (int r4 = 0; r4 < 4; ++r4) { const unsigned m = (unsigned)__ballot(rank == r4); const int lr = __builtin_ctz(m); ti[r4] = lr; tv[r4] = __uint_as_float(__builtin_amdgcn_readlane(__float_as_uint(v), lr)); }
            float w4[4], s = 0.f;
#pragma unroll
            for (int r4 = 0; r4 < 4; ++r4) { w4[r4] = expf(tv[r4] - tv[0]); s += w4[r4]; }
            if (lane == 0) {
                *(int4*)(topi + row * 4) = make_int4(ti[0], ti[1], ti[2], ti[3]);
                *(float4*)(topw + row * 4) = make_float4(w4[0] / s, w4[1] / s, w4[2] / s, w4[3] / s);
#pragma unroll
                for (int r4 = 0; r4 < 4; ++r4) (void)__hip_atomic_fetch_add(hist + ti[r4], 1, __ATOMIC_RELAXED, __HIP_MEMORY_SCOPE_WORKGROUP);
            }
        }
    }
    __syncthreads();
    if (tid_ < 32) cntb[bid_ * 32 + tid_] = hist[tid_];
}
__device__ __forceinline__ void ph_assign2(const int* topi, const int* cntb, int* cnt, int* stok, int* pos, int* tile_e, LAS unsigned char* lds) {
    LAUNDER();
    LAS int* ptot = (LAS int*)lds;
    LAS int* ppre = ptot + 512;
    LAS int* base = ppre + 512;
    LAS int* cur = base + 32;
    { const int e = tid_ & 31, ch = tid_ >> 5; int tot = 0, pre = 0;
      for (int j = 0; j < 16; ++j) { const int bb = ch * 16 + j; if (bb < nb_s) { const int v = cntb[bb * 32 + e]; tot += v; pre += bb < bid_ ? v : 0; } }
      ptot[ch * 32 + e] = tot; ppre[ch * 32 + e] = pre; }
    __syncthreads();
    if (tid_ < 32) { int tot = 0, pre = 0;
        for (int ch = 0; ch < 16; ++ch) { tot += ptot[ch * 32 + tid_]; pre += ppre[ch * 32 + tid_]; }
        ptot[tid_] = tot; ppre[tid_] = pre; cur[tid_] = 0; }
    __syncthreads();
    if (tid_ == 0) { int s = 0;
        for (int e = 0; e < NE; ++e) { base[e] = s + ppre[e]; const int p = (ptot[e] + MPAD - 1) / MPAD * MPAD;
            if (bid_ == 0) for (int tl = s / MPAD; tl < (s + p) / MPAD; ++tl) tile_e[tl] = e;
            s += p; }
        if (bid_ == 0) cnt[64 + NE] = s; }
    __syncthreads();
    if (tid_ < 64) {
        for (int t0 = bid_; t0 < NT / 16; t0 += 8 * nb_s) {
            int ev[8];
#pragma unroll
            for (int k = 0; k < 8; ++k) { const int tile = t0 + k * nb_s; ev[k] = tile < NT / 16 ? topi[tile * 64 + tid_] : -1; }
#pragma unroll
            for (int k = 0; k < 8; ++k) { const int tile = t0 + k * nb_s;
                if (ev[k] >= 0) { const int i = tile * 64 + tid_;
                    const int p = base[ev[k]] + __hip_atomic_fetch_add(cur + ev[k], 1, __ATOMIC_RELAXED, __HIP_MEMORY_SCOPE_WORKGROUP);
                    stok[p] = i >> 2; pos[i] = p; } }
        }
    }
}
__device__ __forceinline__ void ph_combine_norm(unsigned short* x, const unsigned short* y, const int* pos, const float* topw, const float* gate, int ldg,
                                                const float* g1, const float* sh1, const float* sc1, int ld1, unsigned short* hb,
                                                const float* gk, const float* shk, const float* sck, int ldk, unsigned short* hb2,
                                                const float* gfin, float* out, int* cnt, LAS unsigned char* lds) {
    LAUNDER();
    const int lane = tid_ & 63;
    if (GTID < 128) cnt[GTID] = 0;
    LAS float* KA = (LAS float*)lds; LAS float* KH = KA + 8 * DM;
    if (gk) {
        for (int i = tid_; i < 8 * DM / 4; i += NTHR) { const int bb = i >> 8, c4 = (i & 255) * 4;
            const float4 gg = *(const float4*)(gk + c4), sc = *(const float4*)(sck + bb * ldk + c4), sh = *(const float4*)(shk + bb * ldk + c4);
            *(LAS g8::f32x4*)(KA + bb * DM + c4) = (g8::f32x4){gg.x * (1.f + sc.x), gg.y * (1.f + sc.y), gg.z * (1.f + sc.z), gg.w * (1.f + sc.w)};
            *(LAS g8::f32x4*)(KH + bb * DM + c4) = (g8::f32x4){sh.x, sh.y, sh.z, sh.w}; }
        __syncthreads();
    }
    float4 g1v[4];
#pragma unroll
    for (int j = 0; j < 4; ++j) { g1v[j] = make_float4(0.f, 0.f, 0.f, 0.f); if (!gfin) g1v[j] = *(const float4*)(g1 + j * 256 + lane * 4); }
    int4 psn[2]; float4 twn[2];
    { const int r0 = (GTID >> 6) * 2;
#pragma unroll
      for (int q = 0; q < 2; ++q) { psn[q] = *(const int4*)(pos + (r0 + q) * 4); twn[q] = *(const float4*)(topw + (r0 + q) * 4); } }
    for (int row0 = (GTID >> 6) * 2; row0 < NT; row0 += (GSZ >> 6) * 2) {
        int4 ps[2]; float4 tw[2];
#pragma unroll
        for (int q = 0; q < 2; ++q) { ps[q] = psn[q]; tw[q] = twn[q]; }
        { const int rn_ = row0 + (GSZ >> 6) * 2;
          if (rn_ < NT) {
#pragma unroll
              for (int q = 0; q < 2; ++q) { psn[q] = *(const int4*)(pos + (rn_ + q) * 4); twn[q] = *(const float4*)(topw + (rn_ + q) * 4); } } }
        const int bq = row0 / SEQ;
        float4 gpv[4], s1v[4], h1v[4];
        uint2 yv[2][4][4], xu[2][4];
#pragma unroll
        for (int q = 0; q < 2; ++q)
#pragma unroll
            for (int j = 0; j < 4; ++j) { const int col = j * 256 + lane * 4;
                yv[q][0][j] = *(const uint2*)(y + (size_t)ps[q].x * DM + col); yv[q][1][j] = *(const uint2*)(y + (size_t)ps[q].y * DM + col);
                yv[q][2][j] = *(const uint2*)(y + (size_t)ps[q].z * DM + col); yv[q][3][j] = *(const uint2*)(y + (size_t)ps[q].w * DM + col);
                xu[q][j] = *(const uint2*)(x + (size_t)(row0 + q) * DM + col); }
#pragma unroll
        for (int j = 0; j < 4; ++j) { const int col = j * 256 + lane * 4;
            gpv[j] = *(const float4*)(gate + bq * ldg + col);
            s1v[j] = make_float4(0.f, 0.f, 0.f, 0.f); h1v[j] = s1v[j];
            if (!gfin) { s1v[j] = *(const float4*)(sc1 + bq * ld1 + col); h1v[j] = *(const float4*)(sh1 + bq * ld1 + col); }
            }
#pragma unroll
        for (int q = 0; q < 2; ++q) {
            const int row = row0 + q, b = row / SEQ;
            const float w4[4] = {tw[q].x, tw[q].y, tw[q].z, tw[q].w};
            float4 xn[4]; float ss = 0.f;
#pragma unroll
            for (int j = 0; j < 4; ++j) { const int col = j * 256 + lane * 4;
                float a0 = 0.f, a1 = 0.f, a2 = 0.f, a3 = 0.f;
#pragma unroll
                for (int r4 = 0; r4 < 4; ++r4) { const uint2 u = yv[q][r4][j]; const float w = w4[r4];
                    a0 += w * __uint_as_float(u.x << 16); a1 += w * __uint_as_float(u.x & 0xffff0000u); a2 += w * __uint_as_float(u.y << 16); a3 += w * __uint_as_float(u.y & 0xffff0000u); }
                const uint2 u = xu[q][j]; float4 xv = make_float4(__uint_as_float(u.x << 16), __uint_as_float(u.x & 0xffff0000u), __uint_as_float(u.y << 16), __uint_as_float(u.y & 0xffff0000u));
                const float4 gp = gpv[j];
                xv.x += gp.x * a0; xv.y += gp.y * a1; xv.z += gp.z * a2; xv.w += gp.w * a3;
                if (!gfin) *(uint2*)(x + (size_t)row * DM + col) = make_uint2(pack_bf16(xv.x, xv.y), pack_bf16(xv.z, xv.w));
                xn[j] = xv; ss += xv.x * xv.x + xv.y * xv.y + xv.z * xv.z + xv.w * xv.w; }
#pragma unroll
            for (int o = 32; o > 0; o >>= 1) ss += SHX(ss, o);
            const float rn = rsqrtf(ss * (1.f / DM) + 1e-5f);
#pragma unroll
            for (int j = 0; j < 4; ++j) { const int col = j * 256 + lane * 4;
                if (gfin) { const float4 gg = *(const float4*)(gfin + col); *(float4*)(out + (size_t)row * DM + col) = make_float4(xn[j].x * rn * gg.x, xn[j].y * rn * gg.y, xn[j].z * rn * gg.z, xn[j].w * rn * gg.w); }
                else {
                    { const float4 gg = g1v[j], sc = s1v[j], sh = h1v[j];
                      *(uint2*)(hb + (size_t)row * DM + col) = make_uint2(pack_bf16(xn[j].x * rn * gg.x * (1.f + sc.x) + sh.x, xn[j].y * rn * gg.y * (1.f + sc.y) + sh.y),
                                                                         pack_bf16(xn[j].z * rn * gg.z * (1.f + sc.z) + sh.z, xn[j].w * rn * gg.w * (1.f + sc.w) + sh.w)); }
                    if (gk) { const g8::f32x4 ga = *(const LAS g8::f32x4*)(KA + b * DM + col), sh = *(const LAS g8::f32x4*)(KH + b * DM + col);
                      *(uint2*)(hb2 + (size_t)row * DM + col) = make_uint2(pack_bf16(xn[j].x * rn * ga[0] + sh[0], xn[j].y * rn * ga[1] + sh[1]),
                                                                          pack_bf16(xn[j].z * rn * ga[2] + sh[2], xn[j].w * rn * ga[3] + sh[3])); }
                }
            }
        }
    }
}
#define PHASE(name, ...) __device__ __forceinline__ void name(KP kp, const int L) { asm volatile("" : "+s"(kp)); const P __attribute__((address_space(4)))& p = *kp; float* sm = dyn_smem(); (void)sm; \
    LAS unsigned char* lds = (LAS unsigned char*)dyn_smem(); (void)lds; (void)L; const float* md = p.mod + (size_t)L * 8 * 6144; (void)md;  __VA_ARGS__ }
#define ORDER(S, nM, nN) S.init(nM, nN, nb_s, (int)blockIdx.x)
#define ORDERW(S, nM, nN, W) S.init(nM, nN, nb_s, (int)blockIdx.x, W)

PHASE(f_prologue,
      ph_convT(p.gla_w_in, p.wt_gla_in, 1024, GLA_IN, 3328, 2, sm);
      ph_convT(p.gla_w_out, p.wt_gla_out, 1024, 1024, 1024, 2, sm);
      ph_convT(p.kv_w, p.wt_kv, 1024, KV_OUT, KV_OUT, 1, sm);
      ph_convT(p.nsa_w_in, p.wt_nsa_in, 1024, NSA_IN, 1280, 2, sm);
      ph_convT(p.nsa_w_out, p.wt_nsa_out, 1024, 1024, 1024, 2, sm);
      ph_convT(p.cmp_w1, p.wt_cmp1, 2048, 128, 256, 2, sm);
      ph_convT(p.moe_w_gu, p.wt_gu, 1024, 2048, 2048, 4 * NE, sm);
      ph_convT<true>(p.moe_w_down, p.wt_down, 1024, 1024, 1024, 4 * NE, sm);
      ph_c1(p.cmp_pos, p.cmp_w1, p.cmp_b1, p.c1, sm);
      { LAUNDER(); if (GTID < 128) p.cnt[GTID] = 0; }
      ph_mod(p.c, p.ada_w, p.ada_b, p.kv_ada_w, p.kv_ada_b, p.mod, p.kvmod, sm);)
PHASE(f_norm1, ph_norm(p.x_in, p.norm1_g + L * DM, md + 0, md + 1024, (float*)nullptr, p.hb, 6144);)
PHASE(f_gla_in, ProbPlain<1024> S; ORDER(S, NT / 256, 13); S.A = (const char*)p.hb; S.Bt = (const char*)(p.wt_gla_in + (size_t)L * 3328 * 1024); S.lda = 2048;
      g8::gemm_phase(lds, S, g8::EpiPair<PGlaIn>{PGlaIn{p.gqk, p.gvT, p.grb, p.glr, lds + LDS_X_OFF}}, wv_s);)
PHASE(f_gla_gate, ph_gla_p1(p.gqk, p.glr, p.gvT, p.gla_w_gate2 + L * 16 * 512, p.gla_b_gate + L * 512, p.gqd, p.gki, p.gdl, p.gUT, lds);)
PHASE(f_gla_rec, ph_gla_p2(p.gUT, p.gdl, p.gST);)
PHASE(f_gla_post, ph_gla_p3(p.gqd, p.gki, p.gvT, p.gST, p.grb, p.gla_norm_g + L * DM, p.ob, lds);)
PHASE(f_gla_out, ProbPlain<1024> S; ORDER(S, NT / 256, 4); S.A = (const char*)p.ob; S.Bt = (const char*)(p.wt_gla_out + (size_t)L * 1024 * 1024); S.lda = 2048;
      if (L == 0) g8::gemm_phase(lds, S, EpiResid<true>{p.x_in, p.x, md + 2048, 6144}, wv_s);
      else g8::gemm_phase(lds, S, EpiResid<false>{p.x, p.x, md + 2048, 6144}, wv_s);)
PHASE(f_nsa_in, ProbPlain<1024> S; ORDER(S, NT / 256, 5); S.A = (const char*)p.hb; S.Bt = (const char*)(p.wt_nsa_in + (size_t)(L - 2) * 1280 * 1024); S.lda = 2048;
      g8::gemm_phase(lds, S, g8::EpiPair<PNsaIn>{PNsaIn{p.qb, p.gates, p.nsa_b_gate + (L - 2) * 48}}, wv_s);)
PHASE(f_nsa_attn, ph_nsa_attn_mfma(p.qb, p.gates, p.kcmp, p.vcmpT, p.kslc, p.vslcT, p.kwin, p.vwinT, p.ob, p.cnt + 112, lds);)
PHASE(f_nsa_out, ProbPlain<1024> S; ORDER(S, NT / 256, 4); S.A = (const char*)p.ob; S.Bt = (const char*)(p.wt_nsa_out + (size_t)(L - 2) * 1024 * 1024); S.lda = 2048;
      g8::gemm_phase(lds, S, EpiResid<false>{p.x, p.x, md + 2048, 6144}, wv_s);)
PHASE(f_out_probe, ProbPlain<1024> S; ORDER(S, NT / 256, 4); S.A = (const char*)p.ob; S.Bt = (const char*)(L < 2 ? p.wt_gla_out + (size_t)L * 1024 * 1024 : p.wt_nsa_out + (size_t)(L - 2) * 1024 * 1024); S.lda = 2048;
      g8::gemm_phase(lds, S, EpiResid<false>{p.x, p.act, md + 2048, 6144}, wv_s);)
PHASE(f_comb_probe, const float* mdn = p.mod + (size_t)(L < 3 ? L + 1 : L) * 8 * 6144;
      ph_combine_norm(p.act, p.y, p.pos, p.topw, md + 5120, 6144, p.norm1_g + (L < 3 ? L + 1 : L) * DM, mdn + 0, mdn + 1024, 6144, p.qb,
                      (const float*)nullptr, p.kvmod + 0, p.kvmod + 1024, 2048, p.qb, (const float*)nullptr, p.out, p.cnt + 256, lds);)
PHASE(f_norm2, ph_norm_router(p.x, p.norm2_g + L * DM, md + 3072, md + 4096, 6144, p.hb, p.router_w + (size_t)L * DM * 32, p.router_b + L * 32, p.topi, p.topw, p.cntb, p.stok, lds);)
PHASE(f_assign, ph_assign2(p.topi, p.cntb, p.cnt, p.stok, p.pos, p.tile_e, lds);)
PHASE(f_moe_gu, ProbMoe<1024, true> S; ORDER(S, p.cnt[64 + NE] / 256, 8); S.A = (const char*)p.hb; S.Bt = (const char*)(p.wt_gu + (size_t)L * NE * 2048 * 1024); S.tok = p.stok; S.tile_e = p.tile_e;
      S.bias = p.moe_b_gu + (size_t)L * NE * 2048; S.nbias = 2048; S.estride = (size_t)2048 * 1024 * 2; S.xl = lds + LDS_X_OFF;
      g8::gemm_phase(lds, S, EpiSwiglu{p.act, lds + LDS_X_OFF}, wv_s);)
PHASE(f_moe_down, ProbMoe<1024, false> S; ORDER(S, p.cnt[64 + NE] / 256, 4); S.A = (const char*)p.act; S.Bt = (const char*)(p.wt_down + (size_t)L * NE * 1024 * 1024); S.tok = p.stok; S.tile_e = p.tile_e;
      S.bias = p.moe_b_down + (size_t)L * NE * DM; S.nbias = 1024; S.estride = (size_t)1024 * 1024 * 2; S.xl = lds + LDS_X_OFF;
      g8::gemm_phase(lds, S, EpiDown{p.y, lds + LDS_X_OFF}, wv_s);)
PHASE(f_combine, const float* mdn = p.mod + (size_t)(L + 1) * 8 * 6144;
      ph_combine_norm(p.x, p.y, p.pos, p.topw, md + 5120, 6144, p.norm1_g + (L + 1) * DM, mdn + 0, mdn + 1024, 6144, p.hb,
                      L == 1 ? p.kv_norm_g : (const float*)nullptr, p.kvmod + 0, p.kvmod + 1024, 2048, p.ob, L == 3 ? p.final_g : (const float*)nullptr, p.out, p.cnt, lds);)
PHASE(f_kv_gemm, ProbPlain<1024> S; ORDER(S, NT / 256, 6); S.A = (const char*)p.ob; S.Bt = (const char*)p.wt_kv; S.lda = 2048;
      g8::gemm_phase(lds, S, g8::EpiPair<PKv>{PKv{p.csrc, p.kslc, p.vslcT, p.kwin, p.vwinT, lds + LDS_X_OFF}}, wv_s);)
PHASE(f_cmp1, ProbCmp S; ORDER(S, 256, 1); S.csrc = (const char*)p.csrc; S.W1t = (const char*)p.wt_cmp1;
      g8::gemm_phase(lds, S, g8::EpiQuad<QCmp1>{QCmp1{p.hid}}, wv_s);)
PHASE(f_cmp2, ph_gemm(AHid4{p.hid, p.c1}, BCmp{p.cmp_w2, 64, (size_t)128 * 64}, ECmp2b{p.kcmp, p.vcmpT, p.cmp_b2}, NCMP, 64, 128, 64, sm);)

#define BAR() xcd_barrier(bar, wv_s)
#ifndef REP_GEMM
#define REP_GEMM 1
#endif
#ifndef REP_ATTN
#define REP_ATTN 1
#endif
#ifndef REP_MOE
#define REP_MOE 1
#endif
#ifndef REP_GLA
#define REP_GLA 1
#endif
#ifndef REP_OUT
#define REP_OUT 1
#endif
#ifndef REP_N2
#define REP_N2 1
#endif
#ifndef REP_ASG
#define REP_ASG 1
#endif
#ifndef REP_COMB
#define REP_COMB 1
#endif
#ifndef REP_PRO
#define REP_PRO 1
#endif
#define REPEAT(n, ...) { __VA_ARGS__ } if ((n) > 1) { __VA_ARGS__ } if ((n) > 2) { __VA_ARGS__ }
template <int L> __device__ __forceinline__ void layer(KP kp, const XcdBarrier& bar) {
    if (L == 0) { f_norm1(kp, L); BAR(); }
    if (L < 2) {
        REPEAT(REP_GEMM, f_gla_in(kp, L); BAR();) REPEAT(REP_GLA, f_gla_gate(kp, L); BAR(); f_gla_rec(kp, L); BAR(); f_gla_post(kp, L); BAR();) f_gla_out(kp, L); BAR(); if (REP_OUT > 1) { f_out_probe(kp, L); BAR(); }
    } else {
        REPEAT(REP_GEMM, f_nsa_in(kp, L); BAR();) REPEAT(REP_ATTN, f_nsa_attn(kp, L); BAR();) f_nsa_out(kp, L); BAR(); if (REP_OUT > 1) { f_out_probe(kp, L); BAR(); }
    }
    REPEAT(REP_N2, f_norm2(kp, L); BAR();) REPEAT(REP_ASG, f_assign(kp, L); BAR();)
    REPEAT(REP_MOE, f_moe_gu(kp, L); BAR(); f_moe_down(kp, L); BAR();) if (REP_COMB > 1) { f_comb_probe(kp, L); BAR(); } f_combine(kp, L); if (L < 3) BAR();
    if (L == 1) { REPEAT(REP_GEMM, f_kv_gemm(kp, L); BAR();) f_cmp1(kp, L); BAR(); f_cmp2(kp, L); BAR(); }
}
};
__global__ __launch_bounds__(NTHR, 2) void mega(P p_unused) {
    KP kp = (KP)__builtin_amdgcn_kernarg_segment_ptr();
    float* smem = dyn_smem();
    unsigned* bw = (unsigned*)smem + LDS_BAR_OFF / 4;
    if (threadIdx.x == 0) { bw[0] = 0u; bw[1] = 0u; bw[2] = 0u; bw[3] = 0u; }
    __syncthreads();
    XcdBarrier bar = xcd_barrier_post(kp->bar, (volatile LAS unsigned*)bw);
    Ctx cx; cx.nb_s = (int)gridDim.x; cx.wv_s = __builtin_amdgcn_readfirstlane(threadIdx.x >> 6);
    REPEAT(REP_PRO, cx.f_prologue(kp, 0); xcd_barrier(bar, cx.wv_s);)
    cx.layer<0>(kp, bar); cx.layer<1>(kp, bar); cx.layer<2>(kp, bar); cx.layer<3>(kp, bar);
}
}

extern "C" void kernel_launch(void* const* d_in, const int* in_sizes, int n_in, void* d_out, int out_size, void* d_ws, size_t ws_size, hipStream_t stream) {
    P p{};
    const float** pin = (const float**)&p;
    for (int i = 0; i < 30; ++i) pin[i] = (const float*)d_in[i];
    p.out = (float*)d_out;
    char* wp = (char*)d_ws; size_t off = 0;
    auto alloc = [&](size_t bytes) { void* q = wp + off; off += (bytes + 255) & ~(size_t)255; return q; };
    p.bar = (unsigned*)alloc(XCD_BAR_WORDS * 4);
    p.mod = (float*)alloc((size_t)4 * 8 * 6144 * 4);
    p.kvmod = (float*)alloc((size_t)8 * 2048 * 4);
    p.c1 = (float*)alloc(256 * 4);
    p.x = (unsigned short*)alloc((size_t)NT * DM * 2);
    p.hid = (float*)alloc((size_t)4 * 64 * NCMP * 128 * 4);
    p.gates = (float*)alloc((size_t)NT * 48 * 4);
    p.topi = (int*)alloc((size_t)NT * 4 * 4);
    p.topw = (float*)alloc((size_t)NT * 4 * 4);
    p.cnt = (int*)alloc(512 * 4);
    p.cntb = (int*)alloc((size_t)1024 * 32 * 4);
    p.stok = (int*)alloc((size_t)CAP * 4);
    p.pos = (int*)alloc((size_t)NT * 4 * 4);
    p.tile_e = (int*)alloc((size_t)(CAP / MPAD) * 4);
    p.y = (unsigned short*)alloc((size_t)CAP * DM * 2);
    p.hb = (unsigned short*)alloc((size_t)NT * DM * 2);
    p.ob = (unsigned short*)alloc((size_t)NT * DM * 2);
    p.act = (unsigned short*)alloc((size_t)CAP * DM * 2);
    p.csrc = (unsigned short*)alloc((size_t)64 * SEQ * 64 * 2 + 8192);
    p.qb = (unsigned short*)alloc((size_t)NT * DM * 2);
    p.kslc = (unsigned short*)alloc((size_t)32 * SEQ * 64 * 2);
    p.vslcT = (unsigned short*)alloc((size_t)32 * SEQ * 64 * 2);
    p.kwin = (unsigned short*)alloc((size_t)32 * SEQ * 64 * 2);
    p.vwinT = (unsigned short*)alloc((size_t)32 * SEQ * 64 * 2);
    p.kcmp = (unsigned short*)alloc((size_t)32 * 256 * 64 * 2);
    p.vcmpT = (unsigned short*)alloc((size_t)32 * 256 * 64 * 2);
    p.gqk = (unsigned short*)alloc((size_t)NT * 1024 * 2);
    p.gvT = (unsigned short*)alloc((size_t)NT * 1024 * 2);
    p.grb = (unsigned short*)alloc((size_t)NT * 1024 * 2);
    p.gqd = (unsigned short*)alloc((size_t)NT * 512 * 2);
    p.gki = (unsigned short*)alloc((size_t)NT * 512 * 2);
    p.gST = (unsigned short*)alloc((size_t)32 * 64 * 256 * 128 * 2);
    p.glr = (float*)alloc((size_t)NT * 16 * 4);
    p.gdl = (float*)alloc((size_t)32 * 64 * 128 * 4);
    p.gUT = (unsigned short*)alloc((size_t)32 * 64 * 256 * 128 * 2);
    p.wt_gla_in = (unsigned short*)alloc((size_t)2 * 3328 * 1024 * 2);
    p.wt_gla_out = (unsigned short*)alloc((size_t)2 * 1024 * 1024 * 2);
    p.wt_kv = (unsigned short*)alloc((size_t)KV_OUT * 1024 * 2);
    p.wt_nsa_in = (unsigned short*)alloc((size_t)2 * 1280 * 1024 * 2);
    p.wt_nsa_out = (unsigned short*)alloc((size_t)2 * 1024 * 1024 * 2);
    p.wt_cmp1 = (unsigned short*)alloc((size_t)2 * 256 * 2048 * 2);
    p.wt_gu = (unsigned short*)alloc((size_t)4 * NE * 2048 * 1024 * 2);
    p.wt_down = (unsigned short*)alloc((size_t)4 * NE * 1024 * 1024 * 2);
    if (off > ws_size) return;

    static int grid = 0;
    if (!grid) {
        int dev = 0, cus = 0, per_cu = 0;
        (void)hipGetDevice(&dev);
        (void)hipDeviceGetAttribute(&cus, hipDeviceAttributeMultiprocessorCount, dev);
        (void)hipFuncSetAttribute((const void*)mega, hipFuncAttributeMaxDynamicSharedMemorySize, (int)kDynLds);
        (void)hipOccupancyMaxActiveBlocksPerMultiprocessor(&per_cu, mega, NTHR, kDynLds);
        if (per_cu < 1) per_cu = 1;
        grid = cus * 1;
    }
    (void)hipMemsetAsync(p.bar, 0, XCD_BAR_WORDS * sizeof(unsigned), stream);
    hipLaunchKernelGGL(mega, dim3(grid), dim3(NTHR), kDynLds, stream, p);
}
```

```cpp
#include <hip/hip_runtime.h>
#include <stdint.h>
#include <math.h>

namespace {
constexpr int NB = 8, SEQ = 4096, DM = 1024, NT = NB * SEQ;
constexpr int GLA_IN = 3088, NSA_IN = 1072, KV_OUT = 1536;
constexpr int NE = 32, TOPK = 4, NASG = NT * TOPK;
constexpr int MPAD = 256;
constexpr int CAP = NASG + NE * MPAD;
constexpr int NCMP = 255;
constexpr int NTHR = 512;

__device__ __forceinline__ unsigned short f2bf(float f) { unsigned u = __float_as_uint(f); u += 0x7FFFu + ((u >> 16) & 1u); return (unsigned short)(u >> 16); }
typedef __bf16 hbf16x2_t __attribute__((ext_vector_type(2)));
typedef float hf32x2_t __attribute__((ext_vector_type(2)));
__device__ __forceinline__ unsigned pack_bf16(float lo, float hi) { const hf32x2_t v = {lo, hi}; const hbf16x2_t r = __builtin_convertvector(v, hbf16x2_t); return __builtin_bit_cast(unsigned, r); }
__device__ __forceinline__ unsigned pack_bf16_v(float lo, float hi) { return pack_bf16(lo, hi); }
__device__ __forceinline__ float fast_exp(float x) { return __builtin_amdgcn_exp2f(x * 1.4426950408889634f); }
__device__ __forceinline__ float fast_logsigmoid(float z) { return fminf(z, 0.f) - 0.6931471805599453f * __builtin_amdgcn_logf(1.f + __builtin_amdgcn_exp2f(-fabsf(z) * 1.4426950408889634f)); }
__device__ __forceinline__ float fast_silu(float x) { return x * __builtin_amdgcn_rcpf(1.f + __builtin_amdgcn_exp2f(-1.4426950408889634f * x)); }
__device__ __forceinline__ float sigm(float x) { return 1.f / (1.f + expf(-x)); }
__device__ __forceinline__ float siluf(float x) { return x / (1.f + expf(-x)); }
__device__ __forceinline__ float logsigmoidf(float z) { return fminf(z, 0.f) - log1pf(expf(-fabsf(z))); }
__device__ __forceinline__ float gelu_tanh(float x) { return 0.5f * x * (1.f + tanhf(0.7978845608028654f * (x + 0.044715f * x * x * x))); }

#define XB_TMO      128
#define XB_XCNT(j)  (256  + 64 * (j))
#define XB_XSUB(j)  (1280 + 64 * (j))
#define XB_XGEN(j)  (2304 + 64 * (j))
#define XB_TOP      3328
#define XB_TOPGEN   3392
#define XCD_BAR_WORDS 3456
#define XB_SPIN_CAP (1u << 22)
#define LAS __attribute__((address_space(3)))

__device__ __forceinline__ unsigned xb_ld(unsigned* p)              { return __hip_atomic_load(p, __ATOMIC_RELAXED, __HIP_MEMORY_SCOPE_AGENT); }
__device__ __forceinline__ unsigned xb_add(unsigned* p, unsigned v) { return __hip_atomic_fetch_add(p, v, __ATOMIC_RELAXED, __HIP_MEMORY_SCOPE_AGENT); }
__device__ __forceinline__ unsigned xb_xcc_id() { return (unsigned)__builtin_amdgcn_s_getreg((3 << 11) | 20) & 0xFu; }
#define XB_SPIN(cond, bar) do { unsigned _sp = 0; while (cond) { __builtin_amdgcn_s_sleep(1); \
    if ((++_sp & 255u) == 0u) { if (xb_ld(&(bar)[XB_TMO])) break; if (_sp > XB_SPIN_CAP) { atomicAdd(&(bar)[XB_TMO], 1u); break; } } } } while (0)

struct XcdBarrier { unsigned* bar; unsigned x; volatile LAS unsigned* st; };

__device__ __forceinline__ XcdBarrier xcd_barrier_post(unsigned* bar, volatile LAS unsigned* st) {
    XcdBarrier b; b.bar = bar; b.x = xb_xcc_id(); b.st = st;
    if (threadIdx.x == 0) (void)xb_add(&bar[XB_XCNT(b.x)], 1u);
    return b;
}
__device__ __forceinline__ void xcd_barrier_complete(unsigned* bar, unsigned x, unsigned& nloc, unsigned& nx) {
    const unsigned G = gridDim.x * gridDim.y * gridDim.z;
    unsigned sum, cnt, mine, sp = 0u;
    for (;;) {
        sum = 0u; cnt = 0u; mine = 0u;
#pragma unroll
        for (unsigned j = 0; j < 16; ++j) { const unsigned c = xb_ld(&bar[XB_XCNT(j)]); sum += c; cnt += (c > 0u) ? 1u : 0u; mine = (j == x) ? c : mine; }
        if (sum == G) break;
        __builtin_amdgcn_s_sleep(1);
        if ((++sp & 255u) == 0u) { if (xb_ld(&bar[XB_TMO])) break; if (sp > XB_SPIN_CAP) { atomicAdd(&bar[XB_TMO], 1u); break; } }
    }
    nloc = mine > 0u ? mine : 1u; nx = cnt > 0u ? cnt : 1u;
}
__device__ __forceinline__ void xcd_barrier(const XcdBarrier& b, int wv) {
    asm volatile("s_waitcnt vmcnt(0)" ::: "memory");
    __syncthreads();
    int ln_; asm volatile("v_mbcnt_lo_u32_b32 %0, -1, 0\n\tv_mbcnt_hi_u32_b32 %0, -1, %0" : "=v"(ln_));
    if (wv == 0 && ln_ == 0) {
        unsigned* bar = b.bar;
        __builtin_amdgcn_s_waitcnt(0);
        unsigned nloc = b.st[0], nx = b.st[1];
        if (nloc == 0u) { xcd_barrier_complete(bar, b.x, nloc, nx); b.st[0] = nloc; b.st[1] = nx; }
        const unsigned old = xb_add(&bar[XB_XSUB(b.x)], 1u);
        const unsigned gen = old / nloc;
        if (old + 1u == (gen + 1u) * nloc) {
            __builtin_amdgcn_fence(__ATOMIC_RELEASE, "agent");
            asm volatile("s_waitcnt vmcnt(0)" ::: "memory");
            const unsigned og = xb_add(&bar[XB_TOP], 1u);
            const unsigned tg = og / nx;
            if (og + 1u == (tg + 1u) * nx) xb_add(&bar[XB_TOPGEN], 1u);
            else XB_SPIN(xb_ld(&bar[XB_TOPGEN]) == tg, bar);
            __builtin_amdgcn_fence(__ATOMIC_ACQUIRE, "agent");
            xb_add(&bar[XB_XGEN(b.x)], 1u);
            asm volatile("s_waitcnt vmcnt(0)" ::: "memory");
        } else {
            XB_SPIN(xb_ld(&bar[XB_XGEN(b.x)]) == gen, bar);
            __builtin_amdgcn_fence(__ATOMIC_ACQUIRE, "agent");
            asm volatile("s_waitcnt vmcnt(0)" ::: "memory");
        }
    }
    __syncthreads();
}
struct ARow { const float* A; long lda; __device__ bool active(int, int) const { return true; } __device__ float operator()(int, int m, int k) const { return A[(size_t)m * lda + k]; } };
struct AGather { const float* A; const int* tok; const int* tile_e; __device__ bool active(int, int m0) const { return tile_e[m0 / MPAD] >= 0; }
    __device__ float operator()(int, int m, int k) const { const int t = tok[m]; return t >= 0 ? A[(size_t)t * DM + k] : 0.f; } };
struct ARowsIdx { const float* A; const int* tile_e; __device__ bool active(int, int m0) const { return tile_e[m0 / MPAD] >= 0; }
    __device__ float operator()(int, int m, int k) const { return A[(size_t)m * DM + k]; } };
struct ACmp { const float* kv6; const float* pos; __device__ bool active(int, int) const { return true; }
    __device__ float operator()(int z, int m, int k) const { const int t = z >> 5, b = (z >> 2) & 7, g = z & 3, l = k >> 6, d = k & 63;
        return kv6[(size_t)(b * SEQ + 16 * m + l) * KV_OUT + t * 256 + g * 64 + d] + pos[t * 2048 + k]; } };
struct AHid { const float* hid; __device__ bool active(int, int) const { return true; } __device__ float operator()(int z, int m, int k) const { return hid[((size_t)z * NCMP + m) * 128 + k]; } };
struct BMat { const float* B; long ldb; __device__ float operator()(int, int, int k, int n) const { return B[(size_t)k * ldb + n]; } };
struct BExpert { const float* B; const int* tile_e; long ldb; size_t estride; __device__ float operator()(int, int m0, int k, int n) const { const int e = tile_e[m0 / MPAD]; return B[(size_t)e * estride + (size_t)k * ldb + n]; } };
struct BCmp { const float* B; long ldb; size_t tstride; __device__ float operator()(int z, int, int k, int n) const { return B[(size_t)(z >> 5) * tstride + (size_t)k * ldb + n]; } };
struct EStore { float* C; long ldc; __device__ void operator()(int, int m, int, int n0, const float (&v)[8], int N) const {
#pragma unroll
    for (int j = 0; j < 8; ++j) if (n0 + j < N) C[(size_t)m * ldc + n0 + j] = v[j]; } };
struct EResid { float* X; const float* gate; long ldg; __device__ void operator()(int, int m, int, int n0, const float (&v)[8], int N) const { const int b = m / SEQ;
#pragma unroll
    for (int j = 0; j < 8; ++j) { const int n = n0 + j; X[(size_t)m * DM + n] += gate[b * ldg + n] * v[j]; } } };
struct ENsaIn { float* qn; float* gates; const float* bg; __device__ void operator()(int, int m, int, int n0, const float (&v)[8], int N) const {
#pragma unroll
    for (int j = 0; j < 8; ++j) { const int n = n0 + j; if (n < 1024) qn[(size_t)m * 1024 + n] = v[j] * 0.125f; else if (n < N) gates[(size_t)m * 48 + (n - 1024)] = sigm(v[j] + bg[n - 1024]); } } };
struct ESwiglu { float* act; const float* bgu; const int* tile_e; __device__ void operator()(int, int m, int m0, int n0, const float (&v)[8], int N) const { const int e = tile_e[m0 / MPAD];
#pragma unroll
    for (int j = 0; j < 4; ++j) { const int n = n0 + 2 * j; float gt = v[2 * j] + bgu[e * 2048 + n], up = v[2 * j + 1] + bgu[e * 2048 + n + 1];
        gt = fminf(gt, 7.f); up = fminf(fmaxf(up, -7.f), 7.f); act[(size_t)m * 1024 + (n >> 1)] = (up + 1.f) * gt * sigm(1.702f * gt); } } };
struct EDown { float* y; const float* bd; const int* tile_e; __device__ void operator()(int, int m, int m0, int n0, const float (&v)[8], int N) const { const int e = tile_e[m0 / MPAD];
#pragma unroll
    for (int j = 0; j < 8; ++j) y[(size_t)m * 1024 + n0 + j] = v[j] + bd[e * 1024 + n0 + j]; } };
struct ECmp1 { float* hid; const float* b1; __device__ void operator()(int z, int m, int, int n0, const float (&v)[8], int N) const {
#pragma unroll
    for (int j = 0; j < 8; ++j) if (n0 + j < N) hid[((size_t)z * NCMP + m) * 128 + n0 + j] = gelu_tanh(v[j] + b1[(z >> 5) * 128 + n0 + j]); } };
struct ECmp2 { float* comp; const float* b2; __device__ void operator()(int z, int m, int, int n0, const float (&v)[8], int N) const {
#pragma unroll
    for (int j = 0; j < 8; ++j) if (n0 + j < N) comp[((size_t)z * NCMP + m) * 64 + n0 + j] = v[j] + b2[(z >> 5) * 64 + n0 + j]; } };

struct ECmp2b { unsigned short* kcmp; unsigned short* vcmpT; const float* b2; __device__ void operator()(int z, int m, int, int n0, const float (&v)[8], int N) const { const int t = z >> 5, bg = z & 31;
#pragma unroll
    for (int j = 0; j < 8; ++j) { const int d = n0 + j; if (d < N) { const unsigned short o = f2bf(v[j] + b2[t * 64 + d]); if (t == 0) kcmp[((size_t)bg * 256 + m) * 64 + d] = o; else vcmpT[((size_t)bg * 64 + d) * 256 + ((m & ~15) | (((m >> 2) & 1) << 3) | (((m >> 3) & 1) << 2) | (m & 3))] = o; } } } };
struct AHid4 { const float* hidp; const float* c1; __device__ bool active(int, int) const { return true; } __device__ float operator()(int z, int m, int k) const {
    const size_t o = ((size_t)z * NCMP + m) * 128 + k, st = (size_t)64 * NCMP * 128;
    return gelu_tanh(hidp[o] + hidp[o + st] + hidp[o + 2 * st] + hidp[o + 3 * st] + c1[(z >> 5) * 128 + k]); } };
namespace g8 {
typedef unsigned short bf16_t;
typedef short bf16x8 __attribute__((ext_vector_type(8)));
typedef float f32x4 __attribute__((ext_vector_type(4)));
constexpr bool TAIL_HALVES = false;
constexpr int BM = 256, BK = 64, HALF = 128, HTB = HALF * BK * 2, STAGE_BYTES = 8 * HTB, NXCD = 8, WGM = 8;

__device__ __forceinline__ int lds_byte(int r, int c) { const int st = (r >> 4) * 2 + (c >> 5), rr = r & 15, cc = c & 31, ob = rr * 64 + cc * 2; return st * 1024 + (ob ^ (((ob >> 9) & 1) << 5)); }
__device__ __forceinline__ void stage_rc(int b, int& R, int& C) { const int st = b / 1024, sb = b % 1024, swz = sb ^ (((sb >> 9) & 1) << 5); R = (st >> 1) * 16 + swz / 64; C = (st & 1) * 32 + (swz % 64) / 2; }

struct Unit { int pm, pn, ord, half; };
struct Order {
    int nM, nN, nwg, G, c, wgm;
    __device__ __forceinline__ void init(int nM_, int nN_, int G_, int c_, int wgm_ = WGM) { nM = nM_; nN = nN_; nwg = nM * nN; G = G_; c = c_; wgm = wgm_; }
    __device__ __forceinline__ bool next(int i, Unit& u) const {
        long L = (long)i * G + c; u.ord = i; u.half = -1;
        const int F = nwg / G, r = nwg - F * G;
        if (TAIL_HALVES && r > 0 && 2 * r <= G && L >= (long)F * G) { const long h = L - (long)F * G; if (h >= 2 * r) return false; u.half = (int)(h & 1); L = (long)F * G + (h >> 1); }
        if (L >= nwg) return false;
        int wgid = (int)L; { const int q = nwg / NXCD, rr = nwg % NXCD, xcd = wgid % NXCD, off = wgid / NXCD; wgid = (xcd < rr ? xcd * (q + 1) : rr * (q + 1) + (xcd - rr) * q) + off; }
        const int nig = wgm * nN, gid = wgid / nig, fm = gid * wgm, gsz = (nM - fm) < wgm ? (nM - fm) : wgm;
        u.pm = fm + ((wgid % nig) % gsz); u.pn = (wgid % nig) / gsz; return true;
    }
};

template <class Prob, class Epi>
__device__ __forceinline__ void gemm_phase(LAS unsigned char* lds, const Prob& S, const Epi& E, int wv) {
    int tz; asm volatile("v_mbcnt_lo_u32_b32 %0, -1, 0\n\tv_mbcnt_hi_u32_b32 %0, -1, %0" : "=v"(tz)); tz += wv * 64;
    const int tid = tz, wid = __builtin_amdgcn_readfirstlane(tid >> 6), lane = tid & 63, wr = wid >> 2, wc = wid & 3, fr = lane & 15, fq = lane >> 4;
    constexpr int K = Prob::K, nt = K / BK;
    int Rr[2], Cc[2];
    unsigned voffB[2];
#pragma unroll
    for (int i = 0; i < 2; ++i) { stage_rc(tid * 16 + i * 8192, Rr[i], Cc[i]); voffB[i] = (unsigned)(Rr[i] * Prob::LDB + Cc[i]) * 2u; }
    const size_t kstep = (size_t)(BK * 2);
    const size_t hstepB = (size_t)HALF * Prob::LDB * 2;
    const unsigned ldsw = (unsigned)wid * 1024u;
    const int aoff = lds_byte(wr * 64 + fr, fq * 8), boff = lds_byte(wc * 32 + fr, fq * 8);
#define G8_SA(b, h) (((b) * 2 + (h)) * HTB)
#define G8_SB(b, h) ((4 + (b) * 2 + (h)) * HTB)
#define G8_STAGE(bufoff, gbase, voff) do { _Pragma("unroll") for (int _i = 0; _i < 2; ++_i) \
        __builtin_amdgcn_global_load_lds((const unsigned*)((const char*)(gbase) + (voff)[_i]), (LAS unsigned*)(lds + (bufoff) + ldsw + _i * 8192), 16, 0, 0); } while (0)
#define G8_LDA(dst, b, h) do { _Pragma("unroll") for (int m = 0; m < 4; ++m) _Pragma("unroll") for (int k = 0; k < 2; ++k) dst[m][k] = *(const LAS bf16x8*)(lds + G8_SA(b, h) + aoff + m * 2048 + k * 1024); } while (0)
#define G8_LDB(dst, b, h) do { _Pragma("unroll") for (int n = 0; n < 2; ++n) _Pragma("unroll") for (int k = 0; k < 2; ++k) dst[n][k] = *(const LAS bf16x8*)(lds + G8_SB(b, h) + boff + n * 2048 + k * 1024); } while (0)
#define G8_MMA(ai, bj, At, Bt) do { __builtin_amdgcn_s_setprio(1); _Pragma("unroll") for (int m = 0; m < 4; ++m) _Pragma("unroll") for (int n = 0; n < 2; ++n) _Pragma("unroll") for (int k = 0; k < 2; ++k) \
        acc[ai][bj][m][n] = __builtin_amdgcn_mfma_f32_16x16x32_bf16(Bt[n][k], At[m][k], acc[ai][bj][m][n], 0, 0, 0); __builtin_amdgcn_s_setprio(0); } while (0)
#define G8_WAIT_V(n) asm volatile("s_waitcnt vmcnt(" #n ")" ::: "memory")
#define G8_WAIT_L(n) asm volatile("s_waitcnt lgkmcnt(" #n ")" ::: "memory")
#define G8_BAR __builtin_amdgcn_s_barrier()
#define G8_SCHED __builtin_amdgcn_sched_barrier(0)
#define G8_AOFFS(dst, u) do { _Pragma("unroll") for (int _h = 0; _h < 2; ++_h) _Pragma("unroll") for (int _i = 0; _i < 2; ++_i) dst[_h][_i] = S.a_off(u, _h * HALF + Rr[_i]) + (unsigned)Cc[_i] * 2u; } while (0)
    S.prep(tid);
    Unit cur, nxt; int ui = 0;
    if (!S.next(0, cur)) return;
    f32x4 acc[2][2][4][2];
#pragma unroll
    for (int a = 0; a < 2; ++a)
#pragma unroll
        for (int b = 0; b < 2; ++b)
#pragma unroll
            for (int m = 0; m < 4; ++m)
#pragma unroll
                for (int n = 0; n < 2; ++n) acc[a][b][m][n] = (f32x4){0.f, 0.f, 0.f, 0.f};
    bf16x8 At[4][2], B0[2][2], B1[2][2];
    unsigned vA[2][2], nvA[2][2];
    const char* cA = S.a_base(cur); const char* cB = S.b_base(cur) + (cur.half > 0 ? hstepB : 0);
    size_t h2c = cur.half >= 0 ? 0 : hstepB;
    G8_AOFFS(vA, cur);
    S.unit_begin(cur, wid, lane);
    G8_STAGE(G8_SB(0, 0), cB, voffB); G8_STAGE(G8_SA(0, 0), cA, vA[0]); G8_STAGE(G8_SB(0, 1), cB + h2c, voffB); G8_STAGE(G8_SA(0, 1), cA, vA[1]);
    if (wr == 1) G8_BAR;
    G8_WAIT_V(4); G8_BAR;
    G8_STAGE(G8_SB(1, 0), cB + kstep, voffB); G8_STAGE(G8_SA(1, 0), cA + kstep, vA[0]); G8_STAGE(G8_SB(1, 1), cB + h2c + kstep, voffB);
    G8_WAIT_V(6); G8_BAR;
    for (;;) {
        const bool has_next = S.next(ui + 1, nxt);
        const char* nA = has_next ? S.a_base(nxt) : cA; const char* nB = has_next ? S.b_base(nxt) + (nxt.half > 0 ? hstepB : 0) : cB;
        const size_t h2n = has_next ? (nxt.half >= 0 ? 0 : hstepB) : h2c;
        const bool chalf = cur.half >= 0;
        if (has_next) { G8_AOFFS(nvA, nxt); } else {
#pragma unroll
            for (int _h = 0; _h < 2; ++_h)
#pragma unroll
                for (int _i = 0; _i < 2; ++_i) nvA[_h][_i] = vA[_h][_i]; }
#pragma unroll 1
        for (int t = 0; t < nt; t += 2) {
            const bool last = (t == nt - 2);
            const char* a1 = cA + (size_t)(t + 1) * kstep;
            const char* a2 = last ? nA : cA + (size_t)(t + 2) * kstep; const char* b2 = last ? nB : cB + (size_t)(t + 2) * kstep;
            const char* a3 = a2 + kstep; const char* b3 = b2 + kstep; const size_t hs2 = last ? h2n : h2c;
            unsigned w0[2], w1[2];
#pragma unroll
            for (int _i = 0; _i < 2; ++_i) { w0[_i] = last ? nvA[0][_i] : vA[0][_i]; w1[_i] = last ? nvA[1][_i] : vA[1][_i]; }
            G8_LDB(B0, 0, 0); G8_SCHED; G8_LDA(At, 0, 0); G8_STAGE(G8_SA(1, 1), a1, vA[1]);
            G8_WAIT_L(8); G8_BAR; G8_WAIT_L(0); G8_MMA(0, 0, At, B0); G8_BAR; G8_SCHED;
            if (!chalf) { G8_LDB(B1, 0, 1); } G8_STAGE(G8_SB(0, 0), b2, voffB);
            G8_BAR; G8_WAIT_L(0); if (!chalf) { G8_MMA(0, 1, At, B1); } G8_BAR;
            G8_LDA(At, 0, 1); G8_STAGE(G8_SA(0, 0), a2, w0);
            G8_BAR; G8_WAIT_L(0); G8_MMA(1, 0, At, B0); G8_BAR; G8_SCHED;
            G8_STAGE(G8_SB(0, 1), b2 + hs2, voffB);
            G8_WAIT_V(6); G8_BAR; if (!chalf) { G8_MMA(1, 1, At, B1); } G8_BAR;
            G8_LDB(B0, 1, 0); G8_SCHED; G8_LDA(At, 1, 0); G8_STAGE(G8_SA(0, 1), a2, w1);
            G8_WAIT_L(8); G8_BAR; G8_WAIT_L(0); G8_MMA(0, 0, At, B0); G8_BAR; G8_SCHED;
            if (!chalf) { G8_LDB(B1, 1, 1); } G8_STAGE(G8_SB(1, 0), b3, voffB);
            G8_BAR; G8_WAIT_L(0); if (!chalf) { G8_MMA(0, 1, At, B1); } G8_BAR;
            G8_LDA(At, 1, 1); G8_STAGE(G8_SA(1, 0), a3, w0);
            G8_BAR; G8_WAIT_L(0); G8_MMA(1, 0, At, B0); G8_BAR; G8_SCHED;
            G8_STAGE(G8_SB(1, 1), b3 + hs2, voffB);
            G8_WAIT_V(6); G8_BAR; if (!chalf) { G8_MMA(1, 1, At, B1); } G8_BAR;
        }
        if (wr == 0) G8_BAR;
        E(acc, cur, wr, wc, fr, fq);
        if (!has_next) break;
#pragma unroll
        for (int a = 0; a < 2; ++a)
#pragma unroll
            for (int b = 0; b < 2; ++b)
#pragma unroll
                for (int m = 0; m < 4; ++m)
#pragma unroll
                    for (int n = 0; n < 2; ++n) acc[a][b][m][n] = (f32x4){0.f, 0.f, 0.f, 0.f};
        cur = nxt; cA = nA; cB = nB; h2c = h2n; ++ui;
        S.unit_begin(cur, wid, lane);
#pragma unroll
        for (int _h = 0; _h < 2; ++_h)
#pragma unroll
            for (int _i = 0; _i < 2; ++_i) vA[_h][_i] = nvA[_h][_i];
        if (wr == 1) G8_BAR;
    }
    G8_WAIT_V(0);
    G8_BAR;
#undef G8_SA
#undef G8_SB
#undef G8_STAGE
#undef G8_LDA
#undef G8_LDB
#undef G8_MMA
#undef G8_WAIT_V
#undef G8_WAIT_L
#undef G8_BAR
#undef G8_SCHED
#undef G8_AOFFS
}

template <class F> struct EpiQuad {
    F f;
    __device__ __forceinline__ void operator()(const f32x4 (&acc)[2][2][4][2], const Unit& u, int wr, int wc, int fr, int fq) const {
#pragma unroll
        for (int ai = 0; ai < 2; ++ai)
#pragma unroll
            for (int m = 0; m < 4; ++m) { const int row = u.pm * BM + ai * HALF + wr * 64 + m * 16 + fr;
#pragma unroll
                for (int bj = 0; bj < 2; ++bj) { if (u.half >= 0 && bj == 1) continue;
#pragma unroll
                    for (int n = 0; n < 2; ++n) f(u, row, u.pn * BM + (u.half >= 0 ? u.half : bj) * HALF + wc * 32 + n * 16 + 4 * fq, acc[ai][bj][m][n]); } }
    }
};
template <class F> struct EpiPair {
    F f;
    __device__ __forceinline__ void operator()(const f32x4 (&acc)[2][2][4][2], const Unit& u, int wr, int wc, int fr, int fq) const {
#pragma unroll
        for (int ai = 0; ai < 2; ++ai)
#pragma unroll
            for (int m = 0; m < 4; ++m) { const int row = u.pm * BM + ai * HALF + wr * 64 + m * 16 + fr;
#pragma unroll
                for (int bj = 0; bj < 2; ++bj) { if (u.half >= 0 && bj == 1) continue;
                    f(u, row, u.pn * BM + (u.half >= 0 ? u.half : bj) * HALF + wc * 32, fq, wr * 4 + wc, acc[ai][bj][m][0], acc[ai][bj][m][1]); } }
    }
};
}
using g8::Unit; using g8::f32x4;
template <int K_> struct ProbPlain : g8::Order {
    static constexpr int K = K_, LDB = K_;
    const char* A; const char* Bt; long lda;
    __device__ __forceinline__ void prep(int) const {}
    __device__ __forceinline__ void unit_begin(const Unit&, int, int) const {}
    __device__ __forceinline__ const char* a_base(const Unit& u) const { return A + (size_t)u.pm * 256 * lda; }
    __device__ __forceinline__ unsigned a_off(const Unit&, int row) const { return (unsigned)(row * lda); }
    __device__ __forceinline__ const char* b_base(const Unit& u) const { return Bt + (size_t)u.pn * 256 * K * 2; }
};
constexpr int MX_TE = 0, MX_AOFF = 2240, MX_BIAS = MX_AOFF + 18 * 1024, MX_END = MX_BIAS + 2048;
template <int K_, bool GATHER> struct ProbMoe : g8::Order {
    static constexpr int K = K_, LDB = K_;
    const char* A; const char* Bt; const int* tok; const int* tile_e; const float* bias; size_t estride; int nbias; LAS unsigned char* xl;
    __device__ __forceinline__ void prep(int tid) const {
        LAS int* te = (LAS int*)(xl + MX_TE);
        for (int i = tid; i < nM; i += NTHR) te[i] = tile_e[i];
        if (GATHER) { LAS unsigned* ao = (LAS unsigned*)(xl + MX_AOFF); int tv[18];
#pragma unroll
            for (int i = 0; i < 18; ++i) { Unit u; tv[i] = -1; if (tid < 256 && next(i, u)) tv[i] = tok[u.pm * 256 + tid]; }
#pragma unroll
            for (int i = 0; i < 18; ++i) if (tid < 256) ao[i * 256 + tid] = tv[i] >= 0 ? (unsigned)tv[i] * (K * 2) : 0u; }
        __syncthreads();
    }
    __device__ __forceinline__ int expert(const Unit& u) const { return __builtin_amdgcn_readfirstlane(((LAS int*)(xl + MX_TE))[u.pm]); }
    __device__ __forceinline__ void unit_begin(const Unit& u, int wid, int lane) const {
        if (wid == 0) __builtin_amdgcn_global_load_lds((const unsigned*)(bias + (size_t)expert(u) * nbias + u.pn * 256 + lane * 4), (LAS unsigned*)(xl + MX_BIAS + (u.ord & 1) * 1024), 16, 0, 0);
    }
    __device__ __forceinline__ const char* a_base(const Unit& u) const { return GATHER ? A : A + (size_t)u.pm * 256 * K * 2; }
    __device__ __forceinline__ unsigned a_off(const Unit& u, int row) const { if (GATHER) return ((LAS unsigned*)(xl + MX_AOFF))[u.ord * 256 + row]; return (unsigned)(row * K * 2); }
    __device__ __forceinline__ const char* b_base(const Unit& u) const { return Bt + (size_t)expert(u) * estride + (size_t)u.pn * 256 * K * 2; }
};
struct ProbCmp : g8::Order {
    static constexpr int K = 512, LDB = 2048;
    const char* csrc; const char* W1t;
    __device__ __forceinline__ void prep(int) const {}
    __device__ __forceinline__ void unit_begin(const Unit&, int, int) const {}
    __device__ __forceinline__ const char* a_base(const Unit& u) const { return csrc + (size_t)(u.pm >> 2) * SEQ * 64 * 2 + (u.pm & 3) * 1024; }
    __device__ __forceinline__ unsigned a_off(const Unit&, int row) const { return (unsigned)(row * 2048); }
    __device__ __forceinline__ const char* b_base(const Unit& u) const { return W1t + (size_t)(u.pm >> 7) * 256 * 2048 * 2 + (u.pm & 3) * 1024; }
};
typedef unsigned au32x2_ __attribute__((ext_vector_type(2)));
__device__ __forceinline__ uint2 pk4(const f32x4& v) { return make_uint2(pack_bf16(v[0], v[1]), pack_bf16(v[2], v[3])); }
__device__ __forceinline__ void st_pair16(unsigned short* grp, int fq, uint2 qa, uint2 qb) {
    const auto rx = __builtin_amdgcn_permlane16_swap(qa.x, qb.x, false, false);
    const auto ry = __builtin_amdgcn_permlane16_swap(qa.y, qb.y, false, false);
    *(uint4*)(grp + ((fq & 1) ? 16 + 4 * (fq - 1) : 4 * fq)) = make_uint4(rx[0], ry[0], rx[1], ry[1]);
}
struct QStoreF32 { float* C; long ldc; int N; __device__ __forceinline__ void operator()(const Unit&, int row, int col, const f32x4& v) const { if (col < N) *(f32x4*)(C + (size_t)row * ldc + col) = v; } };
template <bool INF32> struct EpiResid {
    const void* Xin; unsigned short* Xout; const float* gate; long ldg;
    __device__ __forceinline__ void operator()(const f32x4 (&acc)[2][2][4][2], const Unit& u, int wr, int wc, int fr, int fq) const {
        const int row0 = u.pm * 256 + wr * 64 + fr, col0 = u.pn * 256 + wc * 32 + 4 * fq, b = (u.pm * 256) / SEQ;
        if (u.half >= 0) {
#pragma unroll
            for (int ai = 0; ai < 2; ++ai)
#pragma unroll
                for (int m = 0; m < 4; ++m)
#pragma unroll
                    for (int n = 0; n < 2; ++n) { const size_t o_ = (size_t)(row0 + ai * 128 + m * 16) * DM + col0 + u.half * 128 + n * 16;
                        const f32x4 g4 = *(const f32x4*)(gate + b * ldg + col0 + u.half * 128 + n * 16); f32x4 xv;
                        if (INF32) xv = *(const f32x4*)((const float*)Xin + o_);
                        else { const uint2 q = *(const uint2*)((const unsigned short*)Xin + o_); xv = (f32x4){__uint_as_float(q.x << 16), __uint_as_float(q.x & 0xffff0000u), __uint_as_float(q.y << 16), __uint_as_float(q.y & 0xffff0000u)}; }
                        const f32x4 o = xv + g4 * acc[ai][0][m][n]; *(uint2*)(Xout + o_) = make_uint2(pack_bf16(o[0], o[1]), pack_bf16(o[2], o[3])); }
            return;
        }
        f32x4 gv[2][2];
#pragma unroll
        for (int bj = 0; bj < 2; ++bj)
#pragma unroll
            for (int n = 0; n < 2; ++n) gv[bj][n] = *(const f32x4*)(gate + b * ldg + col0 + bj * 128 + n * 16);
        if (INF32) {
#pragma unroll
            for (int ai = 0; ai < 2; ++ai) {
#pragma unroll
                for (int bj = 0; bj < 2; ++bj) {
                    f32x4 xv[4][2];
#pragma unroll
                    for (int m = 0; m < 4; ++m)
#pragma unroll
                        for (int n = 0; n < 2; ++n) xv[m][n] = *(const f32x4*)((const float*)Xin + (size_t)(row0 + ai * 128 + m * 16) * DM + col0 + bj * 128 + n * 16);
                    __builtin_amdgcn_sched_barrier(0);
#pragma unroll
                    for (int m = 0; m < 4; ++m)
                        { const f32x4 o0 = xv[m][0] + gv[bj][0] * acc[ai][bj][m][0], o1 = xv[m][1] + gv[bj][1] * acc[ai][bj][m][1];
                          st_pair16(Xout + (size_t)(row0 + ai * 128 + m * 16) * DM + u.pn * 256 + wc * 32 + bj * 128, fq, pk4(o0), pk4(o1)); }
                }
            }
        } else {
            uint2 xu[2][4][2][2];
#pragma unroll
            for (int ai = 0; ai < 2; ++ai)
#pragma unroll
                for (int m = 0; m < 4; ++m)
#pragma unroll
                    for (int bj = 0; bj < 2; ++bj)
#pragma unroll
                        for (int n = 0; n < 2; ++n) xu[ai][m][bj][n] = *(const uint2*)((const unsigned short*)Xin + (size_t)(row0 + ai * 128 + m * 16) * DM + col0 + bj * 128 + n * 16);
            __builtin_amdgcn_sched_barrier(0);
#pragma unroll
            for (int ai = 0; ai < 2; ++ai)
#pragma unroll
                for (int m = 0; m < 4; ++m)
#pragma unroll
                    for (int bj = 0; bj < 2; ++bj) { f32x4 o2[2];
#pragma unroll
                        for (int n = 0; n < 2; ++n) { const uint2 q = xu[ai][m][bj][n];
                            const f32x4 xv = (f32x4){__uint_as_float(q.x << 16), __uint_as_float(q.x & 0xffff0000u), __uint_as_float(q.y << 16), __uint_as_float(q.y & 0xffff0000u)};
                            o2[n] = xv + gv[bj][n] * acc[ai][bj][m][n]; }
                        st_pair16(Xout + (size_t)(row0 + ai * 128 + m * 16) * DM + u.pn * 256 + wc * 32 + bj * 128, fq, pk4(o2[0]), pk4(o2[1])); }
        }
    }
};
struct QNsaIn { float* qn; float* gates; const float* bg; __device__ __forceinline__ void operator()(const Unit&, int row, int col, const f32x4& v) const {
    if (col < 1024) *(f32x4*)(qn + (size_t)row * 1024 + col) = v * 0.125f;
    else if (col < NSA_IN) { const int c = col - 1024; f32x4 o; for (int j = 0; j < 4; ++j) o[j] = sigm(v[j] + bg[c + j]); *(f32x4*)(gates + (size_t)row * 48 + c) = o; } } };
struct QNsaIn2 { unsigned short* qb; float* gates; const float* bg; __device__ __forceinline__ void operator()(const Unit&, int row, int col, const f32x4& v) const {
    if (col < 1024) { const float sc = 0.125f * 1.4426950408889634f; *(uint2*)(qb + (size_t)row * 1024 + col) = make_uint2(pack_bf16(v[0] * sc, v[1] * sc), pack_bf16(v[2] * sc, v[3] * sc)); }
    else if (col < NSA_IN) { const int c = col - 1024; f32x4 o; for (int j = 0; j < 4; ++j) o[j] = sigm(v[j] + bg[c + j]); *(f32x4*)(gates + (size_t)row * 48 + c) = o; } } };
struct QKv2 { unsigned short *csrc, *kslc, *vslcT, *kwin, *vwinT; __device__ __forceinline__ void operator()(const Unit&, int row, int col, const f32x4& v) const {
    const int j = col >> 8, g = (col >> 6) & 3, d = col & 63, b = row / SEQ, s = row % SEQ, bg = b * 4 + g;
    if (j < 2) *(uint2*)(csrc + ((size_t)((j * 32 + bg) * SEQ + s)) * 64 + d) = make_uint2(pack_bf16(v[0], v[1]), pack_bf16(v[2], v[3]));
    else if (j == 2 || j == 4) *(uint2*)((j == 2 ? kslc : kwin) + ((size_t)bg * SEQ + s) * 64 + d) = make_uint2(pack_bf16(v[0], v[1]), pack_bf16(v[2], v[3]));
    else { const int sp = (s & ~15) | (((s >> 2) & 1) << 3) | (((s >> 3) & 1) << 2) | (s & 3);
        unsigned short* vt = (j == 3 ? vslcT : vwinT) + ((size_t)bg * 64 + d) * SEQ + sp;
#pragma unroll
        for (int i = 0; i < 4; ++i) vt[(size_t)i * SEQ] = f2bf(v[i]); } } };
struct QGlaIn { unsigned short *qk, *vT, *rb; float* glr; __device__ __forceinline__ void operator()(const Unit&, int row, int col, const f32x4& v) const {
    if (col < 1024) *(uint2*)(qk + (size_t)row * 1024 + col) = make_uint2(pack_bf16(v[0], v[1]), pack_bf16(v[2], v[3]));
    else if (col < 2048) { const int ce = col - 1024, b = row / SEQ, s = row % SEQ; unsigned short* vt = vT + ((size_t)(b * 4 + (ce >> 8)) * 256 + (ce & 255)) * SEQ + s;
#pragma unroll
        for (int i = 0; i < 4; ++i) vt[(size_t)i * SEQ] = f2bf(v[i]); }
    else if (col < 3072) *(uint2*)(rb + (size_t)row * 1024 + (col - 2048)) = make_uint2(pack_bf16(v[0], v[1]), pack_bf16(v[2], v[3]));
    else if (col < GLA_IN) *(f32x4*)(glr + (size_t)row * 16 + (col - 3072)) = v; } };
__device__ __forceinline__ float fast_sigm(float x) { return __builtin_amdgcn_rcpf(1.f + __builtin_amdgcn_exp2f(-1.4426950408889634f * x)); }
typedef float f32x2_ __attribute__((ext_vector_type(2)));
template <bool PERMK>
__device__ __forceinline__ void st_vT_tile(LAS unsigned char* T, unsigned short* vt_col0, int row, int fq, const f32x4& v0, const f32x4& v1) {
    const int fr = row & 15, lane16 = fr, g = fq;
    *(LAS au32x2_*)(T + fr * 64 + fq * 8) = (au32x2_){pack_bf16(v0[0], v0[1]), pack_bf16(v0[2], v0[3])};
    *(LAS au32x2_*)(T + fr * 64 + 32 + fq * 8) = (au32x2_){pack_bf16(v1[0], v1[1]), pack_bf16(v1[2], v1[3])};
    const int colblk = g & 1, th = g >> 1, j = lane16 >> 2, q = lane16 & 3;
    const int t0 = PERMK ? 4 * th : 8 * th, t1 = PERMK ? 8 + 4 * th : 8 * th + 4;
    LAS unsigned char* a0 = T + (t0 + j) * 64 + colblk * 32 + q * 8;
    LAS unsigned char* a1 = T + (t1 + j) * 64 + colblk * 32 + q * 8;
    au32x2_ r0, r1;
    asm volatile("s_waitcnt lgkmcnt(0)\n\tds_read_b64_tr_b16 %0, %2\n\tds_read_b64_tr_b16 %1, %3\n\ts_waitcnt lgkmcnt(0)" : "=&v"(r0), "=&v"(r1) : "v"(a0), "v"(a1) : "memory");
    *(uint4*)(vt_col0 + (size_t)(colblk * 16 + lane16) * SEQ + 8 * th) = make_uint4(r0.x, r0.y, r1.x, r1.y);
}
struct PGlaIn { unsigned short *qk, *vT, *rb; float* glr; LAS unsigned char* tl; __device__ __forceinline__ void operator()(const Unit&, int row, int gb, int fq, int wv, const f32x4& v0, const f32x4& v1) const {
    if (gb < 1024) st_pair16(qk + (size_t)row * 1024 + gb, fq, pk4(v0), pk4(v1));
    else if (gb < 2048) { const int b = row / SEQ, s = row % SEQ;
#pragma unroll
        for (int n = 0; n < 2; ++n) { const int ce = gb - 1024 + n * 16 + 4 * fq; unsigned short* vt = vT + ((size_t)(b * 4 + (ce >> 8)) * 256 + (ce & 255)) * SEQ + s; const f32x4& v = n ? v1 : v0;
#pragma unroll
            for (int i = 0; i < 4; ++i) vt[(size_t)i * SEQ] = f2bf(v[i]); } }
    else if (gb < 3072) st_pair16(rb + (size_t)row * 1024 + (gb - 2048), fq, pk4(v0), pk4(v1));
    else if (gb == 3072) *(f32x4*)(glr + (size_t)row * 16 + 4 * fq) = v0; } };
struct PNsaIn { unsigned short* qb; float* gates; const float* bg; __device__ __forceinline__ void operator()(const Unit&, int row, int gb, int fq, int, const f32x4& v0, const f32x4& v1) const {
    if (gb < 1024) { const float sc = 0.125f * 1.4426950408889634f; st_pair16(qb + (size_t)row * 1024 + gb, fq, pk4(v0 * sc), pk4(v1 * sc)); }
    else {
#pragma unroll
        for (int n = 0; n < 2; ++n) { const int c = gb - 1024 + n * 16 + 4 * fq; if (c < 48) { const f32x4& v = n ? v1 : v0; f32x4 o; for (int j = 0; j < 4; ++j) o[j] = sigm(v[j] + bg[c + j]); *(f32x4*)(gates + (size_t)row * 48 + c) = o; } } } } };
struct PKv { unsigned short *csrc, *kslc, *vslcT, *kwin, *vwinT; LAS unsigned char* tl; __device__ __forceinline__ void operator()(const Unit&, int row, int gb, int fq, int wv, const f32x4& v0, const f32x4& v1) const {
    const int j = gb >> 8, g = (gb >> 6) & 3, d0 = gb & 63, b = row / SEQ, s = row % SEQ, bg = b * 4 + g;
    if (j < 2) st_pair16(csrc + ((size_t)((j * 32 + bg) * SEQ + s)) * 64 + d0, fq, pk4(v0), pk4(v1));
    else if (j == 2 || j == 4) st_pair16((j == 2 ? kslc : kwin) + ((size_t)bg * SEQ + s) * 64 + d0, fq, pk4(v0), pk4(v1));
    else { const int sp = (s & ~15) | (((s >> 2) & 1) << 3) | (((s >> 3) & 1) << 2) | (s & 3);
#pragma unroll
        for (int n = 0; n < 2; ++n) { unsigned short* vt = (j == 3 ? vslcT : vwinT) + ((size_t)bg * 64 + d0 + n * 16 + 4 * fq) * SEQ + sp; const f32x4& v = n ? v1 : v0;
#pragma unroll
            for (int i = 0; i < 4; ++i) vt[(size_t)i * SEQ] = f2bf(v[i]); } } } };
struct QSwiglu { unsigned short* act; LAS unsigned char* xl; __device__ __forceinline__ void operator()(const Unit& u, int row, int col, const f32x4& v) const {
    const f32x4 bv = *(const LAS f32x4*)(xl + MX_BIAS + (u.ord & 1) * 1024 + (col - u.pn * 256) * 4);
    f32x2_ G = (f32x2_){v[0], v[2]} + (f32x2_){bv[0], bv[2]}, U = (f32x2_){v[1], v[3]} + (f32x2_){bv[1], bv[3]};
    G.x = fminf(G.x, 7.f); G.y = fminf(G.y, 7.f);
    U.x = __builtin_amdgcn_fmed3f(U.x, -7.f, 7.f); U.y = __builtin_amdgcn_fmed3f(U.y, -7.f, 7.f);
    f32x2_ E = G * (-1.702f * 1.4426950408889634f); E.x = __builtin_amdgcn_exp2f(E.x); E.y = __builtin_amdgcn_exp2f(E.y);
    f32x2_ S = E + 1.0f; S.x = __builtin_amdgcn_rcpf(S.x); S.y = __builtin_amdgcn_rcpf(S.y);
    const f32x2_ R = ((U + 1.0f) * G) * S;
    *(unsigned*)(act + (size_t)row * 1024 + (col >> 1)) = pack_bf16(R.x, R.y); } };
struct QDownF { float* y; const float* bd; const int* tile_e; __device__ __forceinline__ void operator()(const Unit& u, int row, int col, const f32x4& v) const {
    const int e = tile_e[u.pm]; *(f32x4*)(y + (size_t)row * 1024 + col) = v + *(const f32x4*)(bd + e * 1024 + col); } };
struct EpiSwiglu { unsigned short* act; LAS unsigned char* xl;
    __device__ __forceinline__ void operator()(const f32x4 (&acc)[2][2][4][2], const Unit& u, int wr, int wc, int fr, int fq) const {
        const int row0 = u.pm * 256 + wr * 64 + fr, cl0 = wc * 32 + 4 * fq;
        f32x4 bv[2][2];
#pragma unroll
        for (int bj = 0; bj < 2; ++bj)
#pragma unroll
            for (int n = 0; n < 2; ++n) bv[bj][n] = *(const LAS f32x4*)(xl + MX_BIAS + (u.ord & 1) * 1024 + (cl0 + bj * 128 + n * 16) * 4);
#pragma unroll
        for (int ai = 0; ai < 2; ++ai)
#pragma unroll
            for (int mp = 0; mp < 2; ++mp) {
                f32x2_ G[8], U[8], E[8];
#pragma unroll
                for (int q = 0; q < 8; ++q) { const int m = mp * 2 + (q >> 2), bj = (q >> 1) & 1, n = q & 1; const f32x4 v = acc[ai][bj][m][n]; const f32x4 b4 = bv[bj][n];
                    G[q] = (f32x2_){v[0], v[2]} + (f32x2_){b4[0], b4[2]}; U[q] = (f32x2_){v[1], v[3]} + (f32x2_){b4[1], b4[3]}; }
#pragma unroll
                for (int q = 0; q < 8; ++q) { G[q].x = fminf(G[q].x, 7.f); G[q].y = fminf(G[q].y, 7.f); U[q].x = __builtin_amdgcn_fmed3f(U[q].x, -7.f, 7.f); U[q].y = __builtin_amdgcn_fmed3f(U[q].y, -7.f, 7.f);
                    E[q] = G[q] * (-1.702f * 1.4426950408889634f); }
#pragma unroll
                for (int q = 0; q < 8; ++q) { E[q].x = __builtin_amdgcn_exp2f(E[q].x); E[q].y = __builtin_amdgcn_exp2f(E[q].y); }
#pragma unroll
                for (int q = 0; q < 8; ++q) { E[q] = E[q] + 1.0f; U[q] = (U[q] + 1.0f) * G[q]; }
#pragma unroll
                for (int q = 0; q < 8; ++q) { E[q].x = __builtin_amdgcn_rcpf(E[q].x); E[q].y = __builtin_amdgcn_rcpf(E[q].y); }
#pragma unroll
                for (int mm = 0; mm < 2; ++mm) { const int m = mp * 2 + mm; unsigned pk[4];
#pragma unroll
                    for (int q4 = 0; q4 < 4; ++q4) { const f32x2_ R = U[mm * 4 + q4] * E[mm * 4 + q4]; pk[q4] = pack_bf16(R.x, R.y); }
                    *(uint4*)(act + (size_t)(row0 + ai * 128 + m * 16) * 1024 + u.pn * 128 + wc * 32 + fq * 8) = make_uint4(pk[0], pk[1], pk[2], pk[3]); }
            }
    }
};
struct EpiDown { unsigned short* y; LAS unsigned char* xl;
    __device__ __forceinline__ void operator()(const f32x4 (&acc)[2][2][4][2], const Unit& u, int wr, int wc, int fr, int fq) const {
        const int hb_ = u.half >= 0 ? u.half : 0; const int nbj = u.half >= 0 ? 1 : 2;
        const int row0 = u.pm * 256 + wr * 64 + fr, cl0 = wc * 32 + 4 * fq;
        f32x4 bv[2][2];
#pragma unroll
        for (int bj = 0; bj < 2; ++bj)
#pragma unroll
            for (int n = 0; n < 2; ++n) bv[bj][n] = *(const LAS f32x4*)(xl + MX_BIAS + (u.ord & 1) * 1024 + (cl0 + (bj + hb_ < 2 ? bj + hb_ : 1) * 128 + n * 16) * 4);
#pragma unroll
        for (int ai = 0; ai < 2; ++ai)
#pragma unroll
            for (int m = 0; m < 4; ++m) {
                unsigned short* rowp = y + (size_t)(row0 + ai * 128 + m * 16) * 1024 + u.pn * 256 + wc * 32;
#pragma unroll
                for (int bj = 0; bj < 2; ++bj) { if (bj >= nbj) continue;
                    const f32x4 o0 = acc[ai][bj][m][0] + bv[bj][0], o1 = acc[ai][bj][m][1] + bv[bj][1];
                    st_pair16(rowp + (bj + hb_) * 128, fq, make_uint2(pack_bf16(o0[0], o0[1]), pack_bf16(o0[2], o0[3])), make_uint2(pack_bf16(o1[0], o1[1]), pack_bf16(o1[2], o1[3]))); }
            }
    }
};
struct QKv { float* kv6; unsigned short* csrc; __device__ __forceinline__ void operator()(const Unit&, int row, int col, const f32x4& v) const {
    *(f32x4*)(kv6 + (size_t)row * KV_OUT + col) = v;
    if (col < 512) { const int t = col >> 8, g = (col >> 6) & 3, d = col & 63, b = row / SEQ, s = row % SEQ;
        *(uint2*)(csrc + ((size_t)((t * 32 + b * 4 + g) * SEQ + s)) * 64 + d) = make_uint2(pack_bf16(v[0], v[1]), pack_bf16(v[2], v[3])); } } };
struct QCmp1 { float* hidp; __device__ __forceinline__ void operator()(const Unit& u, int row, int col, const f32x4& v) const {
    const int z = u.pm >> 2, ks = u.pm & 3, n = row - u.pm * 256; if (col < 128 && n < NCMP) *(f32x4*)(hidp + (((size_t)ks * 64 + z) * NCMP + n) * 128 + col) = v; } };

struct P {
    const float *x_in, *c, *ada_w, *ada_b, *norm1_g, *norm2_g, *gla_w_in, *gla_w_gate2, *gla_b_gate, *gla_norm_g, *gla_w_out, *kv_norm_g, *kv_ada_w, *kv_ada_b,
        *kv_w, *cmp_pos, *cmp_w1, *cmp_b1, *cmp_w2, *cmp_b2, *nsa_w_in, *nsa_b_gate, *nsa_w_out, *router_w, *router_b, *moe_w_gu, *moe_b_gu, *moe_w_down, *moe_b_down, *final_g;
    float* out; unsigned* bar;
    float *mod, *kvmod, *hid, *gates, *topw, *c1, *glr, *gdl;
    unsigned short *x, *y, *hb, *ob, *act, *csrc, *qb, *kslc, *vslcT, *kwin, *vwinT, *kcmp, *vcmpT, *gqk, *gvT, *grb, *gqd, *gki, *gST, *gUT, *wt_gla_in, *wt_gla_out, *wt_kv, *wt_nsa_in, *wt_nsa_out, *wt_cmp1, *wt_gu, *wt_down;
    unsigned long long* sel; int *topi, *cnt, *cntb, *stok, *pos, *tile_e;
};
typedef const P __attribute__((address_space(4)))* KP;
constexpr int LDS_BAR_OFF = g8::STAGE_BYTES;
constexpr int LDS_X_OFF = g8::STAGE_BYTES + 64;
constexpr size_t kDynLds = LDS_X_OFF + MX_END;
__device__ __forceinline__ float* dyn_smem() { extern __shared__ __attribute__((aligned(16))) float smem_[]; return smem_; }
struct Ctx {
int nb_s;
int wv_s;
#define LAUNDER() int tid_; asm volatile("v_mbcnt_lo_u32_b32 %0, -1, 0\n\tv_mbcnt_hi_u32_b32 %0, -1, %0" : "=v"(tid_)); tid_ += wv_s * 64; const int bid_ = blockIdx.x; const int GTID = bid_ * NTHR + tid_; const int GSZ = nb_s * NTHR; (void)GTID; (void)GSZ;
#define SHX(v, o) __uint_as_float((unsigned)__builtin_amdgcn_ds_bpermute(((tid_ ^ (o)) & 63) << 2, (int)__float_as_uint(v)))

__device__ __forceinline__ void ph_mod(const float* c, const float* ada_w, const float* ada_b, const float* kv_ada_w, const float* kv_ada_b,
                                       float* mod, float* kvmod, float* smem) {
    LAUNDER();
    float (*cs)[1024] = (float (*)[1024])smem;
    float* red = smem + 8192;
    for (int i = tid_; i < 8192; i += NTHR) { float v = c[i]; cs[i >> 10][i & 1023] = siluf(v); }
    __syncthreads();
    const int ncol = 4 * 6144 + 2048, cl = tid_ & 127, kq = tid_ >> 7;
    for (int c0 = bid_ * 128; c0 < ncol; c0 += nb_s * 128) {
        const int col = c0 + cl;
        const float* w = nullptr; int ldw = 0; float* out = nullptr; int ldo = 0; const float* bias = nullptr;
        if (col < 4 * 6144) { int L = col / 6144, j = col % 6144; w = ada_w + (size_t)L * 1024 * 6144 + j; ldw = 6144; bias = ada_b + L * 6144 + j; out = mod + (size_t)L * 8 * 6144 + j; ldo = 6144; }
        else if (col < ncol) { int j = col - 4 * 6144; w = kv_ada_w + j; ldw = 2048; bias = kv_ada_b + j; out = kvmod + j; ldo = 2048; }
        float acc[8];
#pragma unroll
        for (int b = 0; b < 8; ++b) acc[b] = 0.f;
        if (w) {
#pragma unroll 4
            for (int k = kq * 256; k < kq * 256 + 256; ++k) { const float wv = w[(size_t)k * ldw];
#pragma unroll
                for (int b = 0; b < 8; ++b) acc[b] += cs[b][k] * wv; } }
#pragma unroll
        for (int b = 0; b < 8; ++b) red[(kq * 128 + cl) * 8 + b] = acc[b];
        __syncthreads();
        if (kq == 0 && w) { const float bv = *bias;
#pragma unroll
            for (int b = 0; b < 8; ++b) out[b * ldo] = red[cl * 8 + b] + red[(128 + cl) * 8 + b] + red[(256 + cl) * 8 + b] + red[(384 + cl) * 8 + b] + bv; }
        __syncthreads();
    }
}

__device__ __forceinline__ void ph_norm(const float* x, const float* g, const float* shift, const float* scale, float* out, unsigned short* outb, int ldmod) {
    LAUNDER();
    const int lane = tid_ & 63;
    float4 gg[4], vn[4];
#pragma unroll
    for (int j = 0; j < 4; ++j) { gg[j] = *(const float4*)(g + j * 256 + lane * 4); vn[j] = make_float4(0.f, 0.f, 0.f, 0.f); }
    if ((GTID >> 6) < NT) {
#pragma unroll
        for (int j = 0; j < 4; ++j) vn[j] = *(const float4*)(x + (size_t)(GTID >> 6) * DM + j * 256 + lane * 4); }
    for (int row = GTID >> 6; row < NT; row += GSZ >> 6) {
        const int b = row / SEQ;
        float4 v[4], sc[4], sh[4]; float ss = 0.f;
#pragma unroll
        for (int j = 0; j < 4; ++j) { v[j] = vn[j]; sc[j] = make_float4(0.f, 0.f, 0.f, 0.f); sh[j] = sc[j];
            if (shift) { sc[j] = *(const float4*)(scale + b * ldmod + j * 256 + lane * 4); sh[j] = *(const float4*)(shift + b * ldmod + j * 256 + lane * 4); } }
        { const int nr = row + (GSZ >> 6);
          if (nr < NT) {
#pragma unroll
              for (int j = 0; j < 4; ++j) vn[j] = *(const float4*)(x + (size_t)nr * DM + j * 256 + lane * 4); } }
#pragma unroll
        for (int j = 0; j < 4; ++j) ss += v[j].x * v[j].x + v[j].y * v[j].y + v[j].z * v[j].z + v[j].w * v[j].w;
        for (int o = 32; o > 0; o >>= 1) ss += SHX(ss, o);
        const float r = rsqrtf(ss * (1.f / DM) + 1e-5f);
#pragma unroll
        for (int j = 0; j < 4; ++j) { const int col = j * 256 + lane * 4;
            float4 y = make_float4(v[j].x * r * gg[j].x, v[j].y * r * gg[j].y, v[j].z * r * gg[j].z, v[j].w * r * gg[j].w);
            if (shift) { y.x = y.x * (1.f + sc[j].x) + sh[j].x; y.y = y.y * (1.f + sc[j].y) + sh[j].y; y.z = y.z * (1.f + sc[j].z) + sh[j].z; y.w = y.w * (1.f + sc[j].w) + sh[j].w; }
            if (out) *(float4*)(out + (size_t)row * DM + col) = y;
            if (outb) *(uint2*)(outb + (size_t)row * DM + col) = make_uint2(pack_bf16(y.x, y.y), pack_bf16(y.z, y.w)); }
    }
}

template <class AF, class BF, class EF>
__device__ __forceinline__ void ph_gemm(AF af, BF bf, EF ef, int M, int N, int K, int Z, float* smem, int boff = 0) {
    LAUNDER();
    float (*As)[132] = (float (*)[132])smem;
    float (*Bs)[132] = (float (*)[132])(smem + 16 * 132);
    const int tm = (M + 127) / 128, tn = (N + 127) / 128, total = Z * tm * tn;
    const int tid = tid_, ty = tid >> 4, tx = tid & 15;
    for (int it = (bid_ >= boff ? bid_ - boff : bid_ - boff + nb_s); it < total; it += nb_s) {
        const int z = it / (tm * tn), rr = it % (tm * tn), m0 = (rr / tn) * 128, n0 = (rr % tn) * 128;
        if (!af.active(z, m0)) continue;
        float acc[4][8];
#pragma unroll
        for (int i = 0; i < 4; ++i)
#pragma unroll
            for (int j = 0; j < 8; ++j) acc[i][j] = 0.f;
#pragma unroll 1
        for (int k0 = 0; k0 < K; k0 += 16) {
            { const int r = tid >> 2, kk = (tid & 3) * 4, m = m0 + r;
#pragma unroll
              for (int j = 0; j < 4; ++j) As[kk + j][r] = (m < M) ? af(z, m, k0 + kk + j) : 0.f; }
            { const int kk = tid >> 5, cc = (tid & 31) * 4;
#pragma unroll
              for (int j = 0; j < 4; ++j) { const int n = n0 + cc + j; Bs[kk][cc + j] = (n < N) ? bf(z, m0, k0 + kk, n) : 0.f; } }
            __syncthreads();
#pragma unroll
            for (int kk = 0; kk < 16; ++kk) {
                float a[4], b[8];
#pragma unroll
                for (int i = 0; i < 4; ++i) a[i] = As[kk][ty * 4 + i];
#pragma unroll
                for (int j = 0; j < 8; ++j) b[j] = Bs[kk][tx * 8 + j];
#pragma unroll
                for (int i = 0; i < 4; ++i)
#pragma unroll
                    for (int j = 0; j < 8; ++j) acc[i][j] += a[i] * b[j];
            }
            __syncthreads();
        }
#pragma unroll
        for (int i = 0; i < 4; ++i) { const int m = m0 + ty * 4 + i; if (m < M) ef(z, m, m0, n0 + tx * 8, acc[i], N); }
    }
}

__device__ __forceinline__ void ph_gla_gate(const float* proj, const float* w2, const float* bg, float* loga) {
    LAUNDER();
    for (size_t i = GTID; i < (size_t)NT * 512; i += GSZ) {
        const int t = (int)(i >> 9), j = (int)(i & 511);
        float z = bg[j];
#pragma unroll
        for (int r = 0; r < 16; ++r) z += proj[(size_t)t * GLA_IN + 3072 + r] * w2[r * 512 + j];
        loga[i] = logsigmoidf(z) * (1.f / 16.f);
    }
}
__device__ __forceinline__ void ph_gla_rec(const float* proj, const float* loga, float* oraw, float* smem) {
    LAUNDER();
    if (bid_ >= 16) return;
    const int half = tid_ >> 8, e = tid_ & 255, item = bid_ * 2 + half;
    float* sq = smem + half * 384; float* sk = sq + 128; float* sa = sk + 128;
    const int b = item >> 2, h = item & 3;
    float st[128];
#pragma unroll
    for (int d = 0; d < 128; ++d) st[d] = 0.f;
    const float* pr = proj + (size_t)b * SEQ * GLA_IN + h * 128 + (e < 128 ? e : 512 + (e - 128));
    const float* pa = loga + (size_t)b * SEQ * 512 + h * 128 + (e & 127);
    const float* pv = proj + (size_t)b * SEQ * GLA_IN + 1024 + h * 256 + e;
    float* po = oraw + (size_t)b * SEQ * DM + h * 256 + e;
#pragma unroll 1
    for (int t = 0; t < SEQ; ++t) {
        if (e < 128) { sq[e] = *pr; sa[e] = expf(*pa); } else { sk[e - 128] = *pr; }
        const float v = *pv;
        __syncthreads();
        float o = 0.f;
#pragma unroll
        for (int d = 0; d < 128; ++d) { st[d] = st[d] * sa[d] + sk[d] * v; o += sq[d] * st[d]; }
        *po = o * 0.08838834764831845f;
        __syncthreads();
        pr += GLA_IN; pa += 512; pv += GLA_IN; po += DM;
    }
}
__device__ __forceinline__ void ph_gla_post(const float* oraw, const float* proj, const float* ng, unsigned short* ob) {
    LAUNDER();
    const int l = tid_ & 63;
    for (int it = GTID >> 6; it < NT * 4; it += GSZ >> 6) {
        const int row = it >> 2, h = it & 3;
        const float4 v = *(const float4*)(oraw + (size_t)row * DM + h * 256 + l * 4);
        float ss = v.x * v.x + v.y * v.y + v.z * v.z + v.w * v.w;
        for (int s = 32; s > 0; s >>= 1) ss += SHX(ss, s);
        const float r = rsqrtf(ss * (1.f / 256.f) + 1e-5f);
        float vv[4] = {v.x, v.y, v.z, v.w};
#pragma unroll
        for (int j = 0; j < 4; ++j) { const int col = h * 256 + l * 4 + j; const float rr = proj[(size_t)row * GLA_IN + 2048 + col];
            ob[(size_t)row * DM + col] = f2bf(vv[j] * r * ng[col] * siluf(rr)); }
    }
}

__device__ __forceinline__ void ph_nsa_cmp(const float* qn, const float* comp, float* pc, float* oc) {
    LAUNDER();
    for (int idx = GTID; idx < NT * 16; idx += GSZ) {
        const int bt = idx >> 4, hd = idx & 15, b = bt / SEQ, t = bt % SEQ, g = hd >> 2;
        const float slope = exp2f(-0.5f * (hd + 1));
        float q[64];
#pragma unroll
        for (int d = 0; d < 64; ++d) q[d] = qn[(size_t)bt * 1024 + hd * 64 + d];
        const int nv = t >= 31 ? min(NCMP, (t - 31) / 16 + 1) : 0;
        const float* kc = comp + (size_t)(0 * 32 + b * 4 + g) * NCMP * 64;
        const float* vc = comp + (size_t)(1 * 32 + b * 4 + g) * NCMP * 64;
        float* pr = pc + (size_t)idx * 256;
        float mx = -1e30f;
        for (int n = 0; n < nv; ++n) { float s = 0.f;
#pragma unroll
            for (int d = 0; d < 64; ++d) s += q[d] * kc[n * 64 + d];
            s -= slope * (float)(t - (16 * n + 31)); pr[n] = s; mx = fmaxf(mx, s); }
        float l = 0.f;
        for (int n = 0; n < nv; ++n) l += expf(pr[n] - mx);
        const float inv = nv > 0 ? 1.f / l : 0.f;
        float o[64];
#pragma unroll
        for (int d = 0; d < 64; ++d) o[d] = 0.f;
        for (int n = 0; n < nv; ++n) { const float p = expf(pr[n] - mx) * inv; pr[n] = p;
#pragma unroll
            for (int d = 0; d < 64; ++d) o[d] += p * vc[n * 64 + d]; }
        for (int n = nv; n < 256; ++n) pr[n] = 0.f;
#pragma unroll
        for (int d = 0; d < 64; ++d) oc[(size_t)idx * 64 + d] = o[d];
    }
}
__device__ __forceinline__ void ph_nsa_sel(const float* pc, unsigned long long* sel) {
    LAUNDER();
    const int j = tid_ & 63;
    for (int idx = GTID >> 6; idx < NT * 4; idx += GSZ >> 6) {
        const int bt = idx >> 2, g = idx & 3, t = bt % SEQ, cur = t >> 6;
        float imp = 0.f;
        for (int hp = 0; hp < 4; ++hp) { const float* pr = pc + ((size_t)bt * 16 + g * 4 + hp) * 256;
            for (int n = max(4 * j - 1, 0); n <= min(4 * j + 3, NCMP - 1); ++n) imp += pr[n]; }
        const bool valid = j <= cur, forced = (j == 0) || (j == cur) || (j == cur - 1);
        const float s = valid ? imp + (forced ? 1e4f : 0.f) : -1e4f;
        int rank = 0;
        for (int jj = 0; jj < 64; ++jj) { const float sj = __uint_as_float((unsigned)__builtin_amdgcn_ds_bpermute(jj << 2, (int)__float_as_uint(s))); rank += (sj > s || (sj == s && jj < j)) ? 1 : 0; }
        const unsigned long long m = __ballot(rank < 16);
        if (j == 0) sel[idx] = m;
    }
}
__device__ __forceinline__ void ph_nsa_attn(const float* qn, const float* gates, const float* kv6, const float* oc, const unsigned long long* sel, float* o, unsigned short* ob) {
    LAUNDER();
    for (int idx = GTID; idx < NT * 16; idx += GSZ) {
        const int bt = idx >> 4, hd = idx & 15, b = bt / SEQ, t = bt % SEQ, g = hd >> 2, cur = t >> 6;
        const float slope = exp2f(-0.5f * (hd + 1));
        float q[64];
#pragma unroll
        for (int d = 0; d < 64; ++d) q[d] = qn[(size_t)bt * 1024 + hd * 64 + d];
        const float gc = gates[(size_t)bt * 48 + 0 * 16 + hd], gs = gates[(size_t)bt * 48 + 1 * 16 + hd], gw = gates[(size_t)bt * 48 + 2 * 16 + hd];
        const unsigned long long msk = sel[(size_t)bt * 4 + g];
        float* orow = o + (size_t)bt * 1024 + hd * 64;
        for (int br = 0; br < 2; ++br) {
            float acc[64];
#pragma unroll
            for (int d = 0; d < 64; ++d) acc[d] = 0.f;
            float mx = -1e30f, l = 0.f;
            const int kcol = (br == 0 ? 2 : 4) * 256 + g * 64, vcol = kcol + 256;
            const int jlo = br == 0 ? 0 : max(0, t - 511), jhi = br == 0 ? cur : t;
            for (int j = jlo; j <= jhi; ++j) {
                int k0, k1;
                if (br == 0) { if (!((msk >> j) & 1ull)) continue; k0 = 64 * j; k1 = min(64 * j + 63, t); } else { k0 = j; k1 = j; }
                for (int key = k0; key <= k1; ++key) {
                    const float* kr = kv6 + (size_t)(b * SEQ + key) * KV_OUT + kcol; const float* vr = kv6 + (size_t)(b * SEQ + key) * KV_OUT + vcol;
                    float s = 0.f;
#pragma unroll
                    for (int d = 0; d < 64; ++d) s += q[d] * kr[d];
                    s -= slope * (float)(t - key);
                    const float mn = fmaxf(mx, s), sc = expf(mx - mn), p = expf(s - mn);
                    l = l * sc + p; mx = mn;
#pragma unroll
                    for (int d = 0; d < 64; ++d) acc[d] = acc[d] * sc + p * vr[d];
                }
            }
            const float gg = (br == 0 ? gs : gw) / l;
            if (br == 0) {
#pragma unroll
                for (int d = 0; d < 64; ++d) orow[d] = gc * oc[(size_t)idx * 64 + d] + gg * acc[d];
            } else {
#pragma unroll
                for (int d = 0; d < 64; ++d) ob[(size_t)bt * 1024 + hd * 64 + d] = f2bf(orow[d] + gg * acc[d]);
            }
        }
    }
}

__device__ __forceinline__ void ph_router(const float* h, const float* rw, const float* rb, float* logits) {
    LAUNDER();
    for (size_t i = GTID; i < (size_t)NT * 32; i += GSZ) {
        const int t = (int)(i >> 5), e = (int)(i & 31);
        float acc = 0.f;
        for (int k = 0; k < 1024; ++k) acc += h[(size_t)t * DM + k] * rw[k * 32 + e];
        logits[i] = acc + rb[e];
    }
}
__device__ __forceinline__ void ph_top4(const float* logits, int* topi, float* topw, int* cnt) {
    LAUNDER();
    for (int t = GTID; t < NT; t += GSZ) {
        float v[32];
#pragma unroll
        for (int e = 0; e < 32; ++e) v[e] = logits[(size_t)t * 32 + e];
        float tv[4]; int ti[4];
#pragma unroll
        for (int r = 0; r < 4; ++r) { float best = -3e38f; int bi = 0;
#pragma unroll
            for (int e = 0; e < 32; ++e) if (v[e] > best) { best = v[e]; bi = e; }
            tv[r] = best; ti[r] = bi;
#pragma unroll
            for (int e = 0; e < 32; ++e) if (e == bi) v[e] = -3e38f; }
        float s = 0.f, w[4];
#pragma unroll
        for (int r = 0; r < 4; ++r) { w[r] = expf(tv[r] - tv[0]); s += w[r]; }
#pragma unroll
        for (int r = 0; r < 4; ++r) { topi[t * 4 + r] = ti[r]; topw[t * 4 + r] = w[r] / s; atomicAdd(&cnt[ti[r]], 1); }
    }
}
__device__ __forceinline__ void ph_offsets(int* cnt, int* tile_e) {
    LAUNDER();
    if (tid_ == 0 && bid_ == 0) { int s = 0;
        for (int e = 0; e < NE; ++e) { cnt[64 + e] = s; const int p = (cnt[e] + MPAD - 1) / MPAD * MPAD; for (int tl = s / MPAD; tl < (s + p) / MPAD; ++tl) tile_e[tl] = e; s += p; }
        cnt[64 + NE] = s; for (int tl = s / MPAD; tl < CAP / MPAD; ++tl) tile_e[tl] = -1; }
}
__device__ __forceinline__ void ph_assign(const int* topi, int* cnt, int* stok, int* pos) {
    LAUNDER();
    for (int i = GTID; i < NASG; i += GSZ) {
        const int e = topi[i];
        const int p = cnt[64 + e] + atomicAdd(&cnt[32 + e], 1);
        stok[p] = i >> 2; pos[i] = p;
    }
}
__device__ __forceinline__ void ph_combine(float* x, const float* y, const int* pos, const float* topw, const float* gate, int ldg) {
    LAUNDER();
    const int lane = tid_ & 63;
    for (int row = GTID >> 6; row < NT; row += GSZ >> 6) {
        const int b = row / SEQ;
#pragma unroll
        for (int j = 0; j < 4; ++j) { const int col = j * 256 + lane * 4;
            float4 acc = make_float4(0.f, 0.f, 0.f, 0.f);
            for (int r = 0; r < 4; ++r) { const float w = topw[row * 4 + r]; const float4 v = *(const float4*)(y + (size_t)pos[row * 4 + r] * DM + col);
                acc.x += w * v.x; acc.y += w * v.y; acc.z += w * v.z; acc.w += w * v.w; }
            float4 xv = *(float4*)(x + (size_t)row * DM + col); const float4 gp = *(const float4*)(gate + b * ldg + col);
            xv.x += gp.x * acc.x; xv.y += gp.y * acc.y; xv.z += gp.z * acc.z; xv.w += gp.w * acc.w;
            *(float4*)(x + (size_t)row * DM + col) = xv; }
    }
}
template <bool PERM128 = false>
__device__ __forceinline__ void ph_convT(const float* src, unsigned short* dst, int K, int N, int Npad, int nmat, float* smem) {
    LAUNDER();
    unsigned (*TT)[64][33] = (unsigned (*)[64][33])smem;
    const int tk = K / 64, tn = Npad / 64, per = tk * tn, total = nmat * per;
    const int kp = tid_ >> 4, ln = (tid_ & 15) * 4;
    float4 v0 = make_float4(0.f, 0.f, 0.f, 0.f), v1 = v0;
    auto fetch = [&](int it, float4& a, float4& b) {
        const int mat = it / per, r = it % per, k0 = (r / tn) * 64, n0 = (r % tn) * 64;
        const float* s = src + (size_t)mat * K * N;
        a = make_float4(0.f, 0.f, 0.f, 0.f); b = a;
        int ka = k0 + 2 * kp, kb = ka + 1;
        if (PERM128) {
            ka = (ka & ~127) | (((ka >> 2) & 1) * 64 + ((ka >> 5) & 3) * 16 + ((ka >> 1) & 1) * 8 + ((ka >> 3) & 3) * 2 + (ka & 1));
            kb = (kb & ~127) | (((kb >> 2) & 1) * 64 + ((kb >> 5) & 3) * 16 + ((kb >> 1) & 1) * 8 + ((kb >> 3) & 3) * 2 + (kb & 1)); }
        if (n0 + ln < N) { a = *(const float4*)(s + (size_t)ka * N + n0 + ln); b = *(const float4*)(s + (size_t)kb * N + n0 + ln); }
    };
    int it = bid_, par = 0;
    if (it < total) fetch(it, v0, v1);
    while (it < total) {
        TT[par][ln][kp] = pack_bf16(v0.x, v1.x); TT[par][ln + 1][kp] = pack_bf16(v0.y, v1.y); TT[par][ln + 2][kp] = pack_bf16(v0.z, v1.z); TT[par][ln + 3][kp] = pack_bf16(v0.w, v1.w);
        const int nxt = it + nb_s;
        if (nxt < total) fetch(nxt, v0, v1);
        __syncthreads();
        { const int mat = it / per, r = it % per, k0 = (r / tn) * 64, n0 = (r % tn) * 64;
          unsigned short* d = dst + (size_t)mat * Npad * K;
          const int n = tid_ >> 3, c = tid_ & 7;
          *(uint4*)(d + (size_t)(n0 + n) * K + k0 + 8 * c) = make_uint4(TT[par][n][4 * c], TT[par][n][4 * c + 1], TT[par][n][4 * c + 2], TT[par][n][4 * c + 3]); }
        it = nxt; par ^= 1;
    }
    __syncthreads();
}
__device__ __forceinline__ void ph_c1(const float* pos, const float* w1, const float* b1, float* c1, float* smem) {
    LAUNDER();
    for (int o = bid_; o < 256; o += nb_s) {
        const int t = o >> 7, e = o & 127; float acc = 0.f;
#pragma unroll
        for (int j = 0; j < 4; ++j) { const int f = tid_ + 512 * j; acc += pos[t * 2048 + f] * w1[((size_t)t * 2048 + f) * 128 + e]; }
#pragma unroll
        for (int s = 32; s > 0; s >>= 1) acc += SHX(acc, s);
        if ((tid_ & 63) == 0) smem[tid_ >> 6] = acc;
        __syncthreads();
        if (tid_ == 0) { float s = b1[t * 128 + e]; for (int w = 0; w < 8; ++w) s += smem[w]; c1[o] = s; }
        __syncthreads();
    }
}
typedef short a_bf16x8 __attribute__((ext_vector_type(8)));
typedef float a_f32x16 __attribute__((ext_vector_type(16)));
typedef unsigned au32x4 __attribute__((ext_vector_type(4)));
typedef unsigned au32x2 __attribute__((ext_vector_type(2)));
static constexpr int AT_TB = 8192;
static constexpr int AT_KC = 0, AT_VC = 4 * AT_TB, AT_KS = 8 * AT_TB, AT_VS = 12 * AT_TB, AT_IMP = g8::STAGE_BYTES + 64  , AT_SELM = AT_IMP + 16384, AT_WM = AT_SELM + 512, AT_END = AT_WM + 64, AT_ONES = AT_END + 8;
static_assert(16 * AT_TB <= g8::STAGE_BYTES && AT_END + 16 <= g8::STAGE_BYTES + 64 + MX_END, "attention LDS map must fit");

__device__ __forceinline__ float xhalf_max(float v) { auto rr = __builtin_amdgcn_permlane32_swap(__float_as_uint(v), __float_as_uint(v), false, false); return fmaxf(__uint_as_float(rr[0]), __uint_as_float(rr[1])); }
__device__ __forceinline__ float xhalf_sum(float v) { auto rr = __builtin_amdgcn_permlane32_swap(__float_as_uint(v), __float_as_uint(v), false, false); return __uint_as_float(rr[0]) + __uint_as_float(rr[1]); }

__device__ __forceinline__ void at_dma1(LAS unsigned char* buf, const char* gb, unsigned go, int wid) {
    __builtin_amdgcn_global_load_lds((const unsigned*)(gb + go), (LAS unsigned*)(buf + wid * 1024), 16, 0, 0);
}
__device__ __forceinline__ void at_glds(LAS unsigned char* buf, const char* gb, unsigned go, int wid) {
    unsigned sv; const unsigned la = (unsigned)(unsigned long long)(buf + wid * 1024);
    asm volatile("s_mov_b32 %0, m0\n\ts_mov_b32 m0, %3\n\ts_nop 0\n\tglobal_load_lds_dwordx4 %1, %2\n\ts_mov_b32 m0, %0" : "=&s"(sv) : "v"(go), "s"(gb), "s"(la) : "memory");
}
__device__ __forceinline__ void at_dma(LAS unsigned char* kbuf, LAS unsigned char* vbuf, const char* kb, const char* vb, unsigned ko, unsigned vo, int wid) {
    at_dma1(kbuf, kb, ko, wid); at_dma1(vbuf, vb, vo, wid);
}
#define AT_SWZ(row, g) ((row) * 128 + ((((g) ^ (((row) >> 1) & 7))) << 4))
#define AT_REGOFF(i) (((i) & 3) + 8 * ((i) >> 2))
__device__ __forceinline__ void at_qk(LAS unsigned char* kbuf, const a_bf16x8 (&qf)[4], a_f32x16 (&st)[2], const int (&off4)[4], float base, float slk, int hh) {
    a_bf16x8 kf[2][4];
#pragma unroll
    for (int kt = 0; kt < 2; ++kt)
#pragma unroll
        for (int s = 0; s < 4; ++s) kf[kt][s] = *(const LAS a_bf16x8*)(kbuf + 4096 * kt + off4[s]);
    a_f32x16 a0, a1;
    const float b0 = base + slk * (float)(4 * hh), b1 = base + slk * (float)(32 + 4 * hh);
#pragma unroll
    for (int i = 0; i < 16; ++i) { a0[i] = b0 + slk * (float)AT_REGOFF(i); a1[i] = b1 + slk * (float)AT_REGOFF(i); }
    __builtin_amdgcn_sched_barrier(0);
    __builtin_amdgcn_s_setprio(1);
#pragma unroll
    for (int s = 0; s < 4; ++s) {
        a0 = __builtin_amdgcn_mfma_f32_32x32x16_bf16(kf[0][s], qf[s], a0, 0, 0, 0);
        a1 = __builtin_amdgcn_mfma_f32_32x32x16_bf16(kf[1][s], qf[s], a1, 0, 0, 0);
    }
    __builtin_amdgcn_s_setprio(0);
    st[0] = a0; st[1] = a1;
}
__device__ __forceinline__ void at_vload(LAS unsigned char* vbuf, a_bf16x8 (&vf)[2][4], const int (&off4)[4]) {
#pragma unroll
    for (int dt = 0; dt < 2; ++dt)
#pragma unroll
        for (int ks = 0; ks < 4; ++ks) vf[dt][ks] = *(const LAS a_bf16x8*)(vbuf + 4096 * dt + off4[ks]);
}
__device__ __forceinline__ void at_pack(const a_f32x16 (&p)[2], a_bf16x8 (&pb)[4]) {
#pragma unroll
    for (int kt = 0; kt < 2; ++kt)
#pragma unroll
        for (int s = 0; s < 2; ++s) {
            au32x4 pw = {pack_bf16(p[kt][8 * s + 0], p[kt][8 * s + 1]), pack_bf16(p[kt][8 * s + 2], p[kt][8 * s + 3]), pack_bf16(p[kt][8 * s + 4], p[kt][8 * s + 5]), pack_bf16(p[kt][8 * s + 6], p[kt][8 * s + 7])};
            pb[kt * 2 + s] = *reinterpret_cast<a_bf16x8*>(&pw); }
}
__device__ __forceinline__ void at_pv(const a_bf16x8 (&vf)[2][4], const a_bf16x8 (&pb)[4], a_f32x16 (&O)[2]) {
    __builtin_amdgcn_s_setprio(1);
#pragma unroll
    for (int ks = 0; ks < 4; ++ks) {
        O[0] = __builtin_amdgcn_mfma_f32_32x32x16_bf16(vf[0][ks], pb[ks], O[0], 0, 0, 0);
        O[1] = __builtin_amdgcn_mfma_f32_32x32x16_bf16(vf[1][ks], pb[ks], O[1], 0, 0, 0);
    }
    __builtin_amdgcn_s_setprio(0);
}
__device__ __forceinline__ void at_mask(a_f32x16 (&st)[2], int hh, int klo, int khi) {
    int d0 = 4 * hh - klo; unsigned span = (unsigned)(khi - klo); const bool any = khi >= klo;
    asm volatile("" : "+v"(d0)); asm volatile("" : "+v"(span));
#pragma unroll
    for (int kt = 0; kt < 2; ++kt)
#pragma unroll
        for (int i = 0; i < 16; ++i) { const bool ok = any && ((unsigned)(32 * kt + AT_REGOFF(i) + d0) <= span); st[kt][i] = ok ? st[kt][i] : -INFINITY; }
}
__device__ __forceinline__ float at_rowmax(const a_f32x16 (&st)[2]) {
    float mt = st[0][0];
#pragma unroll
    for (int i = 1; i < 16; ++i) mt = fmaxf(mt, st[0][i]);
#pragma unroll
    for (int i = 0; i < 16; ++i) mt = fmaxf(mt, st[1][i]);
    return xhalf_max(mt);
}
__device__ __forceinline__ void at_softmax_rel(a_f32x16 (&st)[2], float mref, bool first, float& m, float& l, a_f32x16 (&O)[2]) {
    const float mt = at_rowmax(st);
    float ps = 0.f;
    if (first || __any(mt > 6.f)) {
        float delta = first ? mt : fmaxf(mt, 0.f); delta = (delta == -INFINITY) ? 0.f : delta;
#pragma unroll
        for (int kt = 0; kt < 2; ++kt)
#pragma unroll
            for (int i = 0; i < 16; ++i) { const float pv = __builtin_amdgcn_exp2f(st[kt][i] - delta); st[kt][i] = pv; ps += pv; }
        const float alpha = first ? 0.f : __builtin_amdgcn_exp2f(-delta);
        l = l * alpha + ps; m = mref + delta;
#pragma unroll
        for (int dt = 0; dt < 2; ++dt)
#pragma unroll
            for (int i = 0; i < 16; ++i) O[dt][i] *= alpha;
    } else {
#pragma unroll
        for (int kt = 0; kt < 2; ++kt)
#pragma unroll
            for (int i = 0; i < 16; ++i) { const float pv = __builtin_amdgcn_exp2f(st[kt][i]); st[kt][i] = pv; ps += pv; }
        l += ps;
    }
}

__device__ __forceinline__ void at_mask2(a_f32x16& s0, a_f32x16& s1, int hh, int klo, int khi) {
    const bool any = khi >= klo;
    int d0 = any ? 4 * hh - klo : 0x40000000; unsigned span = any ? (unsigned)(khi - klo) : 0u;
    asm volatile("" : "+v"(d0)); asm volatile("" : "+v"(span));
#pragma unroll
    for (int i = 0; i < 16; ++i) {
        s0[i] = ((unsigned)(AT_REGOFF(i) + d0) <= span) ? s0[i] : -INFINITY;
        s1[i] = ((unsigned)(32 + AT_REGOFF(i) + d0) <= span) ? s1[i] : -INFINITY; }
}
#define AT_MX3(a, b, c) __builtin_fmaxf(__builtin_fmaxf((a), (b)), (c))
__device__ __forceinline__ float at_rowmax2(const a_f32x16& p0, const a_f32x16& p1) {
    float a = AT_MX3(p0[0], p0[1], p1[0]), b = AT_MX3(p0[2], p0[3], p1[1]); a = AT_MX3(a, p1[2], p1[3]);
#pragma unroll
    for (int r = 4; r < 16; r += 4) { a = AT_MX3(a, p0[r], p0[r + 1]); b = AT_MX3(b, p0[r + 2], p0[r + 3]); a = AT_MX3(a, p1[r], p1[r + 1]); b = AT_MX3(b, p1[r + 2], p1[r + 3]); }
    return xhalf_max(__builtin_fmaxf(a, b));
}

__device__ __forceinline__ void ph_nsa_attn_mfma(const unsigned short* qb, const float* gates, const unsigned short* kcmp, const unsigned short* vcmpT,
                                                 const unsigned short* kslc, const unsigned short* vslcT, const unsigned short* kwin, const unsigned short* vwinT,
                                                 unsigned short* ob, int* qcnt, LAS unsigned char* lds) {
    LAUNDER();
    const int wid = wv_s;
    constexpr float LOG2E = 1.4426950408889634f;
    int lane, r, hh, hp, ql, tl = 0, tq = 0, tqh = 0; unsigned ko, voS; int off4[4]; float sl = 0.f;
#define AT_DERIVE(q0_, g_) do { asm volatile("v_mbcnt_lo_u32_b32 %0, -1, 0\n\tv_mbcnt_hi_u32_b32 %0, -1, %0" : "=v"(lane)); r = lane & 31; hh = lane >> 5; hp = r >> 3; ql = r & 7; \
        const int drow_ = 8 * wid + (lane >> 3), dgc_ = (lane & 7) ^ ((drow_ >> 1) & 7); ko = (unsigned)(drow_ * 128 + dgc_ * 16); voS = (unsigned)(drow_ * SEQ * 2 + dgc_ * 16); \
        _Pragma("unroll") for (int s_ = 0; s_ < 4; ++s_) off4[s_] = r * 128 + ((((2 * s_ + hh) ^ ((r >> 1) & 7))) << 4); \
        tl = wid * 8 + ql; tq = (q0_) + tl; tqh = tq - 4 * hh; sl = exp2f(-0.5f * (float)((g_) * 4 + hp + 1)) * LOG2E; } while (0)
    LAS int* qslot = (LAS int*)(lds + AT_END);
    const bool dyn = nb_s == 256;
    int kq = 0, I = bid_, it = 0;
    if (tid_ == 0) { qslot[2] = ~0; qslot[3] = ~0; }
    if (dyn) { if (tid_ == 0) qslot[0] = atomicAdd(qcnt + (bid_ & 7), 1); }
    __syncthreads();
    if (dyn) kq = qslot[0];
    for (;;) {
        if (dyn ? kq >= 256 : I >= 2048) break;
        int knext = 0;
        int lane0; asm volatile("v_mbcnt_lo_u32_b32 %0, -1, 0\n\tv_mbcnt_hi_u32_b32 %0, -1, %0" : "=v"(lane0));
        if (dyn && wid == 0 && lane0 == 0) knext = atomicAdd(qcnt + (bid_ & 7), 1);
        int qi = 63 - (I >> 5), bg = I & 31;
        if (dyn) { bg = (bid_ & 7) + 8 * (kq >> 6); qi = 63 - (kq & 63); }
        const int b = bg >> 2, g = bg & 3, q0 = qi * 64, cur = qi;
        AT_DERIVE(q0, g);
        const int hd = g * 4 + hp;
        const unsigned voC = (unsigned)((8 * wid + (lane >> 3)) * 512 + ((lane & 7) ^ (((8 * wid + (lane >> 3)) >> 1) & 7)) * 16);
        a_bf16x8 qf[4];
#pragma unroll
        for (int s = 0; s < 4; ++s) qf[s] = *(const a_bf16x8*)(qb + (size_t)(b * SEQ + tq) * 1024 + hd * 64 + 16 * s + 8 * hh);
        const float* gp = gates + (size_t)(b * SEQ + tq) * 48 + hd;
        const float gc = gp[0], gs = gp[16], gw = gp[32];
        a_f32x16 Ot[2];
#pragma unroll
        for (int dt = 0; dt < 2; ++dt)
#pragma unroll
            for (int i = 0; i < 16; ++i) Ot[dt][i] = 0.f;
        const int nlast_blk = (q0 + 63 >= 31) ? min(254, (q0 + 63 - 31) >> 4) : -1;
        const int ntc = nlast_blk >= 0 ? (nlast_blk >> 6) + 1 : 0;
        const int nlast = (tq >= 31) ? min(254, (tq - 31) >> 4) : -1;
        for (int T = 0; T < ntc; ++T) at_dma(lds + AT_KC + T * AT_TB, lds + AT_VC + T * AT_TB, (const char*)(kcmp + ((size_t)bg * 256 + 64 * T) * 64), (const char*)(vcmpT + (size_t)bg * 64 * 256 + 64 * T), ko, voC, wid);
        { LAS float* imp = (LAS float*)(lds + AT_IMP) + wid * 512;
#pragma unroll
          for (int i = 0; i < 8; ++i) imp[lane + 64 * i] = 0.f; }
        unsigned long long ptodo = (cur >= 8 ? (0x1FFull << (cur - 8)) : ((1ull << (cur + 1)) - 1ull));
        int pn = __builtin_popcountll(ptodo), pj0 = 0, pj1 = 0, pj2 = 0;
        {
            const char* kbw = (const char*)(kwin + (size_t)bg * SEQ * 64); const char* vbw = (const char*)(vwinT + (size_t)bg * 64 * SEQ);
            pj0 = 63 - __builtin_clzll(ptodo); ptodo &= ~(1ull << pj0);
            at_glds(lds + AT_KS, kbw + (size_t)pj0 * 8192, ko, wid); at_glds(lds + AT_VS, vbw + (size_t)pj0 * 128, voS, wid);
            if (pn > 1) { pj1 = 63 - __builtin_clzll(ptodo); ptodo &= ~(1ull << pj1); at_glds(lds + AT_KS + AT_TB, kbw + (size_t)pj1 * 8192, ko, wid); }
            if (pn > 2) { pj2 = 63 - __builtin_clzll(ptodo); ptodo &= ~(1ull << pj2); at_glds(lds + AT_KS + 2 * AT_TB, kbw + (size_t)pj2 * 8192, ko, wid); }
        }
        if (pn > 2) { asm volatile("s_waitcnt vmcnt(4)" ::: "memory"); } else if (pn > 1) { asm volatile("s_waitcnt vmcnt(3)" ::: "memory"); } else { asm volatile("s_waitcnt vmcnt(2)" ::: "memory"); }
        __syncthreads();
        {
            float m = -INFINITY, l = 0.f;
            a_f32x16 st[2], Oc[2];
#pragma unroll
            for (int dt = 0; dt < 2; ++dt)
#pragma unroll
                for (int i = 0; i < 16; ++i) Oc[dt][i] = 0.f;
            for (int T = 0; T < ntc; ++T) {
                at_qk(lds + AT_KC + T * AT_TB, qf, st, off4, sl * (float)(1024 * T + 31 - tq), sl * 16.f, hh);
                at_mask(st, hh, 0, nlast - 64 * T);
                const float mt = at_rowmax(st);
                const float mn = fmaxf(m, mt), ms = (mn == -INFINITY) ? 0.f : mn;
                float ps = 0.f;
#pragma unroll
                for (int kt = 0; kt < 2; ++kt)
#pragma unroll
                    for (int i = 0; i < 16; ++i) ps += __builtin_amdgcn_exp2f(st[kt][i] - ms);
                l = l * __builtin_amdgcn_exp2f(m - ms) + ps; m = mn;
            }
            l = xhalf_sum(l);
            const float ms = (m == -INFINITY) ? 0.f : m, inv = l > 0.f ? 1.f / l : 0.f;
            LAS float* imp = (LAS float*)(lds + AT_IMP) + wid * 512 + ql * 64;
            for (int T = 0; T < ntc; ++T) {
                at_qk(lds + AT_KC + T * AT_TB, qf, st, off4, sl * (float)(1024 * T + 31 - tq) - ms, sl * 16.f, hh);
                at_mask(st, hh, 0, nlast - 64 * T);
#pragma unroll
                for (int kt = 0; kt < 2; ++kt)
#pragma unroll
                    for (int i = 0; i < 16; ++i) st[kt][i] = __builtin_amdgcn_exp2f(st[kt][i]) * inv;
#pragma unroll
                for (int kt = 0; kt < 2; ++kt)
#pragma unroll
                    for (int c = 0; c < 4; ++c) {
                        float qs = (st[kt][4 * c] + st[kt][4 * c + 1]) + (st[kt][4 * c + 2] + st[kt][4 * c + 3]), ls = st[kt][4 * c + 3];
                        qs += SHX(qs, 8); qs += SHX(qs, 16); ls += SHX(ls, 8); ls += SHX(ls, 16);
                        const int j = 16 * T + 8 * kt + 2 * c + hh;
                        if (hp == 0) { (void)__hip_atomic_fetch_add(imp + j, qs, __ATOMIC_RELAXED, __HIP_MEMORY_SCOPE_WORKGROUP); if (j < 63) (void)__hip_atomic_fetch_add(imp + j + 1, ls, __ATOMIC_RELAXED, __HIP_MEMORY_SCOPE_WORKGROUP); }
                    }
                { a_bf16x8 vf[2][4], pb[4]; at_pack(st, pb); at_vload(lds + AT_VC + T * AT_TB, vf, off4); at_pv(vf, pb, Oc); }
            }
#pragma unroll
            for (int dt = 0; dt < 2; ++dt)
#pragma unroll
                for (int i = 0; i < 16; ++i) Ot[dt][i] = gc * Oc[dt][i];
        }
        unsigned long long wor = 0ull;
        asm volatile("s_waitcnt lgkmcnt(0)" ::: "memory"); __builtin_amdgcn_wave_barrier();
        {
            const bool valid = lane <= cur, forced = (lane == 0) || (lane == cur) || (lane == cur - 1);
            const unsigned long long vmask = __ballot(valid);
            if (cur < 16) {
                if (lane == 0) {
#pragma unroll
                    for (int q = 0; q < 8; ++q) ((LAS unsigned long long*)(lds + AT_SELM))[wid * 8 + q] = vmask; }
                wor = vmask;
            } else {
                for (int q = 0; q < 8; q += 4) {
                    unsigned key[4], T[4];
#pragma unroll
                    for (int c = 0; c < 4; ++c) {
                        const float s = ((LAS float*)(lds + AT_IMP))[wid * 512 + (q + c) * 64 + lane];
                        const float sc = valid ? (forced ? 1e30f : s) : -1e30f;
                        const unsigned ub = __float_as_uint(sc); key[c] = (ub & 0x80000000u) ? ~ub : (ub | 0x80000000u); T[c] = 0u; }
#pragma unroll 1
                    for (int bit = 31; bit >= 0; --bit) {
#pragma unroll
                        for (int c = 0; c < 4; ++c) { const unsigned cand = T[c] | (1u << bit); if (__builtin_popcountll(__ballot(key[c] >= cand)) >= 16) T[c] = cand; } }
#pragma unroll
                    for (int c = 0; c < 4; ++c) {
                        unsigned long long selm = __ballot(key[c] > T[c]), eq = __ballot(key[c] == T[c]);
                        int need = 16 - __builtin_popcountll(selm);
                        for (; need > 0; --need) { const unsigned long long low = eq & (0ull - eq); selm |= low; eq ^= low; }
                        const unsigned long long mk = selm & vmask;
                        if (lane == 0) ((LAS unsigned long long*)(lds + AT_SELM))[wid * 8 + q + c] = mk;
                        wor |= mk; }
                }
            }
            if (lane == 0) ((LAS unsigned long long*)(lds + AT_WM))[wid] = wor;
        }
        __syncthreads();
        unsigned long long U = 0ull;
#pragma unroll
        for (int w = 0; w < 8; ++w) U |= ((LAS unsigned long long*)(lds + AT_WM))[w];
        U = ((unsigned long long)__builtin_amdgcn_readfirstlane((unsigned)(U >> 32)) << 32) | (unsigned long long)__builtin_amdgcn_readfirstlane((unsigned)U);
        { LAS float* gl = (LAS float*)(lds + AT_IMP) + wid * 128 + lane; gl[0] = gs; gl[64] = gw; if (dyn && wid == 0 && lane == 0) qslot[1] = knext; }
        AT_DERIVE(q0, g);
#define AT_OTP(v_) LAS float* v_; { int lx_; asm volatile("v_mbcnt_lo_u32_b32 %0, -1, 0\n\tv_mbcnt_hi_u32_b32 %0, -1, %0" : "=v"(lx_)); v_ = (LAS float*)(lds + AT_KC) + wid * 2048 + lx_ * 4; }
        { AT_OTP(otp);
#pragma unroll
        for (int c = 0; c < 8; ++c) *(LAS g8::f32x4*)(otp + c * 256) = g8::f32x4{Ot[c >> 2][4 * (c & 3)], Ot[c >> 2][4 * (c & 3) + 1], Ot[c >> 2][4 * (c & 3) + 2], Ot[c >> 2][4 * (c & 3) + 3]}; }
#define AT_SB() __builtin_amdgcn_sched_barrier(0)
#define AT_PIN(x) asm volatile("" : "+v"(x))
#define AT_MF(a, b, c) __builtin_amdgcn_mfma_f32_32x32x16_bf16(a, b, c, 0, 0, 0)
#define AT_WAIT_BAR(N) asm volatile("s_waitcnt vmcnt(" #N ") lgkmcnt(0)\n\ts_barrier" ::: "memory")
#define AT_KF(i) ((float)AT_REGOFF(i))
#define AT_PB(w) (*reinterpret_cast<a_bf16x8*>(&(w)))
#define AT_PK(P, i) pack_bf16(P[i], P[(i) + 1])
        for (int bi = 0; bi < 2; ++bi) {
            const int br = 1 - bi;
            const char* kbase = (const char*)((br == 0 ? kslc : kwin) + (size_t)bg * SEQ * 64);
            const char* vbase = (const char*)((br == 0 ? vslcT : vwinT) + (size_t)bg * 64 * SEQ);
            unsigned long long todo = ptodo;
            const int n = pn;
            const LAS unsigned* selp = (const LAS unsigned*)(lds + (br == 0 ? AT_SELM : AT_ONES)) + (br == 0 ? (wid * 8 + ql) * 2 : 0);
            float m = 0.f, l = 0.f, f_ = 1.f; bool resc_ = false;
            a_f32x16 O0, O1, pA0, pA1, pB0, pB1;
#pragma unroll
            for (int i = 0; i < 16; ++i) { O0[i] = 0.f; O1[i] = 0.f; }
            a_bf16x8 kf[8], vf[8]; au32x4 pw0, pw1, pw2, pw3;
            int sl_prev = 0, sl_cur = 0, sl_next = AT_TB;
#define AT_ROT() do { sl_prev = sl_cur; sl_cur = sl_next; sl_next = (sl_next == 2 * AT_TB) ? 0 : sl_next + AT_TB; } while (0)
#define AT_DMAK(jj, so) at_glds(lds + AT_KS + (so), kbase + (size_t)(jj) * 8192, ko, wid)
#define AT_DMAV(jj, so) at_glds(lds + AT_VS + (so), vbase + (size_t)(jj) * 128, voS, wid)
#define AT_POP(jv) do { jv = 63 - __builtin_clzll(todo); todo &= ~(1ull << jv); } while (0)
#define AT_BIAS(jj) ((((selp[(jj) >> 5] >> ((jj) & 31)) & 1u) != 0u) ? (sl * (float)(64 * (jj) - tqh) - m) : -INFINITY)
#define AT_KRD(s) do { kf[2 * (s)] = *(const LAS a_bf16x8*)(kb_ + off4[s]); kf[2 * (s) + 1] = *(const LAS a_bf16x8*)(kb_ + 4096 + off4[s]); } while (0)
#define AT_VRD(i) do { vf[i] = *(const LAS a_bf16x8*)(vp_ + 4096 * ((i) >> 2) + off4[(i) & 3]); } while (0)
            int q1 = pj0, q2 = pj1, q3 = pj2, jnew = 0;
            if (bi == 1) { AT_DMAV(q1, 0); AT_WAIT_BAR(1); } else { AT_WAIT_BAR(0); }
            {
                LAS unsigned char* kb_ = lds + AT_KS;
#pragma unroll
                for (int s = 0; s < 4; ++s) AT_KRD(s);
                const float b = AT_BIAS(q1); float slo = sl; AT_PIN(slo);
#pragma unroll
                for (int i = 0; i < 16; ++i) { pA0[i] = __builtin_fmaf(slo, AT_KF(i), b); pA1[i] = __builtin_fmaf(slo, AT_KF(i) + 32.f, b); }
#pragma unroll
                for (int s = 0; s < 4; ++s) { pA0 = AT_MF(kf[2 * s], qf[s], pA0); pA1 = AT_MF(kf[2 * s + 1], qf[s], pA1); }
                if (q1 == cur || (br == 1 && q1 == cur - 8)) { int lx_; asm volatile("v_mbcnt_lo_u32_b32 %0, -1, 0\n\tv_mbcnt_hi_u32_b32 %0, -1, %0" : "=v"(lx_)); const int tlx_ = wid * 8 + (lx_ & 7);
                    if (q1 == cur) at_mask2(pA0, pA1, lx_ >> 5, 0, tlx_); else at_mask2(pA0, pA1, lx_ >> 5, tlx_ + 1, 63); }
                const float rm = at_rowmax2(pA0, pA1), d = (rm == -INFINITY) ? 0.f : rm; m = d;
#pragma unroll
                for (int i = 0; i < 16; ++i) { pA0[i] = __builtin_amdgcn_exp2f(pA0[i] - d); pA1[i] = __builtin_amdgcn_exp2f(pA1[i] - d); }
            }
            AT_WAIT_BAR(0);
            q1 = q2; q2 = q3; q3 = 0;
            if (n > 3) { AT_POP(q3); AT_DMAK(q3, 0); }
            if (n > 1) AT_DMAV(q1, AT_TB);
            AT_ROT();
            {
                LAS unsigned char* kb_ = lds + AT_KS + sl_cur;
#pragma unroll
                for (int s = 0; s < 4; ++s) AT_KRD(s);
                const float b = AT_BIAS(q1); float slo = sl; AT_PIN(slo);
#pragma unroll
                for (int i = 0; i < 16; ++i) { pB0[i] = __builtin_fmaf(slo, AT_KF(i), b); pB1[i] = __builtin_fmaf(slo, AT_KF(i) + 32.f, b); }
            }
            if (n > 3) { AT_WAIT_BAR(2); } else if (n > 1) { AT_WAIT_BAR(1); } else { AT_WAIT_BAR(0); }
#define AT_GAPA(MF_, a0, a1, a2, a3, W0, W1, PW) do { MF_; sacc += a0; sacc += a1; sacc += a2; sacc += a3; W0; W1; AT_PIN(PW); AT_PIN(sacc); AT_SB(); } while (0)
#define AT_GAPB(MF_, X, i, Y, KO) do { MF_; X[i] = __builtin_amdgcn_exp2f(X[i]); X[(i) + 1] = __builtin_amdgcn_exp2f(X[(i) + 1]); X[(i) + 2] = __builtin_amdgcn_exp2f(X[(i) + 2]); X[(i) + 3] = __builtin_amdgcn_exp2f(X[(i) + 3]); \
        Y[i] = __builtin_fmaf(slo, AT_KF(i) + KO, bn); Y[(i) + 1] = __builtin_fmaf(slo, AT_KF((i) + 1) + KO, bn); Y[(i) + 2] = __builtin_fmaf(slo, AT_KF((i) + 2) + KO, bn); Y[(i) + 3] = __builtin_fmaf(slo, AT_KF((i) + 3) + KO, bn); \
        AT_PIN(X); AT_PIN(Y); AT_SB(); } while (0)
#define AT_STEP(C0, C1, P0, P1, t, ST) do { AT_SB(); \
            const unsigned selw_ = selp[q2 >> 5];                                  \
            { LAS unsigned char* vp_ = lds + AT_VS + sl_prev; \
              AT_VRD(0); AT_SB(); float sacc = P0[0] + P0[1]; \
                                  AT_GAPA(C0 = AT_MF(kf[0], qf[0], C0), P0[2], P0[3], P0[4], P0[5],     pw0[0] = AT_PK(P0, 0),  pw0[1] = AT_PK(P0, 2),  pw0); \
              AT_VRD(4); AT_SB(); AT_GAPA(C1 = AT_MF(kf[1], qf[0], C1), P0[6], P0[7], P0[8], P0[9],     pw0[2] = AT_PK(P0, 4),  pw0[3] = AT_PK(P0, 6),  pw0); \
              AT_VRD(1); AT_SB(); AT_GAPA(C0 = AT_MF(kf[2], qf[1], C0), P0[10], P0[11], P0[12], P0[13], pw1[0] = AT_PK(P0, 8),  pw1[1] = AT_PK(P0, 10), pw1); \
              AT_VRD(5); AT_SB(); AT_GAPA(C1 = AT_MF(kf[3], qf[1], C1), P0[14], P0[15], P1[0], P1[1],   pw1[2] = AT_PK(P0, 12), pw1[3] = AT_PK(P0, 14), pw1); \
              AT_VRD(2); AT_SB(); AT_GAPA(C0 = AT_MF(kf[4], qf[2], C0), P1[2], P1[3], P1[4], P1[5],     pw2[0] = AT_PK(P1, 0),  pw2[1] = AT_PK(P1, 2),  pw2); \
              AT_VRD(6); AT_SB(); AT_GAPA(C1 = AT_MF(kf[5], qf[2], C1), P1[6], P1[7], P1[8], P1[9],     pw2[2] = AT_PK(P1, 4),  pw2[3] = AT_PK(P1, 6),  pw2); \
              AT_VRD(3); AT_SB(); AT_GAPA(C0 = AT_MF(kf[6], qf[3], C0), P1[10], P1[11], P1[12], P1[13], pw3[0] = AT_PK(P1, 8),  pw3[1] = AT_PK(P1, 10), pw3); \
              AT_VRD(7); AT_SB(); AT_GAPA(C1 = AT_MF(kf[7], qf[3], C1), P1[14], P1[15], 0.f, 0.f,       pw3[2] = AT_PK(P1, 12), pw3[3] = AT_PK(P1, 14), pw3); \
              l += sacc; } \
            jnew = 0; \
            if (ST || (t) + 3 < n) { AT_POP(jnew); AT_DMAK(jnew, sl_cur); }              \
            if (ST || (t) + 1 < n) AT_DMAV(q2, sl_next); \
            if (q1 == cur || (br == 1 && q1 == cur - 8)) { int lx_; asm volatile("v_mbcnt_lo_u32_b32 %0, -1, 0\n\tv_mbcnt_hi_u32_b32 %0, -1, %0" : "=v"(lx_)); const int tlx_ = wid * 8 + (lx_ & 7); \
                if (q1 == cur) at_mask2(C0, C1, lx_ >> 5, 0, tlx_); else at_mask2(C0, C1, lx_ >> 5, tlx_ + 1, 63); } \
            resc_ = false; \
            { const float rm = at_rowmax2(C0, C1); \
              if (__any(rm > 6.f)) { const float dl = fmaxf(rm, 0.f); m += dl; f_ = __builtin_amdgcn_exp2f(-dl); l *= f_; resc_ = true; \
                  _Pragma("unroll") for (int i_ = 0; i_ < 16; ++i_) { C0[i_] -= dl; C1[i_] -= dl; } } } \
            { const float bn = (((selw_ >> (q2 & 31)) & 1u) != 0u) ? (sl * (float)(64 * q2 - tqh) - m) : -INFINITY; float slo = sl; AT_PIN(slo); LAS unsigned char* kb_ = lds + AT_KS + sl_next; AT_SB(); \
              AT_GAPB(O0 = AT_MF(vf[0], AT_PB(pw0), O0), C0, 0, P0, 0.f);                              AT_GAPB(O1 = AT_MF(vf[4], AT_PB(pw0), O1), C0, 4, P0, 0.f); \
              AT_KRD(0); AT_SB(); AT_GAPB(O0 = AT_MF(vf[1], AT_PB(pw1), O0), C0, 8, P0, 0.f);          AT_KRD(1); AT_SB(); AT_GAPB(O1 = AT_MF(vf[5], AT_PB(pw1), O1), C0, 12, P0, 0.f); \
              AT_KRD(2); AT_SB(); AT_GAPB(O0 = AT_MF(vf[2], AT_PB(pw2), O0), C1, 0, P1, 32.f);         AT_KRD(3); AT_SB(); AT_GAPB(O1 = AT_MF(vf[6], AT_PB(pw2), O1), C1, 4, P1, 32.f); \
              AT_GAPB(O0 = AT_MF(vf[3], AT_PB(pw3), O0), C1, 8, P1, 32.f);                             AT_GAPB(O1 = AT_MF(vf[7], AT_PB(pw3), O1), C1, 12, P1, 32.f); } \
            if (ST || (t) + 3 < n) { AT_WAIT_BAR(2); } else if ((t) + 2 < n) { AT_WAIT_BAR(1); } else { AT_WAIT_BAR(0); } \
            if (resc_) { _Pragma("unroll") for (int i_ = 0; i_ < 16; ++i_) { O0[i_] *= f_; O1[i_] *= f_; } } \
            AT_ROT(); q1 = q2; q2 = q3; q3 = jnew; \
            } while (0)
            int t = 1;
            for (; t + 4 < n; t += 2) {
                AT_STEP(pB0, pB1, pA0, pA1, t, 1);
                AT_STEP(pA0, pA1, pB0, pB1, t + 1, 1);
            }
            for (; t + 1 < n; t += 2) {
                AT_STEP(pB0, pB1, pA0, pA1, t, 0);
                AT_STEP(pA0, pA1, pB0, pB1, t + 1, 0);
            }
            if (t < n) { AT_STEP(pB0, pB1, pA0, pA1, t, 0); pA0 = pB0; pA1 = pB1; }
            if (bi == 0) {
                const char* kbs = (const char*)(kslc + (size_t)bg * SEQ * 64);
                ptodo = U; pn = __builtin_popcountll(U); pj1 = 0; pj2 = 0;
                pj0 = 63 - __builtin_clzll(ptodo); ptodo &= ~(1ull << pj0); at_glds(lds + AT_KS, kbs + (size_t)pj0 * 8192, ko, wid);
                if (pn > 1) { pj1 = 63 - __builtin_clzll(ptodo); ptodo &= ~(1ull << pj1); at_glds(lds + AT_KS + AT_TB, kbs + (size_t)pj1 * 8192, ko, wid); }
                if (pn > 2) { pj2 = 63 - __builtin_clzll(ptodo); ptodo &= ~(1ull << pj2); at_glds(lds + AT_KS + 2 * AT_TB, kbs + (size_t)pj2 * 8192, ko, wid); }
            }
            {
                float sacc = 0.f;
#pragma unroll
                for (int i = 0; i < 16; ++i) sacc += pA0[i] + pA1[i];
                l += sacc;
                pw0 = au32x4{AT_PK(pA0, 0), AT_PK(pA0, 2), AT_PK(pA0, 4), AT_PK(pA0, 6)}; pw1 = au32x4{AT_PK(pA0, 8), AT_PK(pA0, 10), AT_PK(pA0, 12), AT_PK(pA0, 14)};
                pw2 = au32x4{AT_PK(pA1, 0), AT_PK(pA1, 2), AT_PK(pA1, 4), AT_PK(pA1, 6)}; pw3 = au32x4{AT_PK(pA1, 8), AT_PK(pA1, 10), AT_PK(pA1, 12), AT_PK(pA1, 14)};
                LAS unsigned char* vp_ = lds + AT_VS + sl_prev;
#pragma unroll
                for (int i = 0; i < 8; ++i) AT_VRD(i);
                O0 = AT_MF(vf[0], AT_PB(pw0), O0); O1 = AT_MF(vf[4], AT_PB(pw0), O1); O0 = AT_MF(vf[1], AT_PB(pw1), O0); O1 = AT_MF(vf[5], AT_PB(pw1), O1);
                O0 = AT_MF(vf[2], AT_PB(pw2), O0); O1 = AT_MF(vf[6], AT_PB(pw2), O1); O0 = AT_MF(vf[3], AT_PB(pw3), O0); O1 = AT_MF(vf[7], AT_PB(pw3), O1);
            }
            l = xhalf_sum(l);
            int lb_; asm volatile("v_mbcnt_lo_u32_b32 %0, -1, 0\n\tv_mbcnt_hi_u32_b32 %0, -1, %0" : "=v"(lb_));
            const float gsc = ((LAS float*)(lds + AT_IMP))[wid * 128 + lb_ + 64 * br] / l;
            AT_OTP(otp);
#pragma unroll
            for (int c = 0; c < 8; ++c) {
                g8::f32x4 v = *(LAS g8::f32x4*)(otp + c * 256);
                if (c < 4) { v[0] += gsc * O0[4 * c]; v[1] += gsc * O0[4 * c + 1]; v[2] += gsc * O0[4 * c + 2]; v[3] += gsc * O0[4 * c + 3]; }
                else { v[0] += gsc * O1[4 * (c - 4)]; v[1] += gsc * O1[4 * (c - 4) + 1]; v[2] += gsc * O1[4 * (c - 4) + 2]; v[3] += gsc * O1[4 * (c - 4) + 3]; }
                *(LAS g8::f32x4*)(otp + c * 256) = v;
            }
            asm volatile("s_waitcnt lgkmcnt(0)\n\ts_barrier" ::: "memory");
        }
#undef AT_STEP
#undef AT_GAPA
#undef AT_GAPB
#undef AT_ROT
#undef AT_DMAK
#undef AT_DMAV
#undef AT_POP
#undef AT_BIAS
#undef AT_KRD
#undef AT_VRD
        AT_OTP(otp);
#pragma unroll
        for (int c = 0; c < 8; ++c) { const g8::f32x4 v = *(LAS g8::f32x4*)(otp + c * 256); Ot[c >> 2][4 * (c & 3)] = v[0]; Ot[c >> 2][4 * (c & 3) + 1] = v[1]; Ot[c >> 2][4 * (c & 3) + 2] = v[2]; Ot[c >> 2][4 * (c & 3) + 3] = v[3]; }
        int l2; asm volatile("v_mbcnt_lo_u32_b32 %0, -1, 0\n\tv_mbcnt_hi_u32_b32 %0, -1, %0" : "=v"(l2));
        const int r2 = l2 & 31;
        unsigned short* orow = ob + (size_t)(b * SEQ + q0 + wid * 8 + (r2 & 7)) * 1024 + (g * 4 + (r2 >> 3)) * 64 + 8 * (l2 >> 5);
#pragma unroll
        for (int dt = 0; dt < 2; ++dt)
#pragma unroll
            for (int c = 0; c < 4; c += 2) {
                unsigned ax = pack_bf16(Ot[dt][4 * c], Ot[dt][4 * c + 1]), ay = pack_bf16(Ot[dt][4 * c + 2], Ot[dt][4 * c + 3]);
                unsigned bx = pack_bf16(Ot[dt][4 * c + 4], Ot[dt][4 * c + 5]), by = pack_bf16(Ot[dt][4 * c + 6], Ot[dt][4 * c + 7]);
                const auto rx = __builtin_amdgcn_permlane32_swap(ax, bx, false, false); const auto ry = __builtin_amdgcn_permlane32_swap(ay, by, false, false);
                *(uint4*)(orow + 32 * dt + 8 * c) = make_uint4(rx[0], ry[0], rx[1], ry[1]); }
        asm volatile("s_waitcnt lgkmcnt(0)\n\ts_barrier" ::: "memory");
        if (dyn) kq = qslot[1]; else { I += nb_s; ++it; }
    }
}
__device__ __forceinline__ float bf2f(unsigned short v) { return __uint_as_float(((unsigned)v) << 16); }
__device__ __forceinline__ void ph_gla_p1(const unsigned short* qk, const float* glr, const unsigned short* vT, const float* w2, const float* bgate,
                                          unsigned short* qd, unsigned short* ki, float* dl, unsigned short* UT, LAS unsigned char* lds) {
    LAUNDER();
    const int wid = wv_s, lane = tid_ & 63, r = lane & 31, hh = lane >> 5;
    LAS float* gsum = (LAS float*)lds;
    LAS float* gl = (LAS float*)(lds + 2048);
    LAS unsigned char* ket = lds + 2048 + 4096;
    const int d = tid_ & 127, sg = tid_ >> 7;
    float glp0 = 0.f, glp1 = 0.f, wp[16], bgp = 0.f;
    if (bid_ < 2048) { const int h = bid_ & 3, c = (bid_ >> 2) & 63, b = bid_ >> 8, tok0 = b * SEQ + c * 64;
        glp0 = glr[(size_t)tok0 * 16 + tid_]; glp1 = glr[(size_t)tok0 * 16 + tid_ + 512];
#pragma unroll
        for (int k = 0; k < 16; ++k) wp[k] = w2[k * 512 + h * 128 + d];
        bgp = bgate[h * 128 + d]; }
    for (int it = bid_; it < 2048; it += nb_s) {
        const int h = it & 3, c = (it >> 2) & 63, b = it >> 8, bh = b * 4 + h, tok0 = b * SEQ + c * 64;
        a_bf16x8 vfr[4];
        { const unsigned short* vrow = vT + ((size_t)bh * 256 + 32 * wid + r) * SEQ + c * 64;
#pragma unroll
          for (int ks = 0; ks < 4; ++ks) vfr[ks] = *(const a_bf16x8*)(vrow + 16 * ks + 8 * hh); }
        unsigned short qraw[16], kraw[16];
#pragma unroll
        for (int i = 0; i < 16; ++i) { const size_t o = (size_t)(tok0 + sg * 16 + i) * 1024 + h * 128 + d; qraw[i] = qk[o]; kraw[i] = qk[o + 512]; }
        gl[tid_] = glp0; gl[tid_ + 512] = glp1;
        float w[16];
#pragma unroll
        for (int k = 0; k < 16; ++k) w[k] = wp[k];
        const float bgv = bgp;
        { const int itn = it + nb_s;
          if (itn < 2048) { const int hn = itn & 3, cn = (itn >> 2) & 63, bn = itn >> 8, tokn = bn * SEQ + cn * 64;
              glp0 = glr[(size_t)tokn * 16 + tid_]; glp1 = glr[(size_t)tokn * 16 + tid_ + 512];
#pragma unroll
              for (int k = 0; k < 16; ++k) wp[k] = w2[k * 512 + hn * 128 + d];
              bgp = bgate[hn * 128 + d]; } }
        __syncthreads();
        float la[16]; float run = 0.f;
#pragma unroll
        for (int i = 0; i < 16; ++i) { const int s = sg * 16 + i; float z = bgv;
#pragma unroll
            for (int k = 0; k < 16; ++k) z += gl[s * 16 + k] * w[k];
            run += fast_logsigmoid(z) * (1.f / 16.f); la[i] = run; }
        gsum[sg * 128 + d] = run;
        __syncthreads();
        float pre = 0.f, tot = 0.f;
#pragma unroll
        for (int g = 0; g < 4; ++g) { const float v = gsum[g * 128 + d]; tot += v; pre += (g < sg) ? v : 0.f; }
        const float etot = fast_exp(tot);
#pragma unroll
        for (int i = 0; i < 16; ++i) { const int s = sg * 16 + i; const float bb = la[i] + pre;
            const float q = bf2f(qraw[i]), k = bf2f(kraw[i]);
            const float eb = fast_exp(bb), ieb = __builtin_amdgcn_rcpf(eb);
            qd[(size_t)(tok0 + s) * 512 + h * 128 + d] = f2bf(q * 0.08838834764831845f * eb);
            ki[(size_t)(tok0 + s) * 512 + h * 128 + d] = f2bf(k * ieb);
            *(LAS unsigned short*)(ket + d * 144 + s * 2) = f2bf(k * (etot * ieb)); }
        if (sg == 0) dl[(size_t)(bh * 64 + c) * 128 + d] = etot;
        __syncthreads();
        a_f32x16 acc[4];
#pragma unroll
        for (int dt = 0; dt < 4; ++dt)
#pragma unroll
            for (int i = 0; i < 16; ++i) acc[dt][i] = 0.f;
#pragma unroll
        for (int ks = 0; ks < 4; ++ks) {
            a_bf16x8 bfr[4];
#pragma unroll
            for (int dt = 0; dt < 4; ++dt) bfr[dt] = *(const LAS a_bf16x8*)(ket + (32 * dt + r) * 144 + (16 * ks + 8 * hh) * 2);
            __builtin_amdgcn_sched_barrier(0);
#pragma unroll
            for (int dt = 0; dt < 4; ++dt) acc[dt] = __builtin_amdgcn_mfma_f32_32x32x16_bf16(bfr[dt], vfr[ks], acc[dt], 0, 0, 0); }
        unsigned short* urow = UT + (size_t)(bh * 64 + c) * 256 * 128 + (size_t)(32 * wid + r) * 128 + 8 * hh;
#pragma unroll
        for (int dt = 0; dt < 4; ++dt)
#pragma unroll
            for (int c2 = 0; c2 < 4; c2 += 2) {
                const unsigned ax = pack_bf16_v(acc[dt][4 * c2], acc[dt][4 * c2 + 1]), ay = pack_bf16_v(acc[dt][4 * c2 + 2], acc[dt][4 * c2 + 3]);
                const unsigned bx = pack_bf16_v(acc[dt][4 * c2 + 4], acc[dt][4 * c2 + 5]), by = pack_bf16_v(acc[dt][4 * c2 + 6], acc[dt][4 * c2 + 7]);
                const auto rx = __builtin_amdgcn_permlane32_swap(ax, bx, false, false); const auto ry = __builtin_amdgcn_permlane32_swap(ay, by, false, false);
                *(uint4*)(urow + 32 * dt + 8 * c2) = make_uint4(rx[0], ry[0], rx[1], ry[1]); }
        __syncthreads();
    }
}
__device__ __forceinline__ void ph_gla_p2(const unsigned short* __restrict__ UT, const float* __restrict__ dl, unsigned short* __restrict__ ST) {
    LAUNDER();
#define GP2_LOAD(uu, dv, c0) do { _Pragma("unroll") for (int k_ = 0; k_ < 8; ++k_) { const size_t o_ = ((size_t)(bh * 64 + (c0) + k_) * 256 + e) * 128 + d4; \
        uu[k_] = *(const uint2*)(UT + o_); dv[k_] = *(const float4*)(dl + (size_t)(bh * 64 + (c0) + k_) * 128 + d4); } } while (0)
#define GP2_STEP(uu, dv, c0) do { _Pragma("unroll") for (int k_ = 0; k_ < 8; ++k_) { const size_t o_ = ((size_t)(bh * 64 + (c0) + k_) * 256 + e) * 128 + d4; \
        *(uint2*)(ST + o_) = make_uint2(pack_bf16(S.x, S.y), pack_bf16(S.z, S.w)); \
        S.x = S.x * dv[k_].x + bf2f((unsigned short)(uu[k_].x & 0xffff)); S.y = S.y * dv[k_].y + bf2f((unsigned short)(uu[k_].x >> 16)); \
        S.z = S.z * dv[k_].z + bf2f((unsigned short)(uu[k_].y & 0xffff)); S.w = S.w * dv[k_].w + bf2f((unsigned short)(uu[k_].y >> 16)); } } while (0)
    for (int idx = GTID; idx < 32 * 256 * 32; idx += GSZ) {
        const int bh = idx >> 13, rem = idx & 8191, e = rem >> 5, d4 = (rem & 31) * 4;
        float4 S = make_float4(0.f, 0.f, 0.f, 0.f);
        uint2 ua[8], ub[8]; float4 da[8], db[8];
        GP2_LOAD(ua, da, 0);
#pragma unroll 1
        for (int c0 = 0; c0 < 64; c0 += 16) {
            GP2_LOAD(ub, db, c0 + 8);
            GP2_STEP(ua, da, c0);
            if (c0 + 16 < 64) GP2_LOAD(ua, da, c0 + 16);
            GP2_STEP(ub, db, c0 + 8);
        }
    }
#undef GP2_LOAD
#undef GP2_STEP
}
__device__ __forceinline__ void ph_gla_p3(const unsigned short* qd, const unsigned short* ki, const unsigned short* vT, const unsigned short* ST, const unsigned short* rb,
                                          const float* ng, unsigned short* ob, LAS unsigned char* lds) {
    LAUNDER();
    const int wid = wv_s, lane = tid_ & 63, r = lane & 31, hh = lane >> 5;
    constexpr int PQ = 272;
    LAS unsigned char* QS = lds; LAS unsigned char* KS = lds + 64 * PQ; LAS float* SSQ = (LAS float*)(lds + 2 * 64 * PQ);
    LAS float* NGL = SSQ + 512;
    if (tid_ < 256) *(LAS g8::f32x4*)(NGL + tid_ * 4) = *(const g8::f32x4*)(ng + tid_ * 4);
    au32x4 qpre[2], kpre[2];
    if (bid_ < 2048) { const int h = bid_ & 3, c = (bid_ >> 2) & 63, b = bid_ >> 8, tok0 = b * SEQ + c * 64; const int row = tid_ >> 3, ch = tid_ & 7;
#pragma unroll
        for (int j = 0; j < 2; ++j) { qpre[j] = *(const au32x4*)(qd + (size_t)(tok0 + row) * 512 + h * 128 + (ch + 8 * j) * 8); kpre[j] = *(const au32x4*)(ki + (size_t)(tok0 + row) * 512 + h * 128 + (ch + 8 * j) * 8); } }
    for (int it = bid_; it < 2048; it += nb_s) {
        const int h = it & 3, c = (it >> 2) & 63, b = it >> 8, bh = b * 4 + h, tok0 = b * SEQ + c * 64;
        a_bf16x8 sf[8]; au32x2 vlo[3][2], vhi[3][2];
        uint2 rgp[2][4];
#pragma unroll
        for (int qt = 0; qt < 2; ++qt)
#pragma unroll
            for (int c4 = 0; c4 < 4; ++c4) rgp[qt][c4] = *(const uint2*)(rb + (size_t)(tok0 + 32 * qt + r) * 1024 + h * 256 + 32 * wid + 8 * c4 + 4 * hh);
        { const unsigned short* srow = ST + ((size_t)(bh * 64 + c) * 256 + 32 * wid + r) * 128;
          const unsigned short* vrow = vT + ((size_t)bh * 256 + 32 * wid + r) * SEQ + c * 64;
#pragma unroll
          for (int ks = 0; ks < 8; ++ks) sf[ks] = *(const a_bf16x8*)(srow + 16 * ks + 8 * hh);
#pragma unroll
          for (int t3 = 0; t3 < 3; ++t3) { const int st = t3 == 2 ? 1 : 0;
#pragma unroll
              for (int s2 = 0; s2 < 2; ++s2) { vlo[t3][s2] = *(const au32x2*)(vrow + 32 * st + 16 * s2 + 4 * hh); vhi[t3][s2] = *(const au32x2*)(vrow + 32 * st + 16 * s2 + 4 * hh + 8); } } }
        { const int row = tid_ >> 3, ch = tid_ & 7;
#pragma unroll
          for (int j = 0; j < 2; ++j) { *(LAS au32x4*)(QS + row * PQ + (ch + 8 * j) * 16) = qpre[j]; *(LAS au32x4*)(KS + row * PQ + (ch + 8 * j) * 16) = kpre[j]; }
          const int itn = it + nb_s;
          if (itn < 2048) { const int hn = itn & 3, cn = (itn >> 2) & 63, bn = itn >> 8, tokn = bn * SEQ + cn * 64;
#pragma unroll
              for (int j = 0; j < 2; ++j) { qpre[j] = *(const au32x4*)(qd + (size_t)(tokn + row) * 512 + hn * 128 + (ch + 8 * j) * 8); kpre[j] = *(const au32x4*)(ki + (size_t)(tokn + row) * 512 + hn * 128 + (ch + 8 * j) * 8); } } }
        __syncthreads();
        a_bf16x8 qfr[2][8];
#pragma unroll
        for (int qt = 0; qt < 2; ++qt)
#pragma unroll
            for (int ks = 0; ks < 8; ++ks) qfr[qt][ks] = *(const LAS a_bf16x8*)(QS + (32 * qt + r) * PQ + (16 * ks + 8 * hh) * 2);
        a_f32x16 att[3];
#pragma unroll
        for (int st = 0; st < 2; ++st) {
            a_bf16x8 kfr[8];
#pragma unroll
            for (int ks = 0; ks < 8; ++ks) kfr[ks] = *(const LAS a_bf16x8*)(KS + (32 * st + r) * PQ + (16 * ks + 8 * hh) * 2);
            __builtin_amdgcn_sched_barrier(0);
            if (st == 0) {
                a_f32x16 a0, a1;
#pragma unroll
                for (int i = 0; i < 16; ++i) { a0[i] = 0.f; a1[i] = 0.f; }
#pragma unroll
                for (int ks = 0; ks < 8; ++ks) { a0 = __builtin_amdgcn_mfma_f32_32x32x16_bf16(kfr[ks], qfr[0][ks], a0, 0, 0, 0); a1 = __builtin_amdgcn_mfma_f32_32x32x16_bf16(kfr[ks], qfr[1][ks], a1, 0, 0, 0); }
#pragma unroll
                for (int i = 0; i < 16; ++i) a0[i] = (AT_REGOFF(i) + 4 * hh <= r) ? a0[i] : 0.f;
                att[0] = a0; att[1] = a1;
            } else {
                a_f32x16 a2;
#pragma unroll
                for (int i = 0; i < 16; ++i) a2[i] = 0.f;
#pragma unroll
                for (int ks = 0; ks < 8; ++ks) a2 = __builtin_amdgcn_mfma_f32_32x32x16_bf16(kfr[ks], qfr[1][ks], a2, 0, 0, 0);
#pragma unroll
                for (int i = 0; i < 16; ++i) a2[i] = (AT_REGOFF(i) + 4 * hh <= r) ? a2[i] : 0.f;
                att[2] = a2;
            }
        }
        a_f32x16 O[2];
#pragma unroll
        for (int qt = 0; qt < 2; ++qt)
#pragma unroll
            for (int i = 0; i < 16; ++i) O[qt][i] = 0.f;
#pragma unroll
        for (int ks = 0; ks < 8; ++ks) {
            O[0] = __builtin_amdgcn_mfma_f32_32x32x16_bf16(sf[ks], qfr[0][ks], O[0], 0, 0, 0);
            O[1] = __builtin_amdgcn_mfma_f32_32x32x16_bf16(sf[ks], qfr[1][ks], O[1], 0, 0, 0); }
#pragma unroll
        for (int t3 = 0; t3 < 3; ++t3) { const int qt = t3 == 0 ? 0 : 1;
#pragma unroll
            for (int s2 = 0; s2 < 2; ++s2) {
                au32x4 pw = {pack_bf16(att[t3][8 * s2 + 0], att[t3][8 * s2 + 1]), pack_bf16(att[t3][8 * s2 + 2], att[t3][8 * s2 + 3]), pack_bf16(att[t3][8 * s2 + 4], att[t3][8 * s2 + 5]), pack_bf16(att[t3][8 * s2 + 6], att[t3][8 * s2 + 7])};
                au32x4 aw = {vlo[t3][s2].x, vlo[t3][s2].y, vhi[t3][s2].x, vhi[t3][s2].y};
                O[qt] = __builtin_amdgcn_mfma_f32_32x32x16_bf16(*reinterpret_cast<a_bf16x8*>(&aw), *reinterpret_cast<a_bf16x8*>(&pw), O[qt], 0, 0, 0); } }
#pragma unroll
        for (int qt = 0; qt < 2; ++qt) { float ss = 0.f;
#pragma unroll
            for (int i = 0; i < 16; ++i) ss += O[qt][i] * O[qt][i];
            ss = xhalf_sum(ss); if (hh == 0) SSQ[wid * 64 + 32 * qt + r] = ss; }
        __syncthreads();
#pragma unroll
        for (int qt = 0; qt < 2; ++qt) { float tot = 0.f;
#pragma unroll
            for (int w = 0; w < 8; ++w) tot += SSQ[w * 64 + 32 * qt + r];
            const float rn = rsqrtf(tot * (1.f / 256.f) + 1e-5f);
            const size_t orow = (size_t)(tok0 + 32 * qt + r) * 1024 + h * 256;
            unsigned pk[4][2];
#pragma unroll
            for (int c4 = 0; c4 < 4; ++c4) { const int e0 = 32 * wid + 8 * c4 + 4 * hh;
                const uint2 rg = rgp[qt][c4]; const g8::f32x4 gq = *(const LAS g8::f32x4*)(NGL + h * 256 + e0); const float4 gv = make_float4(gq[0], gq[1], gq[2], gq[3]);
                const float r0 = bf2f((unsigned short)(rg.x & 0xffff)), r1 = bf2f((unsigned short)(rg.x >> 16)), r2 = bf2f((unsigned short)(rg.y & 0xffff)), r3 = bf2f((unsigned short)(rg.y >> 16));
                pk[c4][0] = pack_bf16(O[qt][4 * c4] * rn * gv.x * fast_silu(r0), O[qt][4 * c4 + 1] * rn * gv.y * fast_silu(r1));
                pk[c4][1] = pack_bf16(O[qt][4 * c4 + 2] * rn * gv.z * fast_silu(r2), O[qt][4 * c4 + 3] * rn * gv.w * fast_silu(r3)); }
#pragma unroll
            for (int c4 = 0; c4 < 4; c4 += 2) {
                const auto rx = __builtin_amdgcn_permlane32_swap(pk[c4][0], pk[c4 + 1][0], false, false); const auto ry = __builtin_amdgcn_permlane32_swap(pk[c4][1], pk[c4 + 1][1], false, false);
                *(uint4*)(ob + orow + 32 * wid + 8 * c4 + 8 * hh) = make_uint4(rx[0], ry[0], rx[1], ry[1]); } }
        __syncthreads();
    }
}
__device__ __forceinline__ void ph_norm_router(const unsigned short* x, const float* g, const float* shift, const float* scale, int ldmod, unsigned short* hb,
                                               const float* rw, const float* rbias, int* topi, float* topw, int* cntb, int* stok, LAS unsigned char* lds) {
    LAUNDER();
    const int wid = wv_s, lane = tid_ & 63, e = lane & 31, kh = lane >> 5;
    LAS float* hs = (LAS float*)lds;
    constexpr int HSP = 1028;
    LAS float* part = (LAS float*)(lds + 16 * HSP * 4);
    LAS int* hist = (LAS int*)(lds + 16 * HSP * 4 + 16384);
    for (int i = GTID; i < CAP; i += GSZ) stok[i] = -1;
    g8::bf16x8 wh[4][2], wl[4][2];
#pragma unroll
    for (int ks = 0; ks < 4; ++ks)
#pragma unroll
        for (int nt = 0; nt < 2; ++nt) {
            unsigned hw[4], lw[4];
#pragma unroll
            for (int j2 = 0; j2 < 4; ++j2) { float w0 = rw[(128 * wid + 32 * ks + 8 * (lane >> 4) + 2 * j2) * 32 + 16 * nt + (lane & 15)], w1 = rw[(128 * wid + 32 * ks + 8 * (lane >> 4) + 2 * j2 + 1) * 32 + 16 * nt + (lane & 15)];
                const unsigned hp2 = pack_bf16(w0, w1); hw[j2] = hp2;
                lw[j2] = pack_bf16(w0 - __uint_as_float(hp2 << 16), w1 - __uint_as_float(hp2 & 0xffff0000u)); }
            au32x4 hv = {hw[0], hw[1], hw[2], hw[3]}, lv = {lw[0], lw[1], lw[2], lw[3]};
            wh[ks][nt] = *reinterpret_cast<g8::bf16x8*>(&hv); wl[ks][nt] = *reinterpret_cast<g8::bf16x8*>(&lv); }
    const float rbv = rbias[e];
    if (tid_ < 32) hist[tid_] = 0;
    __syncthreads();
    uint2 xr[2][4];
    float4 gg4[4], scn[4], shn[4];
#pragma unroll
    for (int j = 0; j < 4; ++j) gg4[j] = *(const float4*)(g + j * 256 + lane * 4);
    if (bid_ < NT / 16) {
#pragma unroll
        for (int rr = 0; rr < 2; ++rr)
#pragma unroll
            for (int j = 0; j < 4; ++j) xr[rr][j] = *(const uint2*)(x + (size_t)(bid_ * 16 + wid * 2 + rr) * DM + j * 256 + lane * 4);
        const int b0 = bid_ * 16 / SEQ;
#pragma unroll
        for (int j = 0; j < 4; ++j) { scn[j] = *(const float4*)(scale + b0 * ldmod + j * 256 + lane * 4); shn[j] = *(const float4*)(shift + b0 * ldmod + j * 256 + lane * 4); }
    }
    for (int tile = bid_; tile < NT / 16; tile += nb_s) {
        float4 ga4[4], sh4[4];
#pragma unroll
        for (int j = 0; j < 4; ++j) { ga4[j] = make_float4(gg4[j].x * (1.f + scn[j].x), gg4[j].y * (1.f + scn[j].y), gg4[j].z * (1.f + scn[j].z), gg4[j].w * (1.f + scn[j].w)); sh4[j] = shn[j]; }
#pragma unroll
        for (int rr = 0; rr < 2; ++rr) {
            const int trow = wid * 2 + rr, row = tile * 16 + trow;
            float4 v[4]; float ss = 0.f;
#pragma unroll
            for (int j = 0; j < 4; ++j) { const uint2 u = xr[rr][j]; v[j] = make_float4(__uint_as_float(u.x << 16), __uint_as_float(u.x & 0xffff0000u), __uint_as_float(u.y << 16), __uint_as_float(u.y & 0xffff0000u)); ss += v[j].x * v[j].x + v[j].y * v[j].y + v[j].z * v[j].z + v[j].w * v[j].w; }
#pragma unroll
            for (int o = 32; o > 0; o >>= 1) ss += SHX(ss, o);
            const float rn = rsqrtf(ss * (1.f / DM) + 1e-5f);
#pragma unroll
            for (int j = 0; j < 4; ++j) { const int col = j * 256 + lane * 4;
                float4 y;
                y.x = v[j].x * rn * ga4[j].x + sh4[j].x; y.y = v[j].y * rn * ga4[j].y + sh4[j].y; y.z = v[j].z * rn * ga4[j].z + sh4[j].z; y.w = v[j].w * rn * ga4[j].w + sh4[j].w;
                *(uint2*)(hb + (size_t)row * DM + col) = make_uint2(pack_bf16(y.x, y.y), pack_bf16(y.z, y.w));
                *(LAS g8::f32x4*)(hs + trow * HSP + col) = (g8::f32x4){y.x, y.y, y.z, y.w}; }
        }
        if (tile + nb_s < NT / 16) {
#pragma unroll
            for (int rr = 0; rr < 2; ++rr)
#pragma unroll
                for (int j = 0; j < 4; ++j) xr[rr][j] = *(const uint2*)(x + (size_t)((tile + nb_s) * 16 + wid * 2 + rr) * DM + j * 256 + lane * 4);
            const int bn = (tile + nb_s) * 16 / SEQ;
#pragma unroll
            for (int j = 0; j < 4; ++j) { scn[j] = *(const float4*)(scale + bn * ldmod + j * 256 + lane * 4); shn[j] = *(const float4*)(shift + bn * ldmod + j * 256 + lane * 4); }
        }
        __syncthreads();
        {
            g8::f32x4 acc0 = {0.f, 0.f, 0.f, 0.f}, acc1 = {0.f, 0.f, 0.f, 0.f};
            const LAS float* hp_ = hs + (lane & 15) * HSP + 128 * wid + 8 * (lane >> 4);
#pragma unroll
            for (int ks = 0; ks < 4; ++ks) {
                const g8::f32x4 x0 = *(const LAS g8::f32x4*)(hp_ + 32 * ks), x1 = *(const LAS g8::f32x4*)(hp_ + 32 * ks + 4);
                unsigned hh_[4], ll_[4];
                { unsigned p;
                  p = pack_bf16(x0[0], x0[1]); hh_[0] = p; ll_[0] = pack_bf16(x0[0] - __uint_as_float(p << 16), x0[1] - __uint_as_float(p & 0xffff0000u));
                  p = pack_bf16(x0[2], x0[3]); hh_[1] = p; ll_[1] = pack_bf16(x0[2] - __uint_as_float(p << 16), x0[3] - __uint_as_float(p & 0xffff0000u));
                  p = pack_bf16(x1[0], x1[1]); hh_[2] = p; ll_[2] = pack_bf16(x1[0] - __uint_as_float(p << 16), x1[1] - __uint_as_float(p & 0xffff0000u));
                  p = pack_bf16(x1[2], x1[3]); hh_[3] = p; ll_[3] = pack_bf16(x1[2] - __uint_as_float(p << 16), x1[3] - __uint_as_float(p & 0xffff0000u)); }
                au32x4 hv = {hh_[0], hh_[1], hh_[2], hh_[3]}, lv = {ll_[0], ll_[1], ll_[2], ll_[3]};
                const g8::bf16x8 ah = *reinterpret_cast<g8::bf16x8*>(&hv), al = *reinterpret_cast<g8::bf16x8*>(&lv);
                acc0 = __builtin_amdgcn_mfma_f32_16x16x32_bf16(ah, wh[ks][0], acc0, 0, 0, 0); acc1 = __builtin_amdgcn_mfma_f32_16x16x32_bf16(ah, wh[ks][1], acc1, 0, 0, 0);
                acc0 = __builtin_amdgcn_mfma_f32_16x16x32_bf16(ah, wl[ks][0], acc0, 0, 0, 0); acc1 = __builtin_amdgcn_mfma_f32_16x16x32_bf16(ah, wl[ks][1], acc1, 0, 0, 0);
                acc0 = __builtin_amdgcn_mfma_f32_16x16x32_bf16(al, wh[ks][0], acc0, 0, 0, 0); acc1 = __builtin_amdgcn_mfma_f32_16x16x32_bf16(al, wh[ks][1], acc1, 0, 0, 0);
            }
#pragma unroll
            for (int rg = 0; rg < 4; ++rg) { part[(wid * 16 + 4 * (lane >> 4) + rg) * 32 + (lane & 15)] = acc0[rg]; part[(wid * 16 + 4 * (lane >> 4) + rg) * 32 + 16 + (lane & 15)] = acc1[rg]; }
        }
        __syncthreads();
#pragma unroll
        for (int rr = 0; rr < 2; ++rr) {
            const int t = wid * 2 + rr, row = tile * 16 + t;
            float v = rbv;
#pragma unroll
            for (int w = 0; w < 8; ++w) v += part[(w * 16 + t) * 32 + e];
            int rank = 0;
#pragma unroll
            for (int e2 = 0; e2 < 32; ++e2) { const float ve = __uint_as_float(__builtin_amdgcn_readlane(__float_as_uint(v), e2)); rank += (ve > v || (ve == v && e2 < e)) ? 1 : 0; }
            float tv[4]; int ti[4];
#pragma unroll
            for (int r4 = 0; r4 < 4; ++r4) { const unsigned m = (unsigned)__ballot(rank == r4); const int lr = __builtin_ctz(m); ti[r4] = lr; tv[r4] = __uint_as_float(__builtin_amdgcn_readlane(__float_as_uint(v), lr)); }
            float w4[4], s = 0.f;
#pragma unroll
            for (int r4 = 0; r4 < 4; ++r4) { w4[r4] = expf(tv[r4] - tv[0]); s += w4[r4]; }
            if (lane == 0) {
                *(int4*)(topi + row * 4) = make_int4(ti[0], ti[1], ti[2], ti[3]);
                *(float4*)(topw + row * 4) = make_float4(w4[0] / s, w4[1] / s, w4[2] / s, w4[3] / s);
#pragma unroll
                for (int r4 = 0; r4 < 4; ++r4) (void)__hip_atomic_fetch_add(hist + ti[r4], 1, __ATOMIC_RELAXED, __HIP_MEMORY_SCOPE_WORKGROUP);
            }
        }
    }
    __syncthreads();
    if (tid_ < 32) cntb[bid_ * 32 + tid_] = hist[tid_];
}
__device__ __forceinline__ void ph_assign2(const int* topi, const int* cntb, int* cnt, int* stok, int* pos, int* tile_e, LAS unsigned char* lds) {
    LAUNDER();
    LAS int* ptot = (LAS int*)lds;
    LAS int* ppre = ptot + 512;
    LAS int* base = ppre + 512;
    LAS int* cur = base + 32;
    { const int e = tid_ & 31, ch = tid_ >> 5; int tot = 0, pre = 0;
      for (int j = 0; j < 16; ++j) { const int bb = ch * 16 + j; if (bb < nb_s) { const int v = cntb[bb * 32 + e]; tot += v; pre += bb < bid_ ? v : 0; } }
      ptot[ch * 32 + e] = tot; ppre[ch * 32 + e] = pre; }
    __syncthreads();
    if (tid_ < 32) { int tot = 0, pre = 0;
        for (int ch = 0; ch < 16; ++ch) { tot += ptot[ch * 32 + tid_]; pre += ppre[ch * 32 + tid_]; }
        ptot[tid_] = tot; ppre[tid_] = pre; cur[tid_] = 0; }
    __syncthreads();
    if (tid_ == 0) { int s = 0;
        for (int e = 0; e < NE; ++e) { base[e] = s + ppre[e]; const int p = (ptot[e] + MPAD - 1) / MPAD * MPAD;
            if (bid_ == 0) for (int tl = s / MPAD; tl < (s + p) / MPAD; ++tl) tile_e[tl] = e;
            s += p; }
        if (bid_ == 0) cnt[64 + NE] = s; }
    __syncthreads();
    if (tid_ < 64) {
        for (int t0 = bid_; t0 < NT / 16; t0 += 8 * nb_s) {
            int ev[8];
#pragma unroll
            for (int k = 0; k < 8; ++k) { const int tile = t0 + k * nb_s; ev[k] = tile < NT / 16 ? topi[tile * 64 + tid_] : -1; }
#pragma unroll
            for (int k = 0; k < 8; ++k) { const int tile = t0 + k * nb_s;
                if (ev[k] >= 0) { const int i = tile * 64 + tid_;
                    const int p = base[ev[k]] + __hip_atomic_fetch_add(cur + ev[k], 1, __ATOMIC_RELAXED, __HIP_MEMORY_SCOPE_WORKGROUP);
                    stok[p] = i >> 2; pos[i] = p; } }
        }
    }
}
__device__ __forceinline__ void ph_combine_norm(unsigned short* x, const unsigned short* y, const int* pos, const float* topw, const float* gate, int ldg,
                                                const float* g1, const float* sh1, const float* sc1, int ld1, unsigned short* hb,
                                                const float* gk, const float* shk, const float* sck, int ldk, unsigned short* hb2,
                                                const float* gfin, float* out, int* cnt, LAS unsigned char* lds) {
    LAUNDER();
    const int lane = tid_ & 63;
    if (GTID < 128) cnt[GTID] = 0;
    LAS float* KA = (LAS float*)lds; LAS float* KH = KA + 8 * DM;
    if (gk) {
        for (int i = tid_; i < 8 * DM / 4; i += NTHR) { const int bb = i >> 8, c4 = (i & 255) * 4;
            const float4 gg = *(const float4*)(gk + c4), sc = *(const float4*)(sck + bb * ldk + c4), sh = *(const float4*)(shk + bb * ldk + c4);
            *(LAS g8::f32x4*)(KA + bb * DM + c4) = (g8::f32x4){gg.x * (1.f + sc.x), gg.y * (1.f + sc.y), gg.z * (1.f + sc.z), gg.w * (1.f + sc.w)};
            *(LAS g8::f32x4*)(KH + bb * DM + c4) = (g8::f32x4){sh.x, sh.y, sh.z, sh.w}; }
        __syncthreads();
    }
    float4 g1v[4];
#pragma unroll
    for (int j = 0; j < 4; ++j) { g1v[j] = make_float4(0.f, 0.f, 0.f, 0.f); if (!gfin) g1v[j] = *(const float4*)(g1 + j * 256 + lane * 4); }
    int4 psn[2]; float4 twn[2];
    { const int r0 = (GTID >> 6) * 2;
#pragma unroll
      for (int q = 0; q < 2; ++q) { psn[q] = *(const int4*)(pos + (r0 + q) * 4); twn[q] = *(const float4*)(topw + (r0 + q) * 4); } }
    for (int row0 = (GTID >> 6) * 2; row0 < NT; row0 += (GSZ >> 6) * 2) {
        int4 ps[2]; float4 tw[2];
#pragma unroll
        for (int q = 0; q < 2; ++q) { ps[q] = psn[q]; tw[q] = twn[q]; }
        { const int rn_ = row0 + (GSZ >> 6) * 2;
          if (rn_ < NT) {
#pragma unroll
              for (int q = 0; q < 2; ++q) { psn[q] = *(const int4*)(pos + (rn_ + q) * 4); twn[q] = *(const float4*)(topw + (rn_ + q) * 4); } } }
        const int bq = row0 / SEQ;
        float4 gpv[4], s1v[4], h1v[4];
        uint2 yv[2][4][4], xu[2][4];
#pragma unroll
        for (int q = 0; q < 2; ++q)
#pragma unroll
            for (int j = 0; j < 4; ++j) { const int col = j * 256 + lane * 4;
                yv[q][0][j] = *(const uint2*)(y + (size_t)ps[q].x * DM + col); yv[q][1][j] = *(const uint2*)(y + (size_t)ps[q].y * DM + col);
                yv[q][2][j] = *(const uint2*)(y + (size_t)ps[q].z * DM + col); yv[q][3][j] = *(const uint2*)(y + (size_t)ps[q].w * DM + col);
                xu[q][j] = *(const uint2*)(x + (size_t)(row0 + q) * DM + col); }
#pragma unroll
        for (int j = 0; j < 4; ++j) { const int col = j * 256 + lane * 4;
            gpv[j] = *(const float4*)(gate + bq * ldg + col);
            s1v[j] = make_float4(0.f, 0.f, 0.f, 0.f); h1v[j] = s1v[j];
            if (!gfin) { s1v[j] = *(const float4*)(sc1 + bq * ld1 + col); h1v[j] = *(const float4*)(sh1 + bq * ld1 + col); }
            }
#pragma unroll
        for (int q = 0; q < 2; ++q) {
            const int row = row0 + q, b = row / SEQ;
            const float w4[4] = {tw[q].x, tw[q].y, tw[q].z, tw[q].w};
            float4 xn[4]; float ss = 0.f;
#pragma unroll
            for (int j = 0; j < 4; ++j) { const int col = j * 256 + lane * 4;
                float a0 = 0.f, a1 = 0.f, a2 = 0.f, a3 = 0.f;
#pragma unroll
                for (int r4 = 0; r4 < 4; ++r4) { const uint2 u = yv[q][r4][j]; const float w = w4[r4];
                    a0 += w * __uint_as_float(u.x << 16); a1 += w * __uint_as_float(u.x & 0xffff0000u); a2 += w * __uint_as_float(u.y << 16); a3 += w * __uint_as_float(u.y & 0xffff0000u); }
                const uint2 u = xu[q][j]; float4 xv = make_float4(__uint_as_float(u.x << 16), __uint_as_float(u.x & 0xffff0000u), __uint_as_float(u.y << 16), __uint_as_float(u.y & 0xffff0000u));
                const float4 gp = gpv[j];
                xv.x += gp.x * a0; xv.y += gp.y * a1; xv.z += gp.z * a2; xv.w += gp.w * a3;
                if (!gfin) *(uint2*)(x + (size_t)row * DM + col) = make_uint2(pack_bf16(xv.x, xv.y), pack_bf16(xv.z, xv.w));
                xn[j] = xv; ss += xv.x * xv.x + xv.y * xv.y + xv.z * xv.z + xv.w * xv.w; }
#pragma unroll
            for (int o = 32; o > 0; o >>= 1) ss += SHX(ss, o);
            const float rn = rsqrtf(ss * (1.f / DM) + 1e-5f);
#pragma unroll
            for (int j = 0; j < 4; ++j) { const int col = j * 256 + lane * 4;
                if (gfin) { const float4 gg = *(const float4*)(gfin + col); *(float4*)(out + (size_t)row * DM + col) = make_float4(xn[j].x * rn * gg.x, xn[j].y * rn * gg.y, xn[j].z * rn * gg.z, xn[j].w * rn * gg.w); }
                else {
                    { const float4 gg = g1v[j], sc = s1v[j], sh = h1v[j];
                      *(uint2*)(hb + (size_t)row * DM + col) = make_uint2(pack_bf16(xn[j].x * rn * gg.x * (1.f + sc.x) + sh.x, xn[j].y * rn * gg.y * (1.f + sc.y) + sh.y),
                                                                         pack_bf16(xn[j].z * rn * gg.z * (1.f + sc.z) + sh.z, xn[j].w * rn * gg.w * (1.f + sc.w) + sh.w)); }
                    if (gk) { const g8::f32x4 ga = *(const LAS g8::f32x4*)(KA + b * DM + col), sh = *(const LAS g8::f32x4*)(KH + b * DM + col);
                      *(uint2*)(hb2 + (size_t)row * DM + col) = make_uint2(pack_bf16(xn[j].x * rn * ga[0] + sh[0], xn[j].y * rn * ga[1] + sh[1]),
                                                                          pack_bf16(xn[j].z * rn * ga[2] + sh[2], xn[j].w * rn * ga[3] + sh[3])); }
                }
            }
        }
    }
}
#define PHASE(name, ...) __device__ __forceinline__ void name(KP kp, const int L) { asm volatile("" : "+s"(kp)); const P __attribute__((address_space(4)))& p = *kp; float* sm = dyn_smem(); (void)sm; \
    LAS unsigned char* lds = (LAS unsigned char*)dyn_smem(); (void)lds; (void)L; const float* md = p.mod + (size_t)L * 8 * 6144; (void)md;  __VA_ARGS__ }
#define ORDER(S, nM, nN) S.init(nM, nN, nb_s, (int)blockIdx.x)
#define ORDERW(S, nM, nN, W) S.init(nM, nN, nb_s, (int)blockIdx.x, W)

PHASE(f_prologue,
      ph_convT(p.gla_w_in, p.wt_gla_in, 1024, GLA_IN, 3328, 2, sm);
      ph_convT(p.gla_w_out, p.wt_gla_out, 1024, 1024, 1024, 2, sm);
      ph_convT(p.kv_w, p.wt_kv, 1024, KV_OUT, KV_OUT, 1, sm);
      ph_convT(p.nsa_w_in, p.wt_nsa_in, 1024, NSA_IN, 1280, 2, sm);
      ph_convT(p.nsa_w_out, p.wt_nsa_out, 1024, 1024, 1024, 2, sm);
      ph_convT(p.cmp_w1, p.wt_cmp1, 2048, 128, 256, 2, sm);
      ph_convT(p.moe_w_gu, p.wt_gu, 1024, 2048, 2048, 4 * NE, sm);
      ph_convT<true>(p.moe_w_down, p.wt_down, 1024, 1024, 1024, 4 * NE, sm);
      ph_c1(p.cmp_pos, p.cmp_w1, p.cmp_b1, p.c1, sm);
      { LAUNDER(); if (GTID < 128) p.cnt[GTID] = 0; }
      ph_mod(p.c, p.ada_w, p.ada_b, p.kv_ada_w, p.kv_ada_b, p.mod, p.kvmod, sm);)
PHASE(f_norm1, ph_norm(p.x_in, p.norm1_g + L * DM, md + 0, md + 1024, (float*)nullptr, p.hb, 6144);)
PHASE(f_gla_in, ProbPlain<1024> S; ORDER(S, NT / 256, 13); S.A = (const char*)p.hb; S.Bt = (const char*)(p.wt_gla_in + (size_t)L * 3328 * 1024); S.lda = 2048;
      g8::gemm_phase(lds, S, g8::EpiPair<PGlaIn>{PGlaIn{p.gqk, p.gvT, p.grb, p.glr, lds + LDS_X_OFF}}, wv_s);)
PHASE(f_gla_gate, ph_gla_p1(p.gqk, p.glr, p.gvT, p.gla_w_gate2 + L * 16 * 512, p.gla_b_gate + L * 512, p.gqd, p.gki, p.gdl, p.gUT, lds);)
PHASE(f_gla_rec, ph_gla_p2(p.gUT, p.gdl, p.gST);)
PHASE(f_gla_post, ph_gla_p3(p.gqd, p.gki, p.gvT, p.gST, p.grb, p.gla_norm_g + L * DM, p.ob, lds);)
PHASE(f_gla_out, ProbPlain<1024> S; ORDER(S, NT / 256, 4); S.A = (const char*)p.ob; S.Bt = (const char*)(p.wt_gla_out + (size_t)L * 1024 * 1024); S.lda = 2048;
      if (L == 0) g8::gemm_phase(lds, S, EpiResid<true>{p.x_in, p.x, md + 2048, 6144}, wv_s);
      else g8::gemm_phase(lds, S, EpiResid<false>{p.x, p.x, md + 2048, 6144}, wv_s);)
PHASE(f_nsa_in, ProbPlain<1024> S; ORDER(S, NT / 256, 5); S.A = (const char*)p.hb; S.Bt = (const char*)(p.wt_nsa_in + (size_t)(L - 2) * 1280 * 1024); S.lda = 2048;
      g8::gemm_phase(lds, S, g8::EpiPair<PNsaIn>{PNsaIn{p.qb, p.gates, p.nsa_b_gate + (L - 2) * 48}}, wv_s);)
PHASE(f_nsa_attn, ph_nsa_attn_mfma(p.qb, p.gates, p.kcmp, p.vcmpT, p.kslc, p.vslcT, p.kwin, p.vwinT, p.ob, p.cnt + 112, lds);)
PHASE(f_nsa_out, ProbPlain<1024> S; ORDER(S, NT / 256, 4); S.A = (const char*)p.ob; S.Bt = (const char*)(p.wt_nsa_out + (size_t)(L - 2) * 1024 * 1024); S.lda = 2048;
      g8::gemm_phase(lds, S, EpiResid<false>{p.x, p.x, md + 2048, 6144}, wv_s);)
PHASE(f_out_probe, ProbPlain<1024> S; ORDER(S, NT / 256, 4); S.A = (const char*)p.ob; S.Bt = (const char*)(L < 2 ? p.wt_gla_out + (size_t)L * 1024 * 1024 : p.wt_nsa_out + (size_t)(L - 2) * 1024 * 1024); S.lda = 2048;
      g8::gemm_phase(lds, S, EpiResid<false>{p.x, p.act, md + 2048, 6144}, wv_s);)
PHASE(f_comb_probe, const float* mdn = p.mod + (size_t)(L < 3 ? L + 1 : L) * 8 * 6144;
      ph_combine_norm(p.act, p.y, p.pos, p.topw, md + 5120, 6144, p.norm1_g + (L < 3 ? L + 1 : L) * DM, mdn + 0, mdn + 1024, 6144, p.qb,
                      (const float*)nullptr, p.kvmod + 0, p.kvmod + 1024, 2048, p.qb, (const float*)nullptr, p.out, p.cnt + 256, lds);)
PHASE(f_norm2, ph_norm_router(p.x, p.norm2_g + L * DM, md + 3072, md + 4096, 6144, p.hb, p.router_w + (size_t)L * DM * 32, p.router_b + L * 32, p.topi, p.topw, p.cntb, p.stok, lds);)
PHASE(f_assign, ph_assign2(p.topi, p.cntb, p.cnt, p.stok, p.pos, p.tile_e, lds);)
PHASE(f_moe_gu, ProbMoe<1024, true> S; ORDER(S, p.cnt[64 + NE] / 256, 8); S.A = (const char*)p.hb; S.Bt = (const char*)(p.wt_gu + (size_t)L * NE * 2048 * 1024); S.tok = p.stok; S.tile_e = p.tile_e;
      S.bias = p.moe_b_gu + (size_t)L * NE * 2048; S.nbias = 2048; S.estride = (size_t)2048 * 1024 * 2; S.xl = lds + LDS_X_OFF;
      g8::gemm_phase(lds, S, EpiSwiglu{p.act, lds + LDS_X_OFF}, wv_s);)
PHASE(f_moe_down, ProbMoe<1024, false> S; ORDER(S, p.cnt[64 + NE] / 256, 4); S.A = (const char*)p.act; S.Bt = (const char*)(p.wt_down + (size_t)L * NE * 1024 * 1024); S.tok = p.stok; S.tile_e = p.tile_e;
      S.bias = p.moe_b_down + (size_t)L * NE * DM; S.nbias = 1024; S.estride = (size_t)1024 * 1024 * 2; S.xl = lds + LDS_X_OFF;
      g8::gemm_phase(lds, S, EpiDown{p.y, lds + LDS_X_OFF}, wv_s);)
PHASE(f_combine, const float* mdn = p.mod + (size_t)(L + 1) * 8 * 6144;
      ph_combine_norm(p.x, p.y, p.pos, p.topw, md + 5120, 6144, p.norm1_g + (L + 1) * DM, mdn + 0, mdn + 1024, 6144, p.hb,
                      L == 1 ? p.kv_norm_g : (const float*)nullptr, p.kvmod + 0, p.kvmod + 1024, 2048, p.ob, L == 3 ? p.final_g : (const float*)nullptr, p.out, p.cnt, lds);)
PHASE(f_kv_gemm, ProbPlain<1024> S; ORDER(S, NT / 256, 6); S.A = (const char*)p.ob; S.Bt = (const char*)p.wt_kv; S.lda = 2048;
      g8::gemm_phase(lds, S, g8::EpiPair<PKv>{PKv{p.csrc, p.kslc, p.vslcT, p.kwin, p.vwinT, lds + LDS_X_OFF}}, wv_s);)
PHASE(f_cmp1, ProbCmp S; ORDER(S, 256, 1); S.csrc = (const char*)p.csrc; S.W1t = (const char*)p.wt_cmp1;
      g8::gemm_phase(lds, S, g8::EpiQuad<QCmp1>{QCmp1{p.hid}}, wv_s);)
PHASE(f_cmp2, ph_gemm(AHid4{p.hid, p.c1}, BCmp{p.cmp_w2, 64, (size_t)128 * 64}, ECmp2b{p.kcmp, p.vcmpT, p.cmp_b2}, NCMP, 64, 128, 64, sm, nb_s >= 256 ? 128 : 0);)

#define BAR() xcd_barrier(bar, wv_s)
#ifndef REP_GEMM
#define REP_GEMM 1
#endif
#ifndef REP_ATTN
#define REP_ATTN 1
#endif
#ifndef REP_MOE
#define REP_MOE 1
#endif
#ifndef REP_GLA
#define REP_GLA 1
#endif
#ifndef REP_OUT
#define REP_OUT 1
#endif
#ifndef REP_N2
#define REP_N2 1
#endif
#ifndef REP_ASG
#define REP_ASG 1
#endif
#ifndef REP_COMB
#define REP_COMB 1
#endif
#ifndef REP_PRO
#define REP_PRO 1
#endif
#define REPEAT(n, ...) { __VA_ARGS__ } if ((n) > 1) { __VA_ARGS__ } if ((n) > 2) { __VA_ARGS__ }
template <int L> __device__ __forceinline__ void layer(KP kp, const XcdBarrier& bar) {
    if (L == 0) { f_norm1(kp, L); BAR(); }
    if (L < 2) {
        REPEAT(REP_GEMM, f_gla_in(kp, L); BAR();) REPEAT(REP_GLA, f_gla_gate(kp, L); BAR(); f_gla_rec(kp, L); BAR(); f_gla_post(kp, L); BAR();) f_gla_out(kp, L); BAR(); if (REP_OUT > 1) { f_out_probe(kp, L); BAR(); }
    } else {
        REPEAT(REP_GEMM, f_nsa_in(kp, L); if (L == 2) f_cmp2(kp, L); BAR();) REPEAT(REP_ATTN, f_nsa_attn(kp, L); BAR();) f_nsa_out(kp, L); BAR(); if (REP_OUT > 1) { f_out_probe(kp, L); BAR(); }
    }
    REPEAT(REP_N2, f_norm2(kp, L); BAR();) REPEAT(REP_ASG, f_assign(kp, L); BAR();)
    REPEAT(REP_MOE, f_moe_gu(kp, L); BAR(); f_moe_down(kp, L); BAR();) if (REP_COMB > 1) { f_comb_probe(kp, L); BAR(); } f_combine(kp, L); if (L < 3) BAR();
    if (L == 1) { REPEAT(REP_GEMM, f_kv_gemm(kp, L); BAR();) f_cmp1(kp, L); BAR(); }
}
};
__global__ __launch_bounds__(NTHR, 2) void mega(P p_unused) {
    KP kp = (KP)__builtin_amdgcn_kernarg_segment_ptr();
    float* smem = dyn_smem();
    unsigned* bw = (unsigned*)smem + LDS_BAR_OFF / 4;
    if (threadIdx.x == 0) { bw[0] = 0u; bw[1] = 0u; bw[2] = 0u; bw[3] = 0u; }
    __syncthreads();
    XcdBarrier bar = xcd_barrier_post(kp->bar, (volatile LAS unsigned*)bw);
    Ctx cx; cx.nb_s = (int)gridDim.x; cx.wv_s = __builtin_amdgcn_readfirstlane(threadIdx.x >> 6);
    REPEAT(REP_PRO, cx.f_prologue(kp, 0); xcd_barrier(bar, cx.wv_s);)
    cx.layer<0>(kp, bar); cx.layer<1>(kp, bar); cx.layer<2>(kp, bar); cx.layer<3>(kp, bar);
}
}

extern "C" void kernel_launch(void* const* d_in, const int* in_sizes, int n_in, void* d_out, int out_size, void* d_ws, size_t ws_size, hipStream_t stream) {
    P p{};
    const float** pin = (const float**)&p;
    for (int i = 0; i < 30; ++i) pin[i] = (const float*)d_in[i];
    p.out = (float*)d_out;
    char* wp = (char*)d_ws; size_t off = 0;
    auto alloc = [&](size_t bytes) { void* q = wp + off; off += (bytes + 255) & ~(size_t)255; return q; };
    p.bar = (unsigned*)alloc(XCD_BAR_WORDS * 4);
    p.mod = (float*)alloc((size_t)4 * 8 * 6144 * 4);
    p.kvmod = (float*)alloc((size_t)8 * 2048 * 4);
    p.c1 = (float*)alloc(256 * 4);
    p.x = (unsigned short*)alloc((size_t)NT * DM * 2);
    p.hid = (float*)alloc((size_t)4 * 64 * NCMP * 128 * 4);
    p.gates = (float*)alloc((size_t)NT * 48 * 4);
    p.topi = (int*)alloc((size_t)NT * 4 * 4);
    p.topw = (float*)alloc((size_t)NT * 4 * 4);
    p.cnt = (int*)alloc(512 * 4);
    p.cntb = (int*)alloc((size_t)1024 * 32 * 4);
    p.stok = (int*)alloc((size_t)CAP * 4);
    p.pos = (int*)alloc((size_t)NT * 4 * 4);
    p.tile_e = (int*)alloc((size_t)(CAP / MPAD) * 4);
    p.y = (unsigned short*)alloc((size_t)CAP * DM * 2);
    p.hb = (unsigned short*)alloc((size_t)NT * DM * 2);
    p.ob = (unsigned short*)alloc((size_t)NT * DM * 2);
    p.act = (unsigned short*)alloc((size_t)CAP * DM * 2);
    p.csrc = (unsigned short*)alloc((size_t)64 * SEQ * 64 * 2 + 8192);
    p.qb = (unsigned short*)alloc((size_t)NT * DM * 2);
    p.kslc = (unsigned short*)alloc((size_t)32 * SEQ * 64 * 2);
    p.vslcT = (unsigned short*)alloc((size_t)32 * SEQ * 64 * 2);
    p.kwin = (unsigned short*)alloc((size_t)32 * SEQ * 64 * 2);
    p.vwinT = (unsigned short*)alloc((size_t)32 * SEQ * 64 * 2);
    p.kcmp = (unsigned short*)alloc((size_t)32 * 256 * 64 * 2);
    p.vcmpT = (unsigned short*)alloc((size_t)32 * 256 * 64 * 2);
    p.gqk = (unsigned short*)alloc((size_t)NT * 1024 * 2);
    p.gvT = (unsigned short*)alloc((size_t)NT * 1024 * 2);
    p.grb = (unsigned short*)alloc((size_t)NT * 1024 * 2);
    p.gqd = (unsigned short*)alloc((size_t)NT * 512 * 2);
    p.gki = (unsigned short*)alloc((size_t)NT * 512 * 2);
    p.gST = (unsigned short*)alloc((size_t)32 * 64 * 256 * 128 * 2);
    p.glr = (float*)alloc((size_t)NT * 16 * 4);
    p.gdl = (float*)alloc((size_t)32 * 64 * 128 * 4);
    p.gUT = (unsigned short*)alloc((size_t)32 * 64 * 256 * 128 * 2);
    p.wt_gla_in = (unsigned short*)alloc((size_t)2 * 3328 * 1024 * 2);
    p.wt_gla_out = (unsigned short*)alloc((size_t)2 * 1024 * 1024 * 2);
    p.wt_kv = (unsigned short*)alloc((size_t)KV_OUT * 1024 * 2);
    p.wt_nsa_in = (unsigned short*)alloc((size_t)2 * 1280 * 1024 * 2);
    p.wt_nsa_out = (unsigned short*)alloc((size_t)2 * 1024 * 1024 * 2);
    p.wt_cmp1 = (unsigned short*)alloc((size_t)2 * 256 * 2048 * 2);
    p.wt_gu = (unsigned short*)alloc((size_t)4 * NE * 2048 * 1024 * 2);
    p.wt_down = (unsigned short*)alloc((size_t)4 * NE * 1024 * 1024 * 2);
    if (off > ws_size) return;

    static int grid = 0;
    if (!grid) {
        int dev = 0, cus = 0, per_cu = 0;
        (void)hipGetDevice(&dev);
        (void)hipDeviceGetAttribute(&cus, hipDeviceAttributeMultiprocessorCount, dev);
        (void)hipFuncSetAttribute((const void*)mega, hipFuncAttributeMaxDynamicSharedMemorySize, (int)kDynLds);
        (void)hipOccupancyMaxActiveBlocksPerMultiprocessor(&per_cu, mega, NTHR, kDynLds);
        if (per_cu < 1) per_cu = 1;
        grid = cus * 1;
    }
    (void)hipMemsetAsync(p.bar, 0, XCD_BAR_WORDS * sizeof(unsigned), stream);
    hipLaunchKernelGGL(mega, dim3(grid), dim3(NTHR), kDynLds, stream, p);
}
```

```cpp
#include <hip/hip_runtime.h>
#include <stdint.h>
#include <math.h>

namespace {
constexpr int NB = 8, SEQ = 4096, DM = 1024, NT = NB * SEQ;
constexpr int GLA_IN = 3088, NSA_IN = 1072, KV_OUT = 1536;
constexpr int NE = 32, TOPK = 4, NASG = NT * TOPK;
constexpr int MPAD = 256;
constexpr int CAP = NASG + NE * MPAD;
constexpr int NCMP = 255;
constexpr int NTHR = 512;

__device__ __forceinline__ unsigned short f2bf(float f) { unsigned u = __float_as_uint(f); u += 0x7FFFu + ((u >> 16) & 1u); return (unsigned short)(u >> 16); }
typedef __bf16 hbf16x2_t __attribute__((ext_vector_type(2)));
typedef float hf32x2_t __attribute__((ext_vector_type(2)));
__device__ __forceinline__ unsigned pack_bf16(float lo, float hi) { const hf32x2_t v = {lo, hi}; const hbf16x2_t r = __builtin_convertvector(v, hbf16x2_t); return __builtin_bit_cast(unsigned, r); }
__device__ __forceinline__ unsigned pack_bf16_v(float lo, float hi) { return pack_bf16(lo, hi); }
__device__ __forceinline__ float fast_exp(float x) { return __builtin_amdgcn_exp2f(x * 1.4426950408889634f); }
__device__ __forceinline__ float fast_logsigmoid(float z) { return fminf(z, 0.f) - 0.6931471805599453f * __builtin_amdgcn_logf(1.f + __builtin_amdgcn_exp2f(-fabsf(z) * 1.4426950408889634f)); }
__device__ __forceinline__ float fast_silu(float x) { return x * __builtin_amdgcn_rcpf(1.f + __builtin_amdgcn_exp2f(-1.4426950408889634f * x)); }
__device__ __forceinline__ float sigm(float x) { return 1.f / (1.f + expf(-x)); }
__device__ __forceinline__ float siluf(float x) { return x / (1.f + expf(-x)); }
__device__ __forceinline__ float logsigmoidf(float z) { return fminf(z, 0.f) - log1pf(expf(-fabsf(z))); }
__device__ __forceinline__ float gelu_tanh(float x) { return 0.5f * x * (1.f + tanhf(0.7978845608028654f * (x + 0.044715f * x * x * x))); }

#define XB_TMO      128
#define XB_XCNT(j)  (256  + 64 * (j))
#define XB_XSUB(j)  (1280 + 64 * (j))
#define XB_XGEN(j)  (2304 + 64 * (j))
#define XB_TOP      3328
#define XB_TOPGEN   3392
#define XCD_BAR_WORDS 3456
#define XB_SPIN_CAP (1u << 22)
#define LAS __attribute__((address_space(3)))

__device__ __forceinline__ unsigned xb_ld(unsigned* p)              { return __hip_atomic_load(p, __ATOMIC_RELAXED, __HIP_MEMORY_SCOPE_AGENT); }
__device__ __forceinline__ unsigned xb_add(unsigned* p, unsigned v) { return __hip_atomic_fetch_add(p, v, __ATOMIC_RELAXED, __HIP_MEMORY_SCOPE_AGENT); }
__device__ __forceinline__ unsigned xb_xcc_id() { return (unsigned)__builtin_amdgcn_s_getreg((3 << 11) | 20) & 0xFu; }
#define XB_SPIN(cond, bar) do { unsigned _sp = 0; while (cond) { __builtin_amdgcn_s_sleep(1); \
    if ((++_sp & 255u) == 0u) { if (xb_ld(&(bar)[XB_TMO])) break; if (_sp > XB_SPIN_CAP) { atomicAdd(&(bar)[XB_TMO], 1u); break; } } } } while (0)

struct XcdBarrier { unsigned* bar; unsigned x; volatile LAS unsigned* st; };

__device__ __forceinline__ XcdBarrier xcd_barrier_post(unsigned* bar, volatile LAS unsigned* st) {
    XcdBarrier b; b.bar = bar; b.x = xb_xcc_id(); b.st = st;
    if (threadIdx.x == 0) (void)xb_add(&bar[XB_XCNT(b.x)], 1u);
    return b;
}
__device__ __forceinline__ void xcd_barrier_complete(unsigned* bar, unsigned x, unsigned& nloc, unsigned& nx) {
    const unsigned G = gridDim.x * gridDim.y * gridDim.z;
    unsigned sum, cnt, mine, sp = 0u;
    for (;;) {
        sum = 0u; cnt = 0u; mine = 0u;
#pragma unroll
        for (unsigned j = 0; j < 16; ++j) { const unsigned c = xb_ld(&bar[XB_XCNT(j)]); sum += c; cnt += (c > 0u) ? 1u : 0u; mine = (j == x) ? c : mine; }
        if (sum == G) break;
        __builtin_amdgcn_s_sleep(1);
        if ((++sp & 255u) == 0u) { if (xb_ld(&bar[XB_TMO])) break; if (sp > XB_SPIN_CAP) { atomicAdd(&bar[XB_TMO], 1u); break; } }
    }
    nloc = mine > 0u ? mine : 1u; nx = cnt > 0u ? cnt : 1u;
}
__device__ __forceinline__ void xcd_barrier(const XcdBarrier& b, int wv) {
    asm volatile("s_waitcnt vmcnt(0)" ::: "memory");
    __syncthreads();
    int ln_; asm volatile("v_mbcnt_lo_u32_b32 %0, -1, 0\n\tv_mbcnt_hi_u32_b32 %0, -1, %0" : "=v"(ln_));
    if (wv == 0 && ln_ == 0) {
        unsigned* bar = b.bar;
        __builtin_amdgcn_s_waitcnt(0);
        unsigned nloc = b.st[0], nx = b.st[1];
        if (nloc == 0u) { xcd_barrier_complete(bar, b.x, nloc, nx); b.st[0] = nloc; b.st[1] = nx; }
        const unsigned old = xb_add(&bar[XB_XSUB(b.x)], 1u);
        const unsigned gen = old / nloc;
        if (old + 1u == (gen + 1u) * nloc) {
            __builtin_amdgcn_fence(__ATOMIC_RELEASE, "agent");
            asm volatile("s_waitcnt vmcnt(0)" ::: "memory");
            const unsigned og = xb_add(&bar[XB_TOP], 1u);
            const unsigned tg = og / nx;
            if (og + 1u == (tg + 1u) * nx) xb_add(&bar[XB_TOPGEN], 1u);
            else XB_SPIN(xb_ld(&bar[XB_TOPGEN]) == tg, bar);
            __builtin_amdgcn_fence(__ATOMIC_ACQUIRE, "agent");
            xb_add(&bar[XB_XGEN(b.x)], 1u);
            asm volatile("s_waitcnt vmcnt(0)" ::: "memory");
        } else {
            XB_SPIN(xb_ld(&bar[XB_XGEN(b.x)]) == gen, bar);
            __builtin_amdgcn_fence(__ATOMIC_ACQUIRE, "agent");
            asm volatile("s_waitcnt vmcnt(0)" ::: "memory");
        }
    }
    __syncthreads();
}
struct ARow { const float* A; long lda; __device__ bool active(int, int) const { return true; } __device__ float operator()(int, int m, int k) const { return A[(size_t)m * lda + k]; } };
struct AGather { const float* A; const int* tok; const int* tile_e; __device__ bool active(int, int m0) const { return tile_e[m0 / MPAD] >= 0; }
    __device__ float operator()(int, int m, int k) const { const int t = tok[m]; return t >= 0 ? A[(size_t)t * DM + k] : 0.f; } };
struct ARowsIdx { const float* A; const int* tile_e; __device__ bool active(int, int m0) const { return tile_e[m0 / MPAD] >= 0; }
    __device__ float operator()(int, int m, int k) const { return A[(size_t)m * DM + k]; } };
struct ACmp { const float* kv6; const float* pos; __device__ bool active(int, int) const { return true; }
    __device__ float operator()(int z, int m, int k) const { const int t = z >> 5, b = (z >> 2) & 7, g = z & 3, l = k >> 6, d = k & 63;
        return kv6[(size_t)(b * SEQ + 16 * m + l) * KV_OUT + t * 256 + g * 64 + d] + pos[t * 2048 + k]; } };
struct AHid { const float* hid; __device__ bool active(int, int) const { return true; } __device__ float operator()(int z, int m, int k) const { return hid[((size_t)z * NCMP + m) * 128 + k]; } };
struct BMat { const float* B; long ldb; __device__ float operator()(int, int, int k, int n) const { return B[(size_t)k * ldb + n]; } };
struct BExpert { const float* B; const int* tile_e; long ldb; size_t estride; __device__ float operator()(int, int m0, int k, int n) const { const int e = tile_e[m0 / MPAD]; return B[(size_t)e * estride + (size_t)k * ldb + n]; } };
struct BCmp { const float* B; long ldb; size_t tstride; __device__ float operator()(int z, int, int k, int n) const { return B[(size_t)(z >> 5) * tstride + (size_t)k * ldb + n]; } };
struct EStore { float* C; long ldc; __device__ void operator()(int, int m, int, int n0, const float (&v)[8], int N) const {
#pragma unroll
    for (int j = 0; j < 8; ++j) if (n0 + j < N) C[(size_t)m * ldc + n0 + j] = v[j]; } };
struct EResid { float* X; const float* gate; long ldg; __device__ void operator()(int, int m, int, int n0, const float (&v)[8], int N) const { const int b = m / SEQ;
#pragma unroll
    for (int j = 0; j < 8; ++j) { const int n = n0 + j; X[(size_t)m * DM + n] += gate[b * ldg + n] * v[j]; } } };
struct ENsaIn { float* qn; float* gates; const float* bg; __device__ void operator()(int, int m, int, int n0, const float (&v)[8], int N) const {
#pragma unroll
    for (int j = 0; j < 8; ++j) { const int n = n0 + j; if (n < 1024) qn[(size_t)m * 1024 + n] = v[j] * 0.125f; else if (n < N) gates[(size_t)m * 48 + (n - 1024)] = sigm(v[j] + bg[n - 1024]); } } };
struct ESwiglu { float* act; const float* bgu; const int* tile_e; __device__ void operator()(int, int m, int m0, int n0, const float (&v)[8], int N) const { const int e = tile_e[m0 / MPAD];
#pragma unroll
    for (int j = 0; j < 4; ++j) { const int n = n0 + 2 * j; float gt = v[2 * j] + bgu[e * 2048 + n], up = v[2 * j + 1] + bgu[e * 2048 + n + 1];
        gt = fminf(gt, 7.f); up = fminf(fmaxf(up, -7.f), 7.f); act[(size_t)m * 1024 + (n >> 1)] = (up + 1.f) * gt * sigm(1.702f * gt); } } };
struct EDown { float* y; const float* bd; const int* tile_e; __device__ void operator()(int, int m, int m0, int n0, const float (&v)[8], int N) const { const int e = tile_e[m0 / MPAD];
#pragma unroll
    for (int j = 0; j < 8; ++j) y[(size_t)m * 1024 + n0 + j] = v[j] + bd[e * 1024 + n0 + j]; } };
struct ECmp1 { float* hid; const float* b1; __device__ void operator()(int z, int m, int, int n0, const float (&v)[8], int N) const {
#pragma unroll
    for (int j = 0; j < 8; ++j) if (n0 + j < N) hid[((size_t)z * NCMP + m) * 128 + n0 + j] = gelu_tanh(v[j] + b1[(z >> 5) * 128 + n0 + j]); } };
struct ECmp2 { float* comp; const float* b2; __device__ void operator()(int z, int m, int, int n0, const float (&v)[8], int N) const {
#pragma unroll
    for (int j = 0; j < 8; ++j) if (n0 + j < N) comp[((size_t)z * NCMP + m) * 64 + n0 + j] = v[j] + b2[(z >> 5) * 64 + n0 + j]; } };

struct ECmp2b { unsigned short* kcmp; unsigned short* vcmpT; const float* b2; __device__ void operator()(int z, int m, int, int n0, const float (&v)[8], int N) const { const int t = z >> 5, bg = z & 31;
#pragma unroll
    for (int j = 0; j < 8; ++j) { const int d = n0 + j; if (d < N) { const unsigned short o = f2bf(v[j] + b2[t * 64 + d]); if (t == 0) kcmp[((size_t)bg * 256 + m) * 64 + d] = o; else vcmpT[((size_t)bg * 64 + d) * 256 + ((m & ~15) | (((m >> 2) & 1) << 3) | (((m >> 3) & 1) << 2) | (m & 3))] = o; } } } };
struct AHid4 { const float* hidp; const float* c1; __device__ bool active(int, int) const { return true; } __device__ float operator()(int z, int m, int k) const {
    const size_t o = ((size_t)z * NCMP + m) * 128 + k, st = (size_t)64 * NCMP * 128;
    return gelu_tanh(hidp[o] + hidp[o + st] + hidp[o + 2 * st] + hidp[o + 3 * st] + c1[(z >> 5) * 128 + k]); } };
namespace g8 {
typedef unsigned short bf16_t;
typedef short bf16x8 __attribute__((ext_vector_type(8)));
typedef float f32x4 __attribute__((ext_vector_type(4)));
constexpr bool TAIL_HALVES = false;
constexpr int BM = 256, BK = 64, HALF = 128, HTB = HALF * BK * 2, STAGE_BYTES = 8 * HTB, NXCD = 8, WGM = 8;

__device__ __forceinline__ int lds_byte(int r, int c) { const int st = (r >> 4) * 2 + (c >> 5), rr = r & 15, cc = c & 31, ob = rr * 64 + cc * 2; return st * 1024 + (ob ^ (((ob >> 9) & 1) << 5)); }
__device__ __forceinline__ void stage_rc(int b, int& R, int& C) { const int st = b / 1024, sb = b % 1024, swz = sb ^ (((sb >> 9) & 1) << 5); R = (st >> 1) * 16 + swz / 64; C = (st & 1) * 32 + (swz % 64) / 2; }

struct Unit { int pm, pn, ord, half; };
struct Order {
    int nM, nN, nwg, G, c, wgm;
    __device__ __forceinline__ void init(int nM_, int nN_, int G_, int c_, int wgm_ = WGM) { nM = nM_; nN = nN_; nwg = nM * nN; G = G_; c = c_; wgm = wgm_; }
    __device__ __forceinline__ bool next(int i, Unit& u) const {
        long L = (long)i * G + c; u.ord = i; u.half = -1;
        const int F = nwg / G, r = nwg - F * G;
        if (TAIL_HALVES && r > 0 && 2 * r <= G && L >= (long)F * G) { const long h = L - (long)F * G; if (h >= 2 * r) return false; u.half = (int)(h & 1); L = (long)F * G + (h >> 1); }
        if (L >= nwg) return false;
        int wgid = (int)L; { const int q = nwg / NXCD, rr = nwg % NXCD, xcd = wgid % NXCD, off = wgid / NXCD; wgid = (xcd < rr ? xcd * (q + 1) : rr * (q + 1) + (xcd - rr) * q) + off; }
        const int nig = wgm * nN, gid = wgid / nig, fm = gid * wgm, gsz = (nM - fm) < wgm ? (nM - fm) : wgm;
        u.pm = fm + ((wgid % nig) % gsz); u.pn = (wgid % nig) / gsz; return true;
    }
};

template <class Prob, class Epi>
__device__ __forceinline__ void gemm_phase(LAS unsigned char* lds, const Prob& S, const Epi& E, int wv) {
    int tz; asm volatile("v_mbcnt_lo_u32_b32 %0, -1, 0\n\tv_mbcnt_hi_u32_b32 %0, -1, %0" : "=v"(tz)); tz += wv * 64;
    const int tid = tz, wid = __builtin_amdgcn_readfirstlane(tid >> 6), lane = tid & 63, wr = wid >> 2, wc = wid & 3, fr = lane & 15, fq = lane >> 4;
    constexpr int K = Prob::K, nt = K / BK;
    int Rr[2], Cc[2];
    unsigned voffB[2];
#pragma unroll
    for (int i = 0; i < 2; ++i) { stage_rc(tid * 16 + i * 8192, Rr[i], Cc[i]); voffB[i] = (unsigned)(Rr[i] * Prob::LDB + Cc[i]) * 2u; }
    const size_t kstep = (size_t)(BK * 2);
    const size_t hstepB = (size_t)HALF * Prob::LDB * 2;
    const unsigned ldsw = (unsigned)wid * 1024u;
    const int aoff = lds_byte(wr * 64 + fr, fq * 8), boff = lds_byte(wc * 32 + fr, fq * 8);
#define G8_SA(b, h) (((b) * 2 + (h)) * HTB)
#define G8_SB(b, h) ((4 + (b) * 2 + (h)) * HTB)
#define G8_STAGE(bufoff, gbase, voff) do { _Pragma("unroll") for (int _i = 0; _i < 2; ++_i) \
        __builtin_amdgcn_global_load_lds((const unsigned*)((const char*)(gbase) + (voff)[_i]), (LAS unsigned*)(lds + (bufoff) + ldsw + _i * 8192), 16, 0, 0); } while (0)
#define G8_LDA(dst, b, h) do { _Pragma("unroll") for (int m = 0; m < 4; ++m) _Pragma("unroll") for (int k = 0; k < 2; ++k) dst[m][k] = *(const LAS bf16x8*)(lds + G8_SA(b, h) + aoff + m * 2048 + k * 1024); } while (0)
#define G8_LDB(dst, b, h) do { _Pragma("unroll") for (int n = 0; n < 2; ++n) _Pragma("unroll") for (int k = 0; k < 2; ++k) dst[n][k] = *(const LAS bf16x8*)(lds + G8_SB(b, h) + boff + n * 2048 + k * 1024); } while (0)
#define G8_MMA(ai, bj, At, Bt) do { __builtin_amdgcn_s_setprio(1); _Pragma("unroll") for (int m = 0; m < 4; ++m) _Pragma("unroll") for (int n = 0; n < 2; ++n) _Pragma("unroll") for (int k = 0; k < 2; ++k) \
        acc[ai][bj][m][n] = __builtin_amdgcn_mfma_f32_16x16x32_bf16(Bt[n][k], At[m][k], acc[ai][bj][m][n], 0, 0, 0); __builtin_amdgcn_s_setprio(0); } while (0)
#define G8_WAIT_V(n) asm volatile("s_waitcnt vmcnt(" #n ")" ::: "memory")
#define G8_WAIT_L(n) asm volatile("s_waitcnt lgkmcnt(" #n ")" ::: "memory")
#define G8_BAR __builtin_amdgcn_s_barrier()
#define G8_SCHED __builtin_amdgcn_sched_barrier(0)
#define G8_AOFFS(dst, u) do { _Pragma("unroll") for (int _h = 0; _h < 2; ++_h) _Pragma("unroll") for (int _i = 0; _i < 2; ++_i) dst[_h][_i] = S.a_off(u, _h * HALF + Rr[_i]) + (unsigned)Cc[_i] * 2u; } while (0)
    S.prep(tid);
    Unit cur, nxt; int ui = 0;
    if (!S.next(0, cur)) return;
    f32x4 acc[2][2][4][2];
#pragma unroll
    for (int a = 0; a < 2; ++a)
#pragma unroll
        for (int b = 0; b < 2; ++b)
#pragma unroll
            for (int m = 0; m < 4; ++m)
#pragma unroll
                for (int n = 0; n < 2; ++n) acc[a][b][m][n] = (f32x4){0.f, 0.f, 0.f, 0.f};
    bf16x8 At[4][2], B0[2][2], B1[2][2];
    unsigned vA[2][2], nvA[2][2];
    const char* cA = S.a_base(cur); const char* cB = S.b_base(cur) + (cur.half > 0 ? hstepB : 0);
    size_t h2c = cur.half >= 0 ? 0 : hstepB;
    G8_AOFFS(vA, cur);
    S.unit_begin(cur, wid, lane);
    G8_STAGE(G8_SB(0, 0), cB, voffB); G8_STAGE(G8_SA(0, 0), cA, vA[0]); G8_STAGE(G8_SB(0, 1), cB + h2c, voffB); G8_STAGE(G8_SA(0, 1), cA, vA[1]);
    if (wr == 1) G8_BAR;
    G8_WAIT_V(4); G8_BAR;
    G8_STAGE(G8_SB(1, 0), cB + kstep, voffB); G8_STAGE(G8_SA(1, 0), cA + kstep, vA[0]); G8_STAGE(G8_SB(1, 1), cB + h2c + kstep, voffB);
    G8_WAIT_V(6); G8_BAR;
    for (;;) {
        const bool has_next = S.next(ui + 1, nxt);
        const char* nA = has_next ? S.a_base(nxt) : cA; const char* nB = has_next ? S.b_base(nxt) + (nxt.half > 0 ? hstepB : 0) : cB;
        const size_t h2n = has_next ? (nxt.half >= 0 ? 0 : hstepB) : h2c;
        const bool chalf = cur.half >= 0;
        if (has_next) { G8_AOFFS(nvA, nxt); } else {
#pragma unroll
            for (int _h = 0; _h < 2; ++_h)
#pragma unroll
                for (int _i = 0; _i < 2; ++_i) nvA[_h][_i] = vA[_h][_i]; }
#pragma unroll 1
        for (int t = 0; t < nt; t += 2) {
            const bool last = (t == nt - 2);
            const char* a1 = cA + (size_t)(t + 1) * kstep;
            const char* a2 = last ? nA : cA + (size_t)(t + 2) * kstep; const char* b2 = last ? nB : cB + (size_t)(t + 2) * kstep;
            const char* a3 = a2 + kstep; const char* b3 = b2 + kstep; const size_t hs2 = last ? h2n : h2c;
            unsigned w0[2], w1[2];
#pragma unroll
            for (int _i = 0; _i < 2; ++_i) { w0[_i] = last ? nvA[0][_i] : vA[0][_i]; w1[_i] = last ? nvA[1][_i] : vA[1][_i]; }
            G8_LDB(B0, 0, 0); G8_SCHED; G8_LDA(At, 0, 0); G8_STAGE(G8_SA(1, 1), a1, vA[1]);
            G8_WAIT_L(8); G8_BAR; G8_WAIT_L(0); G8_MMA(0, 0, At, B0); G8_BAR; G8_SCHED;
            if (!chalf) { G8_LDB(B1, 0, 1); } G8_STAGE(G8_SB(0, 0), b2, voffB);
            G8_BAR; G8_WAIT_L(0); if (!chalf) { G8_MMA(0, 1, At, B1); } G8_BAR;
            G8_LDA(At, 0, 1); G8_STAGE(G8_SA(0, 0), a2, w0);
            G8_BAR; G8_WAIT_L(0); G8_MMA(1, 0, At, B0); G8_BAR; G8_SCHED;
            G8_STAGE(G8_SB(0, 1), b2 + hs2, voffB);
            G8_WAIT_V(6); G8_BAR; if (!chalf) { G8_MMA(1, 1, At, B1); } G8_BAR;
            G8_LDB(B0, 1, 0); G8_SCHED; G8_LDA(At, 1, 0); G8_STAGE(G8_SA(0, 1), a2, w1);
            G8_WAIT_L(8); G8_BAR; G8_WAIT_L(0); G8_MMA(0, 0, At, B0); G8_BAR; G8_SCHED;
            if (!chalf) { G8_LDB(B1, 1, 1); } G8_STAGE(G8_SB(1, 0), b3, voffB);
            G8_BAR; G8_WAIT_L(0); if (!chalf) { G8_MMA(0, 1, At, B1); } G8_BAR;
            G8_LDA(At, 1, 1); G8_STAGE(G8_SA(1, 0), a3, w0);
            G8_BAR; G8_WAIT_L(0); G8_MMA(1, 0, At, B0); G8_BAR; G8_SCHED;
            G8_STAGE(G8_SB(1, 1), b3 + hs2, voffB);
            G8_WAIT_V(6); G8_BAR; if (!chalf) { G8_MMA(1, 1, At, B1); } G8_BAR;
        }
        if (wr == 0) G8_BAR;
        E(acc, cur, wr, wc, fr, fq);
        if (!has_next) break;
#pragma unroll
        for (int a = 0; a < 2; ++a)
#pragma unroll
            for (int b = 0; b < 2; ++b)
#pragma unroll
                for (int m = 0; m < 4; ++m)
#pragma unroll
                    for (int n = 0; n < 2; ++n) acc[a][b][m][n] = (f32x4){0.f, 0.f, 0.f, 0.f};
        cur = nxt; cA = nA; cB = nB; h2c = h2n; ++ui;
        S.unit_begin(cur, wid, lane);
#pragma unroll
        for (int _h = 0; _h < 2; ++_h)
#pragma unroll
            for (int _i = 0; _i < 2; ++_i) vA[_h][_i] = nvA[_h][_i];
        if (wr == 1) G8_BAR;
    }
    G8_WAIT_V(0);
    G8_BAR;
#undef G8_SA
#undef G8_SB
#undef G8_STAGE
#undef G8_LDA
#undef G8_LDB
#undef G8_MMA
#undef G8_WAIT_V
#undef G8_WAIT_L
#undef G8_BAR
#undef G8_SCHED
#undef G8_AOFFS
}

template <class F> struct EpiQuad {
    F f;
    __device__ __forceinline__ void operator()(const f32x4 (&acc)[2][2][4][2], const Unit& u, int wr, int wc, int fr, int fq) const {
#pragma unroll
        for (int ai = 0; ai < 2; ++ai)
#pragma unroll
            for (int m = 0; m < 4; ++m) { const int row = u.pm * BM + ai * HALF + wr * 64 + m * 16 + fr;
#pragma unroll
                for (int bj = 0; bj < 2; ++bj) { if (u.half >= 0 && bj == 1) continue;
#pragma unroll
                    for (int n = 0; n < 2; ++n) f(u, row, u.pn * BM + (u.half >= 0 ? u.half : bj) * HALF + wc * 32 + n * 16 + 4 * fq, acc[ai][bj][m][n]); } }
    }
};
template <class F> struct EpiPair {
    F f;
    __device__ __forceinline__ void operator()(const f32x4 (&acc)[2][2][4][2], const Unit& u, int wr, int wc, int fr, int fq) const {
#pragma unroll
        for (int ai = 0; ai < 2; ++ai)
#pragma unroll
            for (int m = 0; m < 4; ++m) { const int row = u.pm * BM + ai * HALF + wr * 64 + m * 16 + fr;
#pragma unroll
                for (int bj = 0; bj < 2; ++bj) { if (u.half >= 0 && bj == 1) continue;
                    f(u, row, u.pn * BM + (u.half >= 0 ? u.half : bj) * HALF + wc * 32, fq, wr * 4 + wc, acc[ai][bj][m][0], acc[ai][bj][m][1]); } }
    }
};
}
using g8::Unit; using g8::f32x4;
template <int K_> struct ProbPlain : g8::Order {
    static constexpr int K = K_, LDB = K_;
    const char* A; const char* Bt; long lda;
    __device__ __forceinline__ void prep(int) const {}
    __device__ __forceinline__ void unit_begin(const Unit&, int, int) const {}
    __device__ __forceinline__ const char* a_base(const Unit& u) const { return A + (size_t)u.pm * 256 * lda; }
    __device__ __forceinline__ unsigned a_off(const Unit&, int row) const { return (unsigned)(row * lda); }
    __device__ __forceinline__ const char* b_base(const Unit& u) const { return Bt + (size_t)u.pn * 256 * K * 2; }
};
constexpr int MX_TE = 0, MX_AOFF = 2240, MX_BIAS = MX_AOFF + 18 * 1024, MX_END = MX_BIAS + 2048;
template <int K_, bool GATHER> struct ProbMoe : g8::Order {
    static constexpr int K = K_, LDB = K_;
    const char* A; const char* Bt; const int* tok; const int* tile_e; const float* bias; size_t estride; int nbias; LAS unsigned char* xl;
    __device__ __forceinline__ void prep(int tid) const {
        LAS int* te = (LAS int*)(xl + MX_TE);
        int tev[2];
#pragma unroll
        for (int k = 0; k < 2; ++k) { const int i = tid + k * NTHR; tev[k] = i < nM ? tile_e[i] : 0; }
        if (GATHER) { LAS unsigned* ao = (LAS unsigned*)(xl + MX_AOFF); int tv[18];
#pragma unroll
            for (int i = 0; i < 18; ++i) { Unit u; tv[i] = -1; if (tid < 256 && next(i, u)) tv[i] = tok[u.pm * 256 + tid]; }
#pragma unroll
            for (int i = 0; i < 18; ++i) if (tid < 256) ao[i * 256 + tid] = tv[i] >= 0 ? (unsigned)tv[i] * (K * 2) : 0u; }
#pragma unroll
        for (int k = 0; k < 2; ++k) { const int i = tid + k * NTHR; if (i < nM) te[i] = tev[k]; }
        __syncthreads();
    }
    __device__ __forceinline__ int expert(const Unit& u) const { return __builtin_amdgcn_readfirstlane(((LAS int*)(xl + MX_TE))[u.pm]); }
    __device__ __forceinline__ void unit_begin(const Unit& u, int wid, int lane) const {
        if (wid == 0) __builtin_amdgcn_global_load_lds((const unsigned*)(bias + (size_t)expert(u) * nbias + u.pn * 256 + lane * 4), (LAS unsigned*)(xl + MX_BIAS + (u.ord & 1) * 1024), 16, 0, 0);
    }
    __device__ __forceinline__ const char* a_base(const Unit& u) const { return GATHER ? A : A + (size_t)u.pm * 256 * K * 2; }
    __device__ __forceinline__ unsigned a_off(const Unit& u, int row) const { if (GATHER) return ((LAS unsigned*)(xl + MX_AOFF))[u.ord * 256 + row]; return (unsigned)(row * K * 2); }
    __device__ __forceinline__ const char* b_base(const Unit& u) const { return Bt + (size_t)expert(u) * estride + (size_t)u.pn * 256 * K * 2; }
};
struct ProbCmp : g8::Order {
    static constexpr int K = 512, LDB = 2048;
    const char* csrc; const char* W1t;
    __device__ __forceinline__ void prep(int) const {}
    __device__ __forceinline__ void unit_begin(const Unit&, int, int) const {}
    __device__ __forceinline__ const char* a_base(const Unit& u) const { return csrc + (size_t)(u.pm >> 2) * SEQ * 64 * 2 + (u.pm & 3) * 1024; }
    __device__ __forceinline__ unsigned a_off(const Unit&, int row) const { return (unsigned)(row * 2048); }
    __device__ __forceinline__ const char* b_base(const Unit& u) const { return W1t + (size_t)(u.pm >> 7) * 256 * 2048 * 2 + (u.pm & 3) * 1024; }
};
typedef unsigned au32x2_ __attribute__((ext_vector_type(2)));
__device__ __forceinline__ uint2 pk4(const f32x4& v) { return make_uint2(pack_bf16(v[0], v[1]), pack_bf16(v[2], v[3])); }
__device__ __forceinline__ void st_pair16(unsigned short* grp, int fq, uint2 qa, uint2 qb) {
    const auto rx = __builtin_amdgcn_permlane16_swap(qa.x, qb.x, false, false);
    const auto ry = __builtin_amdgcn_permlane16_swap(qa.y, qb.y, false, false);
    *(uint4*)(grp + ((fq & 1) ? 16 + 4 * (fq - 1) : 4 * fq)) = make_uint4(rx[0], ry[0], rx[1], ry[1]);
}
struct QStoreF32 { float* C; long ldc; int N; __device__ __forceinline__ void operator()(const Unit&, int row, int col, const f32x4& v) const { if (col < N) *(f32x4*)(C + (size_t)row * ldc + col) = v; } };
template <bool INF32> struct EpiResid {
    const void* Xin; unsigned short* Xout; const float* gate; long ldg;
    __device__ __forceinline__ void operator()(const f32x4 (&acc)[2][2][4][2], const Unit& u, int wr, int wc, int fr, int fq) const {
        const int row0 = u.pm * 256 + wr * 64 + fr, col0 = u.pn * 256 + wc * 32 + 4 * fq, b = (u.pm * 256) / SEQ;
        if (u.half >= 0) {
#pragma unroll
            for (int ai = 0; ai < 2; ++ai)
#pragma unroll
                for (int m = 0; m < 4; ++m)
#pragma unroll
                    for (int n = 0; n < 2; ++n) { const size_t o_ = (size_t)(row0 + ai * 128 + m * 16) * DM + col0 + u.half * 128 + n * 16;
                        const f32x4 g4 = *(const f32x4*)(gate + b * ldg + col0 + u.half * 128 + n * 16); f32x4 xv;
                        if (INF32) xv = *(const f32x4*)((const float*)Xin + o_);
                        else { const uint2 q = *(const uint2*)((const unsigned short*)Xin + o_); xv = (f32x4){__uint_as_float(q.x << 16), __uint_as_float(q.x & 0xffff0000u), __uint_as_float(q.y << 16), __uint_as_float(q.y & 0xffff0000u)}; }
                        const f32x4 o = xv + g4 * acc[ai][0][m][n]; *(uint2*)(Xout + o_) = make_uint2(pack_bf16(o[0], o[1]), pack_bf16(o[2], o[3])); }
            return;
        }
        f32x4 gv[2][2];
#pragma unroll
        for (int bj = 0; bj < 2; ++bj)
#pragma unroll
            for (int n = 0; n < 2; ++n) gv[bj][n] = *(const f32x4*)(gate + b * ldg + col0 + bj * 128 + n * 16);
        if (INF32) {
#pragma unroll
            for (int ai = 0; ai < 2; ++ai) {
#pragma unroll
                for (int bj = 0; bj < 2; ++bj) {
                    f32x4 xv[4][2];
#pragma unroll
                    for (int m = 0; m < 4; ++m)
#pragma unroll
                        for (int n = 0; n < 2; ++n) xv[m][n] = *(const f32x4*)((const float*)Xin + (size_t)(row0 + ai * 128 + m * 16) * DM + col0 + bj * 128 + n * 16);
                    __builtin_amdgcn_sched_barrier(0);
#pragma unroll
                    for (int m = 0; m < 4; ++m)
                        { const f32x4 o0 = xv[m][0] + gv[bj][0] * acc[ai][bj][m][0], o1 = xv[m][1] + gv[bj][1] * acc[ai][bj][m][1];
                          st_pair16(Xout + (size_t)(row0 + ai * 128 + m * 16) * DM + u.pn * 256 + wc * 32 + bj * 128, fq, pk4(o0), pk4(o1)); }
                }
            }
        } else {
            uint2 xu[2][4][2][2];
#pragma unroll
            for (int ai = 0; ai < 2; ++ai)
#pragma unroll
                for (int m = 0; m < 4; ++m)
#pragma unroll
                    for (int bj = 0; bj < 2; ++bj)
#pragma unroll
                        for (int n = 0; n < 2; ++n) xu[ai][m][bj][n] = *(const uint2*)((const unsigned short*)Xin + (size_t)(row0 + ai * 128 + m * 16) * DM + col0 + bj * 128 + n * 16);
            __builtin_amdgcn_sched_barrier(0);
#pragma unroll
            for (int ai = 0; ai < 2; ++ai)
#pragma unroll
                for (int m = 0; m < 4; ++m)
#pragma unroll
                    for (int bj = 0; bj < 2; ++bj) { f32x4 o2[2];
#pragma unroll
                        for (int n = 0; n < 2; ++n) { const uint2 q = xu[ai][m][bj][n];
                            const f32x4 xv = (f32x4){__uint_as_float(q.x << 16), __uint_as_float(q.x & 0xffff0000u), __uint_as_float(q.y << 16), __uint_as_float(q.y & 0xffff0000u)};
                            o2[n] = xv + gv[bj][n] * acc[ai][bj][m][n]; }
                        st_pair16(Xout + (size_t)(row0 + ai * 128 + m * 16) * DM + u.pn * 256 + wc * 32 + bj * 128, fq, pk4(o2[0]), pk4(o2[1])); }
        }
    }
};
struct QNsaIn { float* qn; float* gates; const float* bg; __device__ __forceinline__ void operator()(const Unit&, int row, int col, const f32x4& v) const {
    if (col < 1024) *(f32x4*)(qn + (size_t)row * 1024 + col) = v * 0.125f;
    else if (col < NSA_IN) { const int c = col - 1024; f32x4 o; for (int j = 0; j < 4; ++j) o[j] = sigm(v[j] + bg[c + j]); *(f32x4*)(gates + (size_t)row * 48 + c) = o; } } };
struct QNsaIn2 { unsigned short* qb; float* gates; const float* bg; __device__ __forceinline__ void operator()(const Unit&, int row, int col, const f32x4& v) const {
    if (col < 1024) { const float sc = 0.125f * 1.4426950408889634f; *(uint2*)(qb + (size_t)row * 1024 + col) = make_uint2(pack_bf16(v[0] * sc, v[1] * sc), pack_bf16(v[2] * sc, v[3] * sc)); }
    else if (col < NSA_IN) { const int c = col - 1024; f32x4 o; for (int j = 0; j < 4; ++j) o[j] = sigm(v[j] + bg[c + j]); *(f32x4*)(gates + (size_t)row * 48 + c) = o; } } };
struct QKv2 { unsigned short *csrc, *kslc, *vslcT, *kwin, *vwinT; __device__ __forceinline__ void operator()(const Unit&, int row, int col, const f32x4& v) const {
    const int j = col >> 8, g = (col >> 6) & 3, d = col & 63, b = row / SEQ, s = row % SEQ, bg = b * 4 + g;
    if (j < 2) *(uint2*)(csrc + ((size_t)((j * 32 + bg) * SEQ + s)) * 64 + d) = make_uint2(pack_bf16(v[0], v[1]), pack_bf16(v[2], v[3]));
    else if (j == 2 || j == 4) *(uint2*)((j == 2 ? kslc : kwin) + ((size_t)bg * SEQ + s) * 64 + d) = make_uint2(pack_bf16(v[0], v[1]), pack_bf16(v[2], v[3]));
    else { const int sp = (s & ~15) | (((s >> 2) & 1) << 3) | (((s >> 3) & 1) << 2) | (s & 3);
        unsigned short* vt = (j == 3 ? vslcT : vwinT) + ((size_t)bg * 64 + d) * SEQ + sp;
#pragma unroll
        for (int i = 0; i < 4; ++i) vt[(size_t)i * SEQ] = f2bf(v[i]); } } };
struct QGlaIn { unsigned short *qk, *vT, *rb; float* glr; __device__ __forceinline__ void operator()(const Unit&, int row, int col, const f32x4& v) const {
    if (col < 1024) *(uint2*)(qk + (size_t)row * 1024 + col) = make_uint2(pack_bf16(v[0], v[1]), pack_bf16(v[2], v[3]));
    else if (col < 2048) { const int ce = col - 1024, b = row / SEQ, s = row % SEQ; unsigned short* vt = vT + ((size_t)(b * 4 + (ce >> 8)) * 256 + (ce & 255)) * SEQ + s;
#pragma unroll
        for (int i = 0; i < 4; ++i) vt[(size_t)i * SEQ] = f2bf(v[i]); }
    else if (col < 3072) *(uint2*)(rb + (size_t)row * 1024 + (col - 2048)) = make_uint2(pack_bf16(v[0], v[1]), pack_bf16(v[2], v[3]));
    else if (col < GLA_IN) *(f32x4*)(glr + (size_t)row * 16 + (col - 3072)) = v; } };
__device__ __forceinline__ float fast_sigm(float x) { return __builtin_amdgcn_rcpf(1.f + __builtin_amdgcn_exp2f(-1.4426950408889634f * x)); }
typedef float f32x2_ __attribute__((ext_vector_type(2)));
template <bool PERMK>
__device__ __forceinline__ void st_vT_tile(LAS unsigned char* T, unsigned short* vt_col0, int row, int fq, const f32x4& v0, const f32x4& v1) {
    const int fr = row & 15, lane16 = fr, g = fq;
    *(LAS au32x2_*)(T + fr * 64 + fq * 8) = (au32x2_){pack_bf16(v0[0], v0[1]), pack_bf16(v0[2], v0[3])};
    *(LAS au32x2_*)(T + fr * 64 + 32 + fq * 8) = (au32x2_){pack_bf16(v1[0], v1[1]), pack_bf16(v1[2], v1[3])};
    const int colblk = g & 1, th = g >> 1, j = lane16 >> 2, q = lane16 & 3;
    const int t0 = PERMK ? 4 * th : 8 * th, t1 = PERMK ? 8 + 4 * th : 8 * th + 4;
    LAS unsigned char* a0 = T + (t0 + j) * 64 + colblk * 32 + q * 8;
    LAS unsigned char* a1 = T + (t1 + j) * 64 + colblk * 32 + q * 8;
    au32x2_ r0, r1;
    asm volatile("s_waitcnt lgkmcnt(0)\n\tds_read_b64_tr_b16 %0, %2\n\tds_read_b64_tr_b16 %1, %3\n\ts_waitcnt lgkmcnt(0)" : "=&v"(r0), "=&v"(r1) : "v"(a0), "v"(a1) : "memory");
    *(uint4*)(vt_col0 + (size_t)(colblk * 16 + lane16) * SEQ + 8 * th) = make_uint4(r0.x, r0.y, r1.x, r1.y);
}
struct PGlaIn { unsigned short *qk, *vT, *rb; float* glr; LAS unsigned char* tl; __device__ __forceinline__ void operator()(const Unit&, int row, int gb, int fq, int wv, const f32x4& v0, const f32x4& v1) const {
    if (gb < 1024) st_pair16(qk + (size_t)row * 1024 + gb, fq, pk4(v0), pk4(v1));
    else if (gb < 2048) { const int b = row / SEQ, s = row % SEQ;
#pragma unroll
        for (int n = 0; n < 2; ++n) { const int ce = gb - 1024 + n * 16 + 4 * fq; unsigned short* vt = vT + ((size_t)(b * 4 + (ce >> 8)) * 256 + (ce & 255)) * SEQ + s; const f32x4& v = n ? v1 : v0;
#pragma unroll
            for (int i = 0; i < 4; ++i) vt[(size_t)i * SEQ] = f2bf(v[i]); } }
    else if (gb < 3072) st_pair16(rb + (size_t)row * 1024 + (gb - 2048), fq, pk4(v0), pk4(v1));
    else if (gb == 3072) *(f32x4*)(glr + (size_t)row * 16 + 4 * fq) = v0; } };
struct PNsaIn { unsigned short* qb; float* gates; const float* bg; __device__ __forceinline__ void operator()(const Unit&, int row, int gb, int fq, int, const f32x4& v0, const f32x4& v1) const {
    if (gb < 1024) { const float sc = 0.125f * 1.4426950408889634f; st_pair16(qb + (size_t)row * 1024 + gb, fq, pk4(v0 * sc), pk4(v1 * sc)); }
    else {
#pragma unroll
        for (int n = 0; n < 2; ++n) { const int c = gb - 1024 + n * 16 + 4 * fq; if (c < 48) { const f32x4& v = n ? v1 : v0; f32x4 o; for (int j = 0; j < 4; ++j) o[j] = sigm(v[j] + bg[c + j]); *(f32x4*)(gates + (size_t)row * 48 + c) = o; } } } } };
struct PKv { unsigned short *csrc, *kslc, *vslcT, *kwin, *vwinT; LAS unsigned char* tl; __device__ __forceinline__ void operator()(const Unit&, int row, int gb, int fq, int wv, const f32x4& v0, const f32x4& v1) const {
    const int j = gb >> 8, g = (gb >> 6) & 3, d0 = gb & 63, b = row / SEQ, s = row % SEQ, bg = b * 4 + g;
    if (j < 2) st_pair16(csrc + ((size_t)((j * 32 + bg) * SEQ + s)) * 64 + d0, fq, pk4(v0), pk4(v1));
    else if (j == 2 || j == 4) st_pair16((j == 2 ? kslc : kwin) + ((size_t)bg * SEQ + s) * 64 + d0, fq, pk4(v0), pk4(v1));
    else { const int sp = (s & ~15) | (((s >> 2) & 1) << 3) | (((s >> 3) & 1) << 2) | (s & 3);
#pragma unroll
        for (int n = 0; n < 2; ++n) { unsigned short* vt = (j == 3 ? vslcT : vwinT) + ((size_t)bg * 64 + d0 + n * 16 + 4 * fq) * SEQ + sp; const f32x4& v = n ? v1 : v0;
#pragma unroll
            for (int i = 0; i < 4; ++i) vt[(size_t)i * SEQ] = f2bf(v[i]); } } } };
struct QSwiglu { unsigned short* act; LAS unsigned char* xl; __device__ __forceinline__ void operator()(const Unit& u, int row, int col, const f32x4& v) const {
    const f32x4 bv = *(const LAS f32x4*)(xl + MX_BIAS + (u.ord & 1) * 1024 + (col - u.pn * 256) * 4);
    f32x2_ G = (f32x2_){v[0], v[2]} + (f32x2_){bv[0], bv[2]}, U = (f32x2_){v[1], v[3]} + (f32x2_){bv[1], bv[3]};
    G.x = fminf(G.x, 7.f); G.y = fminf(G.y, 7.f);
    U.x = __builtin_amdgcn_fmed3f(U.x, -7.f, 7.f); U.y = __builtin_amdgcn_fmed3f(U.y, -7.f, 7.f);
    f32x2_ E = G * (-1.702f * 1.4426950408889634f); E.x = __builtin_amdgcn_exp2f(E.x); E.y = __builtin_amdgcn_exp2f(E.y);
    f32x2_ S = E + 1.0f; S.x = __builtin_amdgcn_rcpf(S.x); S.y = __builtin_amdgcn_rcpf(S.y);
    const f32x2_ R = ((U + 1.0f) * G) * S;
    *(unsigned*)(act + (size_t)row * 1024 + (col >> 1)) = pack_bf16(R.x, R.y); } };
struct QDownF { float* y; const float* bd; const int* tile_e; __device__ __forceinline__ void operator()(const Unit& u, int row, int col, const f32x4& v) const {
    const int e = tile_e[u.pm]; *(f32x4*)(y + (size_t)row * 1024 + col) = v + *(const f32x4*)(bd + e * 1024 + col); } };
struct EpiSwiglu { unsigned short* act; LAS unsigned char* xl;
    __device__ __forceinline__ void operator()(const f32x4 (&acc)[2][2][4][2], const Unit& u, int wr, int wc, int fr, int fq) const {
        const int row0 = u.pm * 256 + wr * 64 + fr, cl0 = wc * 32 + 4 * fq;
        f32x4 bv[2][2];
#pragma unroll
        for (int bj = 0; bj < 2; ++bj)
#pragma unroll
            for (int n = 0; n < 2; ++n) bv[bj][n] = *(const LAS f32x4*)(xl + MX_BIAS + (u.ord & 1) * 1024 + (cl0 + bj * 128 + n * 16) * 4);
#pragma unroll
        for (int ai = 0; ai < 2; ++ai)
#pragma unroll
            for (int mp = 0; mp < 2; ++mp) {
                f32x2_ G[8], U[8], E[8];
#pragma unroll
                for (int q = 0; q < 8; ++q) { const int m = mp * 2 + (q >> 2), bj = (q >> 1) & 1, n = q & 1; const f32x4 v = acc[ai][bj][m][n]; const f32x4 b4 = bv[bj][n];
                    G[q] = (f32x2_){v[0], v[2]} + (f32x2_){b4[0], b4[2]}; U[q] = (f32x2_){v[1], v[3]} + (f32x2_){b4[1], b4[3]}; }
#pragma unroll
                for (int q = 0; q < 8; ++q) { G[q].x = fminf(G[q].x, 7.f); G[q].y = fminf(G[q].y, 7.f); U[q].x = __builtin_amdgcn_fmed3f(U[q].x, -7.f, 7.f); U[q].y = __builtin_amdgcn_fmed3f(U[q].y, -7.f, 7.f);
                    E[q] = G[q] * (-1.702f * 1.4426950408889634f); }
#pragma unroll
                for (int q = 0; q < 8; ++q) { E[q].x = __builtin_amdgcn_exp2f(E[q].x); E[q].y = __builtin_amdgcn_exp2f(E[q].y); }
#pragma unroll
                for (int q = 0; q < 8; ++q) { E[q] = E[q] + 1.0f; U[q] = (U[q] + 1.0f) * G[q]; }
#pragma unroll
                for (int q = 0; q < 8; ++q) { E[q].x = __builtin_amdgcn_rcpf(E[q].x); E[q].y = __builtin_amdgcn_rcpf(E[q].y); }
#pragma unroll
                for (int mm = 0; mm < 2; ++mm) { const int m = mp * 2 + mm; unsigned pk[4];
#pragma unroll
                    for (int q4 = 0; q4 < 4; ++q4) { const f32x2_ R = U[mm * 4 + q4] * E[mm * 4 + q4]; pk[q4] = pack_bf16(R.x, R.y); }
                    *(uint4*)(act + (size_t)(row0 + ai * 128 + m * 16) * 1024 + u.pn * 128 + wc * 32 + fq * 8) = make_uint4(pk[0], pk[1], pk[2], pk[3]); }
            }
    }
};
struct EpiDown { unsigned short* y; LAS unsigned char* xl;
    __device__ __forceinline__ void operator()(const f32x4 (&acc)[2][2][4][2], const Unit& u, int wr, int wc, int fr, int fq) const {
        const int hb_ = u.half >= 0 ? u.half : 0; const int nbj = u.half >= 0 ? 1 : 2;
        const int row0 = u.pm * 256 + wr * 64 + fr, cl0 = wc * 32 + 4 * fq;
        f32x4 bv[2][2];
#pragma unroll
        for (int bj = 0; bj < 2; ++bj)
#pragma unroll
            for (int n = 0; n < 2; ++n) bv[bj][n] = *(const LAS f32x4*)(xl + MX_BIAS + (u.ord & 1) * 1024 + (cl0 + (bj + hb_ < 2 ? bj + hb_ : 1) * 128 + n * 16) * 4);
#pragma unroll
        for (int ai = 0; ai < 2; ++ai)
#pragma unroll
            for (int m = 0; m < 4; ++m) {
                unsigned short* rowp = y + (size_t)(row0 + ai * 128 + m * 16) * 1024 + u.pn * 256 + wc * 32;
#pragma unroll
                for (int bj = 0; bj < 2; ++bj) { if (bj >= nbj) continue;
                    const f32x4 o0 = acc[ai][bj][m][0] + bv[bj][0], o1 = acc[ai][bj][m][1] + bv[bj][1];
                    st_pair16(rowp + (bj + hb_) * 128, fq, make_uint2(pack_bf16(o0[0], o0[1]), pack_bf16(o0[2], o0[3])), make_uint2(pack_bf16(o1[0], o1[1]), pack_bf16(o1[2], o1[3]))); }
            }
    }
};
struct QKv { float* kv6; unsigned short* csrc; __device__ __forceinline__ void operator()(const Unit&, int row, int col, const f32x4& v) const {
    *(f32x4*)(kv6 + (size_t)row * KV_OUT + col) = v;
    if (col < 512) { const int t = col >> 8, g = (col >> 6) & 3, d = col & 63, b = row / SEQ, s = row % SEQ;
        *(uint2*)(csrc + ((size_t)((t * 32 + b * 4 + g) * SEQ + s)) * 64 + d) = make_uint2(pack_bf16(v[0], v[1]), pack_bf16(v[2], v[3])); } } };
struct QCmp1 { float* hidp; __device__ __forceinline__ void operator()(const Unit& u, int row, int col, const f32x4& v) const {
    const int z = u.pm >> 2, ks = u.pm & 3, n = row - u.pm * 256; if (col < 128 && n < NCMP) *(f32x4*)(hidp + (((size_t)ks * 64 + z) * NCMP + n) * 128 + col) = v; } };

struct P {
    const float *x_in, *c, *ada_w, *ada_b, *norm1_g, *norm2_g, *gla_w_in, *gla_w_gate2, *gla_b_gate, *gla_norm_g, *gla_w_out, *kv_norm_g, *kv_ada_w, *kv_ada_b,
        *kv_w, *cmp_pos, *cmp_w1, *cmp_b1, *cmp_w2, *cmp_b2, *nsa_w_in, *nsa_b_gate, *nsa_w_out, *router_w, *router_b, *moe_w_gu, *moe_b_gu, *moe_w_down, *moe_b_down, *final_g;
    float* out; unsigned* bar;
    float *mod, *kvmod, *hid, *gates, *topw, *c1, *glr, *gdl;
    unsigned short *x, *y, *hb, *ob, *act, *csrc, *qb, *kslc, *vslcT, *kwin, *vwinT, *kcmp, *vcmpT, *gqk, *gvT, *grb, *gqd, *gki, *gST, *gUT, *wt_gla_in, *wt_gla_out, *wt_kv, *wt_nsa_in, *wt_nsa_out, *wt_cmp1, *wt_gu, *wt_down;
    unsigned long long* sel; int *topi, *cnt, *cntb, *stok, *pos, *tile_e;
};
typedef const P __attribute__((address_space(4)))* KP;
constexpr int LDS_BAR_OFF = g8::STAGE_BYTES;
constexpr int LDS_X_OFF = g8::STAGE_BYTES + 64;
constexpr size_t kDynLds = LDS_X_OFF + MX_END;
__device__ __forceinline__ float* dyn_smem() { extern __shared__ __attribute__((aligned(16))) float smem_[]; return smem_; }
struct Ctx {
int nb_s;
int wv_s;
#define LAUNDER() int tid_; asm volatile("v_mbcnt_lo_u32_b32 %0, -1, 0\n\tv_mbcnt_hi_u32_b32 %0, -1, %0" : "=v"(tid_)); tid_ += wv_s * 64; const int bid_ = blockIdx.x; const int GTID = bid_ * NTHR + tid_; const int GSZ = nb_s * NTHR; (void)GTID; (void)GSZ;
#define SHX(v, o) __uint_as_float((unsigned)__builtin_amdgcn_ds_bpermute(((tid_ ^ (o)) & 63) << 2, (int)__float_as_uint(v)))

__device__ __forceinline__ void ph_mod(const float* c, const float* ada_w, const float* ada_b, const float* kv_ada_w, const float* kv_ada_b,
                                       float* mod, float* kvmod, float* smem) {
    LAUNDER();
    float (*cs)[1024] = (float (*)[1024])smem;
    float* red = smem + 8192;
    for (int i = tid_; i < 8192; i += NTHR) { float v = c[i]; cs[i >> 10][i & 1023] = siluf(v); }
    __syncthreads();
    const int ncol = 4 * 6144 + 2048, cl = tid_ & 127, kq = tid_ >> 7;
    for (int c0 = bid_ * 128; c0 < ncol; c0 += nb_s * 128) {
        const int col = c0 + cl;
        const float* w = nullptr; int ldw = 0; float* out = nullptr; int ldo = 0; const float* bias = nullptr;
        if (col < 4 * 6144) { int L = col / 6144, j = col % 6144; w = ada_w + (size_t)L * 1024 * 6144 + j; ldw = 6144; bias = ada_b + L * 6144 + j; out = mod + (size_t)L * 8 * 6144 + j; ldo = 6144; }
        else if (col < ncol) { int j = col - 4 * 6144; w = kv_ada_w + j; ldw = 2048; bias = kv_ada_b + j; out = kvmod + j; ldo = 2048; }
        float acc[8];
#pragma unroll
        for (int b = 0; b < 8; ++b) acc[b] = 0.f;
        if (w) {
#pragma unroll 4
            for (int k = kq * 256; k < kq * 256 + 256; ++k) { const float wv = w[(size_t)k * ldw];
#pragma unroll
                for (int b = 0; b < 8; ++b) acc[b] += cs[b][k] * wv; } }
#pragma unroll
        for (int b = 0; b < 8; ++b) red[(kq * 128 + cl) * 8 + b] = acc[b];
        __syncthreads();
        if (kq == 0 && w) { const float bv = *bias;
#pragma unroll
            for (int b = 0; b < 8; ++b) out[b * ldo] = red[cl * 8 + b] + red[(128 + cl) * 8 + b] + red[(256 + cl) * 8 + b] + red[(384 + cl) * 8 + b] + bv; }
        __syncthreads();
    }
}

__device__ __forceinline__ void ph_norm(const float* x, const float* g, const float* shift, const float* scale, float* out, unsigned short* outb, int ldmod) {
    LAUNDER();
    const int lane = tid_ & 63;
    float4 gg[4], vn[4];
#pragma unroll
    for (int j = 0; j < 4; ++j) { gg[j] = *(const float4*)(g + j * 256 + lane * 4); vn[j] = make_float4(0.f, 0.f, 0.f, 0.f); }
    if ((GTID >> 6) < NT) {
#pragma unroll
        for (int j = 0; j < 4; ++j) vn[j] = *(const float4*)(x + (size_t)(GTID >> 6) * DM + j * 256 + lane * 4); }
    for (int row = GTID >> 6; row < NT; row += GSZ >> 6) {
        const int b = row / SEQ;
        float4 v[4], sc[4], sh[4]; float ss = 0.f;
#pragma unroll
        for (int j = 0; j < 4; ++j) { v[j] = vn[j]; sc[j] = make_float4(0.f, 0.f, 0.f, 0.f); sh[j] = sc[j];
            if (shift) { sc[j] = *(const float4*)(scale + b * ldmod + j * 256 + lane * 4); sh[j] = *(const float4*)(shift + b * ldmod + j * 256 + lane * 4); } }
        { const int nr = row + (GSZ >> 6);
          if (nr < NT) {
#pragma unroll
              for (int j = 0; j < 4; ++j) vn[j] = *(const float4*)(x + (size_t)nr * DM + j * 256 + lane * 4); } }
#pragma unroll
        for (int j = 0; j < 4; ++j) ss += v[j].x * v[j].x + v[j].y * v[j].y + v[j].z * v[j].z + v[j].w * v[j].w;
        for (int o = 32; o > 0; o >>= 1) ss += SHX(ss, o);
        const float r = rsqrtf(ss * (1.f / DM) + 1e-5f);
#pragma unroll
        for (int j = 0; j < 4; ++j) { const int col = j * 256 + lane * 4;
            float4 y = make_float4(v[j].x * r * gg[j].x, v[j].y * r * gg[j].y, v[j].z * r * gg[j].z, v[j].w * r * gg[j].w);
            if (shift) { y.x = y.x * (1.f + sc[j].x) + sh[j].x; y.y = y.y * (1.f + sc[j].y) + sh[j].y; y.z = y.z * (1.f + sc[j].z) + sh[j].z; y.w = y.w * (1.f + sc[j].w) + sh[j].w; }
            if (out) *(float4*)(out + (size_t)row * DM + col) = y;
            if (outb) *(uint2*)(outb + (size_t)row * DM + col) = make_uint2(pack_bf16(y.x, y.y), pack_bf16(y.z, y.w)); }
    }
}

template <class AF, class BF, class EF>
__device__ __forceinline__ void ph_gemm(AF af, BF bf, EF ef, int M, int N, int K, int Z, float* smem, int boff = 0) {
    LAUNDER();
    float (*As)[132] = (float (*)[132])smem;
    float (*Bs)[132] = (float (*)[132])(smem + 16 * 132);
    const int tm = (M + 127) / 128, tn = (N + 127) / 128, total = Z * tm * tn;
    const int tid = tid_, ty = tid >> 4, tx = tid & 15;
    for (int it = (bid_ >= boff ? bid_ - boff : bid_ - boff + nb_s); it < total; it += nb_s) {
        const int z = it / (tm * tn), rr = it % (tm * tn), m0 = (rr / tn) * 128, n0 = (rr % tn) * 128;
        if (!af.active(z, m0)) continue;
        float acc[4][8];
#pragma unroll
        for (int i = 0; i < 4; ++i)
#pragma unroll
            for (int j = 0; j < 8; ++j) acc[i][j] = 0.f;
#pragma unroll 1
        for (int k0 = 0; k0 < K; k0 += 16) {
            { const int r = tid >> 2, kk = (tid & 3) * 4, m = m0 + r;
#pragma unroll
              for (int j = 0; j < 4; ++j) As[kk + j][r] = (m < M) ? af(z, m, k0 + kk + j) : 0.f; }
            { const int kk = tid >> 5, cc = (tid & 31) * 4;
#pragma unroll
              for (int j = 0; j < 4; ++j) { const int n = n0 + cc + j; Bs[kk][cc + j] = (n < N) ? bf(z, m0, k0 + kk, n) : 0.f; } }
            __syncthreads();
#pragma unroll
            for (int kk = 0; kk < 16; ++kk) {
                float a[4], b[8];
#pragma unroll
                for (int i = 0; i < 4; ++i) a[i] = As[kk][ty * 4 + i];
#pragma unroll
                for (int j = 0; j < 8; ++j) b[j] = Bs[kk][tx * 8 + j];
#pragma unroll
                for (int i = 0; i < 4; ++i)
#pragma unroll
                    for (int j = 0; j < 8; ++j) acc[i][j] += a[i] * b[j];
            }
            __syncthreads();
        }
#pragma unroll
        for (int i = 0; i < 4; ++i) { const int m = m0 + ty * 4 + i; if (m < M) ef(z, m, m0, n0 + tx * 8, acc[i], N); }
    }
}

__device__ __forceinline__ void ph_gla_gate(const float* proj, const float* w2, const float* bg, float* loga) {
    LAUNDER();
    for (size_t i = GTID; i < (size_t)NT * 512; i += GSZ) {
        const int t = (int)(i >> 9), j = (int)(i & 511);
        float z = bg[j];
#pragma unroll
        for (int r = 0; r < 16; ++r) z += proj[(size_t)t * GLA_IN + 3072 + r] * w2[r * 512 + j];
        loga[i] = logsigmoidf(z) * (1.f / 16.f);
    }
}
__device__ __forceinline__ void ph_gla_rec(const float* proj, const float* loga, float* oraw, float* smem) {
    LAUNDER();
    if (bid_ >= 16) return;
    const int half = tid_ >> 8, e = tid_ & 255, item = bid_ * 2 + half;
    float* sq = smem + half * 384; float* sk = sq + 128; float* sa = sk + 128;
    const int b = item >> 2, h = item & 3;
    float st[128];
#pragma unroll
    for (int d = 0; d < 128; ++d) st[d] = 0.f;
    const float* pr = proj + (size_t)b * SEQ * GLA_IN + h * 128 + (e < 128 ? e : 512 + (e - 128));
    const float* pa = loga + (size_t)b * SEQ * 512 + h * 128 + (e & 127);
    const float* pv = proj + (size_t)b * SEQ * GLA_IN + 1024 + h * 256 + e;
    float* po = oraw + (size_t)b * SEQ * DM + h * 256 + e;
#pragma unroll 1
    for (int t = 0; t < SEQ; ++t) {
        if (e < 128) { sq[e] = *pr; sa[e] = expf(*pa); } else { sk[e - 128] = *pr; }
        const float v = *pv;
        __syncthreads();
        float o = 0.f;
#pragma unroll
        for (int d = 0; d < 128; ++d) { st[d] = st[d] * sa[d] + sk[d] * v; o += sq[d] * st[d]; }
        *po = o * 0.08838834764831845f;
        __syncthreads();
        pr += GLA_IN; pa += 512; pv += GLA_IN; po += DM;
    }
}
__device__ __forceinline__ void ph_gla_post(const float* oraw, const float* proj, const float* ng, unsigned short* ob) {
    LAUNDER();
    const int l = tid_ & 63;
    for (int it = GTID >> 6; it < NT * 4; it += GSZ >> 6) {
        const int row = it >> 2, h = it & 3;
        const float4 v = *(const float4*)(oraw + (size_t)row * DM + h * 256 + l * 4);
        float ss = v.x * v.x + v.y * v.y + v.z * v.z + v.w * v.w;
        for (int s = 32; s > 0; s >>= 1) ss += SHX(ss, s);
        const float r = rsqrtf(ss * (1.f / 256.f) + 1e-5f);
        float vv[4] = {v.x, v.y, v.z, v.w};
#pragma unroll
        for (int j = 0; j < 4; ++j) { const int col = h * 256 + l * 4 + j; const float rr = proj[(size_t)row * GLA_IN + 2048 + col];
            ob[(size_t)row * DM + col] = f2bf(vv[j] * r * ng[col] * siluf(rr)); }
    }
}

__device__ __forceinline__ void ph_nsa_cmp(const float* qn, const float* comp, float* pc, float* oc) {
    LAUNDER();
    for (int idx = GTID; idx < NT * 16; idx += GSZ) {
        const int bt = idx >> 4, hd = idx & 15, b = bt / SEQ, t = bt % SEQ, g = hd >> 2;
        const float slope = exp2f(-0.5f * (hd + 1));
        float q[64];
#pragma unroll
        for (int d = 0; d < 64; ++d) q[d] = qn[(size_t)bt * 1024 + hd * 64 + d];
        const int nv = t >= 31 ? min(NCMP, (t - 31) / 16 + 1) : 0;
        const float* kc = comp + (size_t)(0 * 32 + b * 4 + g) * NCMP * 64;
        const float* vc = comp + (size_t)(1 * 32 + b * 4 + g) * NCMP * 64;
        float* pr = pc + (size_t)idx * 256;
        float mx = -1e30f;
        for (int n = 0; n < nv; ++n) { float s = 0.f;
#pragma unroll
            for (int d = 0; d < 64; ++d) s += q[d] * kc[n * 64 + d];
            s -= slope * (float)(t - (16 * n + 31)); pr[n] = s; mx = fmaxf(mx, s); }
        float l = 0.f;
        for (int n = 0; n < nv; ++n) l += expf(pr[n] - mx);
        const float inv = nv > 0 ? 1.f / l : 0.f;
        float o[64];
#pragma unroll
        for (int d = 0; d < 64; ++d) o[d] = 0.f;
        for (int n = 0; n < nv; ++n) { const float p = expf(pr[n] - mx) * inv; pr[n] = p;
#pragma unroll
            for (int d = 0; d < 64; ++d) o[d] += p * vc[n * 64 + d]; }
        for (int n = nv; n < 256; ++n) pr[n] = 0.f;
#pragma unroll
        for (int d = 0; d < 64; ++d) oc[(size_t)idx * 64 + d] = o[d];
    }
}
__device__ __forceinline__ void ph_nsa_sel(const float* pc, unsigned long long* sel) {
    LAUNDER();
    const int j = tid_ & 63;
    for (int idx = GTID >> 6; idx < NT * 4; idx += GSZ >> 6) {
        const int bt = idx >> 2, g = idx & 3, t = bt % SEQ, cur = t >> 6;
        float imp = 0.f;
        for (int hp = 0; hp < 4; ++hp) { const float* pr = pc + ((size_t)bt * 16 + g * 4 + hp) * 256;
            for (int n = max(4 * j - 1, 0); n <= min(4 * j + 3, NCMP - 1); ++n) imp += pr[n]; }
        const bool valid = j <= cur, forced = (j == 0) || (j == cur) || (j == cur - 1);
        const float s = valid ? imp + (forced ? 1e4f : 0.f) : -1e4f;
        int rank = 0;
        for (int jj = 0; jj < 64; ++jj) { const float sj = __uint_as_float((unsigned)__builtin_amdgcn_ds_bpermute(jj << 2, (int)__float_as_uint(s))); rank += (sj > s || (sj == s && jj < j)) ? 1 : 0; }
        const unsigned long long m = __ballot(rank < 16);
        if (j == 0) sel[idx] = m;
    }
}
__device__ __forceinline__ void ph_nsa_attn(const float* qn, const float* gates, const float* kv6, const float* oc, const unsigned long long* sel, float* o, unsigned short* ob) {
    LAUNDER();
    for (int idx = GTID; idx < NT * 16; idx += GSZ) {
        const int bt = idx >> 4, hd = idx & 15, b = bt / SEQ, t = bt % SEQ, g = hd >> 2, cur = t >> 6;
        const float slope = exp2f(-0.5f * (hd + 1));
        float q[64];
#pragma unroll
        for (int d = 0; d < 64; ++d) q[d] = qn[(size_t)bt * 1024 + hd * 64 + d];
        const float gc = gates[(size_t)bt * 48 + 0 * 16 + hd], gs = gates[(size_t)bt * 48 + 1 * 16 + hd], gw = gates[(size_t)bt * 48 + 2 * 16 + hd];
        const unsigned long long msk = sel[(size_t)bt * 4 + g];
        float* orow = o + (size_t)bt * 1024 + hd * 64;
        for (int br = 0; br < 2; ++br) {
            float acc[64];
#pragma unroll
            for (int d = 0; d < 64; ++d) acc[d] = 0.f;
            float mx = -1e30f, l = 0.f;
            const int kcol = (br == 0 ? 2 : 4) * 256 + g * 64, vcol = kcol + 256;
            const int jlo = br == 0 ? 0 : max(0, t - 511), jhi = br == 0 ? cur : t;
            for (int j = jlo; j <= jhi; ++j) {
                int k0, k1;
                if (br == 0) { if (!((msk >> j) & 1ull)) continue; k0 = 64 * j; k1 = min(64 * j + 63, t); } else { k0 = j; k1 = j; }
                for (int key = k0; key <= k1; ++key) {
                    const float* kr = kv6 + (size_t)(b * SEQ + key) * KV_OUT + kcol; const float* vr = kv6 + (size_t)(b * SEQ + key) * KV_OUT + vcol;
                    float s = 0.f;
#pragma unroll
                    for (int d = 0; d < 64; ++d) s += q[d] * kr[d];
                    s -= slope * (float)(t - key);
                    const float mn = fmaxf(mx, s), sc = expf(mx - mn), p = expf(s - mn);
                    l = l * sc + p; mx = mn;
#pragma unroll
                    for (int d = 0; d < 64; ++d) acc[d] = acc[d] * sc + p * vr[d];
                }
            }
            const float gg = (br == 0 ? gs : gw) / l;
            if (br == 0) {
#pragma unroll
                for (int d = 0; d < 64; ++d) orow[d] = gc * oc[(size_t)idx * 64 + d] + gg * acc[d];
            } else {
#pragma unroll
                for (int d = 0; d < 64; ++d) ob[(size_t)bt * 1024 + hd * 64 + d] = f2bf(orow[d] + gg * acc[d]);
            }
        }
    }
}

__device__ __forceinline__ void ph_router(const float* h, const float* rw, const float* rb, float* logits) {
    LAUNDER();
    for (size_t i = GTID; i < (size_t)NT * 32; i += GSZ) {
        const int t = (int)(i >> 5), e = (int)(i & 31);
        float acc = 0.f;
        for (int k = 0; k < 1024; ++k) acc += h[(size_t)t * DM + k] * rw[k * 32 + e];
        logits[i] = acc + rb[e];
    }
}
__device__ __forceinline__ void ph_top4(const float* logits, int* topi, float* topw, int* cnt) {
    LAUNDER();
    for (int t = GTID; t < NT; t += GSZ) {
        float v[32];
#pragma unroll
        for (int e = 0; e < 32; ++e) v[e] = logits[(size_t)t * 32 + e];
        float tv[4]; int ti[4];
#pragma unroll
        for (int r = 0; r < 4; ++r) { float best = -3e38f; int bi = 0;
#pragma unroll
            for (int e = 0; e < 32; ++e) if (v[e] > best) { best = v[e]; bi = e; }
            tv[r] = best; ti[r] = bi;
#pragma unroll
            for (int e = 0; e < 32; ++e) if (e == bi) v[e] = -3e38f; }
        float s = 0.f, w[4];
#pragma unroll
        for (int r = 0; r < 4; ++r) { w[r] = expf(tv[r] - tv[0]); s += w[r]; }
#pragma unroll
        for (int r = 0; r < 4; ++r) { topi[t * 4 + r] = ti[r]; topw[t * 4 + r] = w[r] / s; atomicAdd(&cnt[ti[r]], 1); }
    }
}
__device__ __forceinline__ void ph_offsets(int* cnt, int* tile_e) {
    LAUNDER();
    if (tid_ == 0 && bid_ == 0) { int s = 0;
        for (int e = 0; e < NE; ++e) { cnt[64 + e] = s; const int p = (cnt[e] + MPAD - 1) / MPAD * MPAD; for (int tl = s / MPAD; tl < (s + p) / MPAD; ++tl) tile_e[tl] = e; s += p; }
        cnt[64 + NE] = s; for (int tl = s / MPAD; tl < CAP / MPAD; ++tl) tile_e[tl] = -1; }
}
__device__ __forceinline__ void ph_assign(const int* topi, int* cnt, int* stok, int* pos) {
    LAUNDER();
    for (int i = GTID; i < NASG; i += GSZ) {
        const int e = topi[i];
        const int p = cnt[64 + e] + atomicAdd(&cnt[32 + e], 1);
        stok[p] = i >> 2; pos[i] = p;
    }
}
__device__ __forceinline__ void ph_combine(float* x, const float* y, const int* pos, const float* topw, const float* gate, int ldg) {
    LAUNDER();
    const int lane = tid_ & 63;
    for (int row = GTID >> 6; row < NT; row += GSZ >> 6) {
        const int b = row / SEQ;
#pragma unroll
        for (int j = 0; j < 4; ++j) { const int col = j * 256 + lane * 4;
            float4 acc = make_float4(0.f, 0.f, 0.f, 0.f);
            for (int r = 0; r < 4; ++r) { const float w = topw[row * 4 + r]; const float4 v = *(const float4*)(y + (size_t)pos[row * 4 + r] * DM + col);
                acc.x += w * v.x; acc.y += w * v.y; acc.z += w * v.z; acc.w += w * v.w; }
            float4 xv = *(float4*)(x + (size_t)row * DM + col); const float4 gp = *(const float4*)(gate + b * ldg + col);
            xv.x += gp.x * acc.x; xv.y += gp.y * acc.y; xv.z += gp.z * acc.z; xv.w += gp.w * acc.w;
            *(float4*)(x + (size_t)row * DM + col) = xv; }
    }
}
template <bool PERM128 = false>
__device__ __forceinline__ void ph_convT(const float* src, unsigned short* dst, int K, int N, int Npad, int nmat, float* smem) {
    LAUNDER();
    unsigned (*TT)[64][33] = (unsigned (*)[64][33])smem;
    const int tk = K / 64, tn = Npad / 64, per = tk * tn, total = nmat * per;
    const int kp = tid_ >> 4, ln = (tid_ & 15) * 4;
    float4 v0 = make_float4(0.f, 0.f, 0.f, 0.f), v1 = v0;
    auto fetch = [&](int it, float4& a, float4& b) {
        const int mat = it / per, r = it % per, k0 = (r / tn) * 64, n0 = (r % tn) * 64;
        const float* s = src + (size_t)mat * K * N;
        a = make_float4(0.f, 0.f, 0.f, 0.f); b = a;
        int ka = k0 + 2 * kp, kb = ka + 1;
        if (PERM128) {
            ka = (ka & ~127) | (((ka >> 2) & 1) * 64 + ((ka >> 5) & 3) * 16 + ((ka >> 1) & 1) * 8 + ((ka >> 3) & 3) * 2 + (ka & 1));
            kb = (kb & ~127) | (((kb >> 2) & 1) * 64 + ((kb >> 5) & 3) * 16 + ((kb >> 1) & 1) * 8 + ((kb >> 3) & 3) * 2 + (kb & 1)); }
        if (n0 + ln < N) { a = *(const float4*)(s + (size_t)ka * N + n0 + ln); b = *(const float4*)(s + (size_t)kb * N + n0 + ln); }
    };
    int it = bid_, par = 0;
    if (it < total) fetch(it, v0, v1);
    while (it < total) {
        TT[par][ln][kp] = pack_bf16(v0.x, v1.x); TT[par][ln + 1][kp] = pack_bf16(v0.y, v1.y); TT[par][ln + 2][kp] = pack_bf16(v0.z, v1.z); TT[par][ln + 3][kp] = pack_bf16(v0.w, v1.w);
        const int nxt = it + nb_s;
        if (nxt < total) fetch(nxt, v0, v1);
        __syncthreads();
        { const int mat = it / per, r = it % per, k0 = (r / tn) * 64, n0 = (r % tn) * 64;
          unsigned short* d = dst + (size_t)mat * Npad * K;
          const int n = tid_ >> 3, c = tid_ & 7;
          *(uint4*)(d + (size_t)(n0 + n) * K + k0 + 8 * c) = make_uint4(TT[par][n][4 * c], TT[par][n][4 * c + 1], TT[par][n][4 * c + 2], TT[par][n][4 * c + 3]); }
        it = nxt; par ^= 1;
    }
    __syncthreads();
}
__device__ __forceinline__ void ph_c1(const float* pos, const float* w1, const float* b1, float* c1, float* smem) {
    LAUNDER();
    for (int o = bid_; o < 256; o += nb_s) {
        const int t = o >> 7, e = o & 127; float acc = 0.f;
#pragma unroll
        for (int j = 0; j < 4; ++j) { const int f = tid_ + 512 * j; acc += pos[t * 2048 + f] * w1[((size_t)t * 2048 + f) * 128 + e]; }
#pragma unroll
        for (int s = 32; s > 0; s >>= 1) acc += SHX(acc, s);
        if ((tid_ & 63) == 0) smem[tid_ >> 6] = acc;
        __syncthreads();
        if (tid_ == 0) { float s = b1[t * 128 + e]; for (int w = 0; w < 8; ++w) s += smem[w]; c1[o] = s; }
        __syncthreads();
    }
}
typedef short a_bf16x8 __attribute__((ext_vector_type(8)));
typedef float a_f32x16 __attribute__((ext_vector_type(16)));
typedef unsigned au32x4 __attribute__((ext_vector_type(4)));
typedef unsigned au32x2 __attribute__((ext_vector_type(2)));
static constexpr int AT_TB = 8192;
static constexpr int AT_KC = 0, AT_VC = 4 * AT_TB, AT_KS = 8 * AT_TB, AT_VS = 12 * AT_TB, AT_IMP = g8::STAGE_BYTES + 64  , AT_SELM = AT_IMP + 16384, AT_WM = AT_SELM + 512, AT_END = AT_WM + 64, AT_ONES = AT_END + 8;
static_assert(16 * AT_TB <= g8::STAGE_BYTES && AT_END + 16 <= g8::STAGE_BYTES + 64 + MX_END, "attention LDS map must fit");

__device__ __forceinline__ float xhalf_max(float v) { auto rr = __builtin_amdgcn_permlane32_swap(__float_as_uint(v), __float_as_uint(v), false, false); return fmaxf(__uint_as_float(rr[0]), __uint_as_float(rr[1])); }
__device__ __forceinline__ float xhalf_sum(float v) { auto rr = __builtin_amdgcn_permlane32_swap(__float_as_uint(v), __float_as_uint(v), false, false); return __uint_as_float(rr[0]) + __uint_as_float(rr[1]); }

__device__ __forceinline__ void at_dma1(LAS unsigned char* buf, const char* gb, unsigned go, int wid) {
    __builtin_amdgcn_global_load_lds((const unsigned*)(gb + go), (LAS unsigned*)(buf + wid * 1024), 16, 0, 0);
}
__device__ __forceinline__ void at_glds(LAS unsigned char* buf, const char* gb, unsigned go, int wid) {
    unsigned sv; const unsigned la = (unsigned)(unsigned long long)(buf + wid * 1024);
    asm volatile("s_mov_b32 %0, m0\n\ts_mov_b32 m0, %3\n\ts_nop 0\n\tglobal_load_lds_dwordx4 %1, %2\n\ts_mov_b32 m0, %0" : "=&s"(sv) : "v"(go), "s"(gb), "s"(la) : "memory");
}
__device__ __forceinline__ void at_dma(LAS unsigned char* kbuf, LAS unsigned char* vbuf, const char* kb, const char* vb, unsigned ko, unsigned vo, int wid) {
    at_dma1(kbuf, kb, ko, wid); at_dma1(vbuf, vb, vo, wid);
}
#define AT_SWZ(row, g) ((row) * 128 + ((((g) ^ (((row) >> 1) & 7))) << 4))
#define AT_REGOFF(i) (((i) & 3) + 8 * ((i) >> 2))
__device__ __forceinline__ void at_qk(LAS unsigned char* kbuf, const a_bf16x8 (&qf)[4], a_f32x16 (&st)[2], const int (&off4)[4], float base, float slk, int hh) {
    a_bf16x8 kf[2][4];
#pragma unroll
    for (int kt = 0; kt < 2; ++kt)
#pragma unroll
        for (int s = 0; s < 4; ++s) kf[kt][s] = *(const LAS a_bf16x8*)(kbuf + 4096 * kt + off4[s]);
    a_f32x16 a0, a1;
    const float b0 = base + slk * (float)(4 * hh), b1 = base + slk * (float)(32 + 4 * hh);
#pragma unroll
    for (int i = 0; i < 16; ++i) { a0[i] = b0 + slk * (float)AT_REGOFF(i); a1[i] = b1 + slk * (float)AT_REGOFF(i); }
    __builtin_amdgcn_sched_barrier(0);
    __builtin_amdgcn_s_setprio(1);
#pragma unroll
    for (int s = 0; s < 4; ++s) {
        a0 = __builtin_amdgcn_mfma_f32_32x32x16_bf16(kf[0][s], qf[s], a0, 0, 0, 0);
        a1 = __builtin_amdgcn_mfma_f32_32x32x16_bf16(kf[1][s], qf[s], a1, 0, 0, 0);
    }
    __builtin_amdgcn_s_setprio(0);
    st[0] = a0; st[1] = a1;
}
__device__ __forceinline__ void at_vload(LAS unsigned char* vbuf, a_bf16x8 (&vf)[2][4], const int (&off4)[4]) {
#pragma unroll
    for (int dt = 0; dt < 2; ++dt)
#pragma unroll
        for (int ks = 0; ks < 4; ++ks) vf[dt][ks] = *(const LAS a_bf16x8*)(vbuf + 4096 * dt + off4[ks]);
}
__device__ __forceinline__ void at_pack(const a_f32x16 (&p)[2], a_bf16x8 (&pb)[4]) {
#pragma unroll
    for (int kt = 0; kt < 2; ++kt)
#pragma unroll
        for (int s = 0; s < 2; ++s) {
            au32x4 pw = {pack_bf16(p[kt][8 * s + 0], p[kt][8 * s + 1]), pack_bf16(p[kt][8 * s + 2], p[kt][8 * s + 3]), pack_bf16(p[kt][8 * s + 4], p[kt][8 * s + 5]), pack_bf16(p[kt][8 * s + 6], p[kt][8 * s + 7])};
            pb[kt * 2 + s] = *reinterpret_cast<a_bf16x8*>(&pw); }
}
__device__ __forceinline__ void at_pv(const a_bf16x8 (&vf)[2][4], const a_bf16x8 (&pb)[4], a_f32x16 (&O)[2]) {
    __builtin_amdgcn_s_setprio(1);
#pragma unroll
    for (int ks = 0; ks < 4; ++ks) {
        O[0] = __builtin_amdgcn_mfma_f32_32x32x16_bf16(vf[0][ks], pb[ks], O[0], 0, 0, 0);
        O[1] = __builtin_amdgcn_mfma_f32_32x32x16_bf16(vf[1][ks], pb[ks], O[1], 0, 0, 0);
    }
    __builtin_amdgcn_s_setprio(0);
}
__device__ __forceinline__ void at_mask(a_f32x16 (&st)[2], int hh, int klo, int khi) {
    int d0 = 4 * hh - klo; unsigned span = (unsigned)(khi - klo); const bool any = khi >= klo;
    asm volatile("" : "+v"(d0)); asm volatile("" : "+v"(span));
#pragma unroll
    for (int kt = 0; kt < 2; ++kt)
#pragma unroll
        for (int i = 0; i < 16; ++i) { const bool ok = any && ((unsigned)(32 * kt + AT_REGOFF(i) + d0) <= span); st[kt][i] = ok ? st[kt][i] : -INFINITY; }
}
__device__ __forceinline__ float at_rowmax(const a_f32x16 (&st)[2]) {
    float mt = st[0][0];
#pragma unroll
    for (int i = 1; i < 16; ++i) mt = fmaxf(mt, st[0][i]);
#pragma unroll
    for (int i = 0; i < 16; ++i) mt = fmaxf(mt, st[1][i]);
    return xhalf_max(mt);
}
__device__ __forceinline__ void at_softmax_rel(a_f32x16 (&st)[2], float mref, bool first, float& m, float& l, a_f32x16 (&O)[2]) {
    const float mt = at_rowmax(st);
    float ps = 0.f;
    if (first || __any(mt > 6.f)) {
        float delta = first ? mt : fmaxf(mt, 0.f); delta = (delta == -INFINITY) ? 0.f : delta;
#pragma unroll
        for (int kt = 0; kt < 2; ++kt)
#pragma unroll
            for (int i = 0; i < 16; ++i) { const float pv = __builtin_amdgcn_exp2f(st[kt][i] - delta); st[kt][i] = pv; ps += pv; }
        const float alpha = first ? 0.f : __builtin_amdgcn_exp2f(-delta);
        l = l * alpha + ps; m = mref + delta;
#pragma unroll
        for (int dt = 0; dt < 2; ++dt)
#pragma unroll
            for (int i = 0; i < 16; ++i) O[dt][i] *= alpha;
    } else {
#pragma unroll
        for (int kt = 0; kt < 2; ++kt)
#pragma unroll
            for (int i = 0; i < 16; ++i) { const float pv = __builtin_amdgcn_exp2f(st[kt][i]); st[kt][i] = pv; ps += pv; }
        l += ps;
    }
}

__device__ __forceinline__ void at_mask2(a_f32x16& s0, a_f32x16& s1, int hh, int klo, int khi) {
    const bool any = khi >= klo;
    int d0 = any ? 4 * hh - klo : 0x40000000; unsigned span = any ? (unsigned)(khi - klo) : 0u;
    asm volatile("" : "+v"(d0)); asm volatile("" : "+v"(span));
#pragma unroll
    for (int i = 0; i < 16; ++i) {
        s0[i] = ((unsigned)(AT_REGOFF(i) + d0) <= span) ? s0[i] : -INFINITY;
        s1[i] = ((unsigned)(32 + AT_REGOFF(i) + d0) <= span) ? s1[i] : -INFINITY; }
}
#define AT_MX3(a, b, c) __builtin_fmaxf(__builtin_fmaxf((a), (b)), (c))
__device__ __forceinline__ float at_rowmax2(const a_f32x16& p0, const a_f32x16& p1) {
    float a = AT_MX3(p0[0], p0[1], p1[0]), b = AT_MX3(p0[2], p0[3], p1[1]); a = AT_MX3(a, p1[2], p1[3]);
#pragma unroll
    for (int r = 4; r < 16; r += 4) { a = AT_MX3(a, p0[r], p0[r + 1]); b = AT_MX3(b, p0[r + 2], p0[r + 3]); a = AT_MX3(a, p1[r], p1[r + 1]); b = AT_MX3(b, p1[r + 2], p1[r + 3]); }
    return xhalf_max(__builtin_fmaxf(a, b));
}

__device__ __forceinline__ void ph_nsa_attn_mfma(const unsigned short* qb, const float* gates, const unsigned short* kcmp, const unsigned short* vcmpT,
                                                 const unsigned short* kslc, const unsigned short* vslcT, const unsigned short* kwin, const unsigned short* vwinT,
                                                 unsigned short* ob, int* qcnt, LAS unsigned char* lds) {
    LAUNDER();
    const int wid = wv_s;
    constexpr float LOG2E = 1.4426950408889634f;
    int lane, r, hh, hp, ql, tl = 0, tq = 0, tqh = 0; unsigned ko, voS; int off4[4]; float sl = 0.f;
#define AT_DERIVE(q0_, g_) do { asm volatile("v_mbcnt_lo_u32_b32 %0, -1, 0\n\tv_mbcnt_hi_u32_b32 %0, -1, %0" : "=v"(lane)); r = lane & 31; hh = lane >> 5; hp = r >> 3; ql = r & 7; \
        const int drow_ = 8 * wid + (lane >> 3), dgc_ = (lane & 7) ^ ((drow_ >> 1) & 7); ko = (unsigned)(drow_ * 128 + dgc_ * 16); voS = (unsigned)(drow_ * SEQ * 2 + dgc_ * 16); \
        _Pragma("unroll") for (int s_ = 0; s_ < 4; ++s_) off4[s_] = r * 128 + ((((2 * s_ + hh) ^ ((r >> 1) & 7))) << 4); \
        tl = wid * 8 + ql; tq = (q0_) + tl; tqh = tq - 4 * hh; sl = exp2f(-0.5f * (float)((g_) * 4 + hp + 1)) * LOG2E; } while (0)
    LAS int* qslot = (LAS int*)(lds + AT_END);
    const bool dyn = nb_s == 256;
    int kq = 0, I = bid_, it = 0;
    if (tid_ == 0) { qslot[2] = ~0; qslot[3] = ~0; }
    if (dyn) { if (tid_ == 0) qslot[0] = atomicAdd(qcnt + (bid_ & 7), 1); }
    __syncthreads();
    if (dyn) kq = qslot[0];
    for (;;) {
        if (dyn ? kq >= 256 : I >= 2048) break;
        int knext = 0;
        int lane0; asm volatile("v_mbcnt_lo_u32_b32 %0, -1, 0\n\tv_mbcnt_hi_u32_b32 %0, -1, %0" : "=v"(lane0));
        if (dyn && wid == 0 && lane0 == 0) knext = atomicAdd(qcnt + (bid_ & 7), 1);
        int qi = 63 - (I >> 5), bg = I & 31;
        if (dyn) { bg = (bid_ & 7) + 8 * (kq >> 6); qi = 63 - (kq & 63); }
        const int b = bg >> 2, g = bg & 3, q0 = qi * 64, cur = qi;
        AT_DERIVE(q0, g);
        const int hd = g * 4 + hp;
        const unsigned voC = (unsigned)((8 * wid + (lane >> 3)) * 512 + ((lane & 7) ^ (((8 * wid + (lane >> 3)) >> 1) & 7)) * 16);
        a_bf16x8 qf[4];
#pragma unroll
        for (int s = 0; s < 4; ++s) qf[s] = *(const a_bf16x8*)(qb + (size_t)(b * SEQ + tq) * 1024 + hd * 64 + 16 * s + 8 * hh);
        const float* gp = gates + (size_t)(b * SEQ + tq) * 48 + hd;
        const float gc = gp[0], gs = gp[16], gw = gp[32];
        a_f32x16 Ot[2];
#pragma unroll
        for (int dt = 0; dt < 2; ++dt)
#pragma unroll
            for (int i = 0; i < 16; ++i) Ot[dt][i] = 0.f;
        const int nlast_blk = (q0 + 63 >= 31) ? min(254, (q0 + 63 - 31) >> 4) : -1;
        const int ntc = nlast_blk >= 0 ? (nlast_blk >> 6) + 1 : 0;
        const int nlast = (tq >= 31) ? min(254, (tq - 31) >> 4) : -1;
        for (int T = 0; T < ntc; ++T) at_dma(lds + AT_KC + T * AT_TB, lds + AT_VC + T * AT_TB, (const char*)(kcmp + ((size_t)bg * 256 + 64 * T) * 64), (const char*)(vcmpT + (size_t)bg * 64 * 256 + 64 * T), ko, voC, wid);
        { LAS float* imp = (LAS float*)(lds + AT_IMP) + wid * 512;
#pragma unroll
          for (int i = 0; i < 8; ++i) imp[lane + 64 * i] = 0.f; }
        unsigned long long ptodo = (cur >= 8 ? (0x1FFull << (cur - 8)) : ((1ull << (cur + 1)) - 1ull));
        int pn = __builtin_popcountll(ptodo), pj0 = 0, pj1 = 0, pj2 = 0;
        {
            const char* kbw = (const char*)(kwin + (size_t)bg * SEQ * 64); const char* vbw = (const char*)(vwinT + (size_t)bg * 64 * SEQ);
            pj0 = 63 - __builtin_clzll(ptodo); ptodo &= ~(1ull << pj0);
            at_glds(lds + AT_KS, kbw + (size_t)pj0 * 8192, ko, wid); at_glds(lds + AT_VS, vbw + (size_t)pj0 * 128, voS, wid);
            if (pn > 1) { pj1 = 63 - __builtin_clzll(ptodo); ptodo &= ~(1ull << pj1); at_glds(lds + AT_KS + AT_TB, kbw + (size_t)pj1 * 8192, ko, wid); }
            if (pn > 2) { pj2 = 63 - __builtin_clzll(ptodo); ptodo &= ~(1ull << pj2); at_glds(lds + AT_KS + 2 * AT_TB, kbw + (size_t)pj2 * 8192, ko, wid); }
        }
        if (pn > 2) { asm volatile("s_waitcnt vmcnt(4)" ::: "memory"); } else if (pn > 1) { asm volatile("s_waitcnt vmcnt(3)" ::: "memory"); } else { asm volatile("s_waitcnt vmcnt(2)" ::: "memory"); }
        __syncthreads();
        {
            float m = -INFINITY, l = 0.f;
            a_f32x16 st[2], Oc[2];
#pragma unroll
            for (int dt = 0; dt < 2; ++dt)
#pragma unroll
                for (int i = 0; i < 16; ++i) Oc[dt][i] = 0.f;
            for (int T = 0; T < ntc; ++T) {
                at_qk(lds + AT_KC + T * AT_TB, qf, st, off4, sl * (float)(1024 * T + 31 - tq), sl * 16.f, hh);
                at_mask(st, hh, 0, nlast - 64 * T);
                const float mt = at_rowmax(st);
                const float mn = fmaxf(m, mt), ms = (mn == -INFINITY) ? 0.f : mn;
                float ps = 0.f;
#pragma unroll
                for (int kt = 0; kt < 2; ++kt)
#pragma unroll
                    for (int i = 0; i < 16; ++i) ps += __builtin_amdgcn_exp2f(st[kt][i] - ms);
                l = l * __builtin_amdgcn_exp2f(m - ms) + ps; m = mn;
            }
            l = xhalf_sum(l);
            const float ms = (m == -INFINITY) ? 0.f : m, inv = l > 0.f ? 1.f / l : 0.f;
            LAS float* imp = (LAS float*)(lds + AT_IMP) + wid * 512 + ql * 64;
            for (int T = 0; T < ntc; ++T) {
                at_qk(lds + AT_KC + T * AT_TB, qf, st, off4, sl * (float)(1024 * T + 31 - tq) - ms, sl * 16.f, hh);
                at_mask(st, hh, 0, nlast - 64 * T);
#pragma unroll
                for (int kt = 0; kt < 2; ++kt)
#pragma unroll
                    for (int i = 0; i < 16; ++i) st[kt][i] = __builtin_amdgcn_exp2f(st[kt][i]) * inv;
#pragma unroll
                for (int kt = 0; kt < 2; ++kt)
#pragma unroll
                    for (int c = 0; c < 4; ++c) {
                        float qs = (st[kt][4 * c] + st[kt][4 * c + 1]) + (st[kt][4 * c + 2] + st[kt][4 * c + 3]), ls = st[kt][4 * c + 3];
                        qs += SHX(qs, 8); qs += SHX(qs, 16); ls += SHX(ls, 8); ls += SHX(ls, 16);
                        const int j = 16 * T + 8 * kt + 2 * c + hh;
                        if (hp == 0) { (void)__hip_atomic_fetch_add(imp + j, qs, __ATOMIC_RELAXED, __HIP_MEMORY_SCOPE_WORKGROUP); if (j < 63) (void)__hip_atomic_fetch_add(imp + j + 1, ls, __ATOMIC_RELAXED, __HIP_MEMORY_SCOPE_WORKGROUP); }
                    }
                { a_bf16x8 vf[2][4], pb[4]; at_pack(st, pb); at_vload(lds + AT_VC + T * AT_TB, vf, off4); at_pv(vf, pb, Oc); }
            }
#pragma unroll
            for (int dt = 0; dt < 2; ++dt)
#pragma unroll
                for (int i = 0; i < 16; ++i) Ot[dt][i] = gc * Oc[dt][i];
        }
        unsigned long long wor = 0ull;
        asm volatile("s_waitcnt lgkmcnt(0)" ::: "memory"); __builtin_amdgcn_wave_barrier();
        {
            const bool valid = lane <= cur, forced = (lane == 0) || (lane == cur) || (lane == cur - 1);
            const unsigned long long vmask = __ballot(valid);
            if (cur < 16) {
                if (lane == 0) {
#pragma unroll
                    for (int q = 0; q < 8; ++q) ((LAS unsigned long long*)(lds + AT_SELM))[wid * 8 + q] = vmask; }
                wor = vmask;
            } else {
                for (int q = 0; q < 8; q += 4) {
                    unsigned key[4], T[4];
#pragma unroll
                    for (int c = 0; c < 4; ++c) {
                        const float s = ((LAS float*)(lds + AT_IMP))[wid * 512 + (q + c) * 64 + lane];
                        const float sc = valid ? (forced ? 1e30f : s) : -1e30f;
                        const unsigned ub = __float_as_uint(sc); key[c] = (ub & 0x80000000u) ? ~ub : (ub | 0x80000000u); T[c] = 0u; }
#pragma unroll 1
                    for (int bit = 31; bit >= 0; --bit) {
#pragma unroll
                        for (int c = 0; c < 4; ++c) { const unsigned cand = T[c] | (1u << bit); if (__builtin_popcountll(__ballot(key[c] >= cand)) >= 16) T[c] = cand; } }
#pragma unroll
                    for (int c = 0; c < 4; ++c) {
                        unsigned long long selm = __ballot(key[c] > T[c]), eq = __ballot(key[c] == T[c]);
                        int need = 16 - __builtin_popcountll(selm);
                        for (; need > 0; --need) { const unsigned long long low = eq & (0ull - eq); selm |= low; eq ^= low; }
                        const unsigned long long mk = selm & vmask;
                        if (lane == 0) ((LAS unsigned long long*)(lds + AT_SELM))[wid * 8 + q + c] = mk;
                        wor |= mk; }
                }
            }
            if (lane == 0) ((LAS unsigned long long*)(lds + AT_WM))[wid] = wor;
        }
        __syncthreads();
        unsigned long long U = 0ull;
#pragma unroll
        for (int w = 0; w < 8; ++w) U |= ((LAS unsigned long long*)(lds + AT_WM))[w];
        U = ((unsigned long long)__builtin_amdgcn_readfirstlane((unsigned)(U >> 32)) << 32) | (unsigned long long)__builtin_amdgcn_readfirstlane((unsigned)U);
        { LAS float* gl = (LAS float*)(lds + AT_IMP) + wid * 128 + lane; gl[0] = gs; gl[64] = gw; if (dyn && wid == 0 && lane == 0) qslot[1] = knext; }
        AT_DERIVE(q0, g);
#define AT_OTP(v_) LAS float* v_; { int lx_; asm volatile("v_mbcnt_lo_u32_b32 %0, -1, 0\n\tv_mbcnt_hi_u32_b32 %0, -1, %0" : "=v"(lx_)); v_ = (LAS float*)(lds + AT_KC) + wid * 2048 + lx_ * 4; }
        { AT_OTP(otp);
#pragma unroll
        for (int c = 0; c < 8; ++c) *(LAS g8::f32x4*)(otp + c * 256) = g8::f32x4{Ot[c >> 2][4 * (c & 3)], Ot[c >> 2][4 * (c & 3) + 1], Ot[c >> 2][4 * (c & 3) + 2], Ot[c >> 2][4 * (c & 3) + 3]}; }
#define AT_SB() __builtin_amdgcn_sched_barrier(0)
#define AT_PIN(x) asm volatile("" : "+v"(x))
#define AT_MF(a, b, c) __builtin_amdgcn_mfma_f32_32x32x16_bf16(a, b, c, 0, 0, 0)
#define AT_WAIT_BAR(N) asm volatile("s_waitcnt vmcnt(" #N ") lgkmcnt(0)\n\ts_barrier" ::: "memory")
#define AT_KF(i) ((float)AT_REGOFF(i))
#define AT_PB(w) (*reinterpret_cast<a_bf16x8*>(&(w)))
#define AT_PK(P, i) pack_bf16(P[i], P[(i) + 1])
        for (int bi = 0; bi < 2; ++bi) {
            const int br = 1 - bi;
            const char* kbase = (const char*)((br == 0 ? kslc : kwin) + (size_t)bg * SEQ * 64);
            const char* vbase = (const char*)((br == 0 ? vslcT : vwinT) + (size_t)bg * 64 * SEQ);
            unsigned long long todo = ptodo;
            const int n = pn;
            const LAS unsigned* selp = (const LAS unsigned*)(lds + (br == 0 ? AT_SELM : AT_ONES)) + (br == 0 ? (wid * 8 + ql) * 2 : 0);
            float m = 0.f, l = 0.f, f_ = 1.f; bool resc_ = false;
            a_f32x16 O0, O1, pA0, pA1, pB0, pB1;
#pragma unroll
            for (int i = 0; i < 16; ++i) { O0[i] = 0.f; O1[i] = 0.f; }
            a_bf16x8 kf[8], vf[8]; au32x4 pw0, pw1, pw2, pw3;
            int sl_prev = 0, sl_cur = 0, sl_next = AT_TB;
#define AT_ROT() do { sl_prev = sl_cur; sl_cur = sl_next; sl_next = (sl_next == 2 * AT_TB) ? 0 : sl_next + AT_TB; } while (0)
#define AT_DMAK(jj, so) at_glds(lds + AT_KS + (so), kbase + (size_t)(jj) * 8192, ko, wid)
#define AT_DMAV(jj, so) at_glds(lds + AT_VS + (so), vbase + (size_t)(jj) * 128, voS, wid)
#define AT_POP(jv) do { jv = 63 - __builtin_clzll(todo); todo &= ~(1ull << jv); } while (0)
#define AT_BIAS(jj) ((((selp[(jj) >> 5] >> ((jj) & 31)) & 1u) != 0u) ? (sl * (float)(64 * (jj) - tqh) - m) : -INFINITY)
#define AT_KRD(s) do { kf[2 * (s)] = *(const LAS a_bf16x8*)(kb_ + off4[s]); kf[2 * (s) + 1] = *(const LAS a_bf16x8*)(kb_ + 4096 + off4[s]); } while (0)
#define AT_VRD(i) do { vf[i] = *(const LAS a_bf16x8*)(vp_ + 4096 * ((i) >> 2) + off4[(i) & 3]); } while (0)
            int q1 = pj0, q2 = pj1, q3 = pj2, jnew = 0;
            if (bi == 1) { AT_DMAV(q1, 0); AT_WAIT_BAR(1); } else { AT_WAIT_BAR(0); }
            {
                LAS unsigned char* kb_ = lds + AT_KS;
#pragma unroll
                for (int s = 0; s < 4; ++s) AT_KRD(s);
                const float b = AT_BIAS(q1); float slo = sl; AT_PIN(slo);
#pragma unroll
                for (int i = 0; i < 16; ++i) { pA0[i] = __builtin_fmaf(slo, AT_KF(i), b); pA1[i] = __builtin_fmaf(slo, AT_KF(i) + 32.f, b); }
#pragma unroll
                for (int s = 0; s < 4; ++s) { pA0 = AT_MF(kf[2 * s], qf[s], pA0); pA1 = AT_MF(kf[2 * s + 1], qf[s], pA1); }
                if (q1 == cur || (br == 1 && q1 == cur - 8)) { int lx_; asm volatile("v_mbcnt_lo_u32_b32 %0, -1, 0\n\tv_mbcnt_hi_u32_b32 %0, -1, %0" : "=v"(lx_)); const int tlx_ = wid * 8 + (lx_ & 7);
                    if (q1 == cur) at_mask2(pA0, pA1, lx_ >> 5, 0, tlx_); else at_mask2(pA0, pA1, lx_ >> 5, tlx_ + 1, 63); }
                const float rm = at_rowmax2(pA0, pA1), d = (rm == -INFINITY) ? 0.f : rm; m = d;
#pragma unroll
                for (int i = 0; i < 16; ++i) { pA0[i] = __builtin_amdgcn_exp2f(pA0[i] - d); pA1[i] = __builtin_amdgcn_exp2f(pA1[i] - d); }
            }
            AT_WAIT_BAR(0);
            q1 = q2; q2 = q3; q3 = 0;
            if (n > 3) { AT_POP(q3); AT_DMAK(q3, 0); }
            if (n > 1) AT_DMAV(q1, AT_TB);
            AT_ROT();
            {
                LAS unsigned char* kb_ = lds + AT_KS + sl_cur;
#pragma unroll
                for (int s = 0; s < 4; ++s) AT_KRD(s);
                const float b = AT_BIAS(q1); float slo = sl; AT_PIN(slo);
#pragma unroll
                for (int i = 0; i < 16; ++i) { pB0[i] = __builtin_fmaf(slo, AT_KF(i), b); pB1[i] = __builtin_fmaf(slo, AT_KF(i) + 32.f, b); }
            }
            if (n > 3) { AT_WAIT_BAR(2); } else if (n > 1) { AT_WAIT_BAR(1); } else { AT_WAIT_BAR(0); }
#define AT_GAPA(MF_, a0, a1, a2, a3, W0, W1, PW) do { MF_; sacc += a0; sacc += a1; sacc += a2; sacc += a3; W0; W1; AT_PIN(PW); AT_PIN(sacc); AT_SB(); } while (0)
#define AT_GAPB(MF_, X, i, Y, KO) do { MF_; X[i] = __builtin_amdgcn_exp2f(X[i]); X[(i) + 1] = __builtin_amdgcn_exp2f(X[(i) + 1]); X[(i) + 2] = __builtin_amdgcn_exp2f(X[(i) + 2]); X[(i) + 3] = __builtin_amdgcn_exp2f(X[(i) + 3]); \
        Y[i] = __builtin_fmaf(slo, AT_KF(i) + KO, bn); Y[(i) + 1] = __builtin_fmaf(slo, AT_KF((i) + 1) + KO, bn); Y[(i) + 2] = __builtin_fmaf(slo, AT_KF((i) + 2) + KO, bn); Y[(i) + 3] = __builtin_fmaf(slo, AT_KF((i) + 3) + KO, bn); \
        AT_PIN(X); AT_PIN(Y); AT_SB(); } while (0)
#define AT_STEP(C0, C1, P0, P1, t, ST) do { AT_SB(); \
            const unsigned selw_ = selp[q2 >> 5];                                  \
            { LAS unsigned char* vp_ = lds + AT_VS + sl_prev; \
              AT_VRD(0); AT_SB(); float sacc = P0[0] + P0[1]; \
                                  AT_GAPA(C0 = AT_MF(kf[0], qf[0], C0), P0[2], P0[3], P0[4], P0[5],     pw0[0] = AT_PK(P0, 0),  pw0[1] = AT_PK(P0, 2),  pw0); \
              AT_VRD(4); AT_SB(); AT_GAPA(C1 = AT_MF(kf[1], qf[0], C1), P0[6], P0[7], P0[8], P0[9],     pw0[2] = AT_PK(P0, 4),  pw0[3] = AT_PK(P0, 6),  pw0); \
              AT_VRD(1); AT_SB(); AT_GAPA(C0 = AT_MF(kf[2], qf[1], C0), P0[10], P0[11], P0[12], P0[13], pw1[0] = AT_PK(P0, 8),  pw1[1] = AT_PK(P0, 10), pw1); \
              AT_VRD(5); AT_SB(); AT_GAPA(C1 = AT_MF(kf[3], qf[1], C1), P0[14], P0[15], P1[0], P1[1],   pw1[2] = AT_PK(P0, 12), pw1[3] = AT_PK(P0, 14), pw1); \
              AT_VRD(2); AT_SB(); AT_GAPA(C0 = AT_MF(kf[4], qf[2], C0), P1[2], P1[3], P1[4], P1[5],     pw2[0] = AT_PK(P1, 0),  pw2[1] = AT_PK(P1, 2),  pw2); \
              AT_VRD(6); AT_SB(); AT_GAPA(C1 = AT_MF(kf[5], qf[2], C1), P1[6], P1[7], P1[8], P1[9],     pw2[2] = AT_PK(P1, 4),  pw2[3] = AT_PK(P1, 6),  pw2); \
              AT_VRD(3); AT_SB(); AT_GAPA(C0 = AT_MF(kf[6], qf[3], C0), P1[10], P1[11], P1[12], P1[13], pw3[0] = AT_PK(P1, 8),  pw3[1] = AT_PK(P1, 10), pw3); \
              AT_VRD(7); AT_SB(); AT_GAPA(C1 = AT_MF(kf[7], qf[3], C1), P1[14], P1[15], 0.f, 0.f,       pw3[2] = AT_PK(P1, 12), pw3[3] = AT_PK(P1, 14), pw3); \
              l += sacc; } \
            jnew = 0; \
            if (ST || (t) + 3 < n) { AT_POP(jnew); AT_DMAK(jnew, sl_cur); }              \
            if (ST || (t) + 1 < n) AT_DMAV(q2, sl_next); \
            if (q1 == cur || (br == 1 && q1 == cur - 8)) { int lx_; asm volatile("v_mbcnt_lo_u32_b32 %0, -1, 0\n\tv_mbcnt_hi_u32_b32 %0, -1, %0" : "=v"(lx_)); const int tlx_ = wid * 8 + (lx_ & 7); \
                if (q1 == cur) at_mask2(C0, C1, lx_ >> 5, 0, tlx_); else at_mask2(C0, C1, lx_ >> 5, tlx_ + 1, 63); } \
            resc_ = false; \
            { const float rm = at_rowmax2(C0, C1); \
              if (__any(rm > 6.f)) { const float dl = fmaxf(rm, 0.f); m += dl; f_ = __builtin_amdgcn_exp2f(-dl); l *= f_; resc_ = true; \
                  _Pragma("unroll") for (int i_ = 0; i_ < 16; ++i_) { C0[i_] -= dl; C1[i_] -= dl; } } } \
            { const float bn = (((selw_ >> (q2 & 31)) & 1u) != 0u) ? (sl * (float)(64 * q2 - tqh) - m) : -INFINITY; float slo = sl; AT_PIN(slo); LAS unsigned char* kb_ = lds + AT_KS + sl_next; AT_SB(); \
              AT_GAPB(O0 = AT_MF(vf[0], AT_PB(pw0), O0), C0, 0, P0, 0.f);                              AT_GAPB(O1 = AT_MF(vf[4], AT_PB(pw0), O1), C0, 4, P0, 0.f); \
              AT_KRD(0); AT_SB(); AT_GAPB(O0 = AT_MF(vf[1], AT_PB(pw1), O0), C0, 8, P0, 0.f);          AT_KRD(1); AT_SB(); AT_GAPB(O1 = AT_MF(vf[5], AT_PB(pw1), O1), C0, 12, P0, 0.f); \
              AT_KRD(2); AT_SB(); AT_GAPB(O0 = AT_MF(vf[2], AT_PB(pw2), O0), C1, 0, P1, 32.f);         AT_KRD(3); AT_SB(); AT_GAPB(O1 = AT_MF(vf[6], AT_PB(pw2), O1), C1, 4, P1, 32.f); \
              AT_GAPB(O0 = AT_MF(vf[3], AT_PB(pw3), O0), C1, 8, P1, 32.f);                             AT_GAPB(O1 = AT_MF(vf[7], AT_PB(pw3), O1), C1, 12, P1, 32.f); } \
            if (ST || (t) + 3 < n) { AT_WAIT_BAR(2); } else if ((t) + 2 < n) { AT_WAIT_BAR(1); } else { AT_WAIT_BAR(0); } \
            if (resc_) { _Pragma("unroll") for (int i_ = 0; i_ < 16; ++i_) { O0[i_] *= f_; O1[i_] *= f_; } } \
            AT_ROT(); q1 = q2; q2 = q3; q3 = jnew; \
            } while (0)
            int t = 1;
            for (; t + 4 < n; t += 2) {
                AT_STEP(pB0, pB1, pA0, pA1, t, 1);
                AT_STEP(pA0, pA1, pB0, pB1, t + 1, 1);
            }
            for (; t + 1 < n; t += 2) {
                AT_STEP(pB0, pB1, pA0, pA1, t, 0);
                AT_STEP(pA0, pA1, pB0, pB1, t + 1, 0);
            }
            if (t < n) { AT_STEP(pB0, pB1, pA0, pA1, t, 0); pA0 = pB0; pA1 = pB1; }
            if (bi == 0) {
                const char* kbs = (const char*)(kslc + (size_t)bg * SEQ * 64);
                ptodo = U; pn = __builtin_popcountll(U); pj1 = 0; pj2 = 0;
                pj0 = 63 - __builtin_clzll(ptodo); ptodo &= ~(1ull << pj0); at_glds(lds + AT_KS, kbs + (size_t)pj0 * 8192, ko, wid);
                if (pn > 1) { pj1 = 63 - __builtin_clzll(ptodo); ptodo &= ~(1ull << pj1); at_glds(lds + AT_KS + AT_TB, kbs + (size_t)pj1 * 8192, ko, wid); }
                if (pn > 2) { pj2 = 63 - __builtin_clzll(ptodo); ptodo &= ~(1ull << pj2); at_glds(lds + AT_KS + 2 * AT_TB, kbs + (size_t)pj2 * 8192, ko, wid); }
            }
            {
                float sacc = 0.f;
#pragma unroll
                for (int i = 0; i < 16; ++i) sacc += pA0[i] + pA1[i];
                l += sacc;
                pw0 = au32x4{AT_PK(pA0, 0), AT_PK(pA0, 2), AT_PK(pA0, 4), AT_PK(pA0, 6)}; pw1 = au32x4{AT_PK(pA0, 8), AT_PK(pA0, 10), AT_PK(pA0, 12), AT_PK(pA0, 14)};
                pw2 = au32x4{AT_PK(pA1, 0), AT_PK(pA1, 2), AT_PK(pA1, 4), AT_PK(pA1, 6)}; pw3 = au32x4{AT_PK(pA1, 8), AT_PK(pA1, 10), AT_PK(pA1, 12), AT_PK(pA1, 14)};
                LAS unsigned char* vp_ = lds + AT_VS + sl_prev;
#pragma unroll
                for (int i = 0; i < 8; ++i) AT_VRD(i);
                O0 = AT_MF(vf[0], AT_PB(pw0), O0); O1 = AT_MF(vf[4], AT_PB(pw0), O1); O0 = AT_MF(vf[1], AT_PB(pw1), O0); O1 = AT_MF(vf[5], AT_PB(pw1), O1);
                O0 = AT_MF(vf[2], AT_PB(pw2), O0); O1 = AT_MF(vf[6], AT_PB(pw2), O1); O0 = AT_MF(vf[3], AT_PB(pw3), O0); O1 = AT_MF(vf[7], AT_PB(pw3), O1);
            }
            l = xhalf_sum(l);
            int lb_; asm volatile("v_mbcnt_lo_u32_b32 %0, -1, 0\n\tv_mbcnt_hi_u32_b32 %0, -1, %0" : "=v"(lb_));
            const float gsc = ((LAS float*)(lds + AT_IMP))[wid * 128 + lb_ + 64 * br] / l;
            AT_OTP(otp);
#pragma unroll
            for (int c = 0; c < 8; ++c) {
                g8::f32x4 v = *(LAS g8::f32x4*)(otp + c * 256);
                if (c < 4) { v[0] += gsc * O0[4 * c]; v[1] += gsc * O0[4 * c + 1]; v[2] += gsc * O0[4 * c + 2]; v[3] += gsc * O0[4 * c + 3]; }
                else { v[0] += gsc * O1[4 * (c - 4)]; v[1] += gsc * O1[4 * (c - 4) + 1]; v[2] += gsc * O1[4 * (c - 4) + 2]; v[3] += gsc * O1[4 * (c - 4) + 3]; }
                *(LAS g8::f32x4*)(otp + c * 256) = v;
            }
            asm volatile("s_waitcnt lgkmcnt(0)\n\ts_barrier" ::: "memory");
        }
#undef AT_STEP
#undef AT_GAPA
#undef AT_GAPB
#undef AT_ROT
#undef AT_DMAK
#undef AT_DMAV
#undef AT_POP
#undef AT_BIAS
#undef AT_KRD
#undef AT_VRD
        AT_OTP(otp);
#pragma unroll
        for (int c = 0; c < 8; ++c) { const g8::f32x4 v = *(LAS g8::f32x4*)(otp + c * 256); Ot[c >> 2][4 * (c & 3)] = v[0]; Ot[c >> 2][4 * (c & 3) + 1] = v[1]; Ot[c >> 2][4 * (c & 3) + 2] = v[2]; Ot[c >> 2][4 * (c & 3) + 3] = v[3]; }
        int l2; asm volatile("v_mbcnt_lo_u32_b32 %0, -1, 0\n\tv_mbcnt_hi_u32_b32 %0, -1, %0" : "=v"(l2));
        const int r2 = l2 & 31;
        unsigned short* orow = ob + (size_t)(b * SEQ + q0 + wid * 8 + (r2 & 7)) * 1024 + (g * 4 + (r2 >> 3)) * 64 + 8 * (l2 >> 5);
#pragma unroll
        for (int dt = 0; dt < 2; ++dt)
#pragma unroll
            for (int c = 0; c < 4; c += 2) {
                unsigned ax = pack_bf16(Ot[dt][4 * c], Ot[dt][4 * c + 1]), ay = pack_bf16(Ot[dt][4 * c + 2], Ot[dt][4 * c + 3]);
                unsigned bx = pack_bf16(Ot[dt][4 * c + 4], Ot[dt][4 * c + 5]), by = pack_bf16(Ot[dt][4 * c + 6], Ot[dt][4 * c + 7]);
                const auto rx = __builtin_amdgcn_permlane32_swap(ax, bx, false, false); const auto ry = __builtin_amdgcn_permlane32_swap(ay, by, false, false);
                *(uint4*)(orow + 32 * dt + 8 * c) = make_uint4(rx[0], ry[0], rx[1], ry[1]); }
        asm volatile("s_waitcnt lgkmcnt(0)\n\ts_barrier" ::: "memory");
        if (dyn) kq = qslot[1]; else { I += nb_s; ++it; }
    }
}
__device__ __forceinline__ float bf2f(unsigned short v) { return __uint_as_float(((unsigned)v) << 16); }
__device__ __forceinline__ void ph_gla_p1(const unsigned short* qk, const float* glr, const unsigned short* vT, const float* w2, const float* bgate,
                                          unsigned short* qd, unsigned short* ki, float* dl, unsigned short* UT, LAS unsigned char* lds) {
    LAUNDER();
    const int wid = wv_s, lane = tid_ & 63, r = lane & 31, hh = lane >> 5;
    LAS float* gsum = (LAS float*)lds;
    LAS float* gl = (LAS float*)(lds + 2048);
    LAS unsigned char* ket = lds + 2048 + 4096;
    const int d = tid_ & 127, sg = tid_ >> 7;
    float glp0 = 0.f, glp1 = 0.f, wp[16], bgp = 0.f;
    if (bid_ < 2048) { const int h = bid_ & 3, c = (bid_ >> 2) & 63, b = bid_ >> 8, tok0 = b * SEQ + c * 64;
        glp0 = glr[(size_t)tok0 * 16 + tid_]; glp1 = glr[(size_t)tok0 * 16 + tid_ + 512];
#pragma unroll
        for (int k = 0; k < 16; ++k) wp[k] = w2[k * 512 + h * 128 + d];
        bgp = bgate[h * 128 + d]; }
    for (int it = bid_; it < 2048; it += nb_s) {
        const int h = it & 3, c = (it >> 2) & 63, b = it >> 8, bh = b * 4 + h, tok0 = b * SEQ + c * 64;
        a_bf16x8 vfr[4];
        { const unsigned short* vrow = vT + ((size_t)bh * 256 + 32 * wid + r) * SEQ + c * 64;
#pragma unroll
          for (int ks = 0; ks < 4; ++ks) vfr[ks] = *(const a_bf16x8*)(vrow + 16 * ks + 8 * hh); }
        unsigned short qraw[16], kraw[16];
#pragma unroll
        for (int i = 0; i < 16; ++i) { const size_t o = (size_t)(tok0 + sg * 16 + i) * 1024 + h * 128 + d; qraw[i] = qk[o]; kraw[i] = qk[o + 512]; }
        gl[tid_] = glp0; gl[tid_ + 512] = glp1;
        float w[16];
#pragma unroll
        for (int k = 0; k < 16; ++k) w[k] = wp[k];
        const float bgv = bgp;
        { const int itn = it + nb_s;
          if (itn < 2048) { const int hn = itn & 3, cn = (itn >> 2) & 63, bn = itn >> 8, tokn = bn * SEQ + cn * 64;
              glp0 = glr[(size_t)tokn * 16 + tid_]; glp1 = glr[(size_t)tokn * 16 + tid_ + 512];
#pragma unroll
              for (int k = 0; k < 16; ++k) wp[k] = w2[k * 512 + hn * 128 + d];
              bgp = bgate[hn * 128 + d]; } }
        __syncthreads();
        float la[16]; float run = 0.f;
#pragma unroll
        for (int i = 0; i < 16; ++i) { const int s = sg * 16 + i; float z = bgv;
#pragma unroll
            for (int k = 0; k < 16; ++k) z += gl[s * 16 + k] * w[k];
            run += fast_logsigmoid(z) * (1.f / 16.f); la[i] = run; }
        gsum[sg * 128 + d] = run;
        __syncthreads();
        float pre = 0.f, tot = 0.f;
#pragma unroll
        for (int g = 0; g < 4; ++g) { const float v = gsum[g * 128 + d]; tot += v; pre += (g < sg) ? v : 0.f; }
        const float etot = fast_exp(tot);
#pragma unroll
        for (int i = 0; i < 16; ++i) { const int s = sg * 16 + i; const float bb = la[i] + pre;
            const float q = bf2f(qraw[i]), k = bf2f(kraw[i]);
            const float eb = fast_exp(bb), ieb = __builtin_amdgcn_rcpf(eb);
            qd[(size_t)(tok0 + s) * 512 + h * 128 + d] = f2bf(q * 0.08838834764831845f * eb);
            ki[(size_t)(tok0 + s) * 512 + h * 128 + d] = f2bf(k * ieb);
            *(LAS unsigned short*)(ket + d * 144 + s * 2) = f2bf(k * (etot * ieb)); }
        if (sg == 0) dl[(size_t)(bh * 64 + c) * 128 + d] = etot;
        __syncthreads();
        a_f32x16 acc[4];
#pragma unroll
        for (int dt = 0; dt < 4; ++dt)
#pragma unroll
            for (int i = 0; i < 16; ++i) acc[dt][i] = 0.f;
#pragma unroll
        for (int ks = 0; ks < 4; ++ks) {
            a_bf16x8 bfr[4];
#pragma unroll
            for (int dt = 0; dt < 4; ++dt) bfr[dt] = *(const LAS a_bf16x8*)(ket + (32 * dt + r) * 144 + (16 * ks + 8 * hh) * 2);
            __builtin_amdgcn_sched_barrier(0);
#pragma unroll
            for (int dt = 0; dt < 4; ++dt) acc[dt] = __builtin_amdgcn_mfma_f32_32x32x16_bf16(bfr[dt], vfr[ks], acc[dt], 0, 0, 0); }
        unsigned short* urow = UT + (size_t)(bh * 64 + c) * 256 * 128 + (size_t)(32 * wid + r) * 128 + 8 * hh;
#pragma unroll
        for (int dt = 0; dt < 4; ++dt)
#pragma unroll
            for (int c2 = 0; c2 < 4; c2 += 2) {
                const unsigned ax = pack_bf16_v(acc[dt][4 * c2], acc[dt][4 * c2 + 1]), ay = pack_bf16_v(acc[dt][4 * c2 + 2], acc[dt][4 * c2 + 3]);
                const unsigned bx = pack_bf16_v(acc[dt][4 * c2 + 4], acc[dt][4 * c2 + 5]), by = pack_bf16_v(acc[dt][4 * c2 + 6], acc[dt][4 * c2 + 7]);
                const auto rx = __builtin_amdgcn_permlane32_swap(ax, bx, false, false); const auto ry = __builtin_amdgcn_permlane32_swap(ay, by, false, false);
                *(uint4*)(urow + 32 * dt + 8 * c2) = make_uint4(rx[0], ry[0], rx[1], ry[1]); }
        __syncthreads();
    }
}
__device__ __forceinline__ void ph_gla_p2(const unsigned short* __restrict__ UT, const float* __restrict__ dl, unsigned short* __restrict__ ST) {
    LAUNDER();
#define GP2_LOAD(uu, dv, c0) do { _Pragma("unroll") for (int k_ = 0; k_ < 8; ++k_) { const size_t o_ = ((size_t)(bh * 64 + (c0) + k_) * 256 + e) * 128 + d4; \
        uu[k_] = *(const uint2*)(UT + o_); dv[k_] = *(const float4*)(dl + (size_t)(bh * 64 + (c0) + k_) * 128 + d4); } } while (0)
#define GP2_STEP(uu, dv, c0) do { _Pragma("unroll") for (int k_ = 0; k_ < 8; ++k_) { const size_t o_ = ((size_t)(bh * 64 + (c0) + k_) * 256 + e) * 128 + d4; \
        *(uint2*)(ST + o_) = make_uint2(pack_bf16(S.x, S.y), pack_bf16(S.z, S.w)); \
        S.x = S.x * dv[k_].x + bf2f((unsigned short)(uu[k_].x & 0xffff)); S.y = S.y * dv[k_].y + bf2f((unsigned short)(uu[k_].x >> 16)); \
        S.z = S.z * dv[k_].z + bf2f((unsigned short)(uu[k_].y & 0xffff)); S.w = S.w * dv[k_].w + bf2f((unsigned short)(uu[k_].y >> 16)); } } while (0)
    for (int idx = GTID; idx < 32 * 256 * 32; idx += GSZ) {
        const int bh = idx >> 13, rem = idx & 8191, e = rem >> 5, d4 = (rem & 31) * 4;
        float4 S = make_float4(0.f, 0.f, 0.f, 0.f);
        uint2 ua[8], ub[8]; float4 da[8], db[8];
        GP2_LOAD(ua, da, 0);
#pragma unroll 1
        for (int c0 = 0; c0 < 64; c0 += 16) {
            GP2_LOAD(ub, db, c0 + 8);
            GP2_STEP(ua, da, c0);
            if (c0 + 16 < 64) GP2_LOAD(ua, da, c0 + 16);
            GP2_STEP(ub, db, c0 + 8);
        }
    }
#undef GP2_LOAD
#undef GP2_STEP
}
__device__ __forceinline__ void ph_gla_p3(const unsigned short* qd, const unsigned short* ki, const unsigned short* vT, const unsigned short* ST, const unsigned short* rb,
                                          const float* ng, unsigned short* ob, LAS unsigned char* lds) {
    LAUNDER();
    const int wid = wv_s, lane = tid_ & 63, r = lane & 31, hh = lane >> 5;
    constexpr int PQ = 272;
    LAS unsigned char* QS = lds; LAS unsigned char* KS = lds + 64 * PQ; LAS float* SSQ = (LAS float*)(lds + 2 * 64 * PQ);
    LAS float* NGL = SSQ + 512;
    if (tid_ < 256) *(LAS g8::f32x4*)(NGL + tid_ * 4) = *(const g8::f32x4*)(ng + tid_ * 4);
    au32x4 qpre[2], kpre[2];
    if (bid_ < 2048) { const int h = bid_ & 3, c = (bid_ >> 2) & 63, b = bid_ >> 8, tok0 = b * SEQ + c * 64; const int row = tid_ >> 3, ch = tid_ & 7;
#pragma unroll
        for (int j = 0; j < 2; ++j) { qpre[j] = *(const au32x4*)(qd + (size_t)(tok0 + row) * 512 + h * 128 + (ch + 8 * j) * 8); kpre[j] = *(const au32x4*)(ki + (size_t)(tok0 + row) * 512 + h * 128 + (ch + 8 * j) * 8); } }
    for (int it = bid_; it < 2048; it += nb_s) {
        const int h = it & 3, c = (it >> 2) & 63, b = it >> 8, bh = b * 4 + h, tok0 = b * SEQ + c * 64;
        a_bf16x8 sf[8]; au32x2 vlo[3][2], vhi[3][2];
        uint2 rgp[2][4];
#pragma unroll
        for (int qt = 0; qt < 2; ++qt)
#pragma unroll
            for (int c4 = 0; c4 < 4; ++c4) rgp[qt][c4] = *(const uint2*)(rb + (size_t)(tok0 + 32 * qt + r) * 1024 + h * 256 + 32 * wid + 8 * c4 + 4 * hh);
        { const unsigned short* srow = ST + ((size_t)(bh * 64 + c) * 256 + 32 * wid + r) * 128;
          const unsigned short* vrow = vT + ((size_t)bh * 256 + 32 * wid + r) * SEQ + c * 64;
#pragma unroll
          for (int ks = 0; ks < 8; ++ks) sf[ks] = *(const a_bf16x8*)(srow + 16 * ks + 8 * hh);
#pragma unroll
          for (int t3 = 0; t3 < 3; ++t3) { const int st = t3 == 2 ? 1 : 0;
#pragma unroll
              for (int s2 = 0; s2 < 2; ++s2) { vlo[t3][s2] = *(const au32x2*)(vrow + 32 * st + 16 * s2 + 4 * hh); vhi[t3][s2] = *(const au32x2*)(vrow + 32 * st + 16 * s2 + 4 * hh + 8); } } }
        { const int row = tid_ >> 3, ch = tid_ & 7;
#pragma unroll
          for (int j = 0; j < 2; ++j) { *(LAS au32x4*)(QS + row * PQ + (ch + 8 * j) * 16) = qpre[j]; *(LAS au32x4*)(KS + row * PQ + (ch + 8 * j) * 16) = kpre[j]; }
          const int itn = it + nb_s;
          if (itn < 2048) { const int hn = itn & 3, cn = (itn >> 2) & 63, bn = itn >> 8, tokn = bn * SEQ + cn * 64;
#pragma unroll
              for (int j = 0; j < 2; ++j) { qpre[j] = *(const au32x4*)(qd + (size_t)(tokn + row) * 512 + hn * 128 + (ch + 8 * j) * 8); kpre[j] = *(const au32x4*)(ki + (size_t)(tokn + row) * 512 + hn * 128 + (ch + 8 * j) * 8); } } }
        __syncthreads();
        a_bf16x8 qfr[2][8];
#pragma unroll
        for (int qt = 0; qt < 2; ++qt)
#pragma unroll
            for (int ks = 0; ks < 8; ++ks) qfr[qt][ks] = *(const LAS a_bf16x8*)(QS + (32 * qt + r) * PQ + (16 * ks + 8 * hh) * 2);
        a_f32x16 att[3];
#pragma unroll
        for (int st = 0; st < 2; ++st) {
            a_bf16x8 kfr[8];
#pragma unroll
            for (int ks = 0; ks < 8; ++ks) kfr[ks] = *(const LAS a_bf16x8*)(KS + (32 * st + r) * PQ + (16 * ks + 8 * hh) * 2);
            __builtin_amdgcn_sched_barrier(0);
            if (st == 0) {
                a_f32x16 a0, a1;
#pragma unroll
                for (int i = 0; i < 16; ++i) { a0[i] = 0.f; a1[i] = 0.f; }
#pragma unroll
                for (int ks = 0; ks < 8; ++ks) { a0 = __builtin_amdgcn_mfma_f32_32x32x16_bf16(kfr[ks], qfr[0][ks], a0, 0, 0, 0); a1 = __builtin_amdgcn_mfma_f32_32x32x16_bf16(kfr[ks], qfr[1][ks], a1, 0, 0, 0); }
#pragma unroll
                for (int i = 0; i < 16; ++i) a0[i] = (AT_REGOFF(i) + 4 * hh <= r) ? a0[i] : 0.f;
                att[0] = a0; att[1] = a1;
            } else {
                a_f32x16 a2;
#pragma unroll
                for (int i = 0; i < 16; ++i) a2[i] = 0.f;
#pragma unroll
                for (int ks = 0; ks < 8; ++ks) a2 = __builtin_amdgcn_mfma_f32_32x32x16_bf16(kfr[ks], qfr[1][ks], a2, 0, 0, 0);
#pragma unroll
                for (int i = 0; i < 16; ++i) a2[i] = (AT_REGOFF(i) + 4 * hh <= r) ? a2[i] : 0.f;
                att[2] = a2;
            }
        }
        a_f32x16 O[2];
#pragma unroll
        for (int qt = 0; qt < 2; ++qt)
#pragma unroll
            for (int i = 0; i < 16; ++i) O[qt][i] = 0.f;
#pragma unroll
        for (int ks = 0; ks < 8; ++ks) {
            O[0] = __builtin_amdgcn_mfma_f32_32x32x16_bf16(sf[ks], qfr[0][ks], O[0], 0, 0, 0);
            O[1] = __builtin_amdgcn_mfma_f32_32x32x16_bf16(sf[ks], qfr[1][ks], O[1], 0, 0, 0); }
#pragma unroll
        for (int t3 = 0; t3 < 3; ++t3) { const int qt = t3 == 0 ? 0 : 1;
#pragma unroll
            for (int s2 = 0; s2 < 2; ++s2) {
                au32x4 pw = {pack_bf16(att[t3][8 * s2 + 0], att[t3][8 * s2 + 1]), pack_bf16(att[t3][8 * s2 + 2], att[t3][8 * s2 + 3]), pack_bf16(att[t3][8 * s2 + 4], att[t3][8 * s2 + 5]), pack_bf16(att[t3][8 * s2 + 6], att[t3][8 * s2 + 7])};
                au32x4 aw = {vlo[t3][s2].x, vlo[t3][s2].y, vhi[t3][s2].x, vhi[t3][s2].y};
                O[qt] = __builtin_amdgcn_mfma_f32_32x32x16_bf16(*reinterpret_cast<a_bf16x8*>(&aw), *reinterpret_cast<a_bf16x8*>(&pw), O[qt], 0, 0, 0); } }
#pragma unroll
        for (int qt = 0; qt < 2; ++qt) { float ss = 0.f;
#pragma unroll
            for (int i = 0; i < 16; ++i) ss += O[qt][i] * O[qt][i];
            ss = xhalf_sum(ss); if (hh == 0) SSQ[wid * 64 + 32 * qt + r] = ss; }
        __syncthreads();
#pragma unroll
        for (int qt = 0; qt < 2; ++qt) { float tot = 0.f;
#pragma unroll
            for (int w = 0; w < 8; ++w) tot += SSQ[w * 64 + 32 * qt + r];
            const float rn = rsqrtf(tot * (1.f / 256.f) + 1e-5f);
            const size_t orow = (size_t)(tok0 + 32 * qt + r) * 1024 + h * 256;
            unsigned pk[4][2];
#pragma unroll
            for (int c4 = 0; c4 < 4; ++c4) { const int e0 = 32 * wid + 8 * c4 + 4 * hh;
                const uint2 rg = rgp[qt][c4]; const g8::f32x4 gq = *(const LAS g8::f32x4*)(NGL + h * 256 + e0); const float4 gv = make_float4(gq[0], gq[1], gq[2], gq[3]);
                const float r0 = bf2f((unsigned short)(rg.x & 0xffff)), r1 = bf2f((unsigned short)(rg.x >> 16)), r2 = bf2f((unsigned short)(rg.y & 0xffff)), r3 = bf2f((unsigned short)(rg.y >> 16));
                pk[c4][0] = pack_bf16(O[qt][4 * c4] * rn * gv.x * fast_silu(r0), O[qt][4 * c4 + 1] * rn * gv.y * fast_silu(r1));
                pk[c4][1] = pack_bf16(O[qt][4 * c4 + 2] * rn * gv.z * fast_silu(r2), O[qt][4 * c4 + 3] * rn * gv.w * fast_silu(r3)); }
#pragma unroll
            for (int c4 = 0; c4 < 4; c4 += 2) {
                const auto rx = __builtin_amdgcn_permlane32_swap(pk[c4][0], pk[c4 + 1][0], false, false); const auto ry = __builtin_amdgcn_permlane32_swap(pk[c4][1], pk[c4 + 1][1], false, false);
                *(uint4*)(ob + orow + 32 * wid + 8 * c4 + 8 * hh) = make_uint4(rx[0], ry[0], rx[1], ry[1]); } }
        __syncthreads();
    }
}
__device__ __forceinline__ void ph_norm_router(const unsigned short* x, const float* g, const float* shift, const float* scale, int ldmod, unsigned short* hb,
                                               const float* rw, const float* rbias, int* topi, float* topw, int* cntb, int* stok, LAS unsigned char* lds) {
    LAUNDER();
    const int wid = wv_s, lane = tid_ & 63, e = lane & 31, kh = lane >> 5;
    LAS float* hs = (LAS float*)lds;
    constexpr int HSP = 1028;
    LAS float* part = (LAS float*)(lds + 16 * HSP * 4);
    LAS int* hist = (LAS int*)(lds + 16 * HSP * 4 + 16384);
    for (int i = GTID; i < CAP; i += GSZ) stok[i] = -1;
    g8::bf16x8 wh[4][2], wl[4][2];
#pragma unroll
    for (int ks = 0; ks < 4; ++ks)
#pragma unroll
        for (int nt = 0; nt < 2; ++nt) {
            unsigned hw[4], lw[4];
#pragma unroll
            for (int j2 = 0; j2 < 4; ++j2) { float w0 = rw[(128 * wid + 32 * ks + 8 * (lane >> 4) + 2 * j2) * 32 + 16 * nt + (lane & 15)], w1 = rw[(128 * wid + 32 * ks + 8 * (lane >> 4) + 2 * j2 + 1) * 32 + 16 * nt + (lane & 15)];
                const unsigned hp2 = pack_bf16(w0, w1); hw[j2] = hp2;
                lw[j2] = pack_bf16(w0 - __uint_as_float(hp2 << 16), w1 - __uint_as_float(hp2 & 0xffff0000u)); }
            au32x4 hv = {hw[0], hw[1], hw[2], hw[3]}, lv = {lw[0], lw[1], lw[2], lw[3]};
            wh[ks][nt] = *reinterpret_cast<g8::bf16x8*>(&hv); wl[ks][nt] = *reinterpret_cast<g8::bf16x8*>(&lv); }
    const float rbv = rbias[e];
    if (tid_ < 32) hist[tid_] = 0;
    __syncthreads();
    uint2 xr[2][4];
    float4 gg4[4], scn[4], shn[4];
#pragma unroll
    for (int j = 0; j < 4; ++j) gg4[j] = *(const float4*)(g + j * 256 + lane * 4);
    if (bid_ < NT / 16) {
#pragma unroll
        for (int rr = 0; rr < 2; ++rr)
#pragma unroll
            for (int j = 0; j < 4; ++j) xr[rr][j] = *(const uint2*)(x + (size_t)(bid_ * 16 + wid * 2 + rr) * DM + j * 256 + lane * 4);
        const int b0 = bid_ * 16 / SEQ;
#pragma unroll
        for (int j = 0; j < 4; ++j) { scn[j] = *(const float4*)(scale + b0 * ldmod + j * 256 + lane * 4); shn[j] = *(const float4*)(shift + b0 * ldmod + j * 256 + lane * 4); }
    }
    for (int tile = bid_; tile < NT / 16; tile += nb_s) {
        float4 ga4[4], sh4[4];
#pragma unroll
        for (int j = 0; j < 4; ++j) { ga4[j] = make_float4(gg4[j].x * (1.f + scn[j].x), gg4[j].y * (1.f + scn[j].y), gg4[j].z * (1.f + scn[j].z), gg4[j].w * (1.f + scn[j].w)); sh4[j] = shn[j]; }
#pragma unroll
        for (int rr = 0; rr < 2; ++rr) {
            const int trow = wid * 2 + rr, row = tile * 16 + trow;
            float4 v[4]; float ss = 0.f;
#pragma unroll
            for (int j = 0; j < 4; ++j) { const uint2 u = xr[rr][j]; v[j] = make_float4(__uint_as_float(u.x << 16), __uint_as_float(u.x & 0xffff0000u), __uint_as_float(u.y << 16), __uint_as_float(u.y & 0xffff0000u)); ss += v[j].x * v[j].x + v[j].y * v[j].y + v[j].z * v[j].z + v[j].w * v[j].w; }
#pragma unroll
            for (int o = 32; o > 0; o >>= 1) ss += SHX(ss, o);
            const float rn = rsqrtf(ss * (1.f / DM) + 1e-5f);
#pragma unroll
            for (int j = 0; j < 4; ++j) { const int col = j * 256 + lane * 4;
                float4 y;
                y.x = v[j].x * rn * ga4[j].x + sh4[j].x; y.y = v[j].y * rn * ga4[j].y + sh4[j].y; y.z = v[j].z * rn * ga4[j].z + sh4[j].z; y.w = v[j].w * rn * ga4[j].w + sh4[j].w;
                *(uint2*)(hb + (size_t)row * DM + col) = make_uint2(pack_bf16(y.x, y.y), pack_bf16(y.z, y.w));
                *(LAS g8::f32x4*)(hs + trow * HSP + col) = (g8::f32x4){y.x, y.y, y.z, y.w}; }
        }
        if (tile + nb_s < NT / 16) {
#pragma unroll
            for (int rr = 0; rr < 2; ++rr)
#pragma unroll
                for (int j = 0; j < 4; ++j) xr[rr][j] = *(const uint2*)(x + (size_t)((tile + nb_s) * 16 + wid * 2 + rr) * DM + j * 256 + lane * 4);
            const int bn = (tile + nb_s) * 16 / SEQ;
#pragma unroll
            for (int j = 0; j < 4; ++j) { scn[j] = *(const float4*)(scale + bn * ldmod + j * 256 + lane * 4); shn[j] = *(const float4*)(shift + bn * ldmod + j * 256 + lane * 4); }
        }
        __syncthreads();
        {
            g8::f32x4 acc0 = {0.f, 0.f, 0.f, 0.f}, acc1 = {0.f, 0.f, 0.f, 0.f};
            const LAS float* hp_ = hs + (lane & 15) * HSP + 128 * wid + 8 * (lane >> 4);
#pragma unroll
            for (int ks = 0; ks < 4; ++ks) {
                const g8::f32x4 x0 = *(const LAS g8::f32x4*)(hp_ + 32 * ks), x1 = *(const LAS g8::f32x4*)(hp_ + 32 * ks + 4);
                unsigned hh_[4], ll_[4];
                { unsigned p;
                  p = pack_bf16(x0[0], x0[1]); hh_[0] = p; ll_[0] = pack_bf16(x0[0] - __uint_as_float(p << 16), x0[1] - __uint_as_float(p & 0xffff0000u));
                  p = pack_bf16(x0[2], x0[3]); hh_[1] = p; ll_[1] = pack_bf16(x0[2] - __uint_as_float(p << 16), x0[3] - __uint_as_float(p & 0xffff0000u));
                  p = pack_bf16(x1[0], x1[1]); hh_[2] = p; ll_[2] = pack_bf16(x1[0] - __uint_as_float(p << 16), x1[1] - __uint_as_float(p & 0xffff0000u));
                  p = pack_bf16(x1[2], x1[3]); hh_[3] = p; ll_[3] = pack_bf16(x1[2] - __uint_as_float(p << 16), x1[3] - __uint_as_float(p & 0xffff0000u)); }
                au32x4 hv = {hh_[0], hh_[1], hh_[2], hh_[3]}, lv = {ll_[0], ll_[1], ll_[2], ll_[3]};
                const g8::bf16x8 ah = *reinterpret_cast<g8::bf16x8*>(&hv), al = *reinterpret_cast<g8::bf16x8*>(&lv);
                acc0 = __builtin_amdgcn_mfma_f32_16x16x32_bf16(ah, wh[ks][0], acc0, 0, 0, 0); acc1 = __builtin_amdgcn_mfma_f32_16x16x32_bf16(ah, wh[ks][1], acc1, 0, 0, 0);
                acc0 = __builtin_amdgcn_mfma_f32_16x16x32_bf16(ah, wl[ks][0], acc0, 0, 0, 0); acc1 = __builtin_amdgcn_mfma_f32_16x16x32_bf16(ah, wl[ks][1], acc1, 0, 0, 0);
                acc0 = __builtin_amdgcn_mfma_f32_16x16x32_bf16(al, wh[ks][0], acc0, 0, 0, 0); acc1 = __builtin_amdgcn_mfma_f32_16x16x32_bf16(al, wh[ks][1], acc1, 0, 0, 0);
            }
#pragma unroll
            for (int rg = 0; rg < 4; ++rg) { part[(wid * 16 + 4 * (lane >> 4) + rg) * 32 + (lane & 15)] = acc0[rg]; part[(wid * 16 + 4 * (lane >> 4) + rg) * 32 + 16 + (lane & 15)] = acc1[rg]; }
        }
        __syncthreads();
#pragma unroll
        for (int rr = 0; rr < 2; ++rr) {
            const int t = wid * 2 + rr, row = tile * 16 + t;
            float v = rbv;
#pragma unroll
            for (int w = 0; w < 8; ++w) v += part[(w * 16 + t) * 32 + e];
            int rank = 0;
#pragma unroll
            for (int e2 = 0; e2 < 32; ++e2) { const float ve = __uint_as_float(__builtin_amdgcn_readlane(__float_as_uint(v), e2)); rank += (ve > v || (ve == v && e2 < e)) ? 1 : 0; }
            float tv[4]; int ti[4];
#pragma unroll
            for (int r4 = 0; r4 < 4; ++r4) { const unsigned m = (unsigned)__ballot(rank == r4); const int lr = __builtin_ctz(m); ti[r4] = lr; tv[r4] = __uint_as_float(__builtin_amdgcn_readlane(__float_as_uint(v), lr)); }
            float w4[4], s = 0.f;
#pragma unroll
            for (int r4 = 0; r4 < 4; ++r4) { w4[r4] = expf(tv[r4] - tv[0]); s += w4[r4]; }
            if (lane == 0) {
                *(int4*)(topi + row * 4) = make_int4(ti[0], ti[1], ti[2], ti[3]);
                *(float4*)(topw + row * 4) = make_float4(w4[0] / s, w4[1] / s, w4[2] / s, w4[3] / s);
#pragma unroll
                for (int r4 = 0; r4 < 4; ++r4) (void)__hip_atomic_fetch_add(hist + ti[r4], 1, __ATOMIC_RELAXED, __HIP_MEMORY_SCOPE_WORKGROUP);
            }
        }
    }
    __syncthreads();
    if (tid_ < 32) cntb[bid_ * 32 + tid_] = hist[tid_];
}
__device__ __forceinline__ void ph_assign2(const int* topi, const int* cntb, int* cnt, int* stok, int* pos, int* tile_e, LAS unsigned char* lds) {
    LAUNDER();
    LAS int* ptot = (LAS int*)lds;
    LAS int* ppre = ptot + 512;
    LAS int* base = ppre + 512;
    LAS int* cur = base + 32;
    { const int e = tid_ & 31, ch = tid_ >> 5; int tot = 0, pre = 0;
      for (int j = 0; j < 16; ++j) { const int bb = ch * 16 + j; if (bb < nb_s) { const int v = cntb[bb * 32 + e]; tot += v; pre += bb < bid_ ? v : 0; } }
      ptot[ch * 32 + e] = tot; ppre[ch * 32 + e] = pre; }
    __syncthreads();
    if (tid_ < 32) { int tot = 0, pre = 0;
        for (int ch = 0; ch < 16; ++ch) { tot += ptot[ch * 32 + tid_]; pre += ppre[ch * 32 + tid_]; }
        ptot[tid_] = tot; ppre[tid_] = pre; cur[tid_] = 0; }
    __syncthreads();
    if (tid_ == 0) { int s = 0;
        for (int e = 0; e < NE; ++e) { base[e] = s + ppre[e]; const int p = (ptot[e] + MPAD - 1) / MPAD * MPAD;
            if (bid_ == 0) for (int tl = s / MPAD; tl < (s + p) / MPAD; ++tl) tile_e[tl] = e;
            s += p; }
        if (bid_ == 0) cnt[64 + NE] = s; }
    __syncthreads();
    if (tid_ < 64) {
        for (int t0 = bid_; t0 < NT / 16; t0 += 8 * nb_s) {
            int ev[8];
#pragma unroll
            for (int k = 0; k < 8; ++k) { const int tile = t0 + k * nb_s; ev[k] = tile < NT / 16 ? topi[tile * 64 + tid_] : -1; }
#pragma unroll
            for (int k = 0; k < 8; ++k) { const int tile = t0 + k * nb_s;
                if (ev[k] >= 0) { const int i = tile * 64 + tid_;
                    const int p = base[ev[k]] + __hip_atomic_fetch_add(cur + ev[k], 1, __ATOMIC_RELAXED, __HIP_MEMORY_SCOPE_WORKGROUP);
                    stok[p] = i >> 2; pos[i] = p; } }
        }
    }
}
__device__ __forceinline__ void ph_combine_norm(unsigned short* x, const unsigned short* y, const int* pos, const float* topw, const float* gate, int ldg,
                                                const float* g1, const float* sh1, const float* sc1, int ld1, unsigned short* hb,
                                                const float* gk, const float* shk, const float* sck, int ldk, unsigned short* hb2,
                                                const float* gfin, float* out, int* cnt, LAS unsigned char* lds) {
    LAUNDER();
    const int lane = tid_ & 63;
    if (GTID < 128) cnt[GTID] = 0;
    LAS float* KA = (LAS float*)lds; LAS float* KH = KA + 8 * DM;
    if (gk) {
        for (int i = tid_; i < 8 * DM / 4; i += NTHR) { const int bb = i >> 8, c4 = (i & 255) * 4;
            const float4 gg = *(const float4*)(gk + c4), sc = *(const float4*)(sck + bb * ldk + c4), sh = *(const float4*)(shk + bb * ldk + c4);
            *(LAS g8::f32x4*)(KA + bb * DM + c4) = (g8::f32x4){gg.x * (1.f + sc.x), gg.y * (1.f + sc.y), gg.z * (1.f + sc.z), gg.w * (1.f + sc.w)};
            *(LAS g8::f32x4*)(KH + bb * DM + c4) = (g8::f32x4){sh.x, sh.y, sh.z, sh.w}; }
        __syncthreads();
    }
    float4 g1v[4];
#pragma unroll
    for (int j = 0; j < 4; ++j) { g1v[j] = make_float4(0.f, 0.f, 0.f, 0.f); if (!gfin) g1v[j] = *(const float4*)(g1 + j * 256 + lane * 4); }
    int4 psn[2]; float4 twn[2];
    { const int r0 = (GTID >> 6) * 2;
#pragma unroll
      for (int q = 0; q < 2; ++q) { psn[q] = *(const int4*)(pos + (r0 + q) * 4); twn[q] = *(const float4*)(topw + (r0 + q) * 4); } }
    for (int row0 = (GTID >> 6) * 2; row0 < NT; row0 += (GSZ >> 6) * 2) {
        int4 ps[2]; float4 tw[2];
#pragma unroll
        for (int q = 0; q < 2; ++q) { ps[q] = psn[q]; tw[q] = twn[q]; }
        { const int rn_ = row0 + (GSZ >> 6) * 2;
          if (rn_ < NT) {
#pragma unroll
              for (int q = 0; q < 2; ++q) { psn[q] = *(const int4*)(pos + (rn_ + q) * 4); twn[q] = *(const float4*)(topw + (rn_ + q) * 4); } } }
        const int bq = row0 / SEQ;
        float4 gpv[4], s1v[4], h1v[4];
        uint2 yv[2][4][4], xu[2][4];
#pragma unroll
        for (int q = 0; q < 2; ++q)
#pragma unroll
            for (int j = 0; j < 4; ++j) { const int col = j * 256 + lane * 4;
                yv[q][0][j] = *(const uint2*)(y + (size_t)ps[q].x * DM + col); yv[q][1][j] = *(const uint2*)(y + (size_t)ps[q].y * DM + col);
                yv[q][2][j] = *(const uint2*)(y + (size_t)ps[q].z * DM + col); yv[q][3][j] = *(const uint2*)(y + (size_t)ps[q].w * DM + col);
                xu[q][j] = *(const uint2*)(x + (size_t)(row0 + q) * DM + col); }
#pragma unroll
        for (int j = 0; j < 4; ++j) { const int col = j * 256 + lane * 4;
            gpv[j] = *(const float4*)(gate + bq * ldg + col);
            s1v[j] = make_float4(0.f, 0.f, 0.f, 0.f); h1v[j] = s1v[j];
            if (!gfin) { s1v[j] = *(const float4*)(sc1 + bq * ld1 + col); h1v[j] = *(const float4*)(sh1 + bq * ld1 + col); }
            }
#pragma unroll
        for (int q = 0; q < 2; ++q) {
            const int row = row0 + q, b = row / SEQ;
            const float w4[4] = {tw[q].x, tw[q].y, tw[q].z, tw[q].w};
            float4 xn[4]; float ss = 0.f;
#pragma unroll
            for (int j = 0; j < 4; ++j) { const int col = j * 256 + lane * 4;
                float a0 = 0.f, a1 = 0.f, a2 = 0.f, a3 = 0.f;
#pragma unroll
                for (int r4 = 0; r4 < 4; ++r4) { const uint2 u = yv[q][r4][j]; const float w = w4[r4];
                    a0 += w * __uint_as_float(u.x << 16); a1 += w * __uint_as_float(u.x & 0xffff0000u); a2 += w * __uint_as_float(u.y << 16); a3 += w * __uint_as_float(u.y & 0xffff0000u); }
                const uint2 u = xu[q][j]; float4 xv = make_float4(__uint_as_float(u.x << 16), __uint_as_float(u.x & 0xffff0000u), __uint_as_float(u.y << 16), __uint_as_float(u.y & 0xffff0000u));
                const float4 gp = gpv[j];
                xv.x += gp.x * a0; xv.y += gp.y * a1; xv.z += gp.z * a2; xv.w += gp.w * a3;
                if (!gfin) *(uint2*)(x + (size_t)row * DM + col) = make_uint2(pack_bf16(xv.x, xv.y), pack_bf16(xv.z, xv.w));
                xn[j] = xv; ss += xv.x * xv.x + xv.y * xv.y + xv.z * xv.z + xv.w * xv.w; }
#pragma unroll
            for (int o = 32; o > 0; o >>= 1) ss += SHX(ss, o);
            const float rn = rsqrtf(ss * (1.f / DM) + 1e-5f);
#pragma unroll
            for (int j = 0; j < 4; ++j) { const int col = j * 256 + lane * 4;
                if (gfin) { const float4 gg = *(const float4*)(gfin + col); *(float4*)(out + (size_t)row * DM + col) = make_float4(xn[j].x * rn * gg.x, xn[j].y * rn * gg.y, xn[j].z * rn * gg.z, xn[j].w * rn * gg.w); }
                else {
                    { const float4 gg = g1v[j], sc = s1v[j], sh = h1v[j];
                      *(uint2*)(hb + (size_t)row * DM + col) = make_uint2(pack_bf16(xn[j].x * rn * gg.x * (1.f + sc.x) + sh.x, xn[j].y * rn * gg.y * (1.f + sc.y) + sh.y),
                                                                         pack_bf16(xn[j].z * rn * gg.z * (1.f + sc.z) + sh.z, xn[j].w * rn * gg.w * (1.f + sc.w) + sh.w)); }
                    if (gk) { const g8::f32x4 ga = *(const LAS g8::f32x4*)(KA + b * DM + col), sh = *(const LAS g8::f32x4*)(KH + b * DM + col);
                      *(uint2*)(hb2 + (size_t)row * DM + col) = make_uint2(pack_bf16(xn[j].x * rn * ga[0] + sh[0], xn[j].y * rn * ga[1] + sh[1]),
                                                                          pack_bf16(xn[j].z * rn * ga[2] + sh[2], xn[j].w * rn * ga[3] + sh[3])); }
                }
            }
        }
    }
}
#define PHASE(name, ...) __device__ __forceinline__ void name(KP kp, const int L) { asm volatile("" : "+s"(kp)); const P __attribute__((address_space(4)))& p = *kp; float* sm = dyn_smem(); (void)sm; \
    LAS unsigned char* lds = (LAS unsigned char*)dyn_smem(); (void)lds; (void)L; const float* md = p.mod + (size_t)L * 8 * 6144; (void)md;  __VA_ARGS__ }
#define ORDER(S, nM, nN) S.init(nM, nN, nb_s, (int)blockIdx.x)
#define ORDERW(S, nM, nN, W) S.init(nM, nN, nb_s, (int)blockIdx.x, W)

PHASE(f_prologue,
      ph_convT(p.gla_w_in, p.wt_gla_in, 1024, GLA_IN, 3328, 2, sm);
      ph_convT(p.gla_w_out, p.wt_gla_out, 1024, 1024, 1024, 2, sm);
      ph_convT(p.kv_w, p.wt_kv, 1024, KV_OUT, KV_OUT, 1, sm);
      ph_convT(p.nsa_w_in, p.wt_nsa_in, 1024, NSA_IN, 1280, 2, sm);
      ph_convT(p.nsa_w_out, p.wt_nsa_out, 1024, 1024, 1024, 2, sm);
      ph_convT(p.cmp_w1, p.wt_cmp1, 2048, 128, 256, 2, sm);
      ph_convT(p.moe_w_gu, p.wt_gu, 1024, 2048, 2048, 4 * NE, sm);
      ph_convT<true>(p.moe_w_down, p.wt_down, 1024, 1024, 1024, 4 * NE, sm);
      ph_c1(p.cmp_pos, p.cmp_w1, p.cmp_b1, p.c1, sm);
      { LAUNDER(); if (GTID < 128) p.cnt[GTID] = 0; }
      ph_mod(p.c, p.ada_w, p.ada_b, p.kv_ada_w, p.kv_ada_b, p.mod, p.kvmod, sm);)
PHASE(f_norm1, ph_norm(p.x_in, p.norm1_g + L * DM, md + 0, md + 1024, (float*)nullptr, p.hb, 6144);)
PHASE(f_gla_in, ProbPlain<1024> S; ORDER(S, NT / 256, 13); S.A = (const char*)p.hb; S.Bt = (const char*)(p.wt_gla_in + (size_t)L * 3328 * 1024); S.lda = 2048;
      g8::gemm_phase(lds, S, g8::EpiPair<PGlaIn>{PGlaIn{p.gqk, p.gvT, p.grb, p.glr, lds + LDS_X_OFF}}, wv_s);)
PHASE(f_gla_gate, ph_gla_p1(p.gqk, p.glr, p.gvT, p.gla_w_gate2 + L * 16 * 512, p.gla_b_gate + L * 512, p.gqd, p.gki, p.gdl, p.gUT, lds);)
PHASE(f_gla_rec, ph_gla_p2(p.gUT, p.gdl, p.gST);)
PHASE(f_gla_post, ph_gla_p3(p.gqd, p.gki, p.gvT, p.gST, p.grb, p.gla_norm_g + L * DM, p.ob, lds);)
PHASE(f_gla_out, ProbPlain<1024> S; ORDER(S, NT / 256, 4); S.A = (const char*)p.ob; S.Bt = (const char*)(p.wt_gla_out + (size_t)L * 1024 * 1024); S.lda = 2048;
      if (L == 0) g8::gemm_phase(lds, S, EpiResid<true>{p.x_in, p.x, md + 2048, 6144}, wv_s);
      else g8::gemm_phase(lds, S, EpiResid<false>{p.x, p.x, md + 2048, 6144}, wv_s);)
PHASE(f_nsa_in, ProbPlain<1024> S; ORDER(S, NT / 256, 5); S.A = (const char*)p.hb; S.Bt = (const char*)(p.wt_nsa_in + (size_t)(L - 2) * 1280 * 1024); S.lda = 2048;
      g8::gemm_phase(lds, S, g8::EpiPair<PNsaIn>{PNsaIn{p.qb, p.gates, p.nsa_b_gate + (L - 2) * 48}}, wv_s);)
PHASE(f_nsa_attn, ph_nsa_attn_mfma(p.qb, p.gates, p.kcmp, p.vcmpT, p.kslc, p.vslcT, p.kwin, p.vwinT, p.ob, p.cnt + 112, lds);)
PHASE(f_nsa_out, ProbPlain<1024> S; ORDER(S, NT / 256, 4); S.A = (const char*)p.ob; S.Bt = (const char*)(p.wt_nsa_out + (size_t)(L - 2) * 1024 * 1024); S.lda = 2048;
      g8::gemm_phase(lds, S, EpiResid<false>{p.x, p.x, md + 2048, 6144}, wv_s);)
PHASE(f_out_probe, ProbPlain<1024> S; ORDER(S, NT / 256, 4); S.A = (const char*)p.ob; S.Bt = (const char*)(L < 2 ? p.wt_gla_out + (size_t)L * 1024 * 1024 : p.wt_nsa_out + (size_t)(L - 2) * 1024 * 1024); S.lda = 2048;
      g8::gemm_phase(lds, S, EpiResid<false>{p.x, p.act, md + 2048, 6144}, wv_s);)
PHASE(f_comb_probe, const float* mdn = p.mod + (size_t)(L < 3 ? L + 1 : L) * 8 * 6144;
      ph_combine_norm(p.act, p.y, p.pos, p.topw, md + 5120, 6144, p.norm1_g + (L < 3 ? L + 1 : L) * DM, mdn + 0, mdn + 1024, 6144, p.qb,
                      (const float*)nullptr, p.kvmod + 0, p.kvmod + 1024, 2048, p.qb, (const float*)nullptr, p.out, p.cnt + 256, lds);)
PHASE(f_norm2, ph_norm_router(p.x, p.norm2_g + L * DM, md + 3072, md + 4096, 6144, p.hb, p.router_w + (size_t)L * DM * 32, p.router_b + L * 32, p.topi, p.topw, p.cntb, p.stok, lds);)
PHASE(f_assign, ph_assign2(p.topi, p.cntb, p.cnt, p.stok, p.pos, p.tile_e, lds);)
PHASE(f_moe_gu, ProbMoe<1024, true> S; ORDER(S, p.cnt[64 + NE] / 256, 8); S.A = (const char*)p.hb; S.Bt = (const char*)(p.wt_gu + (size_t)L * NE * 2048 * 1024); S.tok = p.stok; S.tile_e = p.tile_e;
      S.bias = p.moe_b_gu + (size_t)L * NE * 2048; S.nbias = 2048; S.estride = (size_t)2048 * 1024 * 2; S.xl = lds + LDS_X_OFF;
      g8::gemm_phase(lds, S, EpiSwiglu{p.act, lds + LDS_X_OFF}, wv_s);)
PHASE(f_moe_down, ProbMoe<1024, false> S; ORDER(S, p.cnt[64 + NE] / 256, 4); S.A = (const char*)p.act; S.Bt = (const char*)(p.wt_down + (size_t)L * NE * 1024 * 1024); S.tok = p.stok; S.tile_e = p.tile_e;
      S.bias = p.moe_b_down + (size_t)L * NE * DM; S.nbias = 1024; S.estride = (size_t)1024 * 1024 * 2; S.xl = lds + LDS_X_OFF;
      g8::gemm_phase(lds, S, EpiDown{p.y, lds + LDS_X_OFF}, wv_s);)
PHASE(f_combine, const float* mdn = p.mod + (size_t)(L + 1) * 8 * 6144;
      ph_combine_norm(p.x, p.y, p.pos, p.topw, md + 5120, 6144, p.norm1_g + (L + 1) * DM, mdn + 0, mdn + 1024, 6144, p.hb,
                      L == 1 ? p.kv_norm_g : (const float*)nullptr, p.kvmod + 0, p.kvmod + 1024, 2048, p.ob, L == 3 ? p.final_g : (const float*)nullptr, p.out, p.cnt, lds);)
PHASE(f_kv_gemm, ProbPlain<1024> S; ORDER(S, NT / 256, 6); S.A = (const char*)p.ob; S.Bt = (const char*)p.wt_kv; S.lda = 2048;
      g8::gemm_phase(lds, S, g8::EpiPair<PKv>{PKv{p.csrc, p.kslc, p.vslcT, p.kwin, p.vwinT, lds + LDS_X_OFF}}, wv_s);)
PHASE(f_cmp1, ProbCmp S; ORDER(S, 256, 1); S.csrc = (const char*)p.csrc; S.W1t = (const char*)p.wt_cmp1;
      g8::gemm_phase(lds, S, g8::EpiQuad<QCmp1>{QCmp1{p.hid}}, wv_s);)
PHASE(f_cmp2, ph_gemm(AHid4{p.hid, p.c1}, BCmp{p.cmp_w2, 64, (size_t)128 * 64}, ECmp2b{p.kcmp, p.vcmpT, p.cmp_b2}, NCMP, 64, 128, 64, sm, nb_s >= 256 ? 128 : 0);)

#define BAR() xcd_barrier(bar, wv_s)
#ifndef REP_GEMM
#define REP_GEMM 1
#endif
#ifndef REP_ATTN
#define REP_ATTN 1
#endif
#ifndef REP_MOE
#define REP_MOE 1
#endif
#ifndef REP_GLA
#define REP_GLA 1
#endif
#ifndef REP_OUT
#define REP_OUT 1
#endif
#ifndef REP_N2
#define REP_N2 1
#endif
#ifndef REP_ASG
#define REP_ASG 1
#endif
#ifndef REP_COMB
#define REP_COMB 1
#endif
#ifndef REP_PRO
#define REP_PRO 1
#endif
#define REPEAT(n, ...) { __VA_ARGS__ } if ((n) > 1) { __VA_ARGS__ } if ((n) > 2) { __VA_ARGS__ }
template <int L> __device__ __forceinline__ void layer(KP kp, const XcdBarrier& bar) {
    if (L == 0) { f_norm1(kp, L); BAR(); }
    if (L < 2) {
        REPEAT(REP_GEMM, f_gla_in(kp, L); BAR();) REPEAT(REP_GLA, f_gla_gate(kp, L); BAR(); f_gla_rec(kp, L); BAR(); f_gla_post(kp, L); BAR();) f_gla_out(kp, L); BAR(); if (REP_OUT > 1) { f_out_probe(kp, L); BAR(); }
    } else {
        REPEAT(REP_GEMM, f_nsa_in(kp, L); if (L == 2) f_cmp2(kp, L); BAR();) REPEAT(REP_ATTN, f_nsa_attn(kp, L); BAR();) f_nsa_out(kp, L); BAR(); if (REP_OUT > 1) { f_out_probe(kp, L); BAR(); }
    }
    REPEAT(REP_N2, f_norm2(kp, L); BAR();) REPEAT(REP_ASG, f_assign(kp, L); BAR();)
    REPEAT(REP_MOE, f_moe_gu(kp, L); BAR(); f_moe_down(kp, L); BAR();) if (REP_COMB > 1) { f_comb_probe(kp, L); BAR(); } f_combine(kp, L); if (L < 3) BAR();
    if (L == 1) { REPEAT(REP_GEMM, f_kv_gemm(kp, L); BAR();) f_cmp1(kp, L); BAR(); }
}
};
__global__ __launch_bounds__(NTHR, 2) void mega(P p_unused) {
    KP kp = (KP)__builtin_amdgcn_kernarg_segment_ptr();
    float* smem = dyn_smem();
    unsigned* bw = (unsigned*)smem + LDS_BAR_OFF / 4;
    if (threadIdx.x == 0) { bw[0] = 0u; bw[1] = 0u; bw[2] = 0u; bw[3] = 0u; }
    __syncthreads();
    XcdBarrier bar = xcd_barrier_post(kp->bar, (volatile LAS unsigned*)bw);
    Ctx cx; cx.nb_s = (int)gridDim.x; cx.wv_s = __builtin_amdgcn_readfirstlane(threadIdx.x >> 6);
    REPEAT(REP_PRO, cx.f_prologue(kp, 0); xcd_barrier(bar, cx.wv_s);)
    cx.layer<0>(kp, bar); cx.layer<1>(kp, bar); cx.layer<2>(kp, bar); cx.layer<3>(kp, bar);
}
}

extern "C" void kernel_launch(void* const* d_in, const int* in_sizes, int n_in, void* d_out, int out_size, void* d_ws, size_t ws_size, hipStream_t stream) {
    P p{};
    const float** pin = (const float**)&p;
    for (int i = 0; i < 30; ++i) pin[i] = (const float*)d_in[i];
    p.out = (float*)d_out;
    char* wp = (char*)d_ws; size_t off = 0;
    auto alloc = [&](size_t bytes) { void* q = wp + off; off += (bytes + 255) & ~(size_t)255; return q; };
    p.bar = (unsigned*)alloc(XCD_BAR_WORDS * 4);
    p.mod = (float*)alloc((size_t)4 * 8 * 6144 * 4);
    p.kvmod = (float*)alloc((size_t)8 * 2048 * 4);
    p.c1 = (float*)alloc(256 * 4);
    p.x = (unsigned short*)alloc((size_t)NT * DM * 2);
    p.hid = (float*)alloc((size_t)4 * 64 * NCMP * 128 * 4);
    p.gates = (float*)alloc((size_t)NT * 48 * 4);
    p.topi = (int*)alloc((size_t)NT * 4 * 4);
    p.topw = (float*)alloc((size_t)NT * 4 * 4);
    p.cnt = (int*)alloc(512 * 4);
    p.cntb = (int*)alloc((size_t)1024 * 32 * 4);
    p.stok = (int*)alloc((size_t)CAP * 4);
    p.pos = (int*)alloc((size_t)NT * 4 * 4);
    p.tile_e = (int*)alloc((size_t)(CAP / MPAD) * 4);
    p.y = (unsigned short*)alloc((size_t)CAP * DM * 2);
    p.hb = (unsigned short*)alloc((size_t)NT * DM * 2);
    p.ob = (unsigned short*)alloc((size_t)NT * DM * 2);
    p.act = (unsigned short*)alloc((size_t)CAP * DM * 2);
    p.csrc = (unsigned short*)alloc((size_t)64 * SEQ * 64 * 2 + 8192);
    p.qb = (unsigned short*)alloc((size_t)NT * DM * 2);
    p.kslc = (unsigned short*)alloc((size_t)32 * SEQ * 64 * 2);
    p.vslcT = (unsigned short*)alloc((size_t)32 * SEQ * 64 * 2);
    p.kwin = (unsigned short*)alloc((size_t)32 * SEQ * 64 * 2);
    p.vwinT = (unsigned short*)alloc((size_t)32 * SEQ * 64 * 2);
    p.kcmp = (unsigned short*)alloc((size_t)32 * 256 * 64 * 2);
    p.vcmpT = (unsigned short*)alloc((size_t)32 * 256 * 64 * 2);
    p.gqk = (unsigned short*)alloc((size_t)NT * 1024 * 2);
    p.gvT = (unsigned short*)alloc((size_t)NT * 1024 * 2);
    p.grb = (unsigned short*)alloc((size_t)NT * 1024 * 2);
    p.gqd = (unsigned short*)alloc((size_t)NT * 512 * 2);
    p.gki = (unsigned short*)alloc((size_t)NT * 512 * 2);
    p.gST = (unsigned short*)alloc((size_t)32 * 64 * 256 * 128 * 2);
    p.glr = (float*)alloc((size_t)NT * 16 * 4);
    p.gdl = (float*)alloc((size_t)32 * 64 * 128 * 4);
    p.gUT = (unsigned short*)alloc((size_t)32 * 64 * 256 * 128 * 2);
    p.wt_gla_in = (unsigned short*)alloc((size_t)2 * 3328 * 1024 * 2);
    p.wt_gla_out = (unsigned short*)alloc((size_t)2 * 1024 * 1024 * 2);
    p.wt_kv = (unsigned short*)alloc((size_t)KV_OUT * 1024 * 2);
    p.wt_nsa_in = (unsigned short*)alloc((size_t)2 * 1280 * 1024 * 2);
    p.wt_nsa_out = (unsigned short*)alloc((size_t)2 * 1024 * 1024 * 2);
    p.wt_cmp1 = (unsigned short*)alloc((size_t)2 * 256 * 2048 * 2);
    p.wt_gu = (unsigned short*)alloc((size_t)4 * NE * 2048 * 1024 * 2);
    p.wt_down = (unsigned short*)alloc((size_t)4 * NE * 1024 * 1024 * 2);
    if (off > ws_size) return;

    static int grid = 0;
    if (!grid) {
        int dev = 0, cus = 0, per_cu = 0;
        (void)hipGetDevice(&dev);
        (void)hipDeviceGetAttribute(&cus, hipDeviceAttributeMultiprocessorCount, dev);
        (void)hipFuncSetAttribute((const void*)mega, hipFuncAttributeMaxDynamicSharedMemorySize, (int)kDynLds);
        (void)hipOccupancyMaxActiveBlocksPerMultiprocessor(&per_cu, mega, NTHR, kDynLds);
        if (per_cu < 1) per_cu = 1;
        grid = cus * 1;
    }
    (void)hipMemsetAsync(p.bar, 0, XCD_BAR_WORDS * sizeof(unsigned), stream);
    hipLaunchKernelGGL(mega, dim3(grid), dim3(NTHR), kDynLds, stream, p);
}
```
